# Optimizing an MI355X kernel written in HIP

```python
import jax, jax.numpy as jnp
from jax import lax
import numpy as np

D_MODEL = 2048
BATCH = 8
SEQ = 4096
DEPTH = 2

PLE_DIM = 256
N_HEADS = 16
KV_HEADS = 2
Q_PER_KV = N_HEADS // KV_HEADS
HEAD_DIM = 64
ATTN_WIDTH = N_HEADS * HEAD_DIM
KV_WIDTH = KV_HEADS * HEAD_DIM
WINDOW = 128
ATTN_BLOCK = 128
ROT_DIM = HEAD_DIM // 4
ROPE_THETA = 500000.0
HG_HEADS = 4
HG_HEAD_DIM = 128
HG_WIDTH = HG_HEADS * HG_HEAD_DIM
HG_CHUNK = 64
LRU_HEADS = 8
LRU_HEAD_DIM = 64
LRU_WIDTH = LRU_HEADS * LRU_HEAD_DIM
CONV_WIDTH = 4
LRU_C = 8.0
IN_SIZES = (ATTN_WIDTH, KV_WIDTH, KV_WIDTH, HG_WIDTH, HG_WIDTH, HG_WIDTH, HG_WIDTH, LRU_WIDTH, LRU_WIDTH)
IN_COLS = sum(IN_SIZES)
MIX_WIDTH = ATTN_WIDTH + HG_WIDTH + LRU_WIDTH
N_EXPERTS = 64
TOPK = 8
N_GROUPS = 8
TOPK_GROUPS = 4
EXPERTS_PER_GROUP = N_EXPERTS // N_GROUPS
EXPERT_DIM = 512
ROUTED_SCALE = 2.5
MOE_BLOCK = 256
DEEPNORM_ALPHA = (2 * DEPTH) ** 0.25
DEEPNORM_BETA = (8 * DEPTH) ** -0.25
RMS_EPS = 1e-6
LN_EPS = 1e-5
NEG_BIG = -1e30
TINY = 1e-30

kernel_name = "hybrid_swa_hgrn2_rglru_moe_deepnorm"


def rms_norm(x, gain):
    xf = x.astype(jnp.float32)
    y = xf * lax.rsqrt(jnp.mean(xf * xf, axis=-1, keepdims=True) + RMS_EPS) * gain
    return y.astype(x.dtype)


def layer_norm(x, gain, bias):
    xf = x.astype(jnp.float32)
    mu = jnp.mean(xf, axis=-1, keepdims=True)
    xc = xf - mu
    var = jnp.mean(xc * xc, axis=-1, keepdims=True)
    return (xc * lax.rsqrt(var + LN_EPS) * gain + bias).astype(x.dtype)


def rotary_tables(positions):
    inv_freq = ROPE_THETA ** (-jnp.arange(0, ROT_DIM, 2, dtype=jnp.float32) / ROT_DIM)
    ang = positions.astype(jnp.float32)[..., None] * inv_freq
    return jnp.cos(ang)[:, :, None, :], jnp.sin(ang)[:, :, None, :]


def apply_partial_rotary(t, cos, sin):
    tr = t[..., :ROT_DIM].astype(jnp.float32)
    t1, t2 = tr[..., :ROT_DIM // 2], tr[..., ROT_DIM // 2:]
    rot = jnp.concatenate([t1 * cos - t2 * sin, t2 * cos + t1 * sin], axis=-1)
    return jnp.concatenate([rot.astype(t.dtype), t[..., ROT_DIM:]], axis=-1)


def sliding_window_sink_attention(q, k, v, sinks):
    Bsz, S = q.shape[:2]
    nb = S // ATTN_BLOCK
    qb = q.reshape(Bsz, nb, ATTN_BLOCK, KV_HEADS, Q_PER_KV, HEAD_DIM)

    def band(t):
        tb = t.reshape(Bsz, nb, ATTN_BLOCK, KV_HEADS, HEAD_DIM)
        prev = jnp.pad(tb, ((0, 0), (1, 0), (0, 0), (0, 0), (0, 0)))[:, :-1]
        return jnp.concatenate([prev, tb], axis=2)

    kb, vb = band(k), band(v)
    s = jnp.einsum('bnqhgd,bnkhd->bnhgqk', qb, kb, preferred_element_type=jnp.float32) * (HEAD_DIM ** -0.5)
    blk = jnp.arange(nb)[:, None] * ATTN_BLOCK
    qpos = blk + jnp.arange(ATTN_BLOCK)[None]
    kpos = blk - ATTN_BLOCK + jnp.arange(2 * ATTN_BLOCK)[None]
    rel = qpos[:, :, None] - kpos[:, None, :]
    allowed = (rel >= 0) & (rel < WINDOW) & (kpos[:, None, :] >= 0)
    s = jnp.where(allowed[None, :, None, None], s, NEG_BIG)
    sink = sinks.astype(jnp.float32).reshape(KV_HEADS, Q_PER_KV)[None, None, :, :, None, None]
    m = jnp.maximum(jnp.max(s, axis=-1, keepdims=True), sink)
    pr = jnp.exp(s - m)
    probs = pr / (jnp.sum(pr, axis=-1, keepdims=True) + jnp.exp(sink - m))
    o = jnp.einsum('bnhgqk,bnkhd->bnqhgd', probs.astype(v.dtype), vb)
    return o.reshape(Bsz, S, ATTN_WIDTH)


def hgrn2_mixer(q, f_pre, v, g, lb, gain):
    Bsz, S, _ = q.shape
    nc = S // HG_CHUNK
    qf = jax.nn.silu(q.astype(jnp.float32))
    fp = f_pre.astype(jnp.float32)
    vf = v.astype(jnp.float32)
    f = lb + (1.0 - lb) * jax.nn.sigmoid(fp)
    log_f = jnp.log(jnp.maximum(f, TINY))
    kf = (1.0 - lb) * jax.nn.sigmoid(-fp)

    def to_chunks(t):
        return t.reshape(Bsz, nc, HG_CHUNK, HG_HEADS, HG_HEAD_DIM).transpose(1, 0, 3, 2, 4)

    causal = jnp.tril(jnp.ones((HG_CHUNK, HG_CHUNK), dtype=bool))[:, :, None]

    def step(state, xs):
        qc, kc, vc, lfc = xs
        b = jnp.cumsum(lfc, axis=2)
        diff = b[:, :, :, None, :] - b[:, :, None, :, :]
        decay = jnp.where(causal, jnp.exp(jnp.where(causal, diff, 0.0)), 0.0)
        scores = jnp.einsum('bhtk,bhsk,bhtsk->bhts', qc, kc, decay)
        o = jnp.einsum('bhts,bhsv->bhtv', scores, vc) + jnp.einsum('bhtk,bhkv->bhtv', qc * jnp.exp(b), state)
        b_last = b[:, :, -1:, :]
        state = jnp.exp(b_last[:, :, 0, :, None]) * state + jnp.einsum('bhsk,bhsv->bhkv', kc * jnp.exp(b_last - b), vc)
        return state, o

    state0 = jnp.zeros((Bsz, HG_HEADS, HG_HEAD_DIM, HG_HEAD_DIM), jnp.float32)
    _, o = lax.scan(step, state0, (to_chunks(qf), to_chunks(kf), to_chunks(vf), to_chunks(log_f)))
    o = o.transpose(1, 0, 3, 2, 4).reshape(Bsz, S, HG_HEADS, HG_HEAD_DIM)
    o = rms_norm(o, gain).reshape(Bsz, S, HG_WIDTH)
    return (o * jax.nn.silu(g.astype(jnp.float32))).astype(g.dtype)


def rglru_mixer(xr, gr, conv_w, conv_b, w_a, b_a, w_x, b_x, lam, gain):
    Bsz, S, _ = xr.shape
    xc = lax.conv_general_dilated(xr, conv_w[:, None, :], window_strides=(1,), padding=[(CONV_WIDTH - 1, 0)],
                                  dimension_numbers=('NWC', 'WIO', 'NWC'), feature_group_count=LRU_WIDTH) + conv_b
    xc = xc.astype(jnp.float32)
    xh = xc.reshape(Bsz, S, LRU_HEADS, LRU_HEAD_DIM)
    r = jax.nn.sigmoid(jnp.einsum('bshi,hij->bshj', xh, w_a) + b_a).reshape(Bsz, S, LRU_WIDTH)
    ig = jax.nn.sigmoid(jnp.einsum('bshi,hij->bshj', xh, w_x) + b_x).reshape(Bsz, S, LRU_WIDTH)
    log_a = -LRU_C * r * jax.nn.softplus(-lam.astype(jnp.float32))
    a = jnp.exp(log_a)
    u = jnp.sqrt(jnp.maximum(-jnp.expm1(2.0 * log_a), 0.0)) * (ig * xc)

    def combine(left, right):
        a1, b1 = left
        a2, b2 = right
        return a1 * a2, a2 * b1 + b2

    _, h = lax.associative_scan(combine, (a, u), axis=1)
    y = rms_norm(h, gain) * jax.nn.gelu(gr.astype(jnp.float32))
    return y.astype(xr.dtype)


def swiglu(x, w1, w3, w2):
    return (jax.nn.silu(x @ w1) * (x @ w3)) @ w2


def routed_experts(xf, idx, gates, w1, w3, w2):
    T, D = xf.shape
    A = T * TOPK
    e_flat = idx.reshape(-1)
    order = jnp.argsort(e_flat)
    e_sorted = e_flat[order]
    tok_sorted = (order // TOPK).astype(jnp.int32)
    gate_sorted = gates.reshape(-1)[order]
    counts = jnp.bincount(e_flat, length=N_EXPERTS)
    padded = ((counts + MOE_BLOCK - 1) // MOE_BLOCK) * MOE_BLOCK
    start = jnp.cumsum(counts) - counts
    pend = jnp.cumsum(padded)
    dest = (pend - padded)[e_sorted] + jnp.arange(A) - start[e_sorted]
    n_blocks = -(-A // MOE_BLOCK) + N_EXPERTS
    rows = n_blocks * MOE_BLOCK
    row_tok = jnp.full((rows,), T, jnp.int32).at[dest].set(tok_sorted)
    row_gate = jnp.zeros((rows,), xf.dtype).at[dest].set(gate_sorted)
    block_expert = jnp.clip(jnp.searchsorted(pend, jnp.arange(n_blocks) * MOE_BLOCK, side='right'), 0, N_EXPERTS - 1)
    xpad = jnp.concatenate([xf, jnp.zeros((1, D), xf.dtype)], axis=0)

    def step(acc, blk):
        tok, g, e = blk
        xb = xpad[tok]
        yb = swiglu(xb, w1[e], w3[e], w2[e]) * g[:, None]
        return acc.at[tok].add(yb), None

    acc, _ = lax.scan(step, jnp.zeros_like(xpad),
                      (row_tok.reshape(n_blocks, MOE_BLOCK), row_gate.reshape(n_blocks, MOE_BLOCK), block_expert))
    return acc[:T]


def moe_ffn(x, router_w, router_b, w1, w3, w2, sw1, sw3, sw2):
    Bsz, S, D = x.shape
    T = Bsz * S
    xf = x.reshape(T, D)
    scores = jax.nn.sigmoid((xf @ router_w).astype(jnp.float32))
    sel = scores + router_b.astype(jnp.float32)
    group_score = jnp.sum(lax.top_k(sel.reshape(T, N_GROUPS, EXPERTS_PER_GROUP), 2)[0], axis=-1)
    _, gidx = lax.top_k(group_score, TOPK_GROUPS)
    gmask = jnp.sum(jax.nn.one_hot(gidx, N_GROUPS, dtype=jnp.float32), axis=1) > 0
    sel = jnp.where(jnp.repeat(gmask, EXPERTS_PER_GROUP, axis=1), sel, NEG_BIG)
    _, idx = lax.top_k(sel, TOPK)
    w = jnp.take_along_axis(scores, idx, axis=1)
    gates = (w / jnp.sum(w, axis=-1, keepdims=True) * ROUTED_SCALE).astype(x.dtype)
    y = routed_experts(xf, idx, gates, w1, w3, w2) + swiglu(xf, sw1, sw3, sw2)
    return y.reshape(Bsz, S, D)


def setup_inputs(seed: int = 0) -> dict:
    key = jax.random.key(seed)
    ks = iter(jax.random.split(key, 48))
    L, D, E, F = DEPTH, D_MODEL, N_EXPERTS, EXPERT_DIM

    def nrm(shape, scale):
        return jax.random.normal(next(ks), shape, jnp.float32) * scale

    def gain(shape):
        return 1.0 + nrm(shape, 0.02)

    x = nrm((BATCH, SEQ, D), 1.0)
    p = nrm((DEPTH, BATCH, SEQ, PLE_DIM), 1.0)
    offs = jax.random.randint(next(ks), (BATCH, 1), 0, 1024, jnp.int32)
    positions = offs + jnp.arange(SEQ, dtype=jnp.int32)[None, :]
    u = jax.random.uniform(next(ks), (L, LRU_WIDTH), jnp.float32, 0.9, 0.999)
    a0 = u ** (1.0 / LRU_C)
    lru_lambda = jnp.log(a0) - jnp.log1p(-a0)
    return {
        "x": x,
        "p": p,
        "positions": positions,
        "w_in": nrm((L, D, IN_COLS), D ** -0.5),
        "w_out": nrm((L, MIX_WIDTH, D), MIX_WIDTH ** -0.5 * DEEPNORM_BETA),
        "attn_sinks": nrm((L, N_HEADS), 0.5),
        "attn_norm": gain((L, ATTN_WIDTH)),
        "hg_lb_logits": nrm((L, HG_WIDTH), 0.5),
        "hg_norm": gain((L, HG_HEADS, HG_HEAD_DIM)),
        "lru_conv_w": nrm((L, CONV_WIDTH, LRU_WIDTH), CONV_WIDTH ** -0.5),
        "lru_conv_b": nrm((L, LRU_WIDTH), 0.02),
        "lru_wa": nrm((L, LRU_HEADS, LRU_HEAD_DIM, LRU_HEAD_DIM), LRU_HEAD_DIM ** -0.5),
        "lru_ba": nrm((L, LRU_HEADS, LRU_HEAD_DIM), 0.02),
        "lru_wx": nrm((L, LRU_HEADS, LRU_HEAD_DIM, LRU_HEAD_DIM), LRU_HEAD_DIM ** -0.5),
        "lru_bx": nrm((L, LRU_HEADS, LRU_HEAD_DIM), 0.02),
        "lru_lambda": lru_lambda,
        "lru_norm": gain((L, LRU_WIDTH)),
        "ln1_g": gain((L, D)),
        "ln1_b": nrm((L, D), 0.02),
        "router_w": nrm((L, D, E), D ** -0.5),
        "router_b": nrm((L, E), 0.01),
        "exp_w1": nrm((L, E, D, F), D ** -0.5),
        "exp_w3": nrm((L, E, D, F), D ** -0.5),
        "exp_w2": nrm((L, E, F, D), F ** -0.5 * DEEPNORM_BETA),
        "sh_w1": nrm((L, D, F), D ** -0.5),
        "sh_w3": nrm((L, D, F), D ** -0.5),
        "sh_w2": nrm((L, F, D), F ** -0.5 * DEEPNORM_BETA),
        "ple_w": nrm((L, PLE_DIM, D), PLE_DIM ** -0.5 * DEEPNORM_BETA),
        "ple_gate_w": nrm((L, D, D), D ** -0.5),
        "ple_gate_b": nrm((L, D), 0.02),
        "ln2_g": gain((L, D)),
        "ln2_b": nrm((L, D), 0.02),
    }


def reference(x, p, positions, w_in, w_out, attn_sinks, attn_norm, hg_lb_logits, hg_norm,
              lru_conv_w, lru_conv_b, lru_wa, lru_ba, lru_wx, lru_bx, lru_lambda, lru_norm,
              ln1_g, ln1_b, router_w, router_b, exp_w1, exp_w3, exp_w2, sh_w1, sh_w3, sh_w2,
              ple_w, ple_gate_w, ple_gate_b, ln2_g, ln2_b):
    Bsz, S, _ = x.shape
    lb_sm = jax.nn.softmax(hg_lb_logits.astype(jnp.float32), axis=0)
    hg_lb = jnp.maximum(jnp.cumsum(lb_sm, axis=0) - lb_sm[0], 0.0)
    cos, sin = rotary_tables(positions)
    split_at = np.cumsum(IN_SIZES)[:-1].tolist()
    for i in range(DEPTH):
        h = x @ w_in[i]
        aq, ak, av, hq, hf, hi, hg, lx, lg = jnp.split(h, split_at, axis=-1)
        aq = apply_partial_rotary(aq.reshape(Bsz, S, N_HEADS, HEAD_DIM), cos, sin)
        ak = apply_partial_rotary(ak.reshape(Bsz, S, KV_HEADS, HEAD_DIM), cos, sin)
        av = av.reshape(Bsz, S, KV_HEADS, HEAD_DIM)
        y_attn = rms_norm(sliding_window_sink_attention(aq, ak, av, attn_sinks[i]), attn_norm[i])
        y_hg = hgrn2_mixer(hq, hf, hi, hg, hg_lb[i], hg_norm[i])
        y_lru = rglru_mixer(lx, lg, lru_conv_w[i], lru_conv_b[i], lru_wa[i], lru_ba[i],
                            lru_wx[i], lru_bx[i], lru_lambda[i], lru_norm[i])
        mixed = jnp.concatenate([y_attn, y_hg, y_lru], axis=-1) @ w_out[i]
        x = layer_norm(DEEPNORM_ALPHA * x + mixed, ln1_g[i], ln1_b[i])
        y_moe = moe_ffn(x, router_w[i], router_b[i], exp_w1[i], exp_w3[i], exp_w2[i], sh_w1[i], sh_w3[i], sh_w2[i])
        y_ple = jax.nn.sigmoid(x @ ple_gate_w[i] + ple_gate_b[i]) * (p[i] @ ple_w[i])
        x = layer_norm(DEEPNORM_ALPHA * x + y_moe + y_ple, ln2_g[i], ln2_b[i])
    return x
```

```cpp
#include <hip/hip_runtime.h>
#include <cstdio>
#include <cmath>

typedef unsigned short bf16_t;
typedef short bf16x8 __attribute__((ext_vector_type(8)));
typedef float f32x4 __attribute__((ext_vector_type(4)));
typedef unsigned u32x4 __attribute__((ext_vector_type(4)));
typedef unsigned u32x2 __attribute__((ext_vector_type(2)));

constexpr int BATCH = 8, SEQ = 4096, T = BATCH * SEQ, D = 2048, DEPTH = 2, PLE = 256;
constexpr int IN_COLS = 4352;
constexpr int C_AQ = 0, C_AK = 1024, C_AV = 1152, C_HQ = 1280, C_HF = 1792, C_HI = 2304, C_HG = 2816, C_LX = 3328, C_LG = 3840;
constexpr int NE = 64, TOPK = 8, EF = 512;
constexpr int A_ROWS = T * TOPK;
constexpr int MAXTILES = A_ROWS / 256 + NE;
constexpr int A_PAD = MAXTILES * 256;
constexpr float ALPHA = 1.41421356237309515f;
constexpr int RCHUNK = 128, NRCHUNK = T / RCHUNK;
constexpr int LCH = 32, NLCH = SEQ / LCH;

constexpr size_t MiB = 1u << 20;
constexpr size_t WS_CTL = 0;
constexpr size_t WS_CNT = 1 * MiB;
constexpr size_t WS_TILEE = 2 * MiB;
constexpr size_t WS_LOGITS = 4 * MiB;
constexpr size_t WS_TKIDX = 12 * MiB;
constexpr size_t WS_TKGATE = 13 * MiB;
constexpr size_t WS_ROWTOK = 14 * MiB;
constexpr size_t WS_ROWDST = 16 * MiB;
constexpr size_t WS_ROWGATE = 18 * MiB;
constexpr size_t WS_LRUA = 20 * MiB;
constexpr size_t WS_LRUH = 22 * MiB;
constexpr size_t WS_SSQ = 24 * MiB;
constexpr size_t WS_DV = 25 * MiB;
constexpr size_t WS_Y = 68 * MiB;
constexpr size_t WS_HIN = 324 * MiB;
constexpr size_t WS_MIX = 596 * MiB;
constexpr size_t WS_SST = 724 * MiB;
constexpr size_t WS_HM = 1092 * MiB;
constexpr size_t WS_HS = 1364 * MiB;
constexpr size_t WS_U = 1396 * MiB;
constexpr size_t WS_END = 1524 * MiB;

__device__ __forceinline__ bf16_t f2bf(float f) { unsigned u = __float_as_uint(f); u += 0x7fffu + ((u >> 16) & 1u); return (bf16_t)(u >> 16); }
__device__ __forceinline__ float bf2f(bf16_t b) { return __uint_as_float(((unsigned)b) << 16); }
__device__ __forceinline__ unsigned pk2(float lo, float hi) { return (unsigned)f2bf(lo) | ((unsigned)f2bf(hi) << 16); }
__device__ __forceinline__ float sigmoidf_(float x) { return 1.0f / (1.0f + __expf(-x)); }
__device__ __forceinline__ float siluf_(float x) { return x / (1.0f + __expf(-x)); }
__device__ __forceinline__ float gelu_tanh(float x) { const float u = 0.7978845608028654f * (x + 0.044715f * x * x * x); const float e = __expf(2.0f * u); const float th = 1.0f - 2.0f / (e + 1.0f); return 0.5f * x * (1.0f + th); }
__device__ __forceinline__ float wave_sum(float v) {
#pragma unroll
    for (int o = 1; o < 64; o <<= 1) v += __shfl_xor(v, o);
    return v;
}
__device__ __forceinline__ void sincos_pos(float pos, double invf, float& s, float& c) {
    const double a = (double)pos * invf;
    const double q = rint(a * 0.63661977236758134308);
    const float r = (float)(a - q * 1.57079632679489661923);
    const int qi = ((int)q) & 3;
    const float r2 = r * r;
    const float sp = r * (1.0f + r2 * (-1.6666667163e-1f + r2 * (8.3333337680e-3f + r2 * (-1.9841270114e-4f + r2 * 2.7557314297e-6f))));
    const float cp = 1.0f + r2 * (-0.5f + r2 * (4.1666667908e-2f + r2 * (-1.3888889225e-3f + r2 * (2.4801587642e-5f + r2 * -2.7557314297e-7f))));
    const float ss = (qi & 1) ? cp : sp, cc = (qi & 1) ? sp : cp;
    s = (qi & 2) ? -ss : ss;
    c = ((qi + 1) & 2) ? -cc : cc;
}

__device__ __forceinline__ u32x4 pack8(const float4 a, const float4 b) { u32x4 r; r.x = pk2(a.x, a.y); r.y = pk2(a.z, a.w); r.z = pk2(b.x, b.y); r.w = pk2(b.z, b.w); return r; }

template <bool AF32, class AF, class BF, class EF>
__global__ void __launch_bounds__(512) k_sgemm(AF af, BF bf, EF ef, const int* ntile256, int K, int pad_) {
    __shared__ __attribute__((aligned(16))) bf16_t As[128 * 40];
    __shared__ __attribute__((aligned(16))) bf16_t Bs[128 * 40];
    const int tm = blockIdx.y, tn = blockIdx.x;
    if (ntile256 && tm >= 2 * ntile256[0]) return;
    const int tid = threadIdx.x, lane = tid & 63, wid = tid >> 6, wr = wid >> 2, wc = wid & 3;
    const int ar = tid >> 2, ak = (tid & 3) * 8;
    const char* aptr = (const char*)af.row_ptr(tm, ar);
    const int bk = tid >> 4, bn = (tid & 15) * 8;
    const int ldb = bf.ldb;
    const float* bptr = bf.col_ptr(tm, tn, bn) + (size_t)bk * ldb;
    f32x4 acc[4][2];
#pragma unroll
    for (int m = 0; m < 4; ++m)
#pragma unroll
        for (int n = 0; n < 2; ++n) acc[m][n] = (f32x4){0.f, 0.f, 0.f, 0.f};
    for (int k0 = 0; k0 < K; k0 += 32) {
        u32x4 av = (u32x4){0u, 0u, 0u, 0u};
        if (aptr) {
            if (AF32) { const float4 f0 = *(const float4*)(aptr + (size_t)(k0 + ak) * 4), f1 = *(const float4*)(aptr + (size_t)(k0 + ak) * 4 + 16); av = pack8(f0, f1); }
            else av = *(const u32x4*)(aptr + (size_t)(k0 + ak) * 2);
        }
        const float4 b0 = *(const float4*)(bptr + (size_t)k0 * ldb), b1 = *(const float4*)(bptr + (size_t)k0 * ldb + 4);
        __syncthreads();
        *(u32x4*)(As + ar * 40 + ak) = av;
        Bs[(bn + 0) * 40 + bk] = f2bf(b0.x); Bs[(bn + 1) * 40 + bk] = f2bf(b0.y); Bs[(bn + 2) * 40 + bk] = f2bf(b0.z); Bs[(bn + 3) * 40 + bk] = f2bf(b0.w);
        Bs[(bn + 4) * 40 + bk] = f2bf(b1.x); Bs[(bn + 5) * 40 + bk] = f2bf(b1.y); Bs[(bn + 6) * 40 + bk] = f2bf(b1.z); Bs[(bn + 7) * 40 + bk] = f2bf(b1.w);
        __syncthreads();
        bf16x8 a[4], b[2];
#pragma unroll
        for (int m = 0; m < 4; ++m) a[m] = *(const bf16x8*)(As + (wr * 64 + m * 16 + (lane & 15)) * 40 + (lane >> 4) * 8);
#pragma unroll
        for (int n = 0; n < 2; ++n) b[n] = *(const bf16x8*)(Bs + (wc * 32 + n * 16 + (lane & 15)) * 40 + (lane >> 4) * 8);
#pragma unroll
        for (int m = 0; m < 4; ++m)
#pragma unroll
            for (int n = 0; n < 2; ++n) acc[m][n] = __builtin_amdgcn_mfma_f32_16x16x32_bf16(a[m], b[n], acc[m][n], 0, 0, 0);
    }
    ef(tm, tn, acc, wr, wc, lane);
}

struct APlain { const char* A; size_t pitch; __device__ const void* row_ptr(int tm, int r) const { return A + (size_t)(tm * 128 + r) * pitch; } };
struct AGather { const float* X; const int* row_tok; __device__ const void* row_ptr(int tm, int r) const { const int t = row_tok[tm * 128 + r]; return t < 0 ? nullptr : (const void*)(X + (size_t)t * D); } };
struct BPlain { const float* W; int ldb; int pad; __device__ const float* col_ptr(int tm, int tn, int j) const { return W + tn * 128 + j; } };
struct BSwiglu { const float* W1; const float* W3; int ldb; int pad; __device__ const float* col_ptr(int tm, int tn, int j) const { const int wc = j >> 5, n = (j >> 4) & 1, cc = j & 15; return (n ? W3 : W1) + tn * 64 + wc * 16 + cc; } };
struct BGroupSwiglu { const float* W1; const float* W3; const int* tile_e; int ldb; int pad;
    __device__ const float* col_ptr(int tm, int tn, int j) const { const size_t eo = (size_t)tile_e[tm >> 1] * D * EF; const int wc = j >> 5, n = (j >> 4) & 1, cc = j & 15; return (n ? W3 : W1) + eo + tn * 64 + wc * 16 + cc; } };
struct BGroup { const float* W; const int* tile_e; int ldb; int pad; __device__ const float* col_ptr(int tm, int tn, int j) const { return W + (size_t)tile_e[tm >> 1] * EF * D + tn * 128 + j; } };

struct EBf16 { bf16_t* O; int ldo; int pad;
    __device__ void operator()(int tm, int tn, const f32x4 (&acc)[4][2], int wr, int wc, int lane) const {
#pragma unroll
        for (int m = 0; m < 4; ++m)
#pragma unroll
            for (int n = 0; n < 2; ++n)
#pragma unroll
                for (int r = 0; r < 4; ++r) { const int row = tm * 128 + wr * 64 + m * 16 + 4 * (lane >> 4) + r, col = tn * 128 + wc * 32 + n * 16 + (lane & 15); O[(size_t)row * ldo + col] = f2bf(acc[m][n][r]); } } };
struct EResid { const float* xres; float* out; float alpha; int pad;
    __device__ void operator()(int tm, int tn, const f32x4 (&acc)[4][2], int wr, int wc, int lane) const {
#pragma unroll
        for (int m = 0; m < 4; ++m)
#pragma unroll
            for (int n = 0; n < 2; ++n)
#pragma unroll
                for (int r = 0; r < 4; ++r) { const int row = tm * 128 + wr * 64 + m * 16 + 4 * (lane >> 4) + r, col = tn * 128 + wc * 32 + n * 16 + (lane & 15); const size_t i = (size_t)row * D + col; out[i] = alpha * xres[i] + acc[m][n][r]; } } };
struct ESwiglu { bf16_t* H;
    __device__ void operator()(int tm, int tn, const f32x4 (&acc)[4][2], int wr, int wc, int lane) const {
#pragma unroll
        for (int m = 0; m < 4; ++m)
#pragma unroll
            for (int r = 0; r < 4; ++r) { const int row = tm * 128 + wr * 64 + m * 16 + 4 * (lane >> 4) + r, col = tn * 64 + wc * 16 + (lane & 15); H[(size_t)row * EF + col] = f2bf(siluf_(acc[m][0][r]) * acc[m][1][r]); } } };
struct EScatter { bf16_t* Y; const int* row_dst; const float* row_gate;
    __device__ void operator()(int tm, int tn, const f32x4 (&acc)[4][2], int wr, int wc, int lane) const {
#pragma unroll
        for (int m = 0; m < 4; ++m)
#pragma unroll
            for (int r = 0; r < 4; ++r) { const int slot = tm * 128 + wr * 64 + m * 16 + 4 * (lane >> 4) + r; const int dst = row_dst[slot]; const float g = row_gate[slot];
                if (dst >= 0) {
#pragma unroll
                    for (int n = 0; n < 2; ++n) { const int col = tn * 128 + wc * 32 + n * 16 + (lane & 15); Y[(size_t)dst * D + col] = f2bf(g * acc[m][n][r]); } } } } };
struct EGate { bf16_t* U; const float* bias;
    __device__ void operator()(int tm, int tn, const f32x4 (&acc)[4][2], int wr, int wc, int lane) const {
#pragma unroll
        for (int m = 0; m < 4; ++m)
#pragma unroll
            for (int n = 0; n < 2; ++n)
#pragma unroll
                for (int r = 0; r < 4; ++r) { const int row = tm * 128 + wr * 64 + m * 16 + 4 * (lane >> 4) + r, col = tn * 128 + wc * 32 + n * 16 + (lane & 15); const size_t i = (size_t)row * D + col;
                    U[i] = f2bf(sigmoidf_(acc[m][n][r] + bias[col]) * bf2f(U[i])); } } };
struct ECombine { float* xio; const bf16_t* YP; const bf16_t* Y; float alpha; int pad;
    __device__ void operator()(int tm, int tn, const f32x4 (&acc)[4][2], int wr, int wc, int lane) const {
#pragma unroll
        for (int m = 0; m < 4; ++m)
#pragma unroll
            for (int n = 0; n < 2; ++n)
#pragma unroll
                for (int r = 0; r < 4; ++r) { const int row = tm * 128 + wr * 64 + m * 16 + 4 * (lane >> 4) + r, col = tn * 128 + wc * 32 + n * 16 + (lane & 15); const size_t i = (size_t)row * D + col;
                    float s = alpha * xio[i] + acc[m][n][r] + bf2f(YP[i]);
#pragma unroll
                    for (int k = 0; k < TOPK; ++k) s += bf2f(Y[((size_t)row * TOPK + k) * D + col]);
                    xio[i] = s; } } };

__global__ void __launch_bounds__(512) k_layernorm(float* x, const float* gain, const float* bias) {
    const int lane = threadIdx.x & 63, row = blockIdx.x * 8 + (threadIdx.x >> 6);
    float4* xr = (float4*)(x + (size_t)row * D) + lane;
    float4 v[8]; float s = 0.f;
#pragma unroll
    for (int j = 0; j < 8; ++j) { v[j] = xr[64 * j]; s += (v[j].x + v[j].y) + (v[j].z + v[j].w); }
    const float mean = wave_sum(s) * (1.f / D); float q = 0.f;
#pragma unroll
    for (int j = 0; j < 8; ++j) { v[j].x -= mean; v[j].y -= mean; v[j].z -= mean; v[j].w -= mean; q += (v[j].x * v[j].x + v[j].y * v[j].y) + (v[j].z * v[j].z + v[j].w * v[j].w); }
    const float rstd = 1.0f / sqrtf(wave_sum(q) * (1.f / D) + 1e-5f);
#pragma unroll
    for (int j = 0; j < 8; ++j) { const float4 g = ((const float4*)gain)[lane + 64 * j], b = ((const float4*)bias)[lane + 64 * j];
        float4 o; o.x = v[j].x * rstd * g.x + b.x; o.y = v[j].y * rstd * g.y + b.y; o.z = v[j].z * rstd * g.z + b.z; o.w = v[j].w * rstd * g.w + b.w; xr[64 * j] = o; }
}

constexpr int AT_KS = 72, AT_VS = 264, AT_PS = 168;
constexpr int AT_LDS_K = 0, AT_LDS_V = 256 * AT_KS * 2, AT_LDS_P = AT_LDS_V + (64 * AT_VS + 64) * 2, AT_LDS_SS = AT_LDS_P + 8 * 16 * AT_PS * 2, AT_LDS_BYTES = AT_LDS_SS + 8 * 128 * 4;
struct RotTab { double invf[8]; };
__global__ void __launch_bounds__(512) k_attn(const bf16_t* HIN, const int* positions, const float* sinks, bf16_t* MIX, float* SSQ, RotTab rt) {
    extern __shared__ __attribute__((aligned(16))) unsigned char lds[];
    bf16_t* Ks = (bf16_t*)(lds + AT_LDS_K); bf16_t* Vt = (bf16_t*)(lds + AT_LDS_V); bf16_t* Ps = (bf16_t*)(lds + AT_LDS_P); float* SS = (float*)(lds + AT_LDS_SS);
    const int u = blockIdx.x, g = u & 1, n = (u >> 1) & 31, b = u >> 6;
    const int tid = threadIdx.x, lane = tid & 63, w = tid >> 6;
    {
        const int j = tid >> 1, half = tid & 1; const int kp = 128 * (n - 1) + j;
        u32x4 kv[4], vv[4];
        if (kp >= 0) {
            const bf16_t* kr = HIN + (size_t)(b * SEQ + kp) * IN_COLS + C_AK + g * 64 + half * 32;
            const bf16_t* vr = HIN + (size_t)(b * SEQ + kp) * IN_COLS + C_AV + g * 64 + half * 32;
#pragma unroll
            for (int i = 0; i < 4; ++i) { kv[i] = *(const u32x4*)(kr + 8 * i); vv[i] = *(const u32x4*)(vr + 8 * i); }
            if (half == 0) {
                const float pos = (float)positions[b * SEQ + kp];
                unsigned* k0 = (unsigned*)&kv[0]; unsigned* k1 = (unsigned*)&kv[1];
                float t1[8], t2[8];
#pragma unroll
                for (int i = 0; i < 4; ++i) { t1[2 * i] = bf2f((bf16_t)(k0[i] & 0xffff)); t1[2 * i + 1] = bf2f((bf16_t)(k0[i] >> 16)); t2[2 * i] = bf2f((bf16_t)(k1[i] & 0xffff)); t2[2 * i + 1] = bf2f((bf16_t)(k1[i] >> 16)); }
#pragma unroll
                for (int i = 0; i < 8; ++i) { float s, c; sincos_pos(pos, rt.invf[i], s, c); const float a = t1[i] * c - t2[i] * s, bb = t2[i] * c + t1[i] * s; t1[i] = a; t2[i] = bb; }
#pragma unroll
                for (int i = 0; i < 4; ++i) { k0[i] = pk2(t1[2 * i], t1[2 * i + 1]); k1[i] = pk2(t2[2 * i], t2[2 * i + 1]); }
            }
        } else {
#pragma unroll
            for (int i = 0; i < 4; ++i) { kv[i] = (u32x4){0u, 0u, 0u, 0u}; vv[i] = (u32x4){0u, 0u, 0u, 0u}; }
        }
#pragma unroll
        for (int i = 0; i < 4; ++i) *(u32x4*)(Ks + j * AT_KS + half * 32 + 8 * i) = kv[i];
#pragma unroll
        for (int i = 0; i < 4; ++i) { const unsigned* p = (const unsigned*)&vv[i];
#pragma unroll
            for (int e = 0; e < 4; ++e) { const int d = half * 32 + 8 * i + 2 * e; Vt[d * AT_VS + j] = (bf16_t)(p[e] & 0xffff); Vt[(d + 1) * AT_VS + j] = (bf16_t)(p[e] >> 16); } }
        if (tid < 64) {
#pragma unroll
            for (int i = 0; i < 8; ++i) Vt[tid * AT_VS + 256 + i] = 0;
            Vt[64 * AT_VS + tid] = 0;
        }
        for (int i = tid; i < 8 * 16 * 24; i += 512) { const int r = i / 24, c = 144 + i % 24; Ps[r * AT_PS + c] = 0; }
    }
    __syncthreads();
    const int hq = g * 8 + w; const float sink = sinks[hq];
    const int lr = lane & 15, lg = lane >> 4;
    bf16_t* Pw = Ps + w * 16 * AT_PS;
    for (int qi = 0; qi < 8; ++qi) {
        const int tq = b * SEQ + n * 128 + qi * 16 + lr;
        const bf16_t* qr = HIN + (size_t)tq * IN_COLS + C_AQ + hq * 64 + lg * 8;
        u32x4 q0 = *(const u32x4*)qr, q1 = *(const u32x4*)(qr + 32);
        {
            u32x4 other; other.x = __shfl_xor(q0.x, 16); other.y = __shfl_xor(q0.y, 16); other.z = __shfl_xor(q0.z, 16); other.w = __shfl_xor(q0.w, 16);
            if (lg < 2) {
                const float pos = (float)positions[tq];
                const unsigned* me = (const unsigned*)&q0; const unsigned* ot = (const unsigned*)&other; float mv[8], ov[8];
#pragma unroll
                for (int i = 0; i < 4; ++i) { mv[2 * i] = bf2f((bf16_t)(me[i] & 0xffff)); mv[2 * i + 1] = bf2f((bf16_t)(me[i] >> 16)); ov[2 * i] = bf2f((bf16_t)(ot[i] & 0xffff)); ov[2 * i + 1] = bf2f((bf16_t)(ot[i] >> 16)); }
#pragma unroll
                for (int i = 0; i < 8; ++i) { float s, c; sincos_pos(pos, rt.invf[i], s, c); mv[i] = (lg == 0) ? (mv[i] * c - ov[i] * s) : (mv[i] * c + ov[i] * s); }
                q0.x = pk2(mv[0], mv[1]); q0.y = pk2(mv[2], mv[3]); q0.z = pk2(mv[4], mv[5]); q0.w = pk2(mv[6], mv[7]);
            }
        }
        const bf16x8 qa0 = __builtin_bit_cast(bf16x8, q0), qa1 = __builtin_bit_cast(bf16x8, q1);
        f32x4 s[9];
#pragma unroll
        for (int jt = 0; jt < 9; ++jt) {
            const int jrow = (qi + jt) * 16 + lr;
            const int jr = jrow < 256 ? jrow : 255;
            const bf16x8 kb0 = *(const bf16x8*)(Ks + jr * AT_KS + lg * 8), kb1 = *(const bf16x8*)(Ks + jr * AT_KS + 32 + lg * 8);
            f32x4 a = (f32x4){0.f, 0.f, 0.f, 0.f};
            a = __builtin_amdgcn_mfma_f32_16x16x32_bf16(qa0, kb0, a, 0, 0, 0);
            a = __builtin_amdgcn_mfma_f32_16x16x32_bf16(qa1, kb1, a, 0, 0, 0);
            s[jt] = a;
        }
        float mx[4] = {-1e30f, -1e30f, -1e30f, -1e30f};
#pragma unroll
        for (int jt = 0; jt < 9; ++jt)
#pragma unroll
            for (int r = 0; r < 4; ++r) { const int i = 16 * qi + 4 * lg + r, j = 16 * (qi + jt) + lr; const bool ok = (j >= i + 1) && (j <= i + 128) && (j < 256) && (n > 0 || j >= 128);
                const float v = ok ? s[jt][r] * 0.125f : -1e30f; s[jt][r] = v; mx[r] = fmaxf(mx[r], v); }
        float sm[4];
#pragma unroll
        for (int r = 0; r < 4; ++r) { float m = mx[r]; m = fmaxf(m, __shfl_xor(m, 1)); m = fmaxf(m, __shfl_xor(m, 2)); m = fmaxf(m, __shfl_xor(m, 4)); m = fmaxf(m, __shfl_xor(m, 8)); m = fmaxf(m, sink); mx[r] = m; sm[r] = 0.f; }
#pragma unroll
        for (int jt = 0; jt < 9; ++jt)
#pragma unroll
            for (int r = 0; r < 4; ++r) { const float p = (s[jt][r] > -1e29f) ? __expf(s[jt][r] - mx[r]) : 0.f; s[jt][r] = p; sm[r] += p; }
#pragma unroll
        for (int r = 0; r < 4; ++r) { float t = sm[r]; t += __shfl_xor(t, 1); t += __shfl_xor(t, 2); t += __shfl_xor(t, 4); t += __shfl_xor(t, 8); sm[r] = 1.0f / (t + __expf(sink - mx[r])); }
#pragma unroll
        for (int jt = 0; jt < 9; ++jt)
#pragma unroll
            for (int r = 0; r < 4; ++r) Pw[(4 * lg + r) * AT_PS + jt * 16 + lr] = f2bf(s[jt][r] * sm[r]);
        asm volatile("s_waitcnt lgkmcnt(0)" ::: "memory");
        f32x4 o[4];
#pragma unroll
        for (int dt = 0; dt < 4; ++dt) o[dt] = (f32x4){0.f, 0.f, 0.f, 0.f};
#pragma unroll
        for (int ks = 0; ks < 5; ++ks) {
            const bf16x8 pa = *(const bf16x8*)(Pw + lr * AT_PS + ks * 32 + lg * 8);
#pragma unroll
            for (int dt = 0; dt < 4; ++dt) { const bf16x8 vb = *(const bf16x8*)(Vt + (dt * 16 + lr) * AT_VS + qi * 16 + ks * 32 + lg * 8); o[dt] = __builtin_amdgcn_mfma_f32_16x16x32_bf16(pa, vb, o[dt], 0, 0, 0); }
        }
#pragma unroll
        for (int r = 0; r < 4; ++r) {
            const int t = b * SEQ + n * 128 + qi * 16 + 4 * lg + r; float q = 0.f;
#pragma unroll
            for (int dt = 0; dt < 4; ++dt) { const float v = o[dt][r]; q += v * v; MIX[(size_t)t * D + hq * 64 + dt * 16 + lr] = f2bf(v); }
            q += __shfl_xor(q, 1); q += __shfl_xor(q, 2); q += __shfl_xor(q, 4); q += __shfl_xor(q, 8);
            if (lr == 0) SS[w * 128 + qi * 16 + 4 * lg + r] = q;
        }
    }
    __syncthreads();
    if (tid < 128) { float q = 0.f;
#pragma unroll
        for (int ww = 0; ww < 8; ++ww) q += SS[ww * 128 + tid];
        SSQ[(size_t)(b * SEQ + n * 128 + tid) * 2 + g] = q; }
}
__global__ void __launch_bounds__(512) k_attn_fin(bf16_t* MIX, const float* SSQ, const float* gain) {
    const int lane = threadIdx.x & 63, t = blockIdx.x * 8 + (threadIdx.x >> 6);
    const float sc = 1.0f / sqrtf((SSQ[(size_t)t * 2] + SSQ[(size_t)t * 2 + 1]) * (1.0f / 1024.f) + 1e-6f);
    u32x4* p = (u32x4*)(MIX + (size_t)t * D) + lane * 2;
#pragma unroll
    for (int h = 0; h < 2; ++h) { u32x4 v = p[h]; unsigned* w = (unsigned*)&v;
#pragma unroll
        for (int i = 0; i < 4; ++i) { const int c = lane * 16 + h * 8 + 2 * i; w[i] = pk2(bf2f((bf16_t)(w[i] & 0xffff)) * sc * gain[c], bf2f((bf16_t)(w[i] >> 16)) * sc * gain[c + 1]); }
        p[h] = v; }
}

constexpr int HG_S72 = 72, HG_S136 = 136;
__device__ __forceinline__ float hg_lb(const float* lbl, int layer, int col) { if (layer == 0) return 0.f; return sigmoidf_(lbl[512 + col] - lbl[col]); }

constexpr int H1_LDS_KT = 0, H1_LDS_VT = 128 * HG_S72 * 2, H1_LDS_TOT = 2 * 128 * HG_S72 * 2, H1_LDS_BYTES = H1_LDS_TOT + 4 * 128 * 4;
__global__ void __launch_bounds__(512) k_hg1(const bf16_t* HIN, const float* lbl, float* SST, float* DV, int layer, int pad_) {
    extern __shared__ __attribute__((aligned(16))) unsigned char lds[];
    bf16_t* KT = (bf16_t*)(lds + H1_LDS_KT); bf16_t* VT = (bf16_t*)(lds + H1_LDS_VT); float* TOT = (float*)(lds + H1_LDS_TOT);
    const int u = blockIdx.x, c = u & 63, h = (u >> 6) & 3, b = u >> 8;
    const int tid = threadIdx.x, lane = tid & 63, w = tid >> 6, k = tid & 127, tq = tid >> 7;
    const size_t t0 = (size_t)b * SEQ + c * 64;
    const float lb = hg_lb(lbl, layer, h * 128 + k);
    float bl[16], kf[16]; float cum = 0.f;
#pragma unroll
    for (int i = 0; i < 16; ++i) { const size_t row = (t0 + 16 * tq + i) * IN_COLS; const float fp = bf2f(HIN[row + C_HF + h * 128 + k]);
        const float sg = sigmoidf_(fp); const float f = lb + (1.f - lb) * sg; cum += __logf(fmaxf(f, 1e-30f)); bl[i] = cum; kf[i] = (1.f - lb) * sigmoidf_(-fp);
        VT[k * HG_S72 + 16 * tq + i] = HIN[row + C_HI + h * 128 + k]; }
    TOT[tq * 128 + k] = cum;
    __syncthreads();
    float pre = 0.f, total = 0.f;
#pragma unroll
    for (int j = 0; j < 4; ++j) { const float tj = TOT[j * 128 + k]; if (j < tq) pre += tj; total += tj; }
#pragma unroll
    for (int i = 0; i < 16; ++i) KT[k * HG_S72 + 16 * tq + i] = f2bf(kf[i] * __expf(total - (pre + bl[i])));
    if (tq == 0) DV[(size_t)u * 128 + k] = __expf(total);
    __syncthreads();
    const int lr = lane & 15, lg = lane >> 4;
    bf16x8 a[2];
#pragma unroll
    for (int ks = 0; ks < 2; ++ks) a[ks] = *(const bf16x8*)(VT + (w * 16 + lr) * HG_S72 + ks * 32 + lg * 8);
    float* out = SST + (size_t)u * 16384;
#pragma unroll
    for (int kt = 0; kt < 8; ++kt) {
        f32x4 acc = (f32x4){0.f, 0.f, 0.f, 0.f};
#pragma unroll
        for (int ks = 0; ks < 2; ++ks) { const bf16x8 bb = *(const bf16x8*)(KT + (kt * 16 + lr) * HG_S72 + ks * 32 + lg * 8); acc = __builtin_amdgcn_mfma_f32_16x16x32_bf16(a[ks], bb, acc, 0, 0, 0); }
#pragma unroll
        for (int r = 0; r < 4; ++r) out[(w * 16 + 4 * lg + r) * 128 + kt * 16 + lr] = acc[r];
    }
}
__global__ void __launch_bounds__(512) k_hg2(float* SST, const float* DV) {
    const int bh = blockIdx.x >> 3, part = blockIdx.x & 7, e4 = part * 512 + threadIdx.x;
    const int k4 = (e4 & 31) * 4;
    float4 S = make_float4(0.f, 0.f, 0.f, 0.f);
    for (int c = 0; c < 64; ++c) {
        const size_t u = (size_t)bh * 64 + c;
        float4* p = (float4*)(SST + u * 16384) + e4;
        const float4 ds = *p; const float4 dv = *(const float4*)(DV + u * 128 + k4);
        *p = S;
        S.x = dv.x * S.x + ds.x; S.y = dv.y * S.y + ds.y; S.z = dv.z * S.z + ds.z; S.w = dv.w * S.w + ds.w;
    }
}
constexpr int H3_QI = 0, H3_QE = H3_QI + 64 * HG_S136 * 2, H3_KI = H3_QE + 64 * HG_S136 * 2, H3_VT = H3_KI + 160 * HG_S136 * 2, H3_SB = H3_VT + 128 * HG_S72 * 2,
              H3_SC = H3_SB + 128 * HG_S136 * 2, H3_TOT = H3_SC + 64 * HG_S72 * 2, H3_LDS_BYTES = H3_TOT + 4 * 128 * 4;
constexpr int H3_OB = H3_KI, HG_OS = 132;
__global__ void __launch_bounds__(512) k_hg3(const bf16_t* HIN, const float* lbl, const float* SST, const float* gain, bf16_t* MIX, int layer, int pad_) {
    extern __shared__ __attribute__((aligned(16))) unsigned char lds[];
    bf16_t* QI = (bf16_t*)(lds + H3_QI); bf16_t* QE = (bf16_t*)(lds + H3_QE); bf16_t* KI = (bf16_t*)(lds + H3_KI); bf16_t* VT = (bf16_t*)(lds + H3_VT);
    bf16_t* SB = (bf16_t*)(lds + H3_SB); bf16_t* SC = (bf16_t*)(lds + H3_SC); float* TOT = (float*)(lds + H3_TOT); float* OB = (float*)(lds + H3_OB);
    const int u = blockIdx.x, c = u & 63, h = (u >> 6) & 3, b = u >> 8;
    const int tid = threadIdx.x, lane = tid & 63, w = tid >> 6, k = tid & 127, tq = tid >> 7;
    const size_t t0 = (size_t)b * SEQ + c * 64;
    const float lb = hg_lb(lbl, layer, h * 128 + k);
    float bl[16], kf[16], qf[16]; float cum = 0.f;
#pragma unroll
    for (int i = 0; i < 16; ++i) { const size_t row = (t0 + 16 * tq + i) * IN_COLS; const float fp = bf2f(HIN[row + C_HF + h * 128 + k]);
        const float sg = sigmoidf_(fp); const float f = lb + (1.f - lb) * sg; cum += __logf(fmaxf(f, 1e-30f)); bl[i] = cum; kf[i] = (1.f - lb) * sigmoidf_(-fp);
        qf[i] = siluf_(bf2f(HIN[row + C_HQ + h * 128 + k]));
        VT[k * HG_S72 + 16 * tq + i] = HIN[row + C_HI + h * 128 + k]; }
    TOT[tq * 128 + k] = cum;
    { const float4* sp = (const float4*)(SST + (size_t)u * 16384);
#pragma unroll
      for (int i = 0; i < 8; ++i) { const int e4 = tid + 512 * i; const float4 s4 = sp[e4]; const int v = e4 >> 5, k4 = (e4 & 31) * 4; u32x2 pk; pk.x = pk2(s4.x, s4.y); pk.y = pk2(s4.z, s4.w); *(u32x2*)(SB + v * HG_S136 + k4) = pk; } }
    for (int i = tid; i < 64 * HG_S72 / 2; i += 512) ((unsigned*)SC)[i] = 0u;
    __syncthreads();
    float rs[4]; { float acc = 0.f;
#pragma unroll
        for (int j = 0; j < 4; ++j) { rs[j] = acc; acc += TOT[j * 128 + k]; } }
    const float pre = rs[tq];
#pragma unroll
    for (int i = 0; i < 16; ++i) {
        const int s = 16 * tq + i; const float bs = pre + bl[i];
        QI[s * HG_S136 + k] = f2bf(qf[i] * __expf(bl[i]));
        QE[s * HG_S136 + k] = f2bf(qf[i] * __expf(bs));
#pragma unroll
        for (int ii = 0; ii < 4; ++ii) if (ii >= tq) KI[((ii == 0 ? 0 : ii == 1 ? 16 : ii == 2 ? 48 : 96) + s) * HG_S136 + k] = f2bf(kf[i] * __expf(rs[ii] - bs));
    }
    __syncthreads();
    const int lr = lane & 15, lg = lane >> 4;
    for (int tix = w; tix < 10; tix += 8) {
        int i, j; if (tix == 0) { i = 0; j = 0; } else if (tix < 3) { i = 1; j = tix - 1; } else if (tix < 6) { i = 2; j = tix - 3; } else { i = 3; j = tix - 6; }
        const int kb = (i == 0 ? 0 : i == 1 ? 16 : i == 2 ? 48 : 96);
        f32x4 acc = (f32x4){0.f, 0.f, 0.f, 0.f};
#pragma unroll
        for (int ks = 0; ks < 4; ++ks) { const bf16x8 a = *(const bf16x8*)(QI + (16 * i + lr) * HG_S136 + ks * 32 + lg * 8); const bf16x8 bb = *(const bf16x8*)(KI + (kb + 16 * j + lr) * HG_S136 + ks * 32 + lg * 8);
            acc = __builtin_amdgcn_mfma_f32_16x16x32_bf16(a, bb, acc, 0, 0, 0); }
#pragma unroll
        for (int r = 0; r < 4; ++r) { const int tr = 4 * lg + r; const float v = (i == j && lr > tr) ? 0.f : acc[r]; SC[(16 * i + tr) * HG_S72 + 16 * j + lr] = f2bf(v); }
    }
    __syncthreads();
    f32x4 o[4];
#pragma unroll
    for (int tt = 0; tt < 4; ++tt) o[tt] = (f32x4){0.f, 0.f, 0.f, 0.f};
#pragma unroll
    for (int ks = 0; ks < 2; ++ks) { const bf16x8 vb = *(const bf16x8*)(VT + (w * 16 + lr) * HG_S72 + ks * 32 + lg * 8);
#pragma unroll
        for (int tt = 0; tt < 4; ++tt) { const bf16x8 a = *(const bf16x8*)(SC + (16 * tt + lr) * HG_S72 + ks * 32 + lg * 8); o[tt] = __builtin_amdgcn_mfma_f32_16x16x32_bf16(a, vb, o[tt], 0, 0, 0); } }
#pragma unroll
    for (int ks = 0; ks < 4; ++ks) { const bf16x8 sb = *(const bf16x8*)(SB + (w * 16 + lr) * HG_S136 + ks * 32 + lg * 8);
#pragma unroll
        for (int tt = 0; tt < 4; ++tt) { const bf16x8 a = *(const bf16x8*)(QE + (16 * tt + lr) * HG_S136 + ks * 32 + lg * 8); o[tt] = __builtin_amdgcn_mfma_f32_16x16x32_bf16(a, sb, o[tt], 0, 0, 0); } }
#pragma unroll
    for (int tt = 0; tt < 4; ++tt)
#pragma unroll
        for (int r = 0; r < 4; ++r) OB[(16 * tt + 4 * lg + r) * HG_OS + w * 16 + lr] = o[tt][r];
    __syncthreads();
    { const int t = tid >> 3, vg = tid & 7; float ov[16]; float q = 0.f;
#pragma unroll
      for (int i = 0; i < 4; ++i) { const float4 x = *(const float4*)(OB + t * HG_OS + vg * 16 + 4 * i); ov[4 * i] = x.x; ov[4 * i + 1] = x.y; ov[4 * i + 2] = x.z; ov[4 * i + 3] = x.w; q += (x.x * x.x + x.y * x.y) + (x.z * x.z + x.w * x.w); }
      q += __shfl_xor(q, 1); q += __shfl_xor(q, 2); q += __shfl_xor(q, 4);
      const float rinv = 1.0f / sqrtf(q * (1.0f / 128.f) + 1e-6f);
      const size_t row = t0 + t; const bf16_t* gp = HIN + row * IN_COLS + C_HG + h * 128 + vg * 16; const float* gn = gain + h * 128 + vg * 16;
      const u32x4 g0 = *(const u32x4*)gp, g1 = *(const u32x4*)(gp + 8); const unsigned* gw0 = (const unsigned*)&g0; const unsigned* gw1 = (const unsigned*)&g1;
      u32x4 o0, o1; unsigned* ow0 = (unsigned*)&o0; unsigned* ow1 = (unsigned*)&o1;
#pragma unroll
      for (int i = 0; i < 4; ++i) {
          ow0[i] = pk2(ov[2 * i] * rinv * gn[2 * i] * siluf_(bf2f((bf16_t)(gw0[i] & 0xffff))), ov[2 * i + 1] * rinv * gn[2 * i + 1] * siluf_(bf2f((bf16_t)(gw0[i] >> 16))));
          ow1[i] = pk2(ov[8 + 2 * i] * rinv * gn[8 + 2 * i] * siluf_(bf2f((bf16_t)(gw1[i] & 0xffff))), ov[8 + 2 * i + 1] * rinv * gn[8 + 2 * i + 1] * siluf_(bf2f((bf16_t)(gw1[i] >> 16)))); }
      bf16_t* op = MIX + row * D + 1024 + h * 128 + vg * 16; *(u32x4*)op = o0; *(u32x4*)(op + 8) = o1; }
}

constexpr int LRU_LDS_X = 0, LRU_LDS_MS = LCH * 512 * 4, LRU_LDS_BYTES = LRU_LDS_MS + LCH * 4;
template <int PASS>
__global__ void __launch_bounds__(512) k_lru(const bf16_t* HIN, const float* conv_w, const float* conv_b, const float* wa, const float* ba, const float* wx, const float* bx,
                                             const float* lam, const float* gain, float* AGA, float* AGH, bf16_t* MIX) {
    extern __shared__ __attribute__((aligned(16))) unsigned char lds[];
    float* XS = (float*)(lds + LRU_LDS_X); float* MS = (float*)(lds + LRU_LDS_MS);
    const int u = blockIdx.x, ch = u % NLCH, b = u / NLCH;
    const int c = threadIdx.x, lane = c & 63, w = c >> 6, h = c >> 6, j = c & 63;
    const size_t t0 = (size_t)b * SEQ + ch * LCH;
    const float w0 = conv_w[c], w1 = conv_w[512 + c], w2 = conv_w[1024 + c], w3 = conv_w[1536 + c], cb = conv_b[c];
    float xm3 = 0.f, xm2 = 0.f, xm1 = 0.f;
    if (ch > 0) { xm3 = bf2f(HIN[(t0 - 3) * IN_COLS + C_LX + c]); xm2 = bf2f(HIN[(t0 - 2) * IN_COLS + C_LX + c]); xm1 = bf2f(HIN[(t0 - 1) * IN_COLS + C_LX + c]); }
    float xc[LCH];
#pragma unroll
    for (int t = 0; t < LCH; ++t) { const float x0 = bf2f(HIN[(t0 + t) * IN_COLS + C_LX + c]); xc[t] = w0 * xm3 + w1 * xm2 + w2 * xm1 + w3 * x0 + cb; xm3 = xm2; xm2 = xm1; xm1 = x0; XS[t * 512 + c] = xc[t]; }
    __syncthreads();
    float ra[LCH], ia[LCH];
    { const float bav = ba[c], bxv = bx[c];
#pragma unroll
      for (int t = 0; t < LCH; ++t) { ra[t] = bav; ia[t] = bxv; } }
    const float* wap = wa + (size_t)h * 4096 + j; const float* wxp = wx + (size_t)h * 4096 + j;
    for (int i4 = 0; i4 < 16; ++i4) {
        const float a0 = wap[(4 * i4 + 0) * 64], a1 = wap[(4 * i4 + 1) * 64], a2 = wap[(4 * i4 + 2) * 64], a3 = wap[(4 * i4 + 3) * 64];
        const float x0 = wxp[(4 * i4 + 0) * 64], x1 = wxp[(4 * i4 + 1) * 64], x2 = wxp[(4 * i4 + 2) * 64], x3 = wxp[(4 * i4 + 3) * 64];
#pragma unroll
        for (int t = 0; t < LCH; ++t) { const float4 xv = *(const float4*)(XS + t * 512 + h * 64 + 4 * i4);
            ra[t] += xv.x * a0 + xv.y * a1 + xv.z * a2 + xv.w * a3; ia[t] += xv.x * x0 + xv.y * x1 + xv.z * x2 + xv.w * x3; }
    }
    const float lm = lam[c]; const float sp = (lm > 15.f) ? __expf(-lm) : log1pf(__expf(-lm));
    float hl = 0.f, pr = 1.f;
    float hv[LCH], pv[LCH];
#pragma unroll
    for (int t = 0; t < LCH; ++t) { const float r = sigmoidf_(ra[t]), ig = sigmoidf_(ia[t]); const float la = -8.0f * r * sp; const float a = __expf(la);
        const float uu = sqrtf(fmaxf(-expm1f(2.0f * la), 0.f)) * (ig * xc[t]); hl = a * hl + uu; pr *= a; hv[t] = hl; pv[t] = pr; }
    if (PASS == 1) { AGA[((size_t)b * NLCH + ch) * 512 + c] = pr; AGH[((size_t)b * NLCH + ch) * 512 + c] = hl; return; }
    float carry = 0.f;
    for (int jc = 0; jc < ch; ++jc) { const size_t o = ((size_t)b * NLCH + jc) * 512 + c; carry = AGA[o] * carry + AGH[o]; }
    __syncthreads();
#pragma unroll
    for (int t = 0; t < LCH; ++t) { hv[t] += pv[t] * carry; XS[t * 512 + c] = hv[t] * hv[t]; }
    __syncthreads();
    for (int t = w; t < LCH; t += 8) { float q = 0.f;
#pragma unroll
        for (int m = 0; m < 8; ++m) q += XS[t * 512 + lane + 64 * m];
        q = wave_sum(q); if (lane == 0) MS[t] = q; }
    __syncthreads();
    const float gn = gain[c];
#pragma unroll
    for (int t = 0; t < LCH; ++t) { const float rinv = 1.0f / sqrtf(MS[t] * (1.0f / 512.f) + 1e-6f); const float gv = bf2f(HIN[(t0 + t) * IN_COLS + C_LG + c]);
        MIX[(t0 + t) * D + 1536 + c] = f2bf(hv[t] * rinv * gn * gelu_tanh(gv)); }
}

__global__ void __launch_bounds__(512) k_router(const float* X, const float* W, float* LOG) {
    __shared__ float xs[32 * 68]; __shared__ float ws[64 * 64];
    const int tid = threadIdx.x, tt = tid >> 4, eg = tid & 15; const size_t t0 = (size_t)blockIdx.x * 32;
    float a0 = 0.f, a1 = 0.f, a2 = 0.f, a3 = 0.f;
    for (int k0 = 0; k0 < D; k0 += 64) {
        const float4 xv = *(const float4*)(X + (t0 + (tid >> 4)) * D + k0 + (tid & 15) * 4);
        const float4 wv0 = *(const float4*)(W + (size_t)(k0 + (tid >> 4)) * 64 + (tid & 15) * 4), wv1 = *(const float4*)(W + (size_t)(k0 + 32 + (tid >> 4)) * 64 + (tid & 15) * 4);
        __syncthreads();
        *(float4*)(xs + (tid >> 4) * 68 + (tid & 15) * 4) = xv; *(float4*)(ws + (tid >> 4) * 64 + (tid & 15) * 4) = wv0; *(float4*)(ws + (32 + (tid >> 4)) * 64 + (tid & 15) * 4) = wv1;
        __syncthreads();
#pragma unroll 16
        for (int kk = 0; kk < 64; ++kk) { const float x = xs[tt * 68 + kk]; const float4 wv = *(const float4*)(ws + kk * 64 + eg * 4); a0 += x * wv.x; a1 += x * wv.y; a2 += x * wv.z; a3 += x * wv.w; }
    }
    *(float4*)(LOG + (t0 + tt) * 64 + eg * 4) = make_float4(a0, a1, a2, a3);
}
__global__ void __launch_bounds__(512) k_route(const float* LOG, const float* rbias, int* TKIDX, float* TKGATE, int* CNT) {
    __shared__ int hist[64];
    const int tid = threadIdx.x, lane = tid & 63, w = tid >> 6;
    if (tid < 64) hist[tid] = 0;
    __syncthreads();
    const float rb = rbias[lane];
    for (int i = 0; i < 16; ++i) {
        const size_t t = (size_t)blockIdx.x * RCHUNK + w * 16 + i;
        const float score = sigmoidf_(LOG[t * 64 + lane]); const float sel = score + rb;
        float m1 = sel; m1 = fmaxf(m1, __shfl_xor(m1, 1)); m1 = fmaxf(m1, __shfl_xor(m1, 2)); m1 = fmaxf(m1, __shfl_xor(m1, 4));
        const unsigned long long eqm = __ballot(sel == m1); const int gbase = lane & ~7; const unsigned grp = (unsigned)((eqm >> gbase) & 0xffull); const int first = gbase + __builtin_ctz(grp);
        float m2 = (lane == first) ? -3.0e38f : sel; m2 = fmaxf(m2, __shfl_xor(m2, 1)); m2 = fmaxf(m2, __shfl_xor(m2, 2)); m2 = fmaxf(m2, __shfl_xor(m2, 4));
        const float gs = m1 + m2; const int mygrp = lane >> 3;
        int grank = 0;
#pragma unroll
        for (int g2 = 0; g2 < 8; ++g2) { const float og = __shfl(gs, g2 * 8); grank += (og > gs || (og == gs && g2 < mygrp)) ? 1 : 0; }
        const float msel = (grank < 4) ? sel : -1e30f;
        int rank = 0;
#pragma unroll 16
        for (int e2 = 0; e2 < 64; ++e2) { const float os = __shfl(msel, e2); rank += (os > msel || (os == msel && e2 < lane)) ? 1 : 0; }
        const bool pick = rank < TOPK;
        const float wsum = wave_sum(pick ? score : 0.f);
        if (pick) { TKIDX[t * TOPK + rank] = lane; TKGATE[t * TOPK + rank] = score / wsum * 2.5f; atomicAdd(&hist[lane], 1); }
    }
    __syncthreads();
    if (tid < 64) CNT[blockIdx.x * 64 + tid] = hist[tid];
}
__global__ void __launch_bounds__(512) k_assign(const int* CNT, const int* TKIDX, const float* TKGATE, int* ROWTOK, int* ROWDST, float* ROWGATE, int* TILEE) {
    __shared__ int total[64], mybase[64], off[65]; __shared__ unsigned mask[64 * 4];
    const int tid = threadIdx.x, chunk = blockIdx.x;
    if (tid < 256) mask[tid] = 0u;
    if (tid < 64) { int tot = 0, base = 0; for (int cc = 0; cc < NRCHUNK; ++cc) { const int v = CNT[cc * 64 + tid]; tot += v; if (cc < chunk) base += v; } total[tid] = tot; mybase[tid] = base; }
    __syncthreads();
    if (tid == 0) { int o = 0; for (int e = 0; e < 64; ++e) { off[e] = o; o += ((total[e] + 255) / 256) * 256; } off[64] = o; }
    __syncthreads();
    int e_[2]; int tt_[2], k_[2];
#pragma unroll
    for (int r = 0; r < 2; ++r) { const int p = tid + 512 * r; tt_[r] = p >> 3; k_[r] = p & 7; e_[r] = TKIDX[((size_t)chunk * RCHUNK + tt_[r]) * TOPK + k_[r]]; atomicOr(&mask[e_[r] * 4 + (tt_[r] >> 5)], 1u << (tt_[r] & 31)); }
    __syncthreads();
#pragma unroll
    for (int r = 0; r < 2; ++r) { const int e = e_[r], tt = tt_[r]; int rank = 0;
        for (int wd = 0; wd < (tt >> 5); ++wd) rank += __builtin_popcount(mask[e * 4 + wd]);
        rank += __builtin_popcount(mask[e * 4 + (tt >> 5)] & ((1u << (tt & 31)) - 1u));
        const int slot = off[e] + mybase[e] + rank; const int t = chunk * RCHUNK + tt;
        ROWTOK[slot] = t; ROWDST[slot] = t * TOPK + k_[r]; ROWGATE[slot] = TKGATE[(size_t)t * TOPK + k_[r]]; }
    if (chunk < 64) { const int e = chunk; const int lo = off[e] + total[e], hi = off[e + 1]; for (int s = lo + tid; s < hi; s += 512) { ROWTOK[s] = -1; ROWDST[s] = -1; ROWGATE[s] = 0.f; } }
    if (chunk == 0) { for (int e = tid >> 3; e < 64; e += 64) { for (int i = off[e] / 256 + (tid & 7); i < off[e + 1] / 256; i += 8) TILEE[i] = e; } if (tid == 0) TILEE[MAXTILES] = off[64] / 256; }
}

template <class F> static bool set_lds(F f, int bytes) { return hipFuncSetAttribute((const void*)f, hipFuncAttributeMaxDynamicSharedMemorySize, bytes) == hipSuccess; }

extern "C" void kernel_launch(void* const* d_in, const int* in_sizes, int n_in, void* d_out, int out_size, void* d_ws, size_t ws_size, hipStream_t stream) {
    if (n_in != 32 || out_size != T * D || ws_size < WS_END) { fprintf(stderr, "kernel_launch: unexpected sizes n_in %d out %d ws %zu (need %zu)\n", n_in, out_size, ws_size, (size_t)WS_END); return; }
    const float* x = (const float*)d_in[0]; const float* p = (const float*)d_in[1]; const int* positions = (const int*)d_in[2];
    const float* w_in = (const float*)d_in[3]; const float* w_out = (const float*)d_in[4]; const float* attn_sinks = (const float*)d_in[5]; const float* attn_norm = (const float*)d_in[6];
    const float* hg_lb_logits = (const float*)d_in[7]; const float* hg_norm = (const float*)d_in[8];
    const float* lru_conv_w = (const float*)d_in[9]; const float* lru_conv_b = (const float*)d_in[10]; const float* lru_wa = (const float*)d_in[11]; const float* lru_ba = (const float*)d_in[12];
    const float* lru_wx = (const float*)d_in[13]; const float* lru_bx = (const float*)d_in[14]; const float* lru_lambda = (const float*)d_in[15]; const float* lru_norm = (const float*)d_in[16];
    const float* ln1_g = (const float*)d_in[17]; const float* ln1_b = (const float*)d_in[18]; const float* router_w = (const float*)d_in[19]; const float* router_b = (const float*)d_in[20];
    const float* exp_w1 = (const float*)d_in[21]; const float* exp_w3 = (const float*)d_in[22]; const float* exp_w2 = (const float*)d_in[23];
    const float* sh_w1 = (const float*)d_in[24]; const float* sh_w3 = (const float*)d_in[25]; const float* sh_w2 = (const float*)d_in[26];
    const float* ple_w = (const float*)d_in[27]; const float* ple_gate_w = (const float*)d_in[28]; const float* ple_gate_b = (const float*)d_in[29];
    const float* ln2_g = (const float*)d_in[30]; const float* ln2_b = (const float*)d_in[31];
    unsigned char* ws = (unsigned char*)d_ws; float* out = (float*)d_out;
    int* CNT = (int*)(ws + WS_CNT); int* TILEE = (int*)(ws + WS_TILEE); float* LOG = (float*)(ws + WS_LOGITS); int* TKIDX = (int*)(ws + WS_TKIDX); float* TKGATE = (float*)(ws + WS_TKGATE);
    int* ROWTOK = (int*)(ws + WS_ROWTOK); int* ROWDST = (int*)(ws + WS_ROWDST); float* ROWGATE = (float*)(ws + WS_ROWGATE); float* AGA = (float*)(ws + WS_LRUA); float* AGH = (float*)(ws + WS_LRUH);
    float* SSQ = (float*)(ws + WS_SSQ); float* DV = (float*)(ws + WS_DV); bf16_t* Y = (bf16_t*)(ws + WS_Y); bf16_t* HIN = (bf16_t*)(ws + WS_HIN); bf16_t* MIX = (bf16_t*)(ws + WS_MIX);
    float* SST = (float*)(ws + WS_SST); bf16_t* HM = (bf16_t*)(ws + WS_HM); bf16_t* HS = (bf16_t*)(ws + WS_HS); bf16_t* U = (bf16_t*)(ws + WS_U);

    static bool attr_ok = false;
    if (!attr_ok) {
        bool ok = set_lds(k_attn, AT_LDS_BYTES) && set_lds(k_hg1, H1_LDS_BYTES) && set_lds(k_hg3, H3_LDS_BYTES) && set_lds(k_lru<1>, LRU_LDS_BYTES) && set_lds(k_lru<2>, LRU_LDS_BYTES);
        if (!ok) { fprintf(stderr, "kernel_launch: hipFuncSetAttribute failed\n"); return; }
        attr_ok = true;
    }
    RotTab rt; for (int i = 0; i < 8; ++i) rt.invf[i] = std::pow(500000.0, -(double)i / 8.0);
    const dim3 blk(512);
    for (int l = 0; l < DEPTH; ++l) {
        const float* xin = (l == 0) ? x : out;
        k_sgemm<true><<<dim3(IN_COLS / 128, T / 128), blk, 0, stream>>>(APlain{(const char*)xin, (size_t)D * 4}, BPlain{w_in + (size_t)l * D * IN_COLS, IN_COLS, 0}, EBf16{HIN, IN_COLS, 0}, nullptr, D, 0);
        k_attn<<<512, blk, AT_LDS_BYTES, stream>>>(HIN, positions, attn_sinks + l * 16, MIX, SSQ, rt);
        k_attn_fin<<<T / 8, blk, 0, stream>>>(MIX, SSQ, attn_norm + l * 1024);
        k_hg1<<<2048, blk, H1_LDS_BYTES, stream>>>(HIN, hg_lb_logits, SST, DV, l, 0);
        k_hg2<<<256, blk, 0, stream>>>(SST, DV);
        k_hg3<<<2048, blk, H3_LDS_BYTES, stream>>>(HIN, hg_lb_logits, SST, hg_norm + l * 512, MIX, l, 0);
        k_lru<1><<<BATCH * NLCH, blk, LRU_LDS_BYTES, stream>>>(HIN, lru_conv_w + l * 2048, lru_conv_b + l * 512, lru_wa + (size_t)l * 32768, lru_ba + l * 512, lru_wx + (size_t)l * 32768, lru_bx + l * 512,
                                                              lru_lambda + l * 512, lru_norm + l * 512, AGA, AGH, MIX);
        k_lru<2><<<BATCH * NLCH, blk, LRU_LDS_BYTES, stream>>>(HIN, lru_conv_w + l * 2048, lru_conv_b + l * 512, lru_wa + (size_t)l * 32768, lru_ba + l * 512, lru_wx + (size_t)l * 32768, lru_bx + l * 512,
                                                              lru_lambda + l * 512, lru_norm + l * 512, AGA, AGH, MIX);
        k_sgemm<false><<<dim3(D / 128, T / 128), blk, 0, stream>>>(APlain{(const char*)MIX, (size_t)D * 2}, BPlain{w_out + (size_t)l * D * D, D, 0}, EResid{xin, out, ALPHA, 0}, nullptr, D, 0);
        k_layernorm<<<T / 8, blk, 0, stream>>>(out, ln1_g + l * D, ln1_b + l * D);
        k_router<<<T / 32, blk, 0, stream>>>(out, router_w + (size_t)l * D * 64, LOG);
        k_route<<<NRCHUNK, blk, 0, stream>>>(LOG, router_b + l * 64, TKIDX, TKGATE, CNT);
        k_assign<<<NRCHUNK, blk, 0, stream>>>(CNT, TKIDX, TKGATE, ROWTOK, ROWDST, ROWGATE, TILEE);
        k_sgemm<true><<<dim3(EF / 64, MAXTILES * 2), blk, 0, stream>>>(AGather{out, ROWTOK}, BGroupSwiglu{exp_w1 + (size_t)l * NE * D * EF, exp_w3 + (size_t)l * NE * D * EF, TILEE, EF, 0}, ESwiglu{HM}, TILEE + MAXTILES, D, 0);
        k_sgemm<false><<<dim3(D / 128, MAXTILES * 2), blk, 0, stream>>>(APlain{(const char*)HM, (size_t)EF * 2}, BGroup{exp_w2 + (size_t)l * NE * EF * D, TILEE, D, 0}, EScatter{Y, ROWDST, ROWGATE}, TILEE + MAXTILES, EF, 0);
        k_sgemm<true><<<dim3(EF / 64, T / 128), blk, 0, stream>>>(APlain{(const char*)out, (size_t)D * 4}, BSwiglu{sh_w1 + (size_t)l * D * EF, sh_w3 + (size_t)l * D * EF, EF, 0}, ESwiglu{HS}, nullptr, D, 0);
        k_sgemm<true><<<dim3(D / 128, T / 128), blk, 0, stream>>>(APlain{(const char*)(p + (size_t)l * T * PLE), (size_t)PLE * 4}, BPlain{ple_w + (size_t)l * PLE * D, D, 0}, EBf16{U, D, 0}, nullptr, PLE, 0);
        k_sgemm<true><<<dim3(D / 128, T / 128), blk, 0, stream>>>(APlain{(const char*)out, (size_t)D * 4}, BPlain{ple_gate_w + (size_t)l * D * D, D, 0}, EGate{U, ple_gate_b + l * D}, nullptr, D, 0);
        k_sgemm<false><<<dim3(D / 128, T / 128), blk, 0, stream>>>(APlain{(const char*)HS, (size_t)EF * 2}, BPlain{sh_w2 + (size_t)l * EF * D, D, 0}, ECombine{out, U, Y, ALPHA, 0}, nullptr, EF, 0);
        k_layernorm<<<T / 8, blk, 0, stream>>>(out, ln2_g + l * D, ln2_b + l * D);
    }
}
```

```cpp
#include <hip/hip_runtime.h>
#include <cstdio>
#include <cmath>

#ifndef MK_PER_PHASE
#define MK_PER_PHASE 0
#endif

typedef unsigned short bf16_t;
typedef short bf16x8 __attribute__((ext_vector_type(8)));
typedef float f32x4 __attribute__((ext_vector_type(4)));
typedef unsigned u32x4 __attribute__((ext_vector_type(4)));
typedef unsigned u32x2 __attribute__((ext_vector_type(2)));
#define LAS __attribute__((address_space(3)))

constexpr int BATCH = 8, SEQ = 4096, T = BATCH * SEQ, D = 2048, DEPTH = 2, PLE = 256;
constexpr int IN_COLS = 4352;
constexpr int C_AQ = 0, C_AK = 1024, C_AV = 1152, C_HQ = 1280, C_HF = 1792, C_HI = 2304, C_HG = 2816, C_LX = 3328, C_LG = 3840;
constexpr int NE = 64, TOPK = 8, EF = 512;
constexpr int A_ROWS = T * TOPK;
constexpr int MAXTILES = A_ROWS / 256 + NE;
constexpr int A_PAD = MAXTILES * 256;
constexpr float ALPHA = 1.41421356237309515f;
constexpr int RCHUNK = 128, NRCHUNK = T / RCHUNK;
constexpr int LCH = 32, NLCH = SEQ / LCH;

constexpr size_t MiB = 1u << 20;
constexpr size_t WS_CTL = 0, CTL_ZERO_BYTES = 256 * 1024;
constexpr size_t WS_CNT = 1 * MiB;
constexpr size_t WS_TILEE = 2 * MiB;
constexpr size_t WS_LOGITS = 4 * MiB;
constexpr size_t WS_TKIDX = 12 * MiB;
constexpr size_t WS_TKGATE = 13 * MiB;
constexpr size_t WS_ROWTOK = 14 * MiB;
constexpr size_t WS_ROWDST = 16 * MiB;
constexpr size_t WS_ROWGATE = 18 * MiB;
constexpr size_t WS_LRUA = 20 * MiB;
constexpr size_t WS_LRUH = 22 * MiB;
constexpr size_t WS_SSQ = 24 * MiB;
constexpr size_t WS_DV = 25 * MiB;
constexpr size_t WS_Y = 32 * MiB;
constexpr size_t WS_HIN = 32 * MiB;
constexpr size_t WS_MIX = 304 * MiB;
constexpr size_t WS_SST = 432 * MiB;
constexpr size_t WS_PB = 560 * MiB;
constexpr size_t WS_XB = 1056 * MiB;
constexpr size_t WS_HM = 1184 * MiB;
constexpr size_t WS_U = 1488 * MiB;
constexpr size_t WS_W = 1616 * MiB;
constexpr size_t WO_WIN = 0, WO_WOUT = 17 * MiB, WO_GATE = 25 * MiB, WO_PLEW = 33 * MiB, WO_W2 = 34 * MiB, WO_W13 = 164 * MiB, WO_END = 424 * MiB;
constexpr size_t WS_END = WS_W + WO_END;
static_assert((size_t)IN_COLS * D * 2 <= WO_WOUT - WO_WIN && (size_t)65 * 2048 * 512 * 2 <= WO_W13 - WO_W2 && (size_t)65 * 1024 * 2048 * 2 <= WO_END - WO_W13, "weight map");
static_assert(WS_PB + (size_t)T * PLE * 2 <= WS_Y + (size_t)A_ROWS * D * 2 && WS_Y + (size_t)A_ROWS * D * 2 <= WS_XB && WS_HM + (size_t)(A_PAD + T) * EF * 2 <= WS_U, "ws map");

__device__ __forceinline__ int lane_id() { return (int)__builtin_amdgcn_mbcnt_hi(~0u, __builtin_amdgcn_mbcnt_lo(~0u, 0u)); }
__device__ __forceinline__ int opaque_tid(int wv) { int t = wv * 64 + lane_id(); asm volatile("" : "+v"(t)); return t; }
__device__ __forceinline__ bf16_t f2bf(float f) { unsigned u = __float_as_uint(f); u += 0x7fffu + ((u >> 16) & 1u); return (bf16_t)(u >> 16); }
__device__ __forceinline__ float bf2f(bf16_t b) { return __uint_as_float(((unsigned)b) << 16); }
__device__ __forceinline__ float bflo(unsigned w) { return __uint_as_float(w << 16); }
__device__ __forceinline__ float bfhi(unsigned w) { return __uint_as_float(w & 0xffff0000u); }
__device__ __forceinline__ unsigned pk2(float lo, float hi) { return (unsigned)f2bf(lo) | ((unsigned)f2bf(hi) << 16); }
__device__ __forceinline__ unsigned cvt_pk_bf16(float lo, float hi) { unsigned r; asm volatile("v_cvt_pk_bf16_f32 %0, %1, %2" : "=v"(r) : "v"(lo), "v"(hi)); return r; }
__device__ __forceinline__ float sigmoidf_(float x) { return 1.0f / (1.0f + __expf(-x)); }
__device__ __forceinline__ float siluf_(float x) { return x / (1.0f + __expf(-x)); }
__device__ __forceinline__ float gelu_tanh(float x) { const float u = 0.7978845608028654f * (x + 0.044715f * x * x * x); const float e = __expf(2.0f * u); const float th = 1.0f - 2.0f / (e + 1.0f); return 0.5f * x * (1.0f + th); }
__device__ __forceinline__ float wave_sum(float v) {
#pragma unroll
    for (int o = 1; o < 64; o <<= 1) v += __shfl_xor(v, o);
    return v;
}
__device__ __forceinline__ void sincos_pos(float pos, double invf, float& s, float& c) {
    const double a = (double)pos * invf;
    const double q = rint(a * 0.63661977236758134308);
    const float r = (float)(a - q * 1.57079632679489661923);
    const int qi = ((int)q) & 3;
    const float r2 = r * r;
    const float sp = r * (1.0f + r2 * (-1.6666667163e-1f + r2 * (8.3333337680e-3f + r2 * (-1.9841270114e-4f + r2 * 2.7557314297e-6f))));
    const float cp = 1.0f + r2 * (-0.5f + r2 * (4.1666667908e-2f + r2 * (-1.3888889225e-3f + r2 * (2.4801587642e-5f + r2 * -2.7557314297e-7f))));
    const float ss = (qi & 1) ? cp : sp, cc = (qi & 1) ? sp : cp;
    s = (qi & 2) ? -ss : ss;
    c = ((qi + 1) & 2) ? -cc : cc;
}
namespace pg8 {
constexpr int BM = 256, BK = 64, HALF = 128, HTB = HALF * BK * 2, STAGE_BYTES = 8 * HTB, NXCD = 8, WGM = 8;
__host__ __device__ __forceinline__ int lds_byte(int r, int c) { const int st = (r >> 4) * 2 + (c >> 5), rr = r & 15, cc = c & 31, ob = rr * 64 + cc * 2; return st * 1024 + (ob ^ (((ob >> 9) & 1) << 5)); }
__host__ __device__ __forceinline__ void stage_rc(int b, int& R, int& C) { const int st = b / 1024, sb = b % 1024, swz = sb ^ (((sb >> 9) & 1) << 5); R = (st >> 1) * 16 + swz / 64; C = (st & 1) * 32 + (swz % 64) / 2; }
__host__ __device__ __forceinline__ int perm32(int rho) { const int n = rho >> 4, i = rho & 15; return 8 * (i >> 2) + 4 * n + (i & 3); }

struct Unit { int brow, pn, orow, tab; };

__device__ __forceinline__ int xcd_remap(int L, int nwg) { const int q = nwg / NXCD, r = nwg % NXCD, xcd = L % NXCD, off = L / NXCD; return (xcd < r ? xcd * (q + 1) : r * (q + 1) + (xcd - r) * q) + off; }

struct DenseOrder {
    int nM, nN, nwg, G, c, start;
    __device__ void init(int M, int N, int G_, int c_, int start_) { nM = M / BM; nN = N / BM; nwg = nM * nN; G = G_; c = c_; start = start_ % G_; }
    __device__ bool next(int i, Unit& u) const {
        const long L = (long)(i + (c < start ? 1 : 0)) * G + c - start; if (L >= nwg) return false;
        const int wgid = xcd_remap((int)L, nwg);
        const int nig = WGM * nN, gid = wgid / nig, fm = gid * WGM, gsz = (nM - fm) < WGM ? (nM - fm) : WGM;
        const int pm = fm + ((wgid % nig) % gsz); u.pn = (wgid % nig) / gsz; u.orow = pm * BM; u.brow = u.pn * BM; u.tab = 0; return true;
    }
};
struct UpOrder {
    const int* tile_e; int ntiles, nwg, G, c, start;
    __device__ void init(const int* te, int nt_, int G_, int c_, int start_) { tile_e = te; ntiles = nt_; nwg = (nt_ + T / BM) * 4; G = G_; c = c_; start = start_ % G_; }
    __device__ bool next(int i, Unit& u) const {
        const long L = (long)(i + (c < start ? 1 : 0)) * G + c - start; if (L >= nwg) return false;
        const int wgid = xcd_remap((int)L, nwg); const int tile = wgid >> 2; u.pn = wgid & 3; u.tab = i;
        if (tile < ntiles) { u.brow = tile_e[tile] * 1024 + u.pn * BM; u.orow = tile * BM; }
        else { u.brow = 64 * 1024 + u.pn * BM; u.orow = A_PAD + (tile - ntiles) * BM; }
        return true;
    }
};
struct DownOrder {
    const int* tile_e; int lo, hi, t0;
    __device__ void init(const int* te, int nt_, int G_, int c_) { tile_e = te; const int n = nt_ * 8; const int vc = (G_ % 8 == 0) ? (c_ % 8) * (G_ / 8) + c_ / 8 : c_;
        lo = (int)(((long)vc * n) / G_); hi = (int)(((long)(vc + 1) * n) / G_); t0 = lo >> 3; }
    __device__ bool next(int i, Unit& u) const {
        const int id = lo + i; if (id >= hi) return false;
        const int tile = id >> 3; u.pn = id & 7; u.orow = tile * BM; u.brow = tile_e[tile] * 2048 + u.pn * BM; u.tab = tile - t0; return true;
    }
};

struct ListOrder { const LAS int* tab; int n;
    __device__ __forceinline__ bool next(int i, Unit& u) const { if (i >= n) return false; const LAS int* p = tab + i * 4;
        u.brow = __builtin_amdgcn_readfirstlane(p[0]); u.pn = __builtin_amdgcn_readfirstlane(p[1]); u.orow = __builtin_amdgcn_readfirstlane(p[2]); u.tab = __builtin_amdgcn_readfirstlane(p[3]); return true; } };
template <class Sched> __device__ __forceinline__ ListOrder build_list(const int wv, LAS int* tab, int cap, const Sched& S) {
    __syncthreads();
    int n = 0; Unit u;
    for (; n < cap && S.next(n, u); ++n) if (opaque_tid(wv) == 0) { tab[n * 4 + 0] = u.brow; tab[n * 4 + 1] = u.pn; tab[n * 4 + 2] = u.orow; tab[n * 4 + 3] = u.tab; }
    __syncthreads();
    ListOrder L; L.tab = tab; L.n = n; return L;
}

struct EpiStoreBf16 { static constexpr bool PERM = true; bf16_t* O; int ldo; int pad;
    __device__ __forceinline__ void operator()(const f32x4 (&acc)[2][2][4][2], const Unit& u, int wr, int wc, int fr, int fq) const {
        const int row0 = u.orow + wr * 64 + fr, col0 = u.pn * BM + wc * 32 + 8 * fq;
#pragma unroll
        for (int ai = 0; ai < 2; ++ai)
#pragma unroll
            for (int m = 0; m < 4; ++m) { bf16_t* rowp = O + (size_t)(row0 + ai * HALF + m * 16) * ldo + col0;
#pragma unroll
                for (int bj = 0; bj < 2; ++bj) { const f32x4 v0 = acc[ai][bj][m][0], v1 = acc[ai][bj][m][1];
                    u32x4 w; w.x = cvt_pk_bf16(v0[0], v0[1]); w.y = cvt_pk_bf16(v0[2], v0[3]); w.z = cvt_pk_bf16(v1[0], v1[1]); w.w = cvt_pk_bf16(v1[2], v1[3]);
                    *(u32x4*)(rowp + bj * HALF) = w; } }
    } };
struct EpiSwiglu { static constexpr bool PERM = true; bf16_t* H;
    __device__ __forceinline__ void operator()(const f32x4 (&acc)[2][2][4][2], const Unit& u, int wr, int wc, int fr, int fq) const {
        const int row0 = u.orow + wr * 64 + fr, col0 = u.pn * HALF + wc * 32 + 8 * fq;
#pragma unroll
        for (int ai = 0; ai < 2; ++ai)
#pragma unroll
            for (int m = 0; m < 4; ++m) { const f32x4 g0 = acc[ai][0][m][0], g1 = acc[ai][0][m][1], u0 = acc[ai][1][m][0], u1 = acc[ai][1][m][1];
                u32x4 w; w.x = cvt_pk_bf16(siluf_(g0[0]) * u0[0], siluf_(g0[1]) * u0[1]); w.y = cvt_pk_bf16(siluf_(g0[2]) * u0[2], siluf_(g0[3]) * u0[3]);
                w.z = cvt_pk_bf16(siluf_(g1[0]) * u1[0], siluf_(g1[1]) * u1[1]); w.w = cvt_pk_bf16(siluf_(g1[2]) * u1[2], siluf_(g1[3]) * u1[3]);
                *(u32x4*)(H + (size_t)(row0 + ai * HALF + m * 16) * EF + col0) = w; }
    } };
struct EpiResid { static constexpr bool PERM = false; const float* xres; float* out; float alpha; int pad;
    __device__ __forceinline__ void operator()(const f32x4 (&acc)[2][2][4][2], const Unit& u, int wr, int wc, int fr, int fq) const {
        const int row0 = u.orow + wr * 64 + fr, col0 = u.pn * BM + wc * 32 + 4 * fq;
#pragma unroll
        for (int ai = 0; ai < 2; ++ai)
#pragma unroll
            for (int m = 0; m < 4; ++m) { const size_t off = (size_t)(row0 + ai * HALF + m * 16) * D + col0;
#pragma unroll
                for (int bj = 0; bj < 2; ++bj)
#pragma unroll
                    for (int n = 0; n < 2; ++n) { const f32x4 x = *(const f32x4*)(xres + off + bj * HALF + n * 16); *(f32x4*)(out + off + bj * HALF + n * 16) = x * alpha + acc[ai][bj][m][n]; }
                asm volatile("" ::: "memory"); }
    } };
struct EpiAccum { static constexpr bool PERM = false; float* xio;
    __device__ __forceinline__ void operator()(const f32x4 (&acc)[2][2][4][2], const Unit& u, int wr, int wc, int fr, int fq) const {
        const int row0 = u.orow + wr * 64 + fr, col0 = u.pn * BM + wc * 32 + 4 * fq;
#pragma unroll
        for (int ai = 0; ai < 2; ++ai)
#pragma unroll
            for (int m = 0; m < 4; ++m) { const size_t off = (size_t)(row0 + ai * HALF + m * 16) * D + col0;
#pragma unroll
                for (int bj = 0; bj < 2; ++bj)
#pragma unroll
                    for (int n = 0; n < 2; ++n) { const f32x4 x = *(const f32x4*)(xio + off + bj * HALF + n * 16); *(f32x4*)(xio + off + bj * HALF + n * 16) = x + acc[ai][bj][m][n]; }
                asm volatile("" ::: "memory"); }
    } };
struct EpiScatter { static constexpr bool PERM = true; bf16_t* Y; const LAS int* tdst; const LAS float* tgate;
    __device__ __forceinline__ void operator()(const f32x4 (&acc)[2][2][4][2], const Unit& u, int wr, int wc, int fr, int fq) const {
        const int r0 = u.tab * BM + wr * 64 + fr, col0 = u.pn * BM + wc * 32 + 8 * fq;
#pragma unroll
        for (int ai = 0; ai < 2; ++ai)
#pragma unroll
            for (int m = 0; m < 4; ++m) { const int dst = tdst[r0 + ai * HALF + m * 16]; const float g = tgate[r0 + ai * HALF + m * 16];
                if (dst >= 0) { bf16_t* rowp = Y + (size_t)dst * D + col0;
#pragma unroll
                    for (int bj = 0; bj < 2; ++bj) { const f32x4 v0 = acc[ai][bj][m][0] * g, v1 = acc[ai][bj][m][1] * g;
                        u32x4 w; w.x = cvt_pk_bf16(v0[0], v0[1]); w.y = cvt_pk_bf16(v0[2], v0[3]); w.z = cvt_pk_bf16(v1[0], v1[1]); w.w = cvt_pk_bf16(v1[2], v1[3]);
                        *(u32x4*)(rowp + bj * HALF) = w; } } }
    } };
struct EpiGate { static constexpr bool PERM = true; float* xio; const bf16_t* U; const float* bias; float alpha; int pad;
    __device__ __forceinline__ void operator()(const f32x4 (&acc)[2][2][4][2], const Unit& u, int wr, int wc, int fr, int fq) const {
        const int row0 = u.orow + wr * 64 + fr, col0 = u.pn * BM + wc * 32 + 8 * fq;
        f32x4 bv[2][2];
#pragma unroll
        for (int bj = 0; bj < 2; ++bj)
#pragma unroll
            for (int n = 0; n < 2; ++n) bv[bj][n] = *(const f32x4*)(bias + col0 + bj * HALF + 4 * n);
#pragma unroll
        for (int ai = 0; ai < 2; ++ai)
#pragma unroll
            for (int m = 0; m < 4; ++m) { const size_t off = (size_t)(row0 + ai * HALF + m * 16) * D + col0;
#pragma unroll
                for (int bj = 0; bj < 2; ++bj) { const u32x4 uu = *(const u32x4*)(U + off + bj * HALF); const f32x4 x0 = *(const f32x4*)(xio + off + bj * HALF), x1 = *(const f32x4*)(xio + off + bj * HALF + 4);
                    const f32x4 a0 = acc[ai][bj][m][0] + bv[bj][0], a1 = acc[ai][bj][m][1] + bv[bj][1];
                    f32x4 o0, o1;
                    o0[0] = alpha * x0[0] + sigmoidf_(a0[0]) * bflo(uu.x); o0[1] = alpha * x0[1] + sigmoidf_(a0[1]) * bfhi(uu.x); o0[2] = alpha * x0[2] + sigmoidf_(a0[2]) * bflo(uu.y); o0[3] = alpha * x0[3] + sigmoidf_(a0[3]) * bfhi(uu.y);
                    o1[0] = alpha * x1[0] + sigmoidf_(a1[0]) * bflo(uu.z); o1[1] = alpha * x1[1] + sigmoidf_(a1[1]) * bfhi(uu.z); o1[2] = alpha * x1[2] + sigmoidf_(a1[2]) * bflo(uu.w); o1[3] = alpha * x1[3] + sigmoidf_(a1[3]) * bfhi(uu.w);
                    *(f32x4*)(xio + off + bj * HALF) = o0; *(f32x4*)(xio + off + bj * HALF + 4) = o1; }
                asm volatile("" ::: "memory"); }
    } };

template <int K, class Epi, class Sched, bool GATHER>
__device__ __forceinline__ void gemm_phase(const int wv, LAS unsigned char* lds, const bf16_t* Ap_, const bf16_t* Btp_, const Sched& S, const Epi& E, const LAS int* gtab) {
    const bf16_t* Ap = Ap_; const bf16_t* Btp = Btp_; asm volatile("" : "+s"(Ap), "+s"(Btp));
    const int tid = opaque_tid(wv), wid = wv, lane = tid & 63, wr = wid >> 2, wc = wid & 3, fr = lane & 15, fq = lane >> 4;
    constexpr int nt = K / BK;
    unsigned voffB[2], vc[2][2];
#pragma unroll
    for (int i = 0; i < 2; ++i) { int R, C; stage_rc(tid * 16 + i * 8192, R, C); const int Rb = Epi::PERM ? ((R & ~31) + perm32(R & 31)) : R; voffB[i] = (unsigned)(Rb * K + C) * 2u; }
    constexpr size_t kstep = (size_t)(BK * 2);
    constexpr size_t hstep = (size_t)HALF * K * 2;
    constexpr size_t hA = GATHER ? (size_t)0 : hstep;
    const unsigned ldsw = (unsigned)wid * 1024u;
    const int aoff = lds_byte(wr * 64 + fr, fq * 8), boff = lds_byte(wc * 32 + fr, fq * 8);
#define PG8_SA(b, h) (((b) * 2 + (h)) * HTB)
#define PG8_SB(b, h) ((4 + (b) * 2 + (h)) * HTB)
#define PG8_STAGE(bufoff, gbase, voff) do { _Pragma("unroll") for (int _i = 0; _i < 2; ++_i) \
        __builtin_amdgcn_global_load_lds((const unsigned*)((const char*)(gbase) + (voff)[_i]), (LAS unsigned*)(lds + (bufoff) + ldsw + _i * 8192), 16, 0, 0); } while (0)
#define PG8_SETA(v, slot) do { _Pragma("unroll") for (int _h = 0; _h < 2; ++_h) _Pragma("unroll") for (int _i = 0; _i < 2; ++_i) { int _R, _C; stage_rc(tid * 16 + _i * 8192, _R, _C); \
        (v)[_h][_i] = GATHER ? ((unsigned)gtab[(slot) * BM + _h * HALF + _R] * (unsigned)K + (unsigned)_C) * 2u : (unsigned)(_R * K + _C) * 2u; } } while (0)
#define PG8_LDA(dst, b, h) do { _Pragma("unroll") for (int m = 0; m < 4; ++m) _Pragma("unroll") for (int k = 0; k < 2; ++k) dst[m][k] = *(const LAS bf16x8*)(lds + PG8_SA(b, h) + aoff + m * 2048 + k * 1024); } while (0)
#define PG8_LDB(dst, b, h) do { _Pragma("unroll") for (int n = 0; n < 2; ++n) _Pragma("unroll") for (int k = 0; k < 2; ++k) dst[n][k] = *(const LAS bf16x8*)(lds + PG8_SB(b, h) + boff + n * 2048 + k * 1024); } while (0)
#define PG8_MMA(ai, bj, At, Bt) do { __builtin_amdgcn_s_setprio(1); _Pragma("unroll") for (int m = 0; m < 4; ++m) _Pragma("unroll") for (int n = 0; n < 2; ++n) _Pragma("unroll") for (int k = 0; k < 2; ++k) \
        acc[ai][bj][m][n] = __builtin_amdgcn_mfma_f32_16x16x32_bf16(Bt[n][k], At[m][k], acc[ai][bj][m][n], 0, 0, 0); __builtin_amdgcn_s_setprio(0); } while (0)
#define PG8_WAIT_V(n) asm volatile("s_waitcnt vmcnt(" #n ")" ::: "memory")
#define PG8_WAIT_L(n) asm volatile("s_waitcnt lgkmcnt(" #n ")" ::: "memory")
#define PG8_BAR __builtin_amdgcn_s_barrier()
#define PG8_SCHED __builtin_amdgcn_sched_barrier(0)
    Unit cur, nxt; int ui = 0;
    if (!S.next(0, cur)) return;
    f32x4 acc[2][2][4][2];
#pragma unroll
    for (int a = 0; a < 2; ++a)
#pragma unroll
        for (int b = 0; b < 2; ++b)
#pragma unroll
            for (int m = 0; m < 4; ++m)
#pragma unroll
                for (int n = 0; n < 2; ++n) acc[a][b][m][n] = (f32x4){0.f, 0.f, 0.f, 0.f};
    bf16x8 At[4][2], B0[2][2], B1[2][2];
    PG8_SETA(vc, cur.tab);
    const char* cA = (const char*)Ap + (GATHER ? (size_t)0 : (size_t)cur.orow * K * 2); const char* cB = (const char*)Btp + (size_t)cur.brow * K * 2;
    PG8_STAGE(PG8_SB(0, 0), cB, voffB); PG8_STAGE(PG8_SB(0, 1), cB + hstep, voffB); PG8_STAGE(PG8_SA(0, 0), cA, vc[0]); PG8_STAGE(PG8_SA(0, 1), cA + hA, vc[1]);
    if (wr == 1) PG8_BAR;
    PG8_WAIT_V(2); PG8_BAR;
    PG8_STAGE(PG8_SB(1, 0), cB + kstep, voffB); PG8_STAGE(PG8_SA(1, 0), cA + kstep, vc[0]); PG8_STAGE(PG8_SB(1, 1), cB + hstep + kstep, voffB);
    PG8_WAIT_V(6); PG8_BAR;
    for (;;) {
        const bool has_next = S.next(ui + 1, nxt);
        const char* nA = has_next ? (const char*)Ap + (GATHER ? (size_t)0 : (size_t)nxt.orow * K * 2) : cA; const char* nB = has_next ? (const char*)Btp + (size_t)nxt.brow * K * 2 : cB;
        for (int t = 0; t < nt; t += 2) {
            const bool last = (t == nt - 2);
            const char* a1 = cA + (size_t)(t + 1) * kstep;
            const char* a2 = last ? nA : cA + (size_t)(t + 2) * kstep; const char* b2 = last ? nB : cB + (size_t)(t + 2) * kstep;
            const char* a3 = a2 + kstep; const char* b3 = b2 + kstep;
            PG8_LDB(B0, 0, 0); PG8_LDB(B1, 0, 1); PG8_SCHED; PG8_LDA(At, 0, 0); PG8_STAGE(PG8_SA(1, 1), a1 + hA, vc[1]);
            if (GATHER && last && has_next) PG8_SETA(vc, nxt.tab);
            PG8_WAIT_V(8); PG8_WAIT_L(0); PG8_BAR; PG8_MMA(0, 0, At, B0); PG8_MMA(0, 1, At, B1); PG8_BAR; PG8_SCHED;
            PG8_LDA(At, 0, 1); PG8_STAGE(PG8_SB(0, 0), b2, voffB); PG8_STAGE(PG8_SB(0, 1), b2 + hstep, voffB); PG8_STAGE(PG8_SA(0, 0), a2, vc[0]);
            PG8_WAIT_V(8); PG8_WAIT_L(0); PG8_BAR; PG8_MMA(1, 0, At, B0); PG8_MMA(1, 1, At, B1); PG8_BAR; PG8_SCHED;
            PG8_LDB(B0, 1, 0); PG8_LDB(B1, 1, 1); PG8_SCHED; PG8_LDA(At, 1, 0); PG8_STAGE(PG8_SA(0, 1), a2 + hA, vc[1]);
            PG8_WAIT_V(8); PG8_WAIT_L(0); PG8_BAR; PG8_MMA(0, 0, At, B0); PG8_MMA(0, 1, At, B1); PG8_BAR; PG8_SCHED;
            PG8_LDA(At, 1, 1); PG8_STAGE(PG8_SB(1, 0), b3, voffB); PG8_STAGE(PG8_SB(1, 1), b3 + hstep, voffB); PG8_STAGE(PG8_SA(1, 0), a3, vc[0]);
            PG8_WAIT_V(8); PG8_WAIT_L(0); PG8_BAR; PG8_MMA(1, 0, At, B0); PG8_MMA(1, 1, At, B1); PG8_BAR; PG8_SCHED;
        }
        if (wr == 0) PG8_BAR;
        { const int l2 = opaque_tid(wv) & 63; E(acc, cur, wr, wc, l2 & 15, l2 >> 4); }
        if (!has_next) break;
#pragma unroll
        for (int a = 0; a < 2; ++a)
#pragma unroll
            for (int b = 0; b < 2; ++b)
#pragma unroll
                for (int m = 0; m < 4; ++m)
#pragma unroll
                    for (int n = 0; n < 2; ++n) acc[a][b][m][n] = (f32x4){0.f, 0.f, 0.f, 0.f};
        cur = nxt; cA = nA; cB = nB; ++ui;
        if (wr == 1) PG8_BAR;
    }
    PG8_WAIT_V(0);
    PG8_BAR;
#undef PG8_SA
#undef PG8_SB
#undef PG8_STAGE
#undef PG8_SETA
#undef PG8_LDA
#undef PG8_LDB
#undef PG8_MMA
#undef PG8_WAIT_V
#undef PG8_WAIT_L
#undef PG8_BAR
#undef PG8_SCHED
}
}
constexpr int NWAVES = 8, NTHR = 512;
constexpr int RING_OFF = 0, RING_BYTES = 131072;
constexpr int TAB_OFF = RING_BYTES, TAB_BYTES = 24576;
constexpr int MISC_OFF = TAB_OFF + TAB_BYTES;
constexpr int ULIST_OFF = MISC_OFF + 128, ULIST_CAP = 64;
constexpr int LDS_BYTES = 160 * 1024;
static_assert(ULIST_OFF + ULIST_CAP * 16 <= LDS_BYTES, "LDS map");
constexpr int CW_BAR = 1024;

#define XB_TMO      128
#define XB_XCNT(j)  (256  + 64 * (j))
#define XB_XSUB(j)  (1280 + 64 * (j))
#define XB_XGEN(j)  (2304 + 64 * (j))
#define XB_TOP      3328
#define XB_TOPGEN   3392
#define XCD_BAR_WORDS 3456
#define XB_SPIN_CAP (1u << 22)
static_assert((CW_BAR + XCD_BAR_WORDS) * 4 <= (int)CTL_ZERO_BYTES, "barrier words inside the memset region");

__device__ __forceinline__ unsigned xb_ld(unsigned* p)              { return __hip_atomic_load(p, __ATOMIC_RELAXED, __HIP_MEMORY_SCOPE_AGENT); }
__device__ __forceinline__ unsigned xb_add(unsigned* p, unsigned v) { return __hip_atomic_fetch_add(p, v, __ATOMIC_RELAXED, __HIP_MEMORY_SCOPE_AGENT); }
__device__ __forceinline__ unsigned xb_xcc_id() { return (unsigned)__builtin_amdgcn_s_getreg((3 << 11) | 20) & 0xFu; }
#define XB_SPIN(cond, bar) do { unsigned _sp = 0; while (cond) { __builtin_amdgcn_s_sleep(1); \
    if ((++_sp & 255u) == 0u) { if (xb_ld(&(bar)[XB_TMO])) break; if (_sp > XB_SPIN_CAP) { atomicAdd(&(bar)[XB_TMO], 1u); break; } } } } while (0)

struct XcdBarrier { unsigned* bar; unsigned x; volatile LAS unsigned* st; int w0; };
__device__ __forceinline__ XcdBarrier xcd_barrier_post(unsigned* bar, volatile LAS unsigned* st) {
    XcdBarrier b; b.bar = bar; b.x = xb_xcc_id(); b.st = st; b.w0 = (__builtin_amdgcn_readfirstlane(threadIdx.x >> 6) == 0) ? 1 : 0;
    if (threadIdx.x == 0) (void)xb_add(&bar[XB_XCNT(b.x)], 1u);
    return b;
}
__device__ __forceinline__ void xcd_barrier_complete(unsigned* bar, unsigned x, unsigned& nloc, unsigned& nx) {
    const unsigned G = gridDim.x * gridDim.y * gridDim.z;
    unsigned sum, cnt, mine, sp = 0u;
    for (;;) {
        sum = 0u; cnt = 0u; mine = 0u;
#pragma unroll
        for (unsigned j = 0; j < 16; ++j) { const unsigned c = xb_ld(&bar[XB_XCNT(j)]); sum += c; cnt += (c > 0u) ? 1u : 0u; mine = (j == x) ? c : mine; }
        if (sum == G) break;
        __builtin_amdgcn_s_sleep(1);
        if ((++sp & 255u) == 0u) { if (xb_ld(&bar[XB_TMO])) break; if (sp > XB_SPIN_CAP) { atomicAdd(&bar[XB_TMO], 1u); break; } }
    }
    nloc = mine > 0u ? mine : 1u; nx = cnt > 0u ? cnt : 1u;
}
__device__ __forceinline__ void xcd_barrier(const XcdBarrier& b) {
    asm volatile("s_waitcnt vmcnt(0)" ::: "memory");
    __syncthreads();
    if (b.w0 && lane_id() == 0) {
        unsigned* bar = b.bar;
        __builtin_amdgcn_s_waitcnt(0);
        unsigned nloc = b.st[0], nx = b.st[1];
        if (nloc == 0u) { xcd_barrier_complete(bar, b.x, nloc, nx); b.st[0] = nloc; b.st[1] = nx; }
        const unsigned old = xb_add(&bar[XB_XSUB(b.x)], 1u);
        const unsigned gen = old / nloc;
        if (old + 1u == (gen + 1u) * nloc) {
            __builtin_amdgcn_fence(__ATOMIC_RELEASE, "agent");
            asm volatile("s_waitcnt vmcnt(0)" ::: "memory");
            const unsigned og = xb_add(&bar[XB_TOP], 1u);
            const unsigned tg = og / nx;
            if (og + 1u == (tg + 1u) * nx) xb_add(&bar[XB_TOPGEN], 1u);
            else XB_SPIN(xb_ld(&bar[XB_TOPGEN]) == tg, bar);
            __builtin_amdgcn_fence(__ATOMIC_ACQUIRE, "agent");
            xb_add(&bar[XB_XGEN(b.x)], 1u);
            asm volatile("s_waitcnt vmcnt(0)" ::: "memory");
        } else {
            XB_SPIN(xb_ld(&bar[XB_XGEN(b.x)]) == gen, bar);
            __builtin_amdgcn_fence(__ATOMIC_ACQUIRE, "agent");
            asm volatile("s_waitcnt vmcnt(0)" ::: "memory");
        }
    }
    __syncthreads();
}

__device__ __forceinline__ void transpose_item(const float* W, int K, int N, bf16_t* WT, int k0, int n0, int drow, LAS float* scr, int lane) {
#pragma unroll 8
    for (int i = 0; i < 32; ++i) { const int kk = 2 * i + (lane >> 5); scr[kk * 33 + (lane & 31)] = W[(size_t)(k0 + kk) * N + n0 + (lane & 31)]; }
    asm volatile("s_waitcnt lgkmcnt(0)" ::: "memory");
    const int c = lane & 7;
#pragma unroll
    for (int j = 0; j < 4; ++j) { const int n = (lane >> 3) + 8 * j; const LAS float* s = scr + (8 * c) * 33 + n;
        u32x4 o; o.x = pk2(s[0 * 33], s[1 * 33]); o.y = pk2(s[2 * 33], s[3 * 33]); o.z = pk2(s[4 * 33], s[5 * 33]); o.w = pk2(s[6 * 33], s[7 * 33]);
        *(u32x4*)(WT + (size_t)(drow + n) * K + k0 + 8 * c) = o; }
    asm volatile("s_waitcnt lgkmcnt(0)" ::: "memory");
}
struct WPtrs { const float *w_in, *w_out, *gate, *plew, *ew1, *ew3, *ew2, *sw1, *sw3, *sw2; };
__device__ __forceinline__ void convert_weights(unsigned char* ldsb, const WPtrs& P, unsigned char* wsw, int gw, int NGW, int wave, int lane) {
    LAS float* scr = (LAS float*)((LAS unsigned char*)ldsb + wave * 8448);
    bf16_t* WIN = (bf16_t*)(wsw + WO_WIN); bf16_t* WOUT = (bf16_t*)(wsw + WO_WOUT); bf16_t* GATE = (bf16_t*)(wsw + WO_GATE); bf16_t* PLEW = (bf16_t*)(wsw + WO_PLEW);
    bf16_t* W2 = (bf16_t*)(wsw + WO_W2); bf16_t* W13 = (bf16_t*)(wsw + WO_W13);
    constexpr int I_IN = (D / 64) * (IN_COLS / 32), I_OUT = (D / 64) * (D / 32), I_GATE = I_OUT, I_PLE = (PLE / 64) * (D / 32), I_W2 = (EF / 64) * (D / 32), I_W13 = (D / 64) * (EF / 32);
    constexpr int NITEMS = I_IN + I_OUT + I_GATE + I_PLE + 65 * I_W2 + 65 * 2 * I_W13;
    for (int it = gw; it < NITEMS; it += NGW) {
        int r = it;
        if (r < I_IN) { const int nb = IN_COLS / 32; transpose_item(P.w_in, D, IN_COLS, WIN, 64 * (r / nb), 32 * (r % nb), 32 * (r % nb), scr, lane); continue; } r -= I_IN;
        if (r < I_OUT) { const int nb = D / 32; transpose_item(P.w_out, D, D, WOUT, 64 * (r / nb), 32 * (r % nb), 32 * (r % nb), scr, lane); continue; } r -= I_OUT;
        if (r < I_GATE) { const int nb = D / 32; transpose_item(P.gate, D, D, GATE, 64 * (r / nb), 32 * (r % nb), 32 * (r % nb), scr, lane); continue; } r -= I_GATE;
        if (r < I_PLE) { const int nb = D / 32; transpose_item(P.plew, PLE, D, PLEW, 64 * (r / nb), 32 * (r % nb), 32 * (r % nb), scr, lane); continue; } r -= I_PLE;
        if (r < 65 * I_W2) { const int e = r / I_W2, q = r % I_W2, nb = D / 32; const float* src = (e < 64) ? P.ew2 + (size_t)e * EF * D : P.sw2;
            transpose_item(src, EF, D, W2 + (size_t)e * D * EF, 64 * (q / nb), 32 * (q % nb), 32 * (q % nb), scr, lane); continue; } r -= 65 * I_W2;
        { const int e = r / (2 * I_W13), q2 = r % (2 * I_W13), mth = q2 / I_W13, q = q2 % I_W13, nb = EF / 32; const int n0 = 32 * (q % nb);
          const float* src = (e < 64) ? (mth ? P.ew3 : P.ew1) + (size_t)e * D * EF : (mth ? P.sw3 : P.sw1);
          transpose_item(src, D, EF, W13 + (size_t)e * 1024 * D, 64 * (q / nb), n0, 256 * (n0 >> 7) + 128 * mth + (n0 & 127), scr, lane); }
    }
}
__device__ __forceinline__ void convert_rows(const float* src, bf16_t* dst, size_t n, size_t gtid, size_t nthr) {
    for (size_t i = gtid * 8; i < n; i += nthr * 8) { const float4 a = *(const float4*)(src + i), b = *(const float4*)(src + i + 4);
        u32x4 o; o.x = pk2(a.x, a.y); o.y = pk2(a.z, a.w); o.z = pk2(b.x, b.y); o.w = pk2(b.z, b.w); *(u32x4*)(dst + i) = o; }
}

template <bool ADDY>
__device__ __forceinline__ void ln_row(float* xrow, const float* gain, const float* bias, bf16_t* xb, const bf16_t* yrows, int lane) {
    float4* xr = (float4*)xrow + lane;
    float4 v[8]; float s = 0.f;
#pragma unroll
    for (int j = 0; j < 8; ++j) v[j] = xr[64 * j];
    if (ADDY) {
#pragma unroll
        for (int k = 0; k < TOPK; ++k) { const u32x2* yp = (const u32x2*)(yrows + (size_t)k * D) + lane;
#pragma unroll
            for (int j = 0; j < 8; ++j) { const u32x2 y = yp[64 * j]; v[j].x += bflo(y.x); v[j].y += bfhi(y.x); v[j].z += bflo(y.y); v[j].w += bfhi(y.y); } }
    }
#pragma unroll
    for (int j = 0; j < 8; ++j) s += (v[j].x + v[j].y) + (v[j].z + v[j].w);
    const float mean = wave_sum(s) * (1.f / D); float q = 0.f;
#pragma unroll
    for (int j = 0; j < 8; ++j) { v[j].x -= mean; v[j].y -= mean; v[j].z -= mean; v[j].w -= mean; q += (v[j].x * v[j].x + v[j].y * v[j].y) + (v[j].z * v[j].z + v[j].w * v[j].w); }
    const float rstd = 1.0f / sqrtf(wave_sum(q) * (1.f / D) + 1e-5f);
    u32x2* ob = (u32x2*)xb + lane;
#pragma unroll
    for (int j = 0; j < 8; ++j) { const float4 g = ((const float4*)gain)[lane + 64 * j], b = ((const float4*)bias)[lane + 64 * j];
        float4 o; o.x = v[j].x * rstd * g.x + b.x; o.y = v[j].y * rstd * g.y + b.y; o.z = v[j].z * rstd * g.z + b.z; o.w = v[j].w * rstd * g.w + b.w; xr[64 * j] = o;
        u32x2 w; w.x = pk2(o.x, o.y); w.y = pk2(o.z, o.w); ob[64 * j] = w; }
}
constexpr int AT_KS = 72, AT_VS = 264, AT_PS = 168;
constexpr int AT_LDS_K = 0, AT_LDS_V = 256 * AT_KS * 2, AT_LDS_P = AT_LDS_V + (64 * AT_VS + 64) * 2, AT_LDS_SS = AT_LDS_P + 8 * 16 * AT_PS * 2, AT_LDS_BYTES = AT_LDS_SS + 8 * 128 * 4;
static_assert(AT_LDS_BYTES <= RING_BYTES, "attention LDS");
struct RotTab { double invf[8]; };
__device__ __forceinline__ void attn_unit(const int wv, unsigned char* lds, int u, const bf16_t* HIN, const int* positions, const float* sinks, bf16_t* MIX, float* SSQ, const RotTab& rt) {
    bf16_t* Ks = (bf16_t*)(lds + AT_LDS_K); bf16_t* Vt = (bf16_t*)(lds + AT_LDS_V); bf16_t* Ps = (bf16_t*)(lds + AT_LDS_P); float* SS = (float*)(lds + AT_LDS_SS);
    const int g = u & 1, n = (u >> 1) & 31, b = u >> 6;
    const int tid = opaque_tid(wv), lane = tid & 63, w = tid >> 6;
    __syncthreads();
    {
        const int j = tid >> 1, half = tid & 1; const int kp = 128 * (n - 1) + j;
        u32x4 kv[4], vv[4];
        if (kp >= 0) {
            const bf16_t* kr = HIN + (size_t)(b * SEQ + kp) * IN_COLS + C_AK + g * 64 + half * 32;
            const bf16_t* vr = HIN + (size_t)(b * SEQ + kp) * IN_COLS + C_AV + g * 64 + half * 32;
#pragma unroll
            for (int i = 0; i < 4; ++i) { kv[i] = *(const u32x4*)(kr + 8 * i); vv[i] = *(const u32x4*)(vr + 8 * i); }
            if (half == 0) {
                const float pos = (float)positions[b * SEQ + kp];
                float t1[8], t2[8];
                t1[0] = bflo(kv[0].x); t1[1] = bfhi(kv[0].x); t1[2] = bflo(kv[0].y); t1[3] = bfhi(kv[0].y); t1[4] = bflo(kv[0].z); t1[5] = bfhi(kv[0].z); t1[6] = bflo(kv[0].w); t1[7] = bfhi(kv[0].w);
                t2[0] = bflo(kv[1].x); t2[1] = bfhi(kv[1].x); t2[2] = bflo(kv[1].y); t2[3] = bfhi(kv[1].y); t2[4] = bflo(kv[1].z); t2[5] = bfhi(kv[1].z); t2[6] = bflo(kv[1].w); t2[7] = bfhi(kv[1].w);
#pragma unroll
                for (int i = 0; i < 8; ++i) { float s, c; sincos_pos(pos, rt.invf[i], s, c); const float a = t1[i] * c - t2[i] * s, bb = t2[i] * c + t1[i] * s; t1[i] = a; t2[i] = bb; }
                kv[0].x = pk2(t1[0], t1[1]); kv[0].y = pk2(t1[2], t1[3]); kv[0].z = pk2(t1[4], t1[5]); kv[0].w = pk2(t1[6], t1[7]);
                kv[1].x = pk2(t2[0], t2[1]); kv[1].y = pk2(t2[2], t2[3]); kv[1].z = pk2(t2[4], t2[5]); kv[1].w = pk2(t2[6], t2[7]);
            }
        } else {
#pragma unroll
            for (int i = 0; i < 4; ++i) { kv[i] = (u32x4){0u, 0u, 0u, 0u}; vv[i] = (u32x4){0u, 0u, 0u, 0u}; }
        }
#pragma unroll
        for (int i = 0; i < 4; ++i) *(u32x4*)(Ks + j * AT_KS + half * 32 + 8 * i) = kv[i];
#pragma unroll
        for (int i = 0; i < 4; ++i) { const int d = half * 32 + 8 * i;
            Vt[(d + 0) * AT_VS + j] = (bf16_t)(vv[i].x & 0xffff); Vt[(d + 1) * AT_VS + j] = (bf16_t)(vv[i].x >> 16); Vt[(d + 2) * AT_VS + j] = (bf16_t)(vv[i].y & 0xffff); Vt[(d + 3) * AT_VS + j] = (bf16_t)(vv[i].y >> 16);
            Vt[(d + 4) * AT_VS + j] = (bf16_t)(vv[i].z & 0xffff); Vt[(d + 5) * AT_VS + j] = (bf16_t)(vv[i].z >> 16); Vt[(d + 6) * AT_VS + j] = (bf16_t)(vv[i].w & 0xffff); Vt[(d + 7) * AT_VS + j] = (bf16_t)(vv[i].w >> 16); }
        if (tid < 64) {
#pragma unroll
            for (int i = 0; i < 8; ++i) Vt[tid * AT_VS + 256 + i] = 0;
            Vt[64 * AT_VS + tid] = 0;
        }
        for (int i = tid; i < 8 * 16 * 24; i += NTHR) { const int r = i / 24, c = 144 + i % 24; Ps[r * AT_PS + c] = 0; }
    }
    __syncthreads();
    const int hq = g * 8 + w; const float sink = sinks[hq];
    const int lr = lane & 15, lg = lane >> 4;
    bf16_t* Pw = Ps + w * 16 * AT_PS;
    for (int qi = 0; qi < 8; ++qi) {
        const int tq = b * SEQ + n * 128 + qi * 16 + lr;
        const bf16_t* qr = HIN + (size_t)tq * IN_COLS + C_AQ + hq * 64 + lg * 8;
        u32x4 q0 = *(const u32x4*)qr; const u32x4 q1 = *(const u32x4*)(qr + 32);
        {
            u32x4 other; other.x = __shfl_xor(q0.x, 16); other.y = __shfl_xor(q0.y, 16); other.z = __shfl_xor(q0.z, 16); other.w = __shfl_xor(q0.w, 16);
            if (lg < 2) {
                const float pos = (float)positions[tq];
                float mv[8], ov[8];
                mv[0] = bflo(q0.x); mv[1] = bfhi(q0.x); mv[2] = bflo(q0.y); mv[3] = bfhi(q0.y); mv[4] = bflo(q0.z); mv[5] = bfhi(q0.z); mv[6] = bflo(q0.w); mv[7] = bfhi(q0.w);
                ov[0] = bflo(other.x); ov[1] = bfhi(other.x); ov[2] = bflo(other.y); ov[3] = bfhi(other.y); ov[4] = bflo(other.z); ov[5] = bfhi(other.z); ov[6] = bflo(other.w); ov[7] = bfhi(other.w);
#pragma unroll
                for (int i = 0; i < 8; ++i) { float s, c; sincos_pos(pos, rt.invf[i], s, c); mv[i] = (lg == 0) ? (mv[i] * c - ov[i] * s) : (mv[i] * c + ov[i] * s); }
                q0.x = pk2(mv[0], mv[1]); q0.y = pk2(mv[2], mv[3]); q0.z = pk2(mv[4], mv[5]); q0.w = pk2(mv[6], mv[7]);
            }
        }
        const bf16x8 qa0 = __builtin_bit_cast(bf16x8, q0), qa1 = __builtin_bit_cast(bf16x8, q1);
        f32x4 s[9];
#pragma unroll
        for (int jt = 0; jt < 9; ++jt) {
            const int jr = (qi + jt) * 16 + lr;
            const bf16x8 kb0 = *(const bf16x8*)(Ks + jr * AT_KS + lg * 8), kb1 = *(const bf16x8*)(Ks + jr * AT_KS + 32 + lg * 8);
            f32x4 a = (f32x4){0.f, 0.f, 0.f, 0.f};
            a = __builtin_amdgcn_mfma_f32_16x16x32_bf16(qa0, kb0, a, 0, 0, 0);
            a = __builtin_amdgcn_mfma_f32_16x16x32_bf16(qa1, kb1, a, 0, 0, 0);
            s[jt] = a;
        }
        float mx[4] = {-1e30f, -1e30f, -1e30f, -1e30f};
#pragma unroll
        for (int jt = 0; jt < 9; ++jt)
#pragma unroll
            for (int r = 0; r < 4; ++r) { const int i = 16 * qi + 4 * lg + r, j = 16 * (qi + jt) + lr; const bool ok = (j >= i + 1) && (j <= i + 128) && (n > 0 || j >= 128);
                const float v = ok ? s[jt][r] * 0.125f : -1e30f; s[jt][r] = v; mx[r] = fmaxf(mx[r], v); }
        float sm[4];
#pragma unroll
        for (int r = 0; r < 4; ++r) { float m = mx[r]; m = fmaxf(m, __shfl_xor(m, 1)); m = fmaxf(m, __shfl_xor(m, 2)); m = fmaxf(m, __shfl_xor(m, 4)); m = fmaxf(m, __shfl_xor(m, 8)); m = fmaxf(m, sink); mx[r] = m; sm[r] = 0.f; }
#pragma unroll
        for (int jt = 0; jt < 9; ++jt)
#pragma unroll
            for (int r = 0; r < 4; ++r) { const float p = (s[jt][r] > -1e29f) ? __expf(s[jt][r] - mx[r]) : 0.f; s[jt][r] = p; sm[r] += p; }
#pragma unroll
        for (int r = 0; r < 4; ++r) { float t = sm[r]; t += __shfl_xor(t, 1); t += __shfl_xor(t, 2); t += __shfl_xor(t, 4); t += __shfl_xor(t, 8); sm[r] = 1.0f / (t + __expf(sink - mx[r])); }
#pragma unroll
        for (int jt = 0; jt < 9; ++jt)
#pragma unroll
            for (int r = 0; r < 4; ++r) Pw[(4 * lg + r) * AT_PS + jt * 16 + lr] = f2bf(s[jt][r] * sm[r]);
        asm volatile("s_waitcnt lgkmcnt(0)" ::: "memory");
        f32x4 o[4];
#pragma unroll
        for (int dt = 0; dt < 4; ++dt) o[dt] = (f32x4){0.f, 0.f, 0.f, 0.f};
#pragma unroll
        for (int ks = 0; ks < 5; ++ks) {
            const bf16x8 pa = *(const bf16x8*)(Pw + lr * AT_PS + ks * 32 + lg * 8);
#pragma unroll
            for (int dt = 0; dt < 4; ++dt) { const bf16x8 vb = *(const bf16x8*)(Vt + (dt * 16 + lr) * AT_VS + qi * 16 + ks * 32 + lg * 8); o[dt] = __builtin_amdgcn_mfma_f32_16x16x32_bf16(pa, vb, o[dt], 0, 0, 0); }
        }
#pragma unroll
        for (int r = 0; r < 4; ++r) {
            const int t = b * SEQ + n * 128 + qi * 16 + 4 * lg + r; float q = 0.f;
#pragma unroll
            for (int dt = 0; dt < 4; ++dt) { const float v = o[dt][r]; q += v * v; MIX[(size_t)t * D + hq * 64 + dt * 16 + lr] = f2bf(v); }
            q += __shfl_xor(q, 1); q += __shfl_xor(q, 2); q += __shfl_xor(q, 4); q += __shfl_xor(q, 8);
            if (lr == 0) SS[w * 128 + qi * 16 + 4 * lg + r] = q;
        }
    }
    __syncthreads();
    if (tid < 128) { float q = 0.f;
#pragma unroll
        for (int ww = 0; ww < 8; ++ww) q += SS[ww * 128 + tid];
        SSQ[(size_t)(b * SEQ + n * 128 + tid) * 2 + g] = q; }
}
__device__ __forceinline__ void attn_fin_row(bf16_t* MIX, const float* SSQ, const float* gain, int t, int lane) {
    const float sc = 1.0f / sqrtf((SSQ[(size_t)t * 2] + SSQ[(size_t)t * 2 + 1]) * (1.0f / 1024.f) + 1e-6f);
    u32x4* p = (u32x4*)(MIX + (size_t)t * D) + lane * 2;
#pragma unroll
    for (int h = 0; h < 2; ++h) { u32x4 v = p[h]; const int c = lane * 16 + h * 8; const float4 g0 = *(const float4*)(gain + c), g1 = *(const float4*)(gain + c + 4);
        v.x = pk2(bflo(v.x) * sc * g0.x, bfhi(v.x) * sc * g0.y); v.y = pk2(bflo(v.y) * sc * g0.z, bfhi(v.y) * sc * g0.w);
        v.z = pk2(bflo(v.z) * sc * g1.x, bfhi(v.z) * sc * g1.y); v.w = pk2(bflo(v.w) * sc * g1.z, bfhi(v.w) * sc * g1.w);
        p[h] = v; }
}

constexpr int HG_S72 = 72, HG_S136 = 136;
__device__ __forceinline__ float hg_lb(const float* lbl, int layer, int col) { if (layer == 0) return 0.f; return sigmoidf_(lbl[512 + col] - lbl[col]); }
constexpr int H1_LDS_KT = 0, H1_LDS_VT = 128 * HG_S72 * 2, H1_LDS_TOT = 2 * 128 * HG_S72 * 2, H1_LDS_BYTES = H1_LDS_TOT + 4 * 128 * 4;
__device__ __forceinline__ void hg1_unit(const int wv, unsigned char* lds, int u, const bf16_t* HIN, const float* lbl, int layer, float* SST, float* DV) {
    bf16_t* KT = (bf16_t*)(lds + H1_LDS_KT); bf16_t* VT = (bf16_t*)(lds + H1_LDS_VT); float* TOT = (float*)(lds + H1_LDS_TOT);
    const int c = u & 63, h = (u >> 6) & 3, b = u >> 8;
    const int tid = opaque_tid(wv), lane = tid & 63, w = tid >> 6, k = tid & 127, tq = tid >> 7;
    const size_t t0 = (size_t)b * SEQ + c * 64;
    const float lb = hg_lb(lbl, layer, h * 128 + k);
    __syncthreads();
    float bl[16], kf[16]; float cum = 0.f;
#pragma unroll
    for (int i = 0; i < 16; ++i) { const size_t row = (t0 + 16 * tq + i) * IN_COLS; const float fp = bf2f(HIN[row + C_HF + h * 128 + k]);
        const float sg = sigmoidf_(fp); const float f = lb + (1.f - lb) * sg; cum += __logf(fmaxf(f, 1e-30f)); bl[i] = cum; kf[i] = (1.f - lb) * sigmoidf_(-fp);
        VT[k * HG_S72 + 16 * tq + i] = HIN[row + C_HI + h * 128 + k]; }
    TOT[tq * 128 + k] = cum;
    __syncthreads();
    float pre = 0.f, total = 0.f;
#pragma unroll
    for (int j = 0; j < 4; ++j) { const float tj = TOT[j * 128 + k]; if (j < tq) pre += tj; total += tj; }
#pragma unroll
    for (int i = 0; i < 16; ++i) KT[k * HG_S72 + 16 * tq + i] = f2bf(kf[i] * __expf(total - (pre + bl[i])));
    if (tq == 0) DV[(size_t)u * 128 + k] = __expf(total);
    __syncthreads();
    const int lr = lane & 15, lg = lane >> 4;
    bf16x8 a[2];
#pragma unroll
    for (int ks = 0; ks < 2; ++ks) a[ks] = *(const bf16x8*)(VT + (w * 16 + lr) * HG_S72 + ks * 32 + lg * 8);
    float* out = SST + (size_t)u * 16384;
#pragma unroll
    for (int kt = 0; kt < 8; ++kt) {
        f32x4 acc = (f32x4){0.f, 0.f, 0.f, 0.f};
#pragma unroll
        for (int ks = 0; ks < 2; ++ks) { const bf16x8 bb = *(const bf16x8*)(KT + (kt * 16 + lr) * HG_S72 + ks * 32 + lg * 8); acc = __builtin_amdgcn_mfma_f32_16x16x32_bf16(a[ks], bb, acc, 0, 0, 0); }
#pragma unroll
        for (int r = 0; r < 4; ++r) out[(w * 16 + 4 * lg + r) * 128 + kt * 16 + lr] = acc[r];
    }
}
__device__ __forceinline__ void hg2_unit(const int wv, int u, float* SST, const float* DV) {
    const int bh = u >> 3, part = u & 7, e4 = part * 512 + opaque_tid(wv);
    const int k4 = (e4 & 31) * 4;
    float4 S = make_float4(0.f, 0.f, 0.f, 0.f);
    for (int c = 0; c < 64; ++c) {
        const size_t uu = (size_t)bh * 64 + c;
        float4* p = (float4*)(SST + uu * 16384) + e4;
        const float4 ds = *p; const float4 dv = *(const float4*)(DV + uu * 128 + k4);
        *p = S;
        S.x = dv.x * S.x + ds.x; S.y = dv.y * S.y + ds.y; S.z = dv.z * S.z + ds.z; S.w = dv.w * S.w + ds.w;
    }
}
constexpr int H3_QI = 0, H3_QE = H3_QI + 64 * HG_S136 * 2, H3_KI = H3_QE + 64 * HG_S136 * 2, H3_VT = H3_KI + 160 * HG_S136 * 2, H3_SB = H3_VT + 128 * HG_S72 * 2,
              H3_SC = H3_SB + 128 * HG_S136 * 2, H3_TOT = H3_SC + 64 * HG_S72 * 2, H3_LDS_BYTES = H3_TOT + 4 * 128 * 4;
constexpr int H3_OB = H3_KI, HG_OS = 132;
static_assert(H3_LDS_BYTES <= MISC_OFF, "HGRN2 LDS");
__device__ __forceinline__ void hg3_unit(const int wv, unsigned char* lds, int u, const bf16_t* HIN, const float* lbl, int layer, const float* SST, const float* gain, bf16_t* MIX) {
    bf16_t* QI = (bf16_t*)(lds + H3_QI); bf16_t* QE = (bf16_t*)(lds + H3_QE); bf16_t* KI = (bf16_t*)(lds + H3_KI); bf16_t* VT = (bf16_t*)(lds + H3_VT);
    bf16_t* SB = (bf16_t*)(lds + H3_SB); bf16_t* SC = (bf16_t*)(lds + H3_SC); float* TOT = (float*)(lds + H3_TOT); float* OB = (float*)(lds + H3_OB);
    const int c = u & 63, h = (u >> 6) & 3, b = u >> 8;
    const int tid = opaque_tid(wv), lane = tid & 63, w = tid >> 6, k = tid & 127, tq = tid >> 7;
    const size_t t0 = (size_t)b * SEQ + c * 64;
    const float lb = hg_lb(lbl, layer, h * 128 + k);
    __syncthreads();
    float bl[16], kf[16], qf[16]; float cum = 0.f;
#pragma unroll
    for (int i = 0; i < 16; ++i) { const size_t row = (t0 + 16 * tq + i) * IN_COLS; const float fp = bf2f(HIN[row + C_HF + h * 128 + k]);
        const float sg = sigmoidf_(fp); const float f = lb + (1.f - lb) * sg; cum += __logf(fmaxf(f, 1e-30f)); bl[i] = cum; kf[i] = (1.f - lb) * sigmoidf_(-fp);
        qf[i] = siluf_(bf2f(HIN[row + C_HQ + h * 128 + k]));
        VT[k * HG_S72 + 16 * tq + i] = HIN[row + C_HI + h * 128 + k]; }
    TOT[tq * 128 + k] = cum;
    { const float4* sp = (const float4*)(SST + (size_t)u * 16384);
#pragma unroll
      for (int i = 0; i < 8; ++i) { const int e4 = tid + 512 * i; const float4 s4 = sp[e4]; const int v = e4 >> 5, k4 = (e4 & 31) * 4; u32x2 pk; pk.x = pk2(s4.x, s4.y); pk.y = pk2(s4.z, s4.w); *(u32x2*)(SB + v * HG_S136 + k4) = pk; } }
    for (int i = tid; i < 64 * HG_S72 / 2; i += NTHR) ((unsigned*)SC)[i] = 0u;
    __syncthreads();
    float rs[4]; { float acc = 0.f;
#pragma unroll
        for (int j = 0; j < 4; ++j) { rs[j] = acc; acc += TOT[j * 128 + k]; } }
    float pre = 0.f;
#pragma unroll
    for (int j = 0; j < 4; ++j) pre = (j == tq) ? rs[j] : pre;
#pragma unroll
    for (int i = 0; i < 16; ++i) {
        const int s = 16 * tq + i; const float bs = pre + bl[i];
        QI[s * HG_S136 + k] = f2bf(qf[i] * __expf(bl[i]));
        QE[s * HG_S136 + k] = f2bf(qf[i] * __expf(bs));
#pragma unroll
        for (int ii = 0; ii < 4; ++ii) if (ii >= tq) KI[((ii == 0 ? 0 : ii == 1 ? 16 : ii == 2 ? 48 : 96) + s) * HG_S136 + k] = f2bf(kf[i] * __expf(rs[ii] - bs));
    }
    __syncthreads();
    const int lr = lane & 15, lg = lane >> 4;
    for (int tix = w; tix < 10; tix += 8) {
        int i, j; if (tix == 0) { i = 0; j = 0; } else if (tix < 3) { i = 1; j = tix - 1; } else if (tix < 6) { i = 2; j = tix - 3; } else { i = 3; j = tix - 6; }
        const int kb = (i == 0 ? 0 : i == 1 ? 16 : i == 2 ? 48 : 96);
        f32x4 acc = (f32x4){0.f, 0.f, 0.f, 0.f};
#pragma unroll
        for (int ks = 0; ks < 4; ++ks) { const bf16x8 a = *(const bf16x8*)(QI + (16 * i + lr) * HG_S136 + ks * 32 + lg * 8); const bf16x8 bb = *(const bf16x8*)(KI + (kb + 16 * j + lr) * HG_S136 + ks * 32 + lg * 8);
            acc = __builtin_amdgcn_mfma_f32_16x16x32_bf16(a, bb, acc, 0, 0, 0); }
#pragma unroll
        for (int r = 0; r < 4; ++r) { const int tr = 4 * lg + r; const float v = (i == j && lr > tr) ? 0.f : acc[r]; SC[(16 * i + tr) * HG_S72 + 16 * j + lr] = f2bf(v); }
    }
    __syncthreads();
    f32x4 o[4];
#pragma unroll
    for (int tt = 0; tt < 4; ++tt) o[tt] = (f32x4){0.f, 0.f, 0.f, 0.f};
#pragma unroll
    for (int ks = 0; ks < 2; ++ks) { const bf16x8 vb = *(const bf16x8*)(VT + (w * 16 + lr) * HG_S72 + ks * 32 + lg * 8);
#pragma unroll
        for (int tt = 0; tt < 4; ++tt) { const bf16x8 a = *(const bf16x8*)(SC + (16 * tt + lr) * HG_S72 + ks * 32 + lg * 8); o[tt] = __builtin_amdgcn_mfma_f32_16x16x32_bf16(a, vb, o[tt], 0, 0, 0); } }
#pragma unroll
    for (int ks = 0; ks < 4; ++ks) { const bf16x8 sb = *(const bf16x8*)(SB + (w * 16 + lr) * HG_S136 + ks * 32 + lg * 8);
#pragma unroll
        for (int tt = 0; tt < 4; ++tt) { const bf16x8 a = *(const bf16x8*)(QE + (16 * tt + lr) * HG_S136 + ks * 32 + lg * 8); o[tt] = __builtin_amdgcn_mfma_f32_16x16x32_bf16(a, sb, o[tt], 0, 0, 0); } }
#pragma unroll
    for (int tt = 0; tt < 4; ++tt)
#pragma unroll
        for (int r = 0; r < 4; ++r) OB[(16 * tt + 4 * lg + r) * HG_OS + w * 16 + lr] = o[tt][r];
    __syncthreads();
    { const int t = tid >> 3, vg = tid & 7; float ov[16]; float q = 0.f;
#pragma unroll
      for (int i = 0; i < 4; ++i) { const float4 x = *(const float4*)(OB + t * HG_OS + vg * 16 + 4 * i); ov[4 * i] = x.x; ov[4 * i + 1] = x.y; ov[4 * i + 2] = x.z; ov[4 * i + 3] = x.w; q += (x.x * x.x + x.y * x.y) + (x.z * x.z + x.w * x.w); }
      q += __shfl_xor(q, 1); q += __shfl_xor(q, 2); q += __shfl_xor(q, 4);
      const float rinv = 1.0f / sqrtf(q * (1.0f / 128.f) + 1e-6f);
      const size_t row = t0 + t; const bf16_t* gp = HIN + row * IN_COLS + C_HG + h * 128 + vg * 16; const float* gn = gain + h * 128 + vg * 16;
      const u32x4 g0 = *(const u32x4*)gp, g1 = *(const u32x4*)(gp + 8);
      u32x4 o0, o1;
      o0.x = pk2(ov[0] * rinv * gn[0] * siluf_(bflo(g0.x)), ov[1] * rinv * gn[1] * siluf_(bfhi(g0.x))); o0.y = pk2(ov[2] * rinv * gn[2] * siluf_(bflo(g0.y)), ov[3] * rinv * gn[3] * siluf_(bfhi(g0.y)));
      o0.z = pk2(ov[4] * rinv * gn[4] * siluf_(bflo(g0.z)), ov[5] * rinv * gn[5] * siluf_(bfhi(g0.z))); o0.w = pk2(ov[6] * rinv * gn[6] * siluf_(bflo(g0.w)), ov[7] * rinv * gn[7] * siluf_(bfhi(g0.w)));
      o1.x = pk2(ov[8] * rinv * gn[8] * siluf_(bflo(g1.x)), ov[9] * rinv * gn[9] * siluf_(bfhi(g1.x))); o1.y = pk2(ov[10] * rinv * gn[10] * siluf_(bflo(g1.y)), ov[11] * rinv * gn[11] * siluf_(bfhi(g1.y)));
      o1.z = pk2(ov[12] * rinv * gn[12] * siluf_(bflo(g1.z)), ov[13] * rinv * gn[13] * siluf_(bfhi(g1.z))); o1.w = pk2(ov[14] * rinv * gn[14] * siluf_(bflo(g1.w)), ov[15] * rinv * gn[15] * siluf_(bfhi(g1.w)));
      bf16_t* op = MIX + row * D + 1024 + h * 128 + vg * 16; *(u32x4*)op = o0; *(u32x4*)(op + 8) = o1; }
}

constexpr int LRU_LDS_X = 0, LRU_LDS_MS = LCH * 512 * 4, LRU_LDS_BYTES = LRU_LDS_MS + LCH * 4;
struct LruW { const float *conv_w, *conv_b, *wa, *ba, *wx, *bx, *lam, *gain; };
template <int PASS>
__device__ __forceinline__ void lru_unit(const int wv, unsigned char* lds, int u, const bf16_t* HIN, const LruW& W, float* AGA, float* AGH, bf16_t* MIX) {
    float* XS = (float*)(lds + LRU_LDS_X); float* MS = (float*)(lds + LRU_LDS_MS);
    const int ch = u % NLCH, b = u / NLCH;
    const int c = opaque_tid(wv), lane = c & 63, w = c >> 6, h = c >> 6, j = c & 63;
    const size_t t0 = (size_t)b * SEQ + ch * LCH;
    const float w0 = W.conv_w[c], w1 = W.conv_w[512 + c], w2 = W.conv_w[1024 + c], w3 = W.conv_w[1536 + c], cb = W.conv_b[c];
    float xm3 = 0.f, xm2 = 0.f, xm1 = 0.f;
    if (ch > 0) { xm3 = bf2f(HIN[(t0 - 3) * IN_COLS + C_LX + c]); xm2 = bf2f(HIN[(t0 - 2) * IN_COLS + C_LX + c]); xm1 = bf2f(HIN[(t0 - 1) * IN_COLS + C_LX + c]); }
    __syncthreads();
    float xc[LCH];
#pragma unroll
    for (int t = 0; t < LCH; ++t) { const float x0 = bf2f(HIN[(t0 + t) * IN_COLS + C_LX + c]); xc[t] = w0 * xm3 + w1 * xm2 + w2 * xm1 + w3 * x0 + cb; xm3 = xm2; xm2 = xm1; xm1 = x0; XS[t * 512 + c] = xc[t]; }
    __syncthreads();
    float ra[LCH], ia[LCH];
    { const float bav = W.ba[c], bxv = W.bx[c];
#pragma unroll
      for (int t = 0; t < LCH; ++t) { ra[t] = bav; ia[t] = bxv; } }
    const float* wap = W.wa + (size_t)h * 4096 + j; const float* wxp = W.wx + (size_t)h * 4096 + j;
    for (int i4 = 0; i4 < 16; ++i4) {
        const float a0 = wap[(4 * i4 + 0) * 64], a1 = wap[(4 * i4 + 1) * 64], a2 = wap[(4 * i4 + 2) * 64], a3 = wap[(4 * i4 + 3) * 64];
        const float x0 = wxp[(4 * i4 + 0) * 64], x1 = wxp[(4 * i4 + 1) * 64], x2 = wxp[(4 * i4 + 2) * 64], x3 = wxp[(4 * i4 + 3) * 64];
#pragma unroll
        for (int t = 0; t < LCH; ++t) { const float4 xv = *(const float4*)(XS + t * 512 + h * 64 + 4 * i4);
            ra[t] += xv.x * a0 + xv.y * a1 + xv.z * a2 + xv.w * a3; ia[t] += xv.x * x0 + xv.y * x1 + xv.z * x2 + xv.w * x3; }
    }
    const float lm = W.lam[c]; const float sp = (lm > 15.f) ? __expf(-lm) : log1pf(__expf(-lm));
    float hl = 0.f, pr = 1.f;
    float hv[LCH], pv[LCH];
#pragma unroll
    for (int t = 0; t < LCH; ++t) { const float r = sigmoidf_(ra[t]), ig = sigmoidf_(ia[t]); const float la = -8.0f * r * sp; const float a = __expf(la);
        const float uu = sqrtf(fmaxf(-expm1f(2.0f * la), 0.f)) * (ig * xc[t]); hl = a * hl + uu; pr *= a; hv[t] = hl; pv[t] = pr; }
    if (PASS == 1) { AGA[((size_t)b * NLCH + ch) * 512 + c] = pr; AGH[((size_t)b * NLCH + ch) * 512 + c] = hl; return; }
    float carry = 0.f;
    for (int jc = 0; jc < ch; ++jc) { const size_t o = ((size_t)b * NLCH + jc) * 512 + c; carry = AGA[o] * carry + AGH[o]; }
    __syncthreads();
#pragma unroll
    for (int t = 0; t < LCH; ++t) { hv[t] += pv[t] * carry; XS[t * 512 + c] = hv[t] * hv[t]; }
    __syncthreads();
    for (int t = w; t < LCH; t += 8) { float q = 0.f;
#pragma unroll
        for (int m = 0; m < 8; ++m) q += XS[t * 512 + lane + 64 * m];
        q = wave_sum(q); if (lane == 0) MS[t] = q; }
    __syncthreads();
    const float gn = W.gain[c];
#pragma unroll
    for (int t = 0; t < LCH; ++t) { const float rinv = 1.0f / sqrtf(MS[t] * (1.0f / 512.f) + 1e-6f); const float gv = bf2f(HIN[(t0 + t) * IN_COLS + C_LG + c]);
        MIX[(t0 + t) * D + 1536 + c] = f2bf(hv[t] * rinv * gn * gelu_tanh(gv)); }
}

__device__ __forceinline__ void router_unit(const int wv, unsigned char* lds, int u, const float* X, const float* W, float* LOG) {
    float* xs = (float*)lds; float* ws = xs + 32 * 68;
    const int tid = opaque_tid(wv), tt = tid >> 4, eg = tid & 15; const size_t t0 = (size_t)u * 32;
    float a0 = 0.f, a1 = 0.f, a2 = 0.f, a3 = 0.f;
    for (int k0 = 0; k0 < D; k0 += 64) {
        const float4 xv = *(const float4*)(X + (t0 + (tid >> 4)) * D + k0 + (tid & 15) * 4);
        const float4 wv0 = *(const float4*)(W + (size_t)(k0 + (tid >> 4)) * 64 + (tid & 15) * 4), wv1 = *(const float4*)(W + (size_t)(k0 + 32 + (tid >> 4)) * 64 + (tid & 15) * 4);
        __syncthreads();
        *(float4*)(xs + (tid >> 4) * 68 + (tid & 15) * 4) = xv; *(float4*)(ws + (tid >> 4) * 64 + (tid & 15) * 4) = wv0; *(float4*)(ws + (32 + (tid >> 4)) * 64 + (tid & 15) * 4) = wv1;
        __syncthreads();
#pragma unroll 16
        for (int kk = 0; kk < 64; ++kk) { const float x = xs[tt * 68 + kk]; const float4 wv = *(const float4*)(ws + kk * 64 + eg * 4); a0 += x * wv.x; a1 += x * wv.y; a2 += x * wv.z; a3 += x * wv.w; }
    }
    *(float4*)(LOG + (t0 + tt) * 64 + eg * 4) = make_float4(a0, a1, a2, a3);
}
__device__ __forceinline__ void route_unit(const int wv, unsigned char* lds, int u, const float* LOG, const float* rbias, int* TKIDX, float* TKGATE, int* CNT) {
    int* hist = (int*)lds;
    const int tid = opaque_tid(wv), lane = tid & 63, w = tid >> 6;
    __syncthreads();
    if (tid < 64) hist[tid] = 0;
    __syncthreads();
    const float rb = rbias[lane];
    for (int i = 0; i < 16; ++i) {
        const size_t t = (size_t)u * RCHUNK + w * 16 + i;
        const float score = sigmoidf_(LOG[t * 64 + lane]); const float sel = score + rb;
        float m1 = sel; m1 = fmaxf(m1, __shfl_xor(m1, 1)); m1 = fmaxf(m1, __shfl_xor(m1, 2)); m1 = fmaxf(m1, __shfl_xor(m1, 4));
        const unsigned long long eqm = __ballot(sel == m1); const int gbase = lane & ~7; const unsigned grp = (unsigned)((eqm >> gbase) & 0xffull); const int first = gbase + __builtin_ctz(grp);
        float m2 = (lane == first) ? -3.0e38f : sel; m2 = fmaxf(m2, __shfl_xor(m2, 1)); m2 = fmaxf(m2, __shfl_xor(m2, 2)); m2 = fmaxf(m2, __shfl_xor(m2, 4));
        const float gs = m1 + m2; const int mygrp = lane >> 3;
        int grank = 0;
#pragma unroll
        for (int g2 = 0; g2 < 8; ++g2) { const float og = __shfl(gs, g2 * 8); grank += (og > gs || (og == gs && g2 < mygrp)) ? 1 : 0; }
        const float msel = (grank < 4) ? sel : -1e30f;
        int rank = 0;
#pragma unroll 16
        for (int e2 = 0; e2 < 64; ++e2) { const float os = __shfl(msel, e2); rank += (os > msel || (os == msel && e2 < lane)) ? 1 : 0; }
        const bool pick = rank < TOPK;
        const float wsum = wave_sum(pick ? score : 0.f);
        if (pick) { TKIDX[t * TOPK + rank] = lane; TKGATE[t * TOPK + rank] = score / wsum * 2.5f; atomicAdd(&hist[lane], 1); }
    }
    __syncthreads();
    if (tid < 64) CNT[u * 64 + tid] = hist[tid];
}
__device__ __forceinline__ void assign_unit(const int wv, unsigned char* lds, int chunk, const int* CNT, const int* TKIDX, const float* TKGATE, int* ROWTOK, int* ROWDST, float* ROWGATE, int* TILEE) {
    int* total = (int*)lds; int* mybase = total + 64; int* off = mybase + 64; unsigned* mask = (unsigned*)(off + 80);
    const int tid = opaque_tid(wv);
    __syncthreads();
    if (tid < 256) mask[tid] = 0u;
    if (tid < 64) { int tot = 0, base = 0; for (int cc = 0; cc < NRCHUNK; ++cc) { const int v = CNT[cc * 64 + tid]; tot += v; if (cc < chunk) base += v; } total[tid] = tot; mybase[tid] = base; }
    __syncthreads();
    if (tid == 0) { int o = 0; for (int e = 0; e < 64; ++e) { off[e] = o; o += ((total[e] + 255) / 256) * 256; } off[64] = o; }
    __syncthreads();
    int e_[2]; int tt_[2], k_[2];
#pragma unroll
    for (int r = 0; r < 2; ++r) { const int p = tid + 512 * r; tt_[r] = p >> 3; k_[r] = p & 7; e_[r] = TKIDX[((size_t)chunk * RCHUNK + tt_[r]) * TOPK + k_[r]]; atomicOr(&mask[e_[r] * 4 + (tt_[r] >> 5)], 1u << (tt_[r] & 31)); }
    __syncthreads();
#pragma unroll
    for (int r = 0; r < 2; ++r) { const int e = e_[r], tt = tt_[r]; int rank = 0;
        for (int wd = 0; wd < (tt >> 5); ++wd) rank += __builtin_popcount(mask[e * 4 + wd]);
        rank += __builtin_popcount(mask[e * 4 + (tt >> 5)] & ((1u << (tt & 31)) - 1u));
        const int slot = off[e] + mybase[e] + rank; const int t = chunk * RCHUNK + tt;
        ROWTOK[slot] = t; ROWDST[slot] = t * TOPK + k_[r]; ROWGATE[slot] = TKGATE[(size_t)t * TOPK + k_[r]]; }
    if (chunk < 64) { const int e = chunk; const int lo = off[e] + total[e], hi = off[e + 1]; for (int s = lo + tid; s < hi; s += NTHR) { ROWTOK[s] = -1; ROWDST[s] = -1; ROWGATE[s] = 0.f; } }
    if (chunk == 0) { const int e = tid >> 3; for (int i = off[e] / 256 + (tid & 7); i < off[e + 1] / 256; i += 8) TILEE[i] = e; if (tid == 0) TILEE[MAXTILES] = off[64] / 256; }
}
constexpr int PH_PER_LAYER = 14, NPHASE = DEPTH * PH_PER_LAYER;
struct Args { const void* in[32]; float* out; unsigned char* ws; RotTab rt; int ph_lo, ph_hi; };
static_assert(sizeof(Args) == 32 * 8 + 8 + 8 + 64 + 8, "Args has no padding");

template <int l>
__device__ __forceinline__ void layer_program(const int wv, const Args& args, unsigned char* lds, unsigned char* ws, float* out, const XcdBarrier& bar, const int lo, const int hi) {
    constexpr int pb = l * PH_PER_LAYER;
    if (hi <= pb || lo >= pb + PH_PER_LAYER) return;
    LAS unsigned char* ldsL = (LAS unsigned char*)lds;
    const int G = gridDim.x, bid = blockIdx.x;
    const int NGW = G * NWAVES;
    LAS int* ulist = (LAS int*)(ldsL + ULIST_OFF);
#ifndef PHMASK
#define PHMASK 0x3fff
#endif
#define IN(k) (lo <= (k) && (k) < hi && ((PHMASK >> ((k) % PH_PER_LAYER)) & 1))
#define SEAM(k) do { if (!MK_PER_PHASE && IN(k) && IN((k) + 1)) xcd_barrier(bar); } while (0)
#define TIDS() const int tid = opaque_tid(wv), lane = tid & 63, wave = wv, gw = bid * NWAVES + wave; (void)lane; (void)gw
        if (IN(pb + 0)) {
            TIDS();
            WPtrs P; P.w_in = (const float*)args.in[3] + (size_t)l * D * IN_COLS; P.w_out = (const float*)args.in[4] + (size_t)l * D * D; P.gate = (const float*)args.in[28] + (size_t)l * D * D;
            P.plew = (const float*)args.in[27] + (size_t)l * PLE * D; P.ew1 = (const float*)args.in[21] + (size_t)l * NE * D * EF; P.ew3 = (const float*)args.in[22] + (size_t)l * NE * D * EF;
            P.ew2 = (const float*)args.in[23] + (size_t)l * NE * EF * D; P.sw1 = (const float*)args.in[24] + (size_t)l * D * EF; P.sw3 = (const float*)args.in[25] + (size_t)l * D * EF; P.sw2 = (const float*)args.in[26] + (size_t)l * EF * D;
            convert_weights(lds, P, ws + WS_W, gw, NGW, wave, lane);
            convert_rows((const float*)args.in[1] + (size_t)l * T * PLE, (bf16_t*)(ws + WS_PB), (size_t)T * PLE, (size_t)bid * NTHR + tid, (size_t)G * NTHR);
            if (l == 0) convert_rows((const float*)args.in[0], (bf16_t*)(ws + WS_XB), (size_t)T * D, (size_t)bid * NTHR + tid, (size_t)G * NTHR);
        }
        SEAM(pb + 0);
        if (IN(pb + 1)) {
            pg8::DenseOrder S; S.init(T, IN_COLS, G, bid, 0);
            const pg8::ListOrder L = pg8::build_list(wv, ulist, ULIST_CAP, S);
            pg8::EpiStoreBf16 E{(bf16_t*)(ws + WS_HIN), IN_COLS, 0};
            pg8::gemm_phase<D, pg8::EpiStoreBf16, pg8::ListOrder, false>(wv, ldsL, (const bf16_t*)(ws + WS_XB), (const bf16_t*)(ws + WS_W + WO_WIN), L, E, nullptr);
        }
        SEAM(pb + 1);
        if (IN(pb + 2)) {
            const bf16_t* HIN = (const bf16_t*)(ws + WS_HIN); bf16_t* MIX = (bf16_t*)(ws + WS_MIX);
            for (int u = bid; u < 512; u += G) attn_unit(wv, lds, u, HIN, (const int*)args.in[2], (const float*)args.in[5] + l * 16, MIX, (float*)(ws + WS_SSQ), args.rt);
            LruW W; W.conv_w = (const float*)args.in[9] + l * 2048; W.conv_b = (const float*)args.in[10] + l * 512; W.wa = (const float*)args.in[11] + (size_t)l * 32768; W.ba = (const float*)args.in[12] + l * 512;
            W.wx = (const float*)args.in[13] + (size_t)l * 32768; W.bx = (const float*)args.in[14] + l * 512; W.lam = (const float*)args.in[15] + l * 512; W.gain = (const float*)args.in[16] + l * 512;
            for (int u = bid; u < BATCH * NLCH; u += G) lru_unit<1>(wv, lds, u, HIN, W, (float*)(ws + WS_LRUA), (float*)(ws + WS_LRUH), MIX);
            for (int u = bid; u < 2048; u += G) hg1_unit(wv, lds, u, HIN, (const float*)args.in[7], l, (float*)(ws + WS_SST), (float*)(ws + WS_DV));
        }
        SEAM(pb + 2);
        if (IN(pb + 3)) {
            TIDS();
            const bf16_t* HIN = (const bf16_t*)(ws + WS_HIN); bf16_t* MIX = (bf16_t*)(ws + WS_MIX);
            for (int t = gw; t < T; t += NGW) attn_fin_row(MIX, (const float*)(ws + WS_SSQ), (const float*)args.in[6] + l * 1024, t, lane);
            for (int u = bid; u < 256; u += G) hg2_unit(wv, u, (float*)(ws + WS_SST), (const float*)(ws + WS_DV));
            LruW W; W.conv_w = (const float*)args.in[9] + l * 2048; W.conv_b = (const float*)args.in[10] + l * 512; W.wa = (const float*)args.in[11] + (size_t)l * 32768; W.ba = (const float*)args.in[12] + l * 512;
            W.wx = (const float*)args.in[13] + (size_t)l * 32768; W.bx = (const float*)args.in[14] + l * 512; W.lam = (const float*)args.in[15] + l * 512; W.gain = (const float*)args.in[16] + l * 512;
            for (int u = bid; u < BATCH * NLCH; u += G) lru_unit<2>(wv, lds, u, HIN, W, (float*)(ws + WS_LRUA), (float*)(ws + WS_LRUH), MIX);
        }
        SEAM(pb + 3);
        if (IN(pb + 4)) {
            for (int u = bid; u < 2048; u += G) hg3_unit(wv, lds, u, (const bf16_t*)(ws + WS_HIN), (const float*)args.in[7], l, (const float*)(ws + WS_SST), (const float*)args.in[8] + l * 512, (bf16_t*)(ws + WS_MIX));
        }
        SEAM(pb + 4);
        if (IN(pb + 5)) {
            pg8::DenseOrder S; S.init(T, D, G, bid, 0);
            const pg8::ListOrder L = pg8::build_list(wv, ulist, ULIST_CAP, S);
            pg8::EpiResid E{(l == 0) ? (const float*)args.in[0] : (const float*)out, out, ALPHA, 0};
            pg8::gemm_phase<D, pg8::EpiResid, pg8::ListOrder, false>(wv, ldsL, (const bf16_t*)(ws + WS_MIX), (const bf16_t*)(ws + WS_W + WO_WOUT), L, E, nullptr);
        }
        SEAM(pb + 5);
        if (IN(pb + 6)) {
            TIDS();
            const float* g1 = (const float*)args.in[17] + l * D; const float* b1 = (const float*)args.in[18] + l * D; bf16_t* XB = (bf16_t*)(ws + WS_XB);
            for (int t = gw; t < T; t += NGW) ln_row<false>(out + (size_t)t * D, g1, b1, XB + (size_t)t * D, nullptr, lane);
        }
        SEAM(pb + 6);
        if (IN(pb + 7)) {
            for (int u = bid; u < T / 32; u += G) router_unit(wv, lds, u, out, (const float*)args.in[19] + (size_t)l * D * 64, (float*)(ws + WS_LOGITS));
        }
        SEAM(pb + 7);
        if (IN(pb + 8)) {
            for (int u = bid; u < NRCHUNK; u += G) route_unit(wv, lds, u, (const float*)(ws + WS_LOGITS), (const float*)args.in[20] + l * 64, (int*)(ws + WS_TKIDX), (float*)(ws + WS_TKGATE), (int*)(ws + WS_CNT));
        }
        SEAM(pb + 8);
        if (IN(pb + 9)) {
            for (int u = bid; u < NRCHUNK; u += G) assign_unit(wv, lds, u, (const int*)(ws + WS_CNT), (const int*)(ws + WS_TKIDX), (const float*)(ws + WS_TKGATE), (int*)(ws + WS_ROWTOK), (int*)(ws + WS_ROWDST), (float*)(ws + WS_ROWGATE), (int*)(ws + WS_TILEE));
        }
        SEAM(pb + 9);
        if (IN(pb + 10)) {
            { pg8::DenseOrder S; S.init(T, D, G, bid, 0);
              const pg8::ListOrder L = pg8::build_list(wv, ulist, ULIST_CAP, S);
              pg8::EpiStoreBf16 E{(bf16_t*)(ws + WS_U), D, 0};
              pg8::gemm_phase<PLE, pg8::EpiStoreBf16, pg8::ListOrder, false>(wv, ldsL, (const bf16_t*)(ws + WS_PB), (const bf16_t*)(ws + WS_W + WO_PLEW), L, E, nullptr); }
            TIDS();
            const int* TILEE = (const int*)(ws + WS_TILEE); const int* ROWTOK = (const int*)(ws + WS_ROWTOK);
            const int ntiles = TILEE[MAXTILES];
            pg8::UpOrder S2; S2.init(TILEE, ntiles, G, bid, 0);
            const pg8::ListOrder L2 = pg8::build_list(wv, ulist, TAB_BYTES / 1024, S2);
            LAS int* gtab = (LAS int*)(ldsL + TAB_OFF);
            if (tid < 256) for (int j = 0; j < L2.n; ++j) { const int orow = ulist[j * 4 + 2]; int r;
                if (orow < A_PAD) { r = ROWTOK[orow + tid]; r = r < 0 ? 0 : r; } else r = orow - A_PAD + tid;
                gtab[j * 256 + tid] = r; }
            __syncthreads();
            pg8::EpiSwiglu E2{(bf16_t*)(ws + WS_HM)};
            pg8::gemm_phase<D, pg8::EpiSwiglu, pg8::ListOrder, true>(wv, ldsL, (const bf16_t*)(ws + WS_XB), (const bf16_t*)(ws + WS_W + WO_W13), L2, E2, gtab);
        }
        SEAM(pb + 10);
        if (IN(pb + 11)) {
            { pg8::DenseOrder S; S.init(T, D, G, bid, 0);
              const pg8::ListOrder L = pg8::build_list(wv, ulist, ULIST_CAP, S);
              pg8::EpiGate E{out, (const bf16_t*)(ws + WS_U), (const float*)args.in[29] + l * D, ALPHA, 0};
              pg8::gemm_phase<D, pg8::EpiGate, pg8::ListOrder, false>(wv, ldsL, (const bf16_t*)(ws + WS_XB), (const bf16_t*)(ws + WS_W + WO_GATE), L, E, nullptr); }
            TIDS();
            const int* TILEE = (const int*)(ws + WS_TILEE);
            const int ntiles = TILEE[MAXTILES];
            pg8::DownOrder S3; S3.init(TILEE, ntiles, G, bid);
            const pg8::ListOrder L3 = pg8::build_list(wv, ulist, ULIST_CAP, S3);
            LAS int* tdst = (LAS int*)(ldsL + TAB_OFF); LAS float* tgate = (LAS float*)(ldsL + TAB_OFF + TAB_BYTES / 2);
            if (S3.lo < S3.hi && tid < 256) { const int* ROWDST = (const int*)(ws + WS_ROWDST); const float* ROWGATE = (const float*)(ws + WS_ROWGATE); const int tl = (S3.hi - 1) >> 3;
                for (int tile = S3.t0; tile <= tl && tile - S3.t0 < TAB_BYTES / 2048; ++tile) { tdst[(tile - S3.t0) * 256 + tid] = ROWDST[tile * 256 + tid]; tgate[(tile - S3.t0) * 256 + tid] = ROWGATE[tile * 256 + tid]; } }
            __syncthreads();
            pg8::EpiScatter E3{(bf16_t*)(ws + WS_Y), tdst, tgate};
            pg8::gemm_phase<EF, pg8::EpiScatter, pg8::ListOrder, false>(wv, ldsL, (const bf16_t*)(ws + WS_HM), (const bf16_t*)(ws + WS_W + WO_W2), L3, E3, nullptr);
        }
        SEAM(pb + 11);
        if (IN(pb + 12)) {
            pg8::DenseOrder S; S.init(T, D, G, bid, 0);
            const pg8::ListOrder L = pg8::build_list(wv, ulist, ULIST_CAP, S);
            pg8::EpiAccum E{out};
            pg8::gemm_phase<EF, pg8::EpiAccum, pg8::ListOrder, false>(wv, ldsL, (const bf16_t*)(ws + WS_HM) + (size_t)A_PAD * EF, (const bf16_t*)(ws + WS_W + WO_W2) + (size_t)64 * D * EF, L, E, nullptr);
        }
        SEAM(pb + 12);
        if (IN(pb + 13)) {
            TIDS();
            const float* g2 = (const float*)args.in[30] + l * D; const float* b2 = (const float*)args.in[31] + l * D; bf16_t* XB = (bf16_t*)(ws + WS_XB); const bf16_t* Y = (const bf16_t*)(ws + WS_Y);
            for (int t = gw; t < T; t += NGW) ln_row<true>(out + (size_t)t * D, g2, b2, XB + (size_t)t * D, Y + (size_t)t * TOPK * D, lane);
        }

#undef TIDS
#undef IN
#undef SEAM
}

__global__ void __launch_bounds__(NTHR, 2) mega_fwd(Args args) {
    extern __shared__ __attribute__((aligned(16))) unsigned char lds[];
    LAS unsigned char* ldsL = (LAS unsigned char*)lds;
    volatile LAS unsigned* MISC = (volatile LAS unsigned*)(ldsL + MISC_OFF);
    unsigned char* ws = args.ws; float* out = args.out;
    if (threadIdx.x < 32) MISC[threadIdx.x] = 0u;
    __syncthreads();
    XcdBarrier bar; bar.bar = (unsigned*)(ws + WS_CTL) + CW_BAR; bar.x = 0; bar.st = nullptr; bar.w0 = 0;
    if (!MK_PER_PHASE) bar = xcd_barrier_post((unsigned*)(ws + WS_CTL) + CW_BAR, MISC + 8);
    const int lo = args.ph_lo, hi = args.ph_hi;
    const int wv = __builtin_amdgcn_readfirstlane(threadIdx.x >> 6);
    layer_program<0>(wv, args, lds, ws, out, bar, lo, hi);
    if (!MK_PER_PHASE && lo <= PH_PER_LAYER - 1 && hi > PH_PER_LAYER) xcd_barrier(bar);
    layer_program<1>(wv, args, lds, ws, out, bar, lo, hi);
}

extern "C" void kernel_launch(void* const* d_in, const int* in_sizes, int n_in, void* d_out, int out_size, void* d_ws, size_t ws_size, hipStream_t stream) {
    static int grid = 0;
    if (grid == 0) {
        if (n_in != 32 || out_size != T * D || ws_size < WS_END) { fprintf(stderr, "kernel_launch: unexpected sizes n_in %d out %d ws %zu (need %zu); nothing launched\n", n_in, out_size, ws_size, (size_t)WS_END); grid = -1; return; }
        int dev = 0, cus = 0, per_cu = 0;
        if (hipGetDevice(&dev) != hipSuccess || hipDeviceGetAttribute(&cus, hipDeviceAttributeMultiprocessorCount, dev) != hipSuccess) { grid = -1; return; }
        if (hipFuncSetAttribute((const void*)mega_fwd, hipFuncAttributeMaxDynamicSharedMemorySize, LDS_BYTES) != hipSuccess) { fprintf(stderr, "kernel_launch: hipFuncSetAttribute failed\n"); grid = -1; return; }
        if (hipOccupancyMaxActiveBlocksPerMultiprocessor(&per_cu, (const void*)mega_fwd, NTHR, LDS_BYTES) != hipSuccess || per_cu < 1) { fprintf(stderr, "kernel_launch: occupancy query reports %d blocks per CU\n", per_cu); }
        (void)hipGetLastError();
        grid = cus;
    }
    if (grid < 0) return;
    if (hipMemsetAsync((char*)d_ws + WS_CTL, 0, CTL_ZERO_BYTES, stream) != hipSuccess) { fprintf(stderr, "kernel_launch: memset failed\n"); return; }
    Args a{};
    for (int i = 0; i < 32; ++i) a.in[i] = d_in[i];
    a.out = (float*)d_out; a.ws = (unsigned char*)d_ws;
    for (int i = 0; i < 8; ++i) a.rt.invf[i] = std::pow(500000.0, -(double)i / 8.0);
#if MK_PER_PHASE
    for (int ph = 0; ph < NPHASE; ++ph) { a.ph_lo = ph; a.ph_hi = ph + 1; hipLaunchKernelGGL(mega_fwd, dim3(grid), dim3(NTHR), LDS_BYTES, stream, a); }
#else
    a.ph_lo = 0; a.ph_hi = NPHASE;
    hipLaunchKernelGGL(mega_fwd, dim3(grid), dim3(NTHR), LDS_BYTES, stream, a);
#endif
    const hipError_t le = hipPeekAtLastError();
    if (le != hipSuccess) fprintf(stderr, "kernel_launch: launch failed: %s\n", hipGetErrorName(le));
}
```

```cpp
#include <hip/hip_runtime.h>
#include <cstdio>
#include <cmath>

#ifndef MK_PER_PHASE
#define MK_PER_PHASE 0
#endif

typedef unsigned short bf16_t;
typedef short bf16x8 __attribute__((ext_vector_type(8)));
typedef float f32x4 __attribute__((ext_vector_type(4)));
typedef unsigned u32x4 __attribute__((ext_vector_type(4)));
typedef unsigned u32x2 __attribute__((ext_vector_type(2)));
#define LAS __attribute__((address_space(3)))

constexpr int BATCH = 8, SEQ = 4096, T = BATCH * SEQ, D = 2048, DEPTH = 2, PLE = 256;
constexpr int IN_COLS = 4352;
constexpr int C_AQ = 0, C_AK = 1024, C_AV = 1152, C_HQ = 1280, C_HF = 1792, C_HI = 2304, C_HG = 2816, C_LX = 3328, C_LG = 3840;
constexpr int NE = 64, TOPK = 8, EF = 512;
constexpr int A_ROWS = T * TOPK;
constexpr int MAXTILES = A_ROWS / 256 + NE;
constexpr int A_PAD = MAXTILES * 256;
constexpr float ALPHA = 1.41421356237309515f;
constexpr int RCHUNK = 128, NRCHUNK = T / RCHUNK;
constexpr int LCH = 32, NLCH = SEQ / LCH;

constexpr size_t MiB = 1u << 20;
constexpr size_t WS_CTL = 0, CTL_ZERO_BYTES = 256 * 1024;
constexpr size_t WS_CNT = 1 * MiB;
constexpr size_t WS_TILEE = 2 * MiB;
constexpr size_t WS_LOGITS = 4 * MiB;
constexpr size_t WS_TKIDX = 12 * MiB;
constexpr size_t WS_TKGATE = 13 * MiB;
constexpr size_t WS_ROWTOK = 14 * MiB;
constexpr size_t WS_ROWDST = 16 * MiB;
constexpr size_t WS_ROWGATE = 18 * MiB;
constexpr size_t WS_LRUA = 20 * MiB;
constexpr size_t WS_LRUH = 22 * MiB;
constexpr size_t WS_SSQ = 24 * MiB;
constexpr size_t WS_DV = 25 * MiB;
constexpr size_t WS_Y = 32 * MiB;
constexpr size_t WS_HIN = 32 * MiB;
constexpr size_t WS_MIX = 304 * MiB;
constexpr size_t WS_SST = 432 * MiB;
constexpr size_t WS_PB = 560 * MiB;
constexpr size_t WS_LRUHL = 576 * MiB;
constexpr size_t WS_LRUPL = 640 * MiB;
constexpr size_t WS_XB = 1056 * MiB;
constexpr size_t WS_HM = 1184 * MiB;
constexpr size_t WS_U = 1488 * MiB;
constexpr size_t WS_W = 1616 * MiB;
constexpr size_t WO_WIN = 0, WO_WOUT = 17 * MiB, WO_GATE = 25 * MiB, WO_PLEW = 33 * MiB, WO_W2 = 34 * MiB, WO_W13 = 164 * MiB, WO_ROUT = 424 * MiB, WO_END = 425 * MiB;
constexpr size_t WS_END = WS_W + WO_END;
static_assert((size_t)IN_COLS * D * 2 <= WO_WOUT - WO_WIN && (size_t)65 * 2048 * 512 * 2 <= WO_W13 - WO_W2 && (size_t)65 * 1024 * 2048 * 2 <= WO_ROUT - WO_W13, "weight map");
static_assert(WS_PB + (size_t)T * PLE * 2 <= WS_Y + (size_t)A_ROWS * D * 2 && WS_Y + (size_t)A_ROWS * D * 2 <= WS_XB && WS_HM + (size_t)(A_PAD + T) * EF * 2 <= WS_U, "ws map");

__device__ __forceinline__ int lane_id() { return (int)__builtin_amdgcn_mbcnt_hi(~0u, __builtin_amdgcn_mbcnt_lo(~0u, 0u)); }
__device__ __forceinline__ int opaque_tid(int wv) { int t = wv * 64 + lane_id(); asm volatile("" : "+v"(t)); return t; }
__device__ __forceinline__ bf16_t f2bf(float f) { unsigned u = __float_as_uint(f); u += 0x7fffu + ((u >> 16) & 1u); return (bf16_t)(u >> 16); }
__device__ __forceinline__ float bf2f(bf16_t b) { return __uint_as_float(((unsigned)b) << 16); }
__device__ __forceinline__ float bflo(unsigned w) { return __uint_as_float(w << 16); }
__device__ __forceinline__ float bfhi(unsigned w) { return __uint_as_float(w & 0xffff0000u); }
__device__ __forceinline__ unsigned pk2(float lo, float hi) { return (unsigned)f2bf(lo) | ((unsigned)f2bf(hi) << 16); }
__device__ __forceinline__ unsigned cvt_pk_bf16(float lo, float hi) { unsigned r; asm("v_cvt_pk_bf16_f32 %0, %1, %2" : "=v"(r) : "v"(lo), "v"(hi)); return r; }
__device__ __forceinline__ bf16_t f2bf_hw(float f) { return (bf16_t)(cvt_pk_bf16(f, f) & 0xffffu); }
__device__ __forceinline__ float rcpf_(float x) { return __builtin_amdgcn_rcpf(x); }
__device__ __forceinline__ float rsqf_(float x) { return __builtin_amdgcn_rsqf(x); }
__device__ __forceinline__ float sigmoidf_(float x) { return rcpf_(1.0f + __expf(-x)); }
__device__ __forceinline__ float siluf_(float x) { return x * rcpf_(1.0f + __expf(-x)); }
__device__ __forceinline__ float gelu_tanh(float x) { const float u = 0.7978845608028654f * (x + 0.044715f * x * x * x); const float e = __expf(2.0f * u); const float th = 1.0f - 2.0f * rcpf_(e + 1.0f); return 0.5f * x * (1.0f + th); }
__device__ __forceinline__ float wave_sum(float v) {
#pragma unroll
    for (int o = 1; o < 64; o <<= 1) v += __shfl_xor(v, o);
    return v;
}
__device__ __forceinline__ void sincos_pos(float pos, double invf, float& s, float& c) {
    const double a = (double)pos * invf;
    const double q = rint(a * 0.63661977236758134308);
    const float r = (float)(a - q * 1.57079632679489661923);
    const int qi = ((int)q) & 3;
    const float r2 = r * r;
    const float sp = r * (1.0f + r2 * (-1.6666667163e-1f + r2 * (8.3333337680e-3f + r2 * (-1.9841270114e-4f + r2 * 2.7557314297e-6f))));
    const float cp = 1.0f + r2 * (-0.5f + r2 * (4.1666667908e-2f + r2 * (-1.3888889225e-3f + r2 * (2.4801587642e-5f + r2 * -2.7557314297e-7f))));
    const float ss = (qi & 1) ? cp : sp, cc = (qi & 1) ? sp : cp;
    s = (qi & 2) ? -ss : ss;
    c = ((qi + 1) & 2) ? -cc : cc;
}
namespace pg8 {
constexpr int BM = 256, BK = 64, HALF = 128, HTB = HALF * BK * 2, STAGE_BYTES = 8 * HTB, NXCD = 8, WGM = 8;
__host__ __device__ __forceinline__ int lds_byte(int r, int c) { const int st = (r >> 4) * 2 + (c >> 5), rr = r & 15, cc = c & 31, ob = rr * 64 + cc * 2; return st * 1024 + (ob ^ (((ob >> 9) & 1) << 5)); }
__host__ __device__ __forceinline__ void stage_rc(int b, int& R, int& C) { const int st = b / 1024, sb = b % 1024, swz = sb ^ (((sb >> 9) & 1) << 5); R = (st >> 1) * 16 + swz / 64; C = (st & 1) * 32 + (swz % 64) / 2; }
__host__ __device__ __forceinline__ int perm32(int rho) { const int n = rho >> 4, i = rho & 15; return 8 * (i >> 2) + 4 * n + (i & 3); }

struct Unit { int brow, pn, orow, tab; };

__device__ __forceinline__ int xcd_remap(int L, int nwg) { const int q = nwg / NXCD, r = nwg % NXCD, xcd = L % NXCD, off = L / NXCD; return (xcd < r ? xcd * (q + 1) : r * (q + 1) + (xcd - r) * q) + off; }

struct DenseOrder {
    int nM, nN, nwg, G, c, start;
    __device__ void init(int M, int N, int G_, int c_, int start_) { nM = M / BM; nN = N / BM; nwg = nM * nN; G = G_; c = c_; start = start_ % G_; }
    __device__ bool next(int i, Unit& u) const {
        const long L = (long)(i + (c < start ? 1 : 0)) * G + c - start; if (L >= nwg) return false;
        const int wgid = xcd_remap((int)L, nwg);
        const int nig = WGM * nN, gid = wgid / nig, fm = gid * WGM, gsz = (nM - fm) < WGM ? (nM - fm) : WGM;
        const int pm = fm + ((wgid % nig) % gsz); u.pn = (wgid % nig) / gsz; u.orow = pm * BM; u.brow = u.pn * BM; u.tab = 0; return true;
    }
};
struct UpOrder {
    const int* tile_e; int ntiles, nwg, G, c, start;
    __device__ void init(const int* te, int nt_, int G_, int c_, int start_) { tile_e = te; ntiles = nt_; nwg = (nt_ + T / BM) * 4; G = G_; c = c_; start = start_ % G_; }
    __device__ bool next(int i, Unit& u) const {
        const long L = (long)(i + (c < start ? 1 : 0)) * G + c - start; if (L >= nwg) return false;
        const int wgid = xcd_remap((int)L, nwg); const int tile = wgid >> 2; u.pn = wgid & 3; u.tab = i;
        if (tile < ntiles) { u.brow = tile_e[tile] * 1024 + u.pn * BM; u.orow = tile * BM; }
        else { u.brow = 64 * 1024 + u.pn * BM; u.orow = A_PAD + (tile - ntiles) * BM; }
        return true;
    }
};
struct DownOrder {
    const int* tile_e; int lo, hi, t0;
    __device__ void init(const int* te, int nt_, int G_, int c_) { tile_e = te; const int n = nt_ * 8; const int vc = (G_ % 8 == 0) ? (c_ % 8) * (G_ / 8) + c_ / 8 : c_;
        lo = (int)(((long)vc * n) / G_); hi = (int)(((long)(vc + 1) * n) / G_); t0 = lo >> 3; }
    __device__ bool next(int i, Unit& u) const {
        const int id = lo + i; if (id >= hi) return false;
        const int tile = id >> 3; u.pn = id & 7; u.orow = tile * BM; u.brow = tile_e[tile] * 2048 + u.pn * BM; u.tab = tile - t0; return true;
    }
};

struct ListOrder { const LAS int* tab; int n;
    __device__ __forceinline__ bool next(int i, Unit& u) const { if (i >= n) return false; const LAS int* p = tab + i * 4;
        u.brow = __builtin_amdgcn_readfirstlane(p[0]); u.pn = __builtin_amdgcn_readfirstlane(p[1]); u.orow = __builtin_amdgcn_readfirstlane(p[2]); u.tab = __builtin_amdgcn_readfirstlane(p[3]); return true; } };
template <class Sched> __device__ __forceinline__ ListOrder build_list(const int wv, LAS int* tab, int cap, const Sched& S) {
    __syncthreads();
    int n = 0; Unit u;
    for (; n < cap && S.next(n, u); ++n) if (opaque_tid(wv) == 0) { tab[n * 4 + 0] = u.brow; tab[n * 4 + 1] = u.pn; tab[n * 4 + 2] = u.orow; tab[n * 4 + 3] = u.tab; }
    __syncthreads();
    ListOrder L; L.tab = tab; L.n = n; return L;
}

struct EpiStoreBf16 { static constexpr bool PERM = true; bf16_t* O; int ldo; int pad;
    __device__ __forceinline__ void operator()(const f32x4 (&acc)[2][2][4][2], const Unit& u, int wr, int wc, int fr, int fq) const {
        const int row0 = u.orow + wr * 64 + fr, col0 = u.pn * BM + wc * 32 + 8 * fq;
#pragma unroll
        for (int ai = 0; ai < 2; ++ai)
#pragma unroll
            for (int m = 0; m < 4; ++m) { bf16_t* rowp = O + (size_t)(row0 + ai * HALF + m * 16) * ldo + col0;
#pragma unroll
                for (int bj = 0; bj < 2; ++bj) { const f32x4 v0 = acc[ai][bj][m][0], v1 = acc[ai][bj][m][1];
                    u32x4 w; w.x = cvt_pk_bf16(v0[0], v0[1]); w.y = cvt_pk_bf16(v0[2], v0[3]); w.z = cvt_pk_bf16(v1[0], v1[1]); w.w = cvt_pk_bf16(v1[2], v1[3]);
                    *(u32x4*)(rowp + bj * HALF) = w; } }
    } };
struct EpiSwiglu { static constexpr bool PERM = true; bf16_t* H;
    __device__ __forceinline__ void operator()(const f32x4 (&acc)[2][2][4][2], const Unit& u, int wr, int wc, int fr, int fq) const {
        const int row0 = u.orow + wr * 64 + fr, col0 = u.pn * HALF + wc * 32 + 8 * fq;
#pragma unroll
        for (int ai = 0; ai < 2; ++ai)
#pragma unroll
            for (int m = 0; m < 4; ++m) { const f32x4 g0 = acc[ai][0][m][0], g1 = acc[ai][0][m][1], u0 = acc[ai][1][m][0], u1 = acc[ai][1][m][1];
                u32x4 w; w.x = cvt_pk_bf16(siluf_(g0[0]) * u0[0], siluf_(g0[1]) * u0[1]); w.y = cvt_pk_bf16(siluf_(g0[2]) * u0[2], siluf_(g0[3]) * u0[3]);
                w.z = cvt_pk_bf16(siluf_(g1[0]) * u1[0], siluf_(g1[1]) * u1[1]); w.w = cvt_pk_bf16(siluf_(g1[2]) * u1[2], siluf_(g1[3]) * u1[3]);
                *(u32x4*)(H + (size_t)(row0 + ai * HALF + m * 16) * EF + col0) = w; }
    } };
struct EpiResid { static constexpr bool PERM = false; const float* xres; float* out; float alpha; int pad;
    __device__ __forceinline__ void operator()(const f32x4 (&acc)[2][2][4][2], const Unit& u, int wr, int wc, int fr, int fq) const {
        const int row0 = u.orow + wr * 64 + fr, col0 = u.pn * BM + wc * 32 + 4 * fq;
#pragma unroll
        for (int ai = 0; ai < 2; ++ai)
#pragma unroll
            for (int m = 0; m < 4; ++m) { const size_t off = (size_t)(row0 + ai * HALF + m * 16) * D + col0;
#pragma unroll
                for (int bj = 0; bj < 2; ++bj)
#pragma unroll
                    for (int n = 0; n < 2; ++n) { const f32x4 x = *(const f32x4*)(xres + off + bj * HALF + n * 16); *(f32x4*)(out + off + bj * HALF + n * 16) = x * alpha + acc[ai][bj][m][n]; }
                asm volatile("" ::: "memory"); }
    } };
struct EpiAccum { static constexpr bool PERM = false; float* xio;
    __device__ __forceinline__ void operator()(const f32x4 (&acc)[2][2][4][2], const Unit& u, int wr, int wc, int fr, int fq) const {
        const int row0 = u.orow + wr * 64 + fr, col0 = u.pn * BM + wc * 32 + 4 * fq;
#pragma unroll
        for (int ai = 0; ai < 2; ++ai)
#pragma unroll
            for (int m = 0; m < 4; ++m) { const size_t off = (size_t)(row0 + ai * HALF + m * 16) * D + col0;
#pragma unroll
                for (int bj = 0; bj < 2; ++bj)
#pragma unroll
                    for (int n = 0; n < 2; ++n) { const f32x4 x = *(const f32x4*)(xio + off + bj * HALF + n * 16); *(f32x4*)(xio + off + bj * HALF + n * 16) = x + acc[ai][bj][m][n]; }
                asm volatile("" ::: "memory"); }
    } };
struct EpiScatter { static constexpr bool PERM = true; bf16_t* Y; const LAS int* tdst; const LAS float* tgate;
    __device__ __forceinline__ void operator()(const f32x4 (&acc)[2][2][4][2], const Unit& u, int wr, int wc, int fr, int fq) const {
        const int r0 = u.tab * BM + wr * 64 + fr, col0 = u.pn * BM + wc * 32 + 8 * fq;
#pragma unroll
        for (int ai = 0; ai < 2; ++ai)
#pragma unroll
            for (int m = 0; m < 4; ++m) { const int dst = tdst[r0 + ai * HALF + m * 16]; const float g = tgate[r0 + ai * HALF + m * 16];
                if (dst >= 0) { bf16_t* rowp = Y + (size_t)dst * D + col0;
#pragma unroll
                    for (int bj = 0; bj < 2; ++bj) { const f32x4 v0 = acc[ai][bj][m][0] * g, v1 = acc[ai][bj][m][1] * g;
                        u32x4 w; w.x = cvt_pk_bf16(v0[0], v0[1]); w.y = cvt_pk_bf16(v0[2], v0[3]); w.z = cvt_pk_bf16(v1[0], v1[1]); w.w = cvt_pk_bf16(v1[2], v1[3]);
                        *(u32x4*)(rowp + bj * HALF) = w; } } }
    } };
struct EpiGate { static constexpr bool PERM = true; bf16_t* U; const float* bias;
    __device__ __forceinline__ void operator()(const f32x4 (&acc)[2][2][4][2], const Unit& u, int wr, int wc, int fr, int fq) const {
        const int row0 = u.orow + wr * 64 + fr, col0 = u.pn * BM + wc * 32 + 8 * fq;
        f32x4 bv[2][2];
#pragma unroll
        for (int bj = 0; bj < 2; ++bj)
#pragma unroll
            for (int n = 0; n < 2; ++n) bv[bj][n] = *(const f32x4*)(bias + col0 + bj * HALF + 4 * n);
#pragma unroll
        for (int ai = 0; ai < 2; ++ai)
#pragma unroll
            for (int m = 0; m < 4; ++m) { bf16_t* rowp = U + (size_t)(row0 + ai * HALF + m * 16) * D + col0;
#pragma unroll
                for (int bj = 0; bj < 2; ++bj) { const u32x4 uu = *(const u32x4*)(rowp + bj * HALF);
                    const f32x4 a0 = acc[ai][bj][m][0] + bv[bj][0], a1 = acc[ai][bj][m][1] + bv[bj][1];
                    u32x4 w; w.x = cvt_pk_bf16(sigmoidf_(a0[0]) * bflo(uu.x), sigmoidf_(a0[1]) * bfhi(uu.x)); w.y = cvt_pk_bf16(sigmoidf_(a0[2]) * bflo(uu.y), sigmoidf_(a0[3]) * bfhi(uu.y));
                    w.z = cvt_pk_bf16(sigmoidf_(a1[0]) * bflo(uu.z), sigmoidf_(a1[1]) * bfhi(uu.z)); w.w = cvt_pk_bf16(sigmoidf_(a1[2]) * bflo(uu.w), sigmoidf_(a1[3]) * bfhi(uu.w));
                    *(u32x4*)(rowp + bj * HALF) = w; }
                asm volatile("" ::: "memory"); }
    } };
struct EpiRouter { static constexpr bool PERM = false; float* LOG;
    __device__ __forceinline__ void operator()(const f32x4 (&acc)[2][2][4][2], const Unit& u, int wr, int wc, int fr, int fq) const {
        if (wc < 2) { const int row0 = u.orow + wr * 64 + fr, col0 = wc * 32 + 4 * fq;
#pragma unroll
            for (int ai = 0; ai < 2; ++ai)
#pragma unroll
                for (int m = 0; m < 4; ++m)
#pragma unroll
                    for (int n = 0; n < 2; ++n) *(f32x4*)(LOG + (size_t)(row0 + ai * HALF + m * 16) * 64 + col0 + n * 16) = acc[ai][0][m][n]; }
    } };

template <int K, class Epi, class Sched, bool GATHER>
__device__ __forceinline__ void gemm_phase(const int wv, LAS unsigned char* lds, const bf16_t* Ap_, const bf16_t* Btp_, const Sched& S, const Epi& E, const LAS int* gtab) {
    const bf16_t* Ap = Ap_; const bf16_t* Btp = Btp_; asm volatile("" : "+s"(Ap), "+s"(Btp));
    const int tid = opaque_tid(wv), wid = wv, lane = tid & 63, wr = wid >> 2, wc = wid & 3, fr = lane & 15, fq = lane >> 4;
    constexpr int nt = K / BK;
    unsigned voffB[2], vc[2][2];
#pragma unroll
    for (int i = 0; i < 2; ++i) { int R, C; stage_rc(tid * 16 + i * 8192, R, C); const int Rb = Epi::PERM ? ((R & ~31) + perm32(R & 31)) : R; voffB[i] = (unsigned)(Rb * K + C) * 2u; }
    constexpr size_t kstep = (size_t)(BK * 2);
    constexpr size_t hstep = (size_t)HALF * K * 2;
    constexpr size_t hA = GATHER ? (size_t)0 : hstep;
    const unsigned ldsw = (unsigned)wid * 1024u;
    const int aoff = lds_byte(wr * 64 + fr, fq * 8), boff = lds_byte(wc * 32 + fr, fq * 8);
#define PG8_SA(b, h) (((b) * 2 + (h)) * HTB)
#define PG8_SB(b, h) ((4 + (b) * 2 + (h)) * HTB)
#define PG8_STAGE(bufoff, gbase, voff) do { _Pragma("unroll") for (int _i = 0; _i < 2; ++_i) \
        __builtin_amdgcn_global_load_lds((const unsigned*)((const char*)(gbase) + (voff)[_i]), (LAS unsigned*)(lds + (bufoff) + ldsw + _i * 8192), 16, 0, 0); } while (0)
#define PG8_SETA(v, slot) do { _Pragma("unroll") for (int _h = 0; _h < 2; ++_h) _Pragma("unroll") for (int _i = 0; _i < 2; ++_i) { int _R, _C; stage_rc(tid * 16 + _i * 8192, _R, _C); \
        (v)[_h][_i] = GATHER ? ((unsigned)gtab[(slot) * BM + _h * HALF + _R] * (unsigned)K + (unsigned)_C) * 2u : (unsigned)(_R * K + _C) * 2u; } } while (0)
#define PG8_LDA(dst, b, h) do { _Pragma("unroll") for (int m = 0; m < 4; ++m) _Pragma("unroll") for (int k = 0; k < 2; ++k) dst[m][k] = *(const LAS bf16x8*)(lds + PG8_SA(b, h) + aoff + m * 2048 + k * 1024); } while (0)
#define PG8_LDB(dst, b, h) do { _Pragma("unroll") for (int n = 0; n < 2; ++n) _Pragma("unroll") for (int k = 0; k < 2; ++k) dst[n][k] = *(const LAS bf16x8*)(lds + PG8_SB(b, h) + boff + n * 2048 + k * 1024); } while (0)
#define PG8_MMA(ai, bj, At, Bt) do { __builtin_amdgcn_s_setprio(1); _Pragma("unroll") for (int m = 0; m < 4; ++m) _Pragma("unroll") for (int n = 0; n < 2; ++n) _Pragma("unroll") for (int k = 0; k < 2; ++k) \
        acc[ai][bj][m][n] = __builtin_amdgcn_mfma_f32_16x16x32_bf16(Bt[n][k], At[m][k], acc[ai][bj][m][n], 0, 0, 0); __builtin_amdgcn_s_setprio(0); } while (0)
#define PG8_WAIT_V(n) asm volatile("s_waitcnt vmcnt(" #n ")" ::: "memory")
#define PG8_WAIT_L(n) asm volatile("s_waitcnt lgkmcnt(" #n ")" ::: "memory")
#define PG8_BAR __builtin_amdgcn_s_barrier()
#define PG8_SCHED __builtin_amdgcn_sched_barrier(0)
    Unit cur, nxt; int ui = 0;
    if (!S.next(0, cur)) return;
    f32x4 acc[2][2][4][2];
#pragma unroll
    for (int a = 0; a < 2; ++a)
#pragma unroll
        for (int b = 0; b < 2; ++b)
#pragma unroll
            for (int m = 0; m < 4; ++m)
#pragma unroll
                for (int n = 0; n < 2; ++n) acc[a][b][m][n] = (f32x4){0.f, 0.f, 0.f, 0.f};
    bf16x8 At[4][2], B0[2][2], B1[2][2];
    PG8_SETA(vc, cur.tab);
    const char* cA = (const char*)Ap + (GATHER ? (size_t)0 : (size_t)cur.orow * K * 2); const char* cB = (const char*)Btp + (size_t)cur.brow * K * 2;
    PG8_STAGE(PG8_SB(0, 0), cB, voffB); PG8_STAGE(PG8_SB(0, 1), cB + hstep, voffB); PG8_STAGE(PG8_SA(0, 0), cA, vc[0]); PG8_STAGE(PG8_SA(0, 1), cA + hA, vc[1]);
    if (wr == 1) PG8_BAR;
    PG8_WAIT_V(2); PG8_BAR;
    PG8_STAGE(PG8_SB(1, 0), cB + kstep, voffB); PG8_STAGE(PG8_SA(1, 0), cA + kstep, vc[0]); PG8_STAGE(PG8_SB(1, 1), cB + hstep + kstep, voffB);
    PG8_WAIT_V(6); PG8_BAR;
    for (;;) {
        const bool has_next = S.next(ui + 1, nxt);
        const char* nA = has_next ? (const char*)Ap + (GATHER ? (size_t)0 : (size_t)nxt.orow * K * 2) : cA; const char* nB = has_next ? (const char*)Btp + (size_t)nxt.brow * K * 2 : cB;
        for (int t = 0; t < nt; t += 2) {
            const bool last = (t == nt - 2);
            const char* a1 = cA + (size_t)(t + 1) * kstep;
            const char* a2 = last ? nA : cA + (size_t)(t + 2) * kstep; const char* b2 = last ? nB : cB + (size_t)(t + 2) * kstep;
            const char* a3 = a2 + kstep; const char* b3 = b2 + kstep;
            PG8_LDB(B0, 0, 0); PG8_LDB(B1, 0, 1); PG8_SCHED; PG8_LDA(At, 0, 0); PG8_STAGE(PG8_SA(1, 1), a1 + hA, vc[1]);
            if (GATHER && last && has_next) PG8_SETA(vc, nxt.tab);
            PG8_WAIT_V(8); PG8_WAIT_L(0); PG8_BAR; PG8_MMA(0, 0, At, B0); PG8_MMA(0, 1, At, B1); PG8_BAR; PG8_SCHED;
            PG8_LDA(At, 0, 1); PG8_STAGE(PG8_SB(0, 0), b2, voffB); PG8_STAGE(PG8_SB(0, 1), b2 + hstep, voffB); PG8_STAGE(PG8_SA(0, 0), a2, vc[0]);
            PG8_WAIT_V(8); PG8_WAIT_L(0); PG8_BAR; PG8_MMA(1, 0, At, B0); PG8_MMA(1, 1, At, B1); PG8_BAR; PG8_SCHED;
            PG8_LDB(B0, 1, 0); PG8_LDB(B1, 1, 1); PG8_SCHED; PG8_LDA(At, 1, 0); PG8_STAGE(PG8_SA(0, 1), a2 + hA, vc[1]);
            PG8_WAIT_V(8); PG8_WAIT_L(0); PG8_BAR; PG8_MMA(0, 0, At, B0); PG8_MMA(0, 1, At, B1); PG8_BAR; PG8_SCHED;
            PG8_LDA(At, 1, 1); PG8_STAGE(PG8_SB(1, 0), b3, voffB); PG8_STAGE(PG8_SB(1, 1), b3 + hstep, voffB); PG8_STAGE(PG8_SA(1, 0), a3, vc[0]);
            PG8_WAIT_V(8); PG8_WAIT_L(0); PG8_BAR; PG8_MMA(1, 0, At, B0); PG8_MMA(1, 1, At, B1); PG8_BAR; PG8_SCHED;
        }
        if (wr == 0) PG8_BAR;
        { const int l2 = opaque_tid(wv) & 63; E(acc, cur, wr, wc, l2 & 15, l2 >> 4); }
        if (!has_next) break;
#pragma unroll
        for (int a = 0; a < 2; ++a)
#pragma unroll
            for (int b = 0; b < 2; ++b)
#pragma unroll
                for (int m = 0; m < 4; ++m)
#pragma unroll
                    for (int n = 0; n < 2; ++n) acc[a][b][m][n] = (f32x4){0.f, 0.f, 0.f, 0.f};
        cur = nxt; cA = nA; cB = nB; ++ui;
        if (wr == 1) PG8_BAR;
    }
    PG8_WAIT_V(0);
    PG8_BAR;
#undef PG8_SA
#undef PG8_SB
#undef PG8_STAGE
#undef PG8_SETA
#undef PG8_LDA
#undef PG8_LDB
#undef PG8_MMA
#undef PG8_WAIT_V
#undef PG8_WAIT_L
#undef PG8_BAR
#undef PG8_SCHED
}
}
constexpr int NWAVES = 8, NTHR = 512;
constexpr int RING_OFF = 0, RING_BYTES = 131072;
constexpr int TAB_OFF = RING_BYTES, TAB_BYTES = 24576;
constexpr int MISC_OFF = TAB_OFF + TAB_BYTES;
constexpr int ULIST_OFF = MISC_OFF + 128, ULIST_CAP = 64;
constexpr int LDS_BYTES = 160 * 1024;
static_assert(ULIST_OFF + ULIST_CAP * 16 <= LDS_BYTES, "LDS map");
constexpr int CW_BAR = 1024;

#define XB_TMO      128
#define XB_XCNT(j)  (256  + 64 * (j))
#define XB_XSUB(j)  (1280 + 64 * (j))
#define XB_XGEN(j)  (2304 + 64 * (j))
#define XB_TOP      3328
#define XB_TOPGEN   3392
#define XCD_BAR_WORDS 3456
#define XB_SPIN_CAP (1u << 22)
static_assert((CW_BAR + XCD_BAR_WORDS) * 4 <= (int)CTL_ZERO_BYTES, "barrier words inside the memset region");

__device__ __forceinline__ unsigned xb_ld(unsigned* p)              { return __hip_atomic_load(p, __ATOMIC_RELAXED, __HIP_MEMORY_SCOPE_AGENT); }
__device__ __forceinline__ unsigned xb_add(unsigned* p, unsigned v) { return __hip_atomic_fetch_add(p, v, __ATOMIC_RELAXED, __HIP_MEMORY_SCOPE_AGENT); }
__device__ __forceinline__ unsigned xb_xcc_id() { return (unsigned)__builtin_amdgcn_s_getreg((3 << 11) | 20) & 0xFu; }
#define XB_SPIN(cond, bar) do { unsigned _sp = 0; while (cond) { __builtin_amdgcn_s_sleep(1); \
    if ((++_sp & 255u) == 0u) { if (xb_ld(&(bar)[XB_TMO])) break; if (_sp > XB_SPIN_CAP) { atomicAdd(&(bar)[XB_TMO], 1u); break; } } } } while (0)

struct XcdBarrier { unsigned* bar; unsigned x; volatile LAS unsigned* st; int w0; };
__device__ __forceinline__ XcdBarrier xcd_barrier_post(unsigned* bar, volatile LAS unsigned* st) {
    XcdBarrier b; b.bar = bar; b.x = xb_xcc_id(); b.st = st; b.w0 = (__builtin_amdgcn_readfirstlane(threadIdx.x >> 6) == 0) ? 1 : 0;
    if (threadIdx.x == 0) (void)xb_add(&bar[XB_XCNT(b.x)], 1u);
    return b;
}
__device__ __forceinline__ void xcd_barrier_complete(unsigned* bar, unsigned x, unsigned& nloc, unsigned& nx) {
    const unsigned G = gridDim.x * gridDim.y * gridDim.z;
    unsigned sum, cnt, mine, sp = 0u;
    for (;;) {
        sum = 0u; cnt = 0u; mine = 0u;
#pragma unroll
        for (unsigned j = 0; j < 16; ++j) { const unsigned c = xb_ld(&bar[XB_XCNT(j)]); sum += c; cnt += (c > 0u) ? 1u : 0u; mine = (j == x) ? c : mine; }
        if (sum == G) break;
        __builtin_amdgcn_s_sleep(1);
        if ((++sp & 255u) == 0u) { if (xb_ld(&bar[XB_TMO])) break; if (sp > XB_SPIN_CAP) { atomicAdd(&bar[XB_TMO], 1u); break; } }
    }
    nloc = mine > 0u ? mine : 1u; nx = cnt > 0u ? cnt : 1u;
}
__device__ __forceinline__ void xcd_barrier(const XcdBarrier& b) {
    asm volatile("s_waitcnt vmcnt(0)" ::: "memory");
    __syncthreads();
    if (b.w0 && lane_id() == 0) {
        unsigned* bar = b.bar;
        __builtin_amdgcn_s_waitcnt(0);
        unsigned nloc = b.st[0], nx = b.st[1];
        if (nloc == 0u) { xcd_barrier_complete(bar, b.x, nloc, nx); b.st[0] = nloc; b.st[1] = nx; }
        const unsigned old = xb_add(&bar[XB_XSUB(b.x)], 1u);
        const unsigned gen = old / nloc;
        if (old + 1u == (gen + 1u) * nloc) {
            __builtin_amdgcn_fence(__ATOMIC_RELEASE, "agent");
            asm volatile("s_waitcnt vmcnt(0)" ::: "memory");
            const unsigned og = xb_add(&bar[XB_TOP], 1u);
            const unsigned tg = og / nx;
            if (og + 1u == (tg + 1u) * nx) xb_add(&bar[XB_TOPGEN], 1u);
            else XB_SPIN(xb_ld(&bar[XB_TOPGEN]) == tg, bar);
            __builtin_amdgcn_fence(__ATOMIC_ACQUIRE, "agent");
            xb_add(&bar[XB_XGEN(b.x)], 1u);
            asm volatile("s_waitcnt vmcnt(0)" ::: "memory");
        } else {
            XB_SPIN(xb_ld(&bar[XB_XGEN(b.x)]) == gen, bar);
            __builtin_amdgcn_fence(__ATOMIC_ACQUIRE, "agent");
            asm volatile("s_waitcnt vmcnt(0)" ::: "memory");
        }
    }
    __syncthreads();
}

__device__ __forceinline__ void transpose_item(const float* W, int K, int N, bf16_t* WT, int k0, int n0, int drow, LAS float* scr, int lane) {
#pragma unroll 8
    for (int i = 0; i < 32; ++i) { const int kk = 2 * i + (lane >> 5); scr[kk * 33 + (lane & 31)] = W[(size_t)(k0 + kk) * N + n0 + (lane & 31)]; }
    asm volatile("s_waitcnt lgkmcnt(0)" ::: "memory");
    const int c = lane & 7;
#pragma unroll
    for (int j = 0; j < 4; ++j) { const int n = (lane >> 3) + 8 * j; const LAS float* s = scr + (8 * c) * 33 + n;
        u32x4 o; o.x = pk2(s[0 * 33], s[1 * 33]); o.y = pk2(s[2 * 33], s[3 * 33]); o.z = pk2(s[4 * 33], s[5 * 33]); o.w = pk2(s[6 * 33], s[7 * 33]);
        *(u32x4*)(WT + (size_t)(drow + n) * K + k0 + 8 * c) = o; }
    asm volatile("s_waitcnt lgkmcnt(0)" ::: "memory");
}
struct WPtrs { const float *w_in, *w_out, *gate, *plew, *ew1, *ew3, *ew2, *sw1, *sw3, *sw2, *rw; };
__device__ __forceinline__ void convert_weights(unsigned char* ldsb, const WPtrs& P, unsigned char* wsw, int gw, int NGW, int wave, int lane) {
    LAS float* scr = (LAS float*)((LAS unsigned char*)ldsb + wave * 8448);
    bf16_t* WIN = (bf16_t*)(wsw + WO_WIN); bf16_t* WOUT = (bf16_t*)(wsw + WO_WOUT); bf16_t* GATE = (bf16_t*)(wsw + WO_GATE); bf16_t* PLEW = (bf16_t*)(wsw + WO_PLEW);
    bf16_t* W2 = (bf16_t*)(wsw + WO_W2); bf16_t* W13 = (bf16_t*)(wsw + WO_W13); bf16_t* ROUT = (bf16_t*)(wsw + WO_ROUT);
    constexpr int I_IN = (D / 64) * (IN_COLS / 32), I_OUT = (D / 64) * (D / 32), I_GATE = I_OUT, I_PLE = (PLE / 64) * (D / 32), I_W2 = (EF / 64) * (D / 32), I_W13 = (D / 64) * (EF / 32), I_R = (D / 64) * (NE / 32);
    constexpr int NITEMS = I_R + I_IN + I_OUT + I_GATE + I_PLE + 65 * I_W2 + 65 * 2 * I_W13;
    for (int it = gw; it < NITEMS; it += NGW) {
        int r = it;
        if (r < I_R) { const int nb = NE / 32; transpose_item(P.rw, D, NE, ROUT, 64 * (r / nb), 32 * (r % nb), 32 * (r % nb), scr, lane); continue; } r -= I_R;
        if (r < I_IN) { const int nb = IN_COLS / 32; transpose_item(P.w_in, D, IN_COLS, WIN, 64 * (r / nb), 32 * (r % nb), 32 * (r % nb), scr, lane); continue; } r -= I_IN;
        if (r < I_OUT) { const int nb = D / 32; transpose_item(P.w_out, D, D, WOUT, 64 * (r / nb), 32 * (r % nb), 32 * (r % nb), scr, lane); continue; } r -= I_OUT;
        if (r < I_GATE) { const int nb = D / 32; transpose_item(P.gate, D, D, GATE, 64 * (r / nb), 32 * (r % nb), 32 * (r % nb), scr, lane); continue; } r -= I_GATE;
        if (r < I_PLE) { const int nb = D / 32; transpose_item(P.plew, PLE, D, PLEW, 64 * (r / nb), 32 * (r % nb), 32 * (r % nb), scr, lane); continue; } r -= I_PLE;
        if (r < 65 * I_W2) { const int e = r / I_W2, q = r % I_W2, nb = D / 32; const float* src = (e < 64) ? P.ew2 + (size_t)e * EF * D : P.sw2;
            transpose_item(src, EF, D, W2 + (size_t)e * D * EF, 64 * (q / nb), 32 * (q % nb), 32 * (q % nb), scr, lane); continue; } r -= 65 * I_W2;
        { const int e = r / (2 * I_W13), q2 = r % (2 * I_W13), mth = q2 / I_W13, q = q2 % I_W13, nb = EF / 32; const int n0 = 32 * (q % nb);
          const float* src = (e < 64) ? (mth ? P.ew3 : P.ew1) + (size_t)e * D * EF : (mth ? P.sw3 : P.sw1);
          transpose_item(src, D, EF, W13 + (size_t)e * 1024 * D, 64 * (q / nb), n0, 256 * (n0 >> 7) + 128 * mth + (n0 & 127), scr, lane); }
    }
    for (int i = gw * 64 + lane; i < (256 - NE) * D * 2 / 16; i += NGW * 64) ((u32x4*)(ROUT + (size_t)NE * D))[i] = (u32x4){0u, 0u, 0u, 0u};
}
__device__ __forceinline__ void convert_rows(const float* src, bf16_t* dst, size_t n, size_t gtid, size_t nthr) {
    for (size_t i = gtid * 8; i < n; i += nthr * 8) { const float4 a = *(const float4*)(src + i), b = *(const float4*)(src + i + 4);
        u32x4 o; o.x = pk2(a.x, a.y); o.y = pk2(a.z, a.w); o.z = pk2(b.x, b.y); o.w = pk2(b.z, b.w); *(u32x4*)(dst + i) = o; }
}

template <bool ADDY>
__device__ __forceinline__ void ln_row(float* xrow, const float* gain, const float* bias, bf16_t* xb, const bf16_t* yrows, const bf16_t* yp, const bf16_t* ysh, int lane) {
    float4* xr = (float4*)xrow + lane;
    float4 v[8]; float s = 0.f;
#pragma unroll
    for (int j = 0; j < 8; ++j) v[j] = xr[64 * j];
    if (ADDY) {
#pragma unroll
        for (int j = 0; j < 8; ++j) { const u32x2 a = ((const u32x2*)yp + lane)[64 * j], b = ((const u32x2*)ysh + lane)[64 * j];
            v[j].x = ALPHA * v[j].x + (bflo(a.x) + bflo(b.x)); v[j].y = ALPHA * v[j].y + (bfhi(a.x) + bfhi(b.x)); v[j].z = ALPHA * v[j].z + (bflo(a.y) + bflo(b.y)); v[j].w = ALPHA * v[j].w + (bfhi(a.y) + bfhi(b.y)); }
#pragma unroll
        for (int k = 0; k < TOPK; ++k) { const u32x2* ypk = (const u32x2*)(yrows + (size_t)k * D) + lane;
#pragma unroll
            for (int j = 0; j < 8; ++j) { const u32x2 y = ypk[64 * j]; v[j].x += bflo(y.x); v[j].y += bfhi(y.x); v[j].z += bflo(y.y); v[j].w += bfhi(y.y); } }
    }
#pragma unroll
    for (int j = 0; j < 8; ++j) s += (v[j].x + v[j].y) + (v[j].z + v[j].w);
    const float mean = wave_sum(s) * (1.f / D); float q = 0.f;
#pragma unroll
    for (int j = 0; j < 8; ++j) { v[j].x -= mean; v[j].y -= mean; v[j].z -= mean; v[j].w -= mean; q += (v[j].x * v[j].x + v[j].y * v[j].y) + (v[j].z * v[j].z + v[j].w * v[j].w); }
    const float rstd = rsqf_(wave_sum(q) * (1.f / D) + 1e-5f);
    u32x2* ob = (u32x2*)xb + lane;
#pragma unroll
    for (int j = 0; j < 8; ++j) { const float4 g = ((const float4*)gain)[lane + 64 * j], b = ((const float4*)bias)[lane + 64 * j];
        float4 o; o.x = v[j].x * rstd * g.x + b.x; o.y = v[j].y * rstd * g.y + b.y; o.z = v[j].z * rstd * g.z + b.z; o.w = v[j].w * rstd * g.w + b.w; xr[64 * j] = o;
        u32x2 w; w.x = pk2(o.x, o.y); w.y = pk2(o.z, o.w); ob[64 * j] = w; }
}
constexpr int AT_KS = 72, AT_VS = 264, AT_PS = 168;
constexpr int AT_LDS_K = 0, AT_LDS_V = 256 * AT_KS * 2, AT_LDS_P = AT_LDS_V + (64 * AT_VS + 64) * 2, AT_LDS_SS = AT_LDS_P + 8 * 16 * AT_PS * 2, AT_LDS_CS = AT_LDS_SS + 8 * 128 * 4, AT_LDS_BYTES = AT_LDS_CS + 128 * 16 * 4;
static_assert(AT_LDS_BYTES <= RING_BYTES, "attention LDS");
struct RotTab { double invf[8]; };
__device__ __forceinline__ void attn_unit(const int wv, unsigned char* lds, int u, const bf16_t* HIN, const int* positions, const float* sinks, bf16_t* MIX, float* SSQ, const RotTab& rt) {
    bf16_t* Ks = (bf16_t*)(lds + AT_LDS_K); bf16_t* Vt = (bf16_t*)(lds + AT_LDS_V); bf16_t* Ps = (bf16_t*)(lds + AT_LDS_P); float* SS = (float*)(lds + AT_LDS_SS); float* CS = (float*)(lds + AT_LDS_CS);
    const int g = u & 1, n = (u >> 1) & 31, b = u >> 6;
    const int tid = opaque_tid(wv), lane = tid & 63, w = tid >> 6;
    __syncthreads();
    {
        const int j = tid >> 1, half = tid & 1; const int kp = 128 * (n - 1) + j;
        u32x4 kv[4], vv[4];
        if (kp >= 0) {
            const bf16_t* kr = HIN + (size_t)(b * SEQ + kp) * IN_COLS + C_AK + g * 64 + half * 32;
            const bf16_t* vr = HIN + (size_t)(b * SEQ + kp) * IN_COLS + C_AV + g * 64 + half * 32;
#pragma unroll
            for (int i = 0; i < 4; ++i) { kv[i] = *(const u32x4*)(kr + 8 * i); vv[i] = *(const u32x4*)(vr + 8 * i); }
            if (half == 0) {
                const float pos = (float)positions[b * SEQ + kp];
                float t1[8], t2[8];
                t1[0] = bflo(kv[0].x); t1[1] = bfhi(kv[0].x); t1[2] = bflo(kv[0].y); t1[3] = bfhi(kv[0].y); t1[4] = bflo(kv[0].z); t1[5] = bfhi(kv[0].z); t1[6] = bflo(kv[0].w); t1[7] = bfhi(kv[0].w);
                t2[0] = bflo(kv[1].x); t2[1] = bfhi(kv[1].x); t2[2] = bflo(kv[1].y); t2[3] = bfhi(kv[1].y); t2[4] = bflo(kv[1].z); t2[5] = bfhi(kv[1].z); t2[6] = bflo(kv[1].w); t2[7] = bfhi(kv[1].w);
#pragma unroll
                for (int i = 0; i < 8; ++i) { float sn, cs; sincos_pos(pos, rt.invf[i], sn, cs); const float a = t1[i] * cs - t2[i] * sn, bb = t2[i] * cs + t1[i] * sn; t1[i] = a; t2[i] = bb;
                    if (j >= 128) { CS[(j - 128) * 16 + i] = cs; CS[(j - 128) * 16 + 8 + i] = sn; } }
                kv[0].x = cvt_pk_bf16(t1[0], t1[1]); kv[0].y = cvt_pk_bf16(t1[2], t1[3]); kv[0].z = cvt_pk_bf16(t1[4], t1[5]); kv[0].w = cvt_pk_bf16(t1[6], t1[7]);
                kv[1].x = cvt_pk_bf16(t2[0], t2[1]); kv[1].y = cvt_pk_bf16(t2[2], t2[3]); kv[1].z = cvt_pk_bf16(t2[4], t2[5]); kv[1].w = cvt_pk_bf16(t2[6], t2[7]);
            }
        } else {
#pragma unroll
            for (int i = 0; i < 4; ++i) { kv[i] = (u32x4){0u, 0u, 0u, 0u}; vv[i] = (u32x4){0u, 0u, 0u, 0u}; }
        }
#pragma unroll
        for (int i = 0; i < 4; ++i) *(u32x4*)(Ks + j * AT_KS + half * 32 + 8 * i) = kv[i];
#pragma unroll
        for (int i = 0; i < 4; ++i) { const int d = half * 32 + 8 * i;
            Vt[(d + 0) * AT_VS + j] = (bf16_t)(vv[i].x & 0xffff); Vt[(d + 1) * AT_VS + j] = (bf16_t)(vv[i].x >> 16); Vt[(d + 2) * AT_VS + j] = (bf16_t)(vv[i].y & 0xffff); Vt[(d + 3) * AT_VS + j] = (bf16_t)(vv[i].y >> 16);
            Vt[(d + 4) * AT_VS + j] = (bf16_t)(vv[i].z & 0xffff); Vt[(d + 5) * AT_VS + j] = (bf16_t)(vv[i].z >> 16); Vt[(d + 6) * AT_VS + j] = (bf16_t)(vv[i].w & 0xffff); Vt[(d + 7) * AT_VS + j] = (bf16_t)(vv[i].w >> 16); }
        if (tid < 64) {
#pragma unroll
            for (int i = 0; i < 8; ++i) Vt[tid * AT_VS + 256 + i] = 0;
            Vt[64 * AT_VS + tid] = 0;
        }
        for (int i = tid; i < 8 * 16 * 24; i += NTHR) { const int r = i / 24, c = 144 + i % 24; Ps[r * AT_PS + c] = 0; }
    }
    __syncthreads();
    const int hq = g * 8 + w;
    constexpr float LOG2E = 1.4426950408889634f, C2 = 0.125f * LOG2E;
    const float sink2 = sinks[hq] * LOG2E;
    const int lr = lane & 15, lg = lane >> 4;
    bf16_t* Pw = Ps + w * 16 * AT_PS;
    for (int qi = 0; qi < 8; ++qi) {
        const int tq = b * SEQ + n * 128 + qi * 16 + lr;
        const bf16_t* qr = HIN + (size_t)tq * IN_COLS + C_AQ + hq * 64 + lg * 8;
        u32x4 q0 = *(const u32x4*)qr; const u32x4 q1 = *(const u32x4*)(qr + 32);
        {
            u32x4 other; other.x = __shfl_xor(q0.x, 16); other.y = __shfl_xor(q0.y, 16); other.z = __shfl_xor(q0.z, 16); other.w = __shfl_xor(q0.w, 16);
            if (lg < 2) {
                const float4 c0 = *(const float4*)(CS + (qi * 16 + lr) * 16), c1 = *(const float4*)(CS + (qi * 16 + lr) * 16 + 4), s0 = *(const float4*)(CS + (qi * 16 + lr) * 16 + 8), s1 = *(const float4*)(CS + (qi * 16 + lr) * 16 + 12);
                const float cs[8] = {c0.x, c0.y, c0.z, c0.w, c1.x, c1.y, c1.z, c1.w}; const float sn[8] = {s0.x, s0.y, s0.z, s0.w, s1.x, s1.y, s1.z, s1.w};
                float mv[8], ov[8];
                mv[0] = bflo(q0.x); mv[1] = bfhi(q0.x); mv[2] = bflo(q0.y); mv[3] = bfhi(q0.y); mv[4] = bflo(q0.z); mv[5] = bfhi(q0.z); mv[6] = bflo(q0.w); mv[7] = bfhi(q0.w);
                ov[0] = bflo(other.x); ov[1] = bfhi(other.x); ov[2] = bflo(other.y); ov[3] = bfhi(other.y); ov[4] = bflo(other.z); ov[5] = bfhi(other.z); ov[6] = bflo(other.w); ov[7] = bfhi(other.w);
                const float sg = (lg == 0) ? -1.f : 1.f;
#pragma unroll
                for (int i = 0; i < 8; ++i) mv[i] = mv[i] * cs[i] + sg * ov[i] * sn[i];
                q0.x = cvt_pk_bf16(mv[0], mv[1]); q0.y = cvt_pk_bf16(mv[2], mv[3]); q0.z = cvt_pk_bf16(mv[4], mv[5]); q0.w = cvt_pk_bf16(mv[6], mv[7]);
            }
        }
        const bf16x8 qa0 = __builtin_bit_cast(bf16x8, q0), qa1 = __builtin_bit_cast(bf16x8, q1);
        f32x4 s[9];
#pragma unroll
        for (int jt = 0; jt < 9; ++jt) {
            const int jr = (qi + jt) * 16 + lr;
            const bf16x8 kb0 = *(const bf16x8*)(Ks + jr * AT_KS + lg * 8), kb1 = *(const bf16x8*)(Ks + jr * AT_KS + 32 + lg * 8);
            f32x4 a = (f32x4){0.f, 0.f, 0.f, 0.f};
            a = __builtin_amdgcn_mfma_f32_16x16x32_bf16(kb0, qa0, a, 0, 0, 0);
            a = __builtin_amdgcn_mfma_f32_16x16x32_bf16(kb1, qa1, a, 0, 0, 0);
            s[jt] = a;
        }
#pragma unroll
        for (int r = 0; r < 4; ++r) { if (!(4 * lg + r > lr)) s[0][r] = -3.0e38f; if (!(4 * lg + r <= lr)) s[8][r] = -3.0e38f; }
        if (n == 0) {
#pragma unroll
            for (int jt = 0; jt < 8; ++jt) if (qi + jt < 8) s[jt] = (f32x4){-3.0e38f, -3.0e38f, -3.0e38f, -3.0e38f};
        }
        float m = -3.0e38f;
#pragma unroll
        for (int jt = 0; jt < 9; ++jt) m = fmaxf(fmaxf(m, fmaxf(s[jt][0], s[jt][1])), fmaxf(s[jt][2], s[jt][3]));
        m = fmaxf(m, __shfl_xor(m, 16)); m = fmaxf(m, __shfl_xor(m, 32));
        const float m2 = fmaxf(m * C2, sink2);
        float sum = 0.f;
#pragma unroll
        for (int jt = 0; jt < 9; ++jt) {
            f32x4 p;
#pragma unroll
            for (int r = 0; r < 4; ++r) { p[r] = __builtin_amdgcn_exp2f(fmaf(s[jt][r], C2, -m2)); sum += p[r]; }
            u32x2 pk; pk.x = cvt_pk_bf16(p[0], p[1]); pk.y = cvt_pk_bf16(p[2], p[3]);
            *(u32x2*)(Pw + lr * AT_PS + jt * 16 + 4 * lg) = pk;
        }
        sum += __shfl_xor(sum, 16); sum += __shfl_xor(sum, 32);
        const float inv = rcpf_(sum + __builtin_amdgcn_exp2f(sink2 - m2));
        asm volatile("s_waitcnt lgkmcnt(0)" ::: "memory");
        f32x4 o[4];
#pragma unroll
        for (int dt = 0; dt < 4; ++dt) o[dt] = (f32x4){0.f, 0.f, 0.f, 0.f};
#pragma unroll
        for (int ks = 0; ks < 5; ++ks) {
            const bf16x8 pa = *(const bf16x8*)(Pw + lr * AT_PS + ks * 32 + lg * 8);
#pragma unroll
            for (int dt = 0; dt < 4; ++dt) { const bf16x8 vb = *(const bf16x8*)(Vt + (dt * 16 + lr) * AT_VS + qi * 16 + ks * 32 + lg * 8); o[dt] = __builtin_amdgcn_mfma_f32_16x16x32_bf16(vb, pa, o[dt], 0, 0, 0); }
        }
        float q = 0.f;
        bf16_t* orow = MIX + (size_t)tq * D + hq * 64 + 4 * lg;
#pragma unroll
        for (int dt = 0; dt < 4; ++dt) { const f32x4 v = o[dt] * inv; q += (v[0] * v[0] + v[1] * v[1]) + (v[2] * v[2] + v[3] * v[3]);
            u32x2 pk; pk.x = cvt_pk_bf16(v[0], v[1]); pk.y = cvt_pk_bf16(v[2], v[3]); *(u32x2*)(orow + dt * 16) = pk; }
        q += __shfl_xor(q, 16); q += __shfl_xor(q, 32);
        if (lg == 0) SS[w * 128 + qi * 16 + lr] = q;
    }
    __syncthreads();
    if (tid < 128) { float q = 0.f;
#pragma unroll
        for (int ww = 0; ww < 8; ++ww) q += SS[ww * 128 + tid];
        SSQ[(size_t)(b * SEQ + n * 128 + tid) * 2 + g] = q; }
}
__device__ __forceinline__ void attn_fin_row(bf16_t* MIX, const float* SSQ, const float* gain, int t, int lane) {
    const float sc = rsqf_((SSQ[(size_t)t * 2] + SSQ[(size_t)t * 2 + 1]) * (1.0f / 1024.f) + 1e-6f);
    u32x4* p = (u32x4*)(MIX + (size_t)t * D) + lane * 2;
#pragma unroll
    for (int h = 0; h < 2; ++h) { u32x4 v = p[h]; const int c = lane * 16 + h * 8; const float4 g0 = *(const float4*)(gain + c), g1 = *(const float4*)(gain + c + 4);
        v.x = pk2(bflo(v.x) * sc * g0.x, bfhi(v.x) * sc * g0.y); v.y = pk2(bflo(v.y) * sc * g0.z, bfhi(v.y) * sc * g0.w);
        v.z = pk2(bflo(v.z) * sc * g1.x, bfhi(v.z) * sc * g1.y); v.w = pk2(bflo(v.w) * sc * g1.z, bfhi(v.w) * sc * g1.w);
        p[h] = v; }
}

constexpr int HG_S72 = 72, HG_S136 = 136;
__device__ __forceinline__ float hg_lb(const float* lbl, int layer, int col) { if (layer == 0) return 0.f; return sigmoidf_(lbl[512 + col] - lbl[col]); }
constexpr int H1_LDS_KT = 0, H1_LDS_VT = 128 * HG_S72 * 2, H1_LDS_TOT = 2 * 128 * HG_S72 * 2, H1_LDS_BYTES = H1_LDS_TOT + 4 * 128 * 4;
__device__ __forceinline__ void hg1_unit(const int wv, unsigned char* lds, int u, const bf16_t* HIN, const float* lbl, int layer, float* SST, float* DV) {
    bf16_t* KT = (bf16_t*)(lds + H1_LDS_KT); bf16_t* VT = (bf16_t*)(lds + H1_LDS_VT); float* TOT = (float*)(lds + H1_LDS_TOT);
    const int c = u & 63, h = (u >> 6) & 3, b = u >> 8;
    const int tid = opaque_tid(wv), lane = tid & 63, w = tid >> 6, k = tid & 127, tq = tid >> 7;
    const size_t t0 = (size_t)b * SEQ + c * 64;
    const float lb = hg_lb(lbl, layer, h * 128 + k);
    __syncthreads();
    float bl[16], kf[16]; float cum = 0.f;
#pragma unroll
    for (int i = 0; i < 16; ++i) { const size_t row = (t0 + 16 * tq + i) * IN_COLS; const float fp = bf2f(HIN[row + C_HF + h * 128 + k]);
        const float sg = sigmoidf_(fp); const float f = lb + (1.f - lb) * sg; cum += __logf(fmaxf(f, 1e-30f)); bl[i] = cum; kf[i] = (1.f - lb) * (1.f - sg);
        VT[k * HG_S72 + 16 * tq + i] = HIN[row + C_HI + h * 128 + k]; }
    TOT[tq * 128 + k] = cum;
    __syncthreads();
    float pre = 0.f, total = 0.f;
#pragma unroll
    for (int j = 0; j < 4; ++j) { const float tj = TOT[j * 128 + k]; if (j < tq) pre += tj; total += tj; }
#pragma unroll
    for (int i = 0; i < 16; ++i) KT[k * HG_S72 + 16 * tq + i] = f2bf_hw(kf[i] * __expf(total - (pre + bl[i])));
    if (tq == 0) DV[(size_t)u * 128 + k] = __expf(total);
    __syncthreads();
    const int lr = lane & 15, lg = lane >> 4;
    bf16x8 a[2];
#pragma unroll
    for (int ks = 0; ks < 2; ++ks) a[ks] = *(const bf16x8*)(VT + (w * 16 + lr) * HG_S72 + ks * 32 + lg * 8);
    float* out = SST + (size_t)u * 16384;
#pragma unroll
    for (int kt = 0; kt < 8; ++kt) {
        f32x4 acc = (f32x4){0.f, 0.f, 0.f, 0.f};
#pragma unroll
        for (int ks = 0; ks < 2; ++ks) { const bf16x8 bb = *(const bf16x8*)(KT + (kt * 16 + lr) * HG_S72 + ks * 32 + lg * 8); acc = __builtin_amdgcn_mfma_f32_16x16x32_bf16(a[ks], bb, acc, 0, 0, 0); }
#pragma unroll
        for (int r = 0; r < 4; ++r) out[(w * 16 + 4 * lg + r) * 128 + kt * 16 + lr] = acc[r];
    }
}
__device__ __forceinline__ void hg2_unit(const int wv, int u, float* SST, const float* DV) {
    const int bh = u >> 3, part = u & 7, e4 = part * 512 + opaque_tid(wv);
    const int k4 = (e4 & 31) * 4;
    float4 S = make_float4(0.f, 0.f, 0.f, 0.f);
    for (int c = 0; c < 64; ++c) {
        const size_t uu = (size_t)bh * 64 + c;
        float4* p = (float4*)(SST + uu * 16384) + e4;
        const float4 ds = *p; const float4 dv = *(const float4*)(DV + uu * 128 + k4);
        *p = S;
        S.x = dv.x * S.x + ds.x; S.y = dv.y * S.y + ds.y; S.z = dv.z * S.z + ds.z; S.w = dv.w * S.w + ds.w;
    }
}
constexpr int H3_QI = 0, H3_QE = H3_QI + 64 * HG_S136 * 2, H3_KI = H3_QE + 64 * HG_S136 * 2, H3_VT = H3_KI + 160 * HG_S136 * 2, H3_SB = H3_VT + 128 * HG_S72 * 2,
              H3_SC = H3_SB + 128 * HG_S136 * 2, H3_TOT = H3_SC + 64 * HG_S72 * 2, H3_LDS_BYTES = H3_TOT + 4 * 128 * 4;
constexpr int H3_OB = H3_KI, HG_OS = 132;
static_assert(H3_LDS_BYTES <= MISC_OFF, "HGRN2 LDS");
__device__ __forceinline__ void hg3_unit(const int wv, unsigned char* lds, int u, const bf16_t* HIN, const float* lbl, int layer, const float* SST, const float* gain, bf16_t* MIX) {
    bf16_t* QI = (bf16_t*)(lds + H3_QI); bf16_t* QE = (bf16_t*)(lds + H3_QE); bf16_t* KI = (bf16_t*)(lds + H3_KI); bf16_t* VT = (bf16_t*)(lds + H3_VT);
    bf16_t* SB = (bf16_t*)(lds + H3_SB); bf16_t* SC = (bf16_t*)(lds + H3_SC); float* TOT = (float*)(lds + H3_TOT); float* OB = (float*)(lds + H3_OB);
    const int c = u & 63, h = (u >> 6) & 3, b = u >> 8;
    const int tid = opaque_tid(wv), lane = tid & 63, w = tid >> 6, k = tid & 127, tq = tid >> 7;
    const size_t t0 = (size_t)b * SEQ + c * 64;
    const float lb = hg_lb(lbl, layer, h * 128 + k);
    __syncthreads();
    float bl[16], kf[16], qf[16]; float cum = 0.f;
#pragma unroll
    for (int i = 0; i < 16; ++i) { const size_t row = (t0 + 16 * tq + i) * IN_COLS; const float fp = bf2f(HIN[row + C_HF + h * 128 + k]);
        const float sg = sigmoidf_(fp); const float f = lb + (1.f - lb) * sg; cum += __logf(fmaxf(f, 1e-30f)); bl[i] = cum; kf[i] = (1.f - lb) * (1.f - sg);
        qf[i] = siluf_(bf2f(HIN[row + C_HQ + h * 128 + k]));
        VT[k * HG_S72 + 16 * tq + i] = HIN[row + C_HI + h * 128 + k]; }
    TOT[tq * 128 + k] = cum;
    { const float4* sp = (const float4*)(SST + (size_t)u * 16384);
#pragma unroll
      for (int i = 0; i < 8; ++i) { const int e4 = tid + 512 * i; const float4 s4 = sp[e4]; const int v = e4 >> 5, k4 = (e4 & 31) * 4; u32x2 pk; pk.x = pk2(s4.x, s4.y); pk.y = pk2(s4.z, s4.w); *(u32x2*)(SB + v * HG_S136 + k4) = pk; } }
    for (int i = tid; i < 64 * HG_S72 / 2; i += NTHR) ((unsigned*)SC)[i] = 0u;
    __syncthreads();
    float rs[4]; { float acc = 0.f;
#pragma unroll
        for (int j = 0; j < 4; ++j) { rs[j] = acc; acc += TOT[j * 128 + k]; } }
    float pre = 0.f;
#pragma unroll
    for (int j = 0; j < 4; ++j) pre = (j == tq) ? rs[j] : pre;
    const float epre = __expf(pre);
    float fk[4];
#pragma unroll
    for (int ii = 0; ii < 4; ++ii) fk[ii] = __expf(fminf(rs[ii] - pre, 0.f));
#pragma unroll
    for (int i = 0; i < 16; ++i) {
        const int s = 16 * tq + i; const float e1 = fmaxf(__expf(bl[i]), 1e-30f), inv = rcpf_(e1);
        const float qi = qf[i] * e1, ki = kf[i] * inv;
        QI[s * HG_S136 + k] = f2bf_hw(qi);
        QE[s * HG_S136 + k] = f2bf_hw(qi * epre);
#pragma unroll
        for (int ii = 0; ii < 4; ++ii) if (ii >= tq) KI[((ii == 0 ? 0 : ii == 1 ? 16 : ii == 2 ? 48 : 96) + s) * HG_S136 + k] = f2bf_hw(ki * fk[ii]);
    }
    __syncthreads();
    const int lr = lane & 15, lg = lane >> 4;
    for (int tix = w; tix < 10; tix += 8) {
        int i, j; if (tix == 0) { i = 0; j = 0; } else if (tix < 3) { i = 1; j = tix - 1; } else if (tix < 6) { i = 2; j = tix - 3; } else { i = 3; j = tix - 6; }
        const int kb = (i == 0 ? 0 : i == 1 ? 16 : i == 2 ? 48 : 96);
        f32x4 acc = (f32x4){0.f, 0.f, 0.f, 0.f};
#pragma unroll
        for (int ks = 0; ks < 4; ++ks) { const bf16x8 a = *(const bf16x8*)(QI + (16 * i + lr) * HG_S136 + ks * 32 + lg * 8); const bf16x8 bb = *(const bf16x8*)(KI + (kb + 16 * j + lr) * HG_S136 + ks * 32 + lg * 8);
            acc = __builtin_amdgcn_mfma_f32_16x16x32_bf16(a, bb, acc, 0, 0, 0); }
#pragma unroll
        for (int r = 0; r < 4; ++r) { const int tr = 4 * lg + r; const float v = (i == j && lr > tr) ? 0.f : acc[r]; SC[(16 * i + tr) * HG_S72 + 16 * j + lr] = f2bf_hw(v); }
    }
    __syncthreads();
    f32x4 o[4];
#pragma unroll
    for (int tt = 0; tt < 4; ++tt) o[tt] = (f32x4){0.f, 0.f, 0.f, 0.f};
#pragma unroll
    for (int ks = 0; ks < 2; ++ks) { const bf16x8 vb = *(const bf16x8*)(VT + (w * 16 + lr) * HG_S72 + ks * 32 + lg * 8);
#pragma unroll
        for (int tt = 0; tt < 4; ++tt) { const bf16x8 a = *(const bf16x8*)(SC + (16 * tt + lr) * HG_S72 + ks * 32 + lg * 8); o[tt] = __builtin_amdgcn_mfma_f32_16x16x32_bf16(a, vb, o[tt], 0, 0, 0); } }
#pragma unroll
    for (int ks = 0; ks < 4; ++ks) { const bf16x8 sb = *(const bf16x8*)(SB + (w * 16 + lr) * HG_S136 + ks * 32 + lg * 8);
#pragma unroll
        for (int tt = 0; tt < 4; ++tt) { const bf16x8 a = *(const bf16x8*)(QE + (16 * tt + lr) * HG_S136 + ks * 32 + lg * 8); o[tt] = __builtin_amdgcn_mfma_f32_16x16x32_bf16(a, sb, o[tt], 0, 0, 0); } }
#pragma unroll
    for (int tt = 0; tt < 4; ++tt)
#pragma unroll
        for (int r = 0; r < 4; ++r) OB[(16 * tt + 4 * lg + r) * HG_OS + w * 16 + lr] = o[tt][r];
    __syncthreads();
    { const int t = tid >> 3, vg = tid & 7; float ov[16]; float q = 0.f;
#pragma unroll
      for (int i = 0; i < 4; ++i) { const float4 x = *(const float4*)(OB + t * HG_OS + vg * 16 + 4 * i); ov[4 * i] = x.x; ov[4 * i + 1] = x.y; ov[4 * i + 2] = x.z; ov[4 * i + 3] = x.w; q += (x.x * x.x + x.y * x.y) + (x.z * x.z + x.w * x.w); }
      q += __shfl_xor(q, 1); q += __shfl_xor(q, 2); q += __shfl_xor(q, 4);
      const float rinv = rsqf_(q * (1.0f / 128.f) + 1e-6f);
      const size_t row = t0 + t; const bf16_t* gp = HIN + row * IN_COLS + C_HG + h * 128 + vg * 16; const float* gn = gain + h * 128 + vg * 16;
      const u32x4 g0 = *(const u32x4*)gp, g1 = *(const u32x4*)(gp + 8);
      u32x4 o0, o1;
      o0.x = pk2(ov[0] * rinv * gn[0] * siluf_(bflo(g0.x)), ov[1] * rinv * gn[1] * siluf_(bfhi(g0.x))); o0.y = pk2(ov[2] * rinv * gn[2] * siluf_(bflo(g0.y)), ov[3] * rinv * gn[3] * siluf_(bfhi(g0.y)));
      o0.z = pk2(ov[4] * rinv * gn[4] * siluf_(bflo(g0.z)), ov[5] * rinv * gn[5] * siluf_(bfhi(g0.z))); o0.w = pk2(ov[6] * rinv * gn[6] * siluf_(bflo(g0.w)), ov[7] * rinv * gn[7] * siluf_(bfhi(g0.w)));
      o1.x = pk2(ov[8] * rinv * gn[8] * siluf_(bflo(g1.x)), ov[9] * rinv * gn[9] * siluf_(bfhi(g1.x))); o1.y = pk2(ov[10] * rinv * gn[10] * siluf_(bflo(g1.y)), ov[11] * rinv * gn[11] * siluf_(bfhi(g1.y)));
      o1.z = pk2(ov[12] * rinv * gn[12] * siluf_(bflo(g1.z)), ov[13] * rinv * gn[13] * siluf_(bfhi(g1.z))); o1.w = pk2(ov[14] * rinv * gn[14] * siluf_(bflo(g1.w)), ov[15] * rinv * gn[15] * siluf_(bfhi(g1.w)));
      bf16_t* op = MIX + row * D + 1024 + h * 128 + vg * 16; *(u32x4*)op = o0; *(u32x4*)(op + 8) = o1; }
}

constexpr int LRU_LDS_X = 0, LRU_LDS_MS = LCH * 512 * 4, LRU_LDS_BYTES = LRU_LDS_MS + LCH * 4;
struct LruW { const float *conv_w, *conv_b, *wa, *ba, *wx, *bx, *lam, *gain; };
__device__ __forceinline__ void lru1_unit(const int wv, unsigned char* lds, int u, const bf16_t* HIN, const LruW& W, float* AGA, float* AGH, float* HL, float* PL) {
    float* XS = (float*)(lds + LRU_LDS_X);
    const int ch = u % NLCH, b = u / NLCH;
    const int c = opaque_tid(wv), h = c >> 6, j = c & 63;
    const size_t t0 = (size_t)b * SEQ + ch * LCH;
    const float w0 = W.conv_w[c], w1 = W.conv_w[512 + c], w2 = W.conv_w[1024 + c], w3 = W.conv_w[1536 + c], cb = W.conv_b[c];
    float xm3 = 0.f, xm2 = 0.f, xm1 = 0.f;
    if (ch > 0) { xm3 = bf2f(HIN[(t0 - 3) * IN_COLS + C_LX + c]); xm2 = bf2f(HIN[(t0 - 2) * IN_COLS + C_LX + c]); xm1 = bf2f(HIN[(t0 - 1) * IN_COLS + C_LX + c]); }
    __syncthreads();
    float xc[LCH];
#pragma unroll
    for (int t = 0; t < LCH; ++t) { const float x0 = bf2f(HIN[(t0 + t) * IN_COLS + C_LX + c]); xc[t] = w0 * xm3 + w1 * xm2 + w2 * xm1 + w3 * x0 + cb; xm3 = xm2; xm2 = xm1; xm1 = x0; XS[t * 512 + c] = xc[t]; }
    __syncthreads();
    float ra[LCH], ia[LCH];
    { const float bav = W.ba[c], bxv = W.bx[c];
#pragma unroll
      for (int t = 0; t < LCH; ++t) { ra[t] = bav; ia[t] = bxv; } }
    const float* wap = W.wa + (size_t)h * 4096 + j; const float* wxp = W.wx + (size_t)h * 4096 + j;
    for (int i4 = 0; i4 < 16; ++i4) {
        const float a0 = wap[(4 * i4 + 0) * 64], a1 = wap[(4 * i4 + 1) * 64], a2 = wap[(4 * i4 + 2) * 64], a3 = wap[(4 * i4 + 3) * 64];
        const float x0 = wxp[(4 * i4 + 0) * 64], x1 = wxp[(4 * i4 + 1) * 64], x2 = wxp[(4 * i4 + 2) * 64], x3 = wxp[(4 * i4 + 3) * 64];
#pragma unroll
        for (int t = 0; t < LCH; ++t) { const float4 xv = *(const float4*)(XS + t * 512 + h * 64 + 4 * i4);
            ra[t] += xv.x * a0 + xv.y * a1 + xv.z * a2 + xv.w * a3; ia[t] += xv.x * x0 + xv.y * x1 + xv.z * x2 + xv.w * x3; }
    }
    const float lm = W.lam[c]; const float sp = (lm > 15.f) ? __expf(-lm) : __logf(1.0f + __expf(-lm));
    float hl = 0.f, pr = 1.f;
#pragma unroll
    for (int t = 0; t < LCH; ++t) { const float r = sigmoidf_(ra[t]), ig = sigmoidf_(ia[t]); const float la = -8.0f * r * sp; const float a = __expf(la);
        const float uu = __builtin_amdgcn_sqrtf(fmaxf(1.0f - a * a, 0.f)) * (ig * xc[t]); hl = a * hl + uu; pr *= a;
        HL[(t0 + t) * 512 + c] = hl; PL[(t0 + t) * 512 + c] = pr; }
    AGA[((size_t)b * NLCH + ch) * 512 + c] = pr; AGH[((size_t)b * NLCH + ch) * 512 + c] = hl;
}
__device__ __forceinline__ void lru_carry_unit(const int wv, int b, const float* AGA, float* AGH) {
    const int c = opaque_tid(wv); float carry = 0.f;
    for (int c0 = 0; c0 < NLCH; c0 += 16) {
        float a[16], hh[16];
#pragma unroll
        for (int i = 0; i < 16; ++i) { const size_t o = ((size_t)b * NLCH + c0 + i) * 512 + c; a[i] = AGA[o]; hh[i] = AGH[o]; }
#pragma unroll
        for (int i = 0; i < 16; ++i) { const size_t o = ((size_t)b * NLCH + c0 + i) * 512 + c; AGH[o] = carry; carry = a[i] * carry + hh[i]; }
    }
}
__device__ __forceinline__ void lru2_unit(const int wv, unsigned char* lds, int u, const bf16_t* HIN, const float* gain, const float* CAR, const float* HL, const float* PL, bf16_t* MIX) {
    float* XS = (float*)(lds + LRU_LDS_X); float* MS = (float*)(lds + LRU_LDS_MS);
    const int ch = u % NLCH, b = u / NLCH;
    const int c = opaque_tid(wv), lane = c & 63, w = c >> 6;
    const size_t t0 = (size_t)b * SEQ + ch * LCH;
    const float carry = CAR[((size_t)b * NLCH + ch) * 512 + c];
    float hv[LCH];
#pragma unroll
    for (int t = 0; t < LCH; ++t) hv[t] = HL[(t0 + t) * 512 + c] + PL[(t0 + t) * 512 + c] * carry;
    __syncthreads();
#pragma unroll
    for (int t = 0; t < LCH; ++t) XS[t * 512 + c] = hv[t] * hv[t];
    __syncthreads();
    for (int t = w; t < LCH; t += 8) { float q = 0.f;
#pragma unroll
        for (int m = 0; m < 8; ++m) q += XS[t * 512 + lane + 64 * m];
        q = wave_sum(q); if (lane == 0) MS[t] = q; }
    __syncthreads();
    const float gn = gain[c];
#pragma unroll
    for (int t = 0; t < LCH; ++t) { const float rinv = rsqf_(MS[t] * (1.0f / 512.f) + 1e-6f); const float gv = bf2f(HIN[(t0 + t) * IN_COLS + C_LG + c]);
        MIX[(t0 + t) * D + 1536 + c] = f2bf(hv[t] * rinv * gn * gelu_tanh(gv)); }
}

__device__ __forceinline__ void router_unit(const int wv, unsigned char* lds, int u, const float* X, const float* W, float* LOG) {
    float* xs = (float*)lds; float* ws = xs + 32 * 68;
    const int tid = opaque_tid(wv), tt = tid >> 4, eg = tid & 15; const size_t t0 = (size_t)u * 32;
    float a0 = 0.f, a1 = 0.f, a2 = 0.f, a3 = 0.f;
    for (int k0 = 0; k0 < D; k0 += 64) {
        const float4 xv = *(const float4*)(X + (t0 + (tid >> 4)) * D + k0 + (tid & 15) * 4);
        const float4 wv0 = *(const float4*)(W + (size_t)(k0 + (tid >> 4)) * 64 + (tid & 15) * 4), wv1 = *(const float4*)(W + (size_t)(k0 + 32 + (tid >> 4)) * 64 + (tid & 15) * 4);
        __syncthreads();
        *(float4*)(xs + (tid >> 4) * 68 + (tid & 15) * 4) = xv; *(float4*)(ws + (tid >> 4) * 64 + (tid & 15) * 4) = wv0; *(float4*)(ws + (32 + (tid >> 4)) * 64 + (tid & 15) * 4) = wv1;
        __syncthreads();
#pragma unroll 16
        for (int kk = 0; kk < 64; ++kk) { const float x = xs[tt * 68 + kk]; const float4 wv = *(const float4*)(ws + kk * 64 + eg * 4); a0 += x * wv.x; a1 += x * wv.y; a2 += x * wv.z; a3 += x * wv.w; }
    }
    *(float4*)(LOG + (t0 + tt) * 64 + eg * 4) = make_float4(a0, a1, a2, a3);
}
__device__ __forceinline__ void route_unit(const int wv, unsigned char* lds, int u, const float* LOG, const float* rbias, int* TKIDX, float* TKGATE, int* CNT) {
    int* hist = (int*)lds;
    const int tid = opaque_tid(wv), lane = tid & 63, w = tid >> 6;
    __syncthreads();
    if (tid < 64) hist[tid] = 0;
    __syncthreads();
    const float rb = rbias[lane];
    float lgt[16];
#pragma unroll
    for (int i = 0; i < 16; ++i) lgt[i] = LOG[((size_t)u * RCHUNK + w * 16 + i) * 64 + lane];
#pragma unroll
    for (int i = 0; i < 16; ++i) {
        const size_t t = (size_t)u * RCHUNK + w * 16 + i;
        const float score = sigmoidf_(lgt[i]); const float sel = score + rb;
        float m1 = sel; m1 = fmaxf(m1, __shfl_xor(m1, 1)); m1 = fmaxf(m1, __shfl_xor(m1, 2)); m1 = fmaxf(m1, __shfl_xor(m1, 4));
        const unsigned long long eqm = __ballot(sel == m1); const int gbase = lane & ~7; const unsigned grp = (unsigned)((eqm >> gbase) & 0xffull); const int first = gbase + __builtin_ctz(grp);
        float m2 = (lane == first) ? -3.0e38f : sel; m2 = fmaxf(m2, __shfl_xor(m2, 1)); m2 = fmaxf(m2, __shfl_xor(m2, 2)); m2 = fmaxf(m2, __shfl_xor(m2, 4));
        const float gs = m1 + m2; const int mygrp = lane >> 3;
        int grank = 0;
#pragma unroll
        for (int g2 = 0; g2 < 8; ++g2) { const float og = __shfl(gs, g2 * 8); grank += (og > gs || (og == gs && g2 < mygrp)) ? 1 : 0; }
        const float msel = (grank < 4) ? sel : -1e30f;
        int rank = 0;
#pragma unroll 16
        for (int e2 = 0; e2 < 64; ++e2) { const float os = __shfl(msel, e2); rank += (os > msel || (os == msel && e2 < lane)) ? 1 : 0; }
        const bool pick = rank < TOPK;
        const float wsum = wave_sum(pick ? score : 0.f);
        if (pick) { TKIDX[t * TOPK + rank] = lane; TKGATE[t * TOPK + rank] = score / wsum * 2.5f; atomicAdd(&hist[lane], 1); }
    }
    __syncthreads();
    if (tid < 64) CNT[u * 64 + tid] = hist[tid];
}
__device__ __forceinline__ void assign_unit(const int wv, unsigned char* lds, int chunk, const int* CNT, const int* TKIDX, const float* TKGATE, int* ROWTOK, int* ROWDST, float* ROWGATE, int* TILEE) {
    int* total = (int*)lds; int* mybase = total + 64; int* off = mybase + 64; unsigned* mask = (unsigned*)(off + 80); int* part = (int*)(mask + 256);
    const int tid = opaque_tid(wv);
    __syncthreads();
    if (tid < 256) mask[tid] = 0u;
    { const int e = tid & 63, pt = tid >> 6; int tot = 0, base = 0;
#pragma unroll 8
      for (int cc = pt * (NRCHUNK / 8); cc < (pt + 1) * (NRCHUNK / 8); ++cc) { const int v = CNT[cc * 64 + e]; tot += v; if (cc < chunk) base += v; }
      part[pt * 64 + e] = tot; part[512 + pt * 64 + e] = base; }
    __syncthreads();
    if (tid < 64) { int tot = 0, base = 0;
#pragma unroll
        for (int pt = 0; pt < 8; ++pt) { tot += part[pt * 64 + tid]; base += part[512 + pt * 64 + tid]; } total[tid] = tot; mybase[tid] = base; }
    __syncthreads();
    if (tid == 0) { int o = 0; for (int e = 0; e < 64; ++e) { off[e] = o; o += ((total[e] + 255) / 256) * 256; } off[64] = o; }
    __syncthreads();
    int e_[2]; int tt_[2], k_[2];
#pragma unroll
    for (int r = 0; r < 2; ++r) { const int p = tid + 512 * r; tt_[r] = p >> 3; k_[r] = p & 7; e_[r] = TKIDX[((size_t)chunk * RCHUNK + tt_[r]) * TOPK + k_[r]]; atomicOr(&mask[e_[r] * 4 + (tt_[r] >> 5)], 1u << (tt_[r] & 31)); }
    __syncthreads();
#pragma unroll
    for (int r = 0; r < 2; ++r) { const int e = e_[r], tt = tt_[r]; int rank = 0;
        for (int wd = 0; wd < (tt >> 5); ++wd) rank += __builtin_popcount(mask[e * 4 + wd]);
        rank += __builtin_popcount(mask[e * 4 + (tt >> 5)] & ((1u << (tt & 31)) - 1u));
        const int slot = off[e] + mybase[e] + rank; const int t = chunk * RCHUNK + tt;
        ROWTOK[slot] = t; ROWDST[slot] = t * TOPK + k_[r]; ROWGATE[slot] = TKGATE[(size_t)t * TOPK + k_[r]]; }
    if (chunk < 64) { const int e = chunk; const int lo = off[e] + total[e], hi = off[e + 1]; for (int s = lo + tid; s < hi; s += NTHR) { ROWTOK[s] = -1; ROWDST[s] = -1; ROWGATE[s] = 0.f; } }
    if (chunk == 0) { const int e = tid >> 3; for (int i = off[e] / 256 + (tid & 7); i < off[e + 1] / 256; i += 8) TILEE[i] = e; if (tid == 0) TILEE[MAXTILES] = off[64] / 256; }
}
constexpr int PH_PER_LAYER = 14, NPHASE = DEPTH * PH_PER_LAYER;
struct Args { const void* in[32]; float* out; unsigned char* ws; RotTab rt; int ph_lo, ph_hi, sub, pad; };
static_assert(sizeof(Args) == 32 * 8 + 8 + 8 + 64 + 16, "Args has no padding");

template <int l, int SUB>
__device__ __forceinline__ void layer_program(const int wv, const Args& args, unsigned char* lds, unsigned char* ws, float* out, const XcdBarrier& bar, const int lo, const int hi) {
    constexpr int pb = l * PH_PER_LAYER;
    if (hi <= pb || lo >= pb + PH_PER_LAYER) return;
    LAS unsigned char* ldsL = (LAS unsigned char*)lds;
    const int G = gridDim.x, bid = blockIdx.x;
    const int NGW = G * NWAVES;
    LAS int* ulist = (LAS int*)(ldsL + ULIST_OFF);
#ifndef PHMASK
#define PHMASK 0x3fff
#endif
#define IN(k) (lo <= (k) && (k) < hi && ((PHMASK >> ((k) % PH_PER_LAYER)) & 1))
#define SEAM(k) do { if (!MK_PER_PHASE && IN(k) && IN((k) + 1)) xcd_barrier(bar); } while (0)
#define TIDS() const int tid = opaque_tid(wv), lane = tid & 63, wave = wv, gw = bid * NWAVES + wave; (void)lane; (void)gw
        if (IN(pb + 0)) {
            TIDS();
            WPtrs P; P.w_in = (const float*)args.in[3] + (size_t)l * D * IN_COLS; P.w_out = (const float*)args.in[4] + (size_t)l * D * D; P.gate = (const float*)args.in[28] + (size_t)l * D * D;
            P.plew = (const float*)args.in[27] + (size_t)l * PLE * D; P.ew1 = (const float*)args.in[21] + (size_t)l * NE * D * EF; P.ew3 = (const float*)args.in[22] + (size_t)l * NE * D * EF;
            P.ew2 = (const float*)args.in[23] + (size_t)l * NE * EF * D; P.sw1 = (const float*)args.in[24] + (size_t)l * D * EF; P.sw3 = (const float*)args.in[25] + (size_t)l * D * EF; P.sw2 = (const float*)args.in[26] + (size_t)l * EF * D; P.rw = (const float*)args.in[19] + (size_t)l * D * NE;
            convert_weights(lds, P, ws + WS_W, gw, NGW, wave, lane);
            convert_rows((const float*)args.in[1] + (size_t)l * T * PLE, (bf16_t*)(ws + WS_PB), (size_t)T * PLE, (size_t)bid * NTHR + tid, (size_t)G * NTHR);
            if (l == 0) convert_rows((const float*)args.in[0], (bf16_t*)(ws + WS_XB), (size_t)T * D, (size_t)bid * NTHR + tid, (size_t)G * NTHR);
        }
        SEAM(pb + 0);
        if (IN(pb + 1)) {
            pg8::DenseOrder S; S.init(T, IN_COLS, G, bid, 0);
            const pg8::ListOrder L = pg8::build_list(wv, ulist, ULIST_CAP, S);
            pg8::EpiStoreBf16 E{(bf16_t*)(ws + WS_HIN), IN_COLS, 0};
            pg8::gemm_phase<D, pg8::EpiStoreBf16, pg8::ListOrder, false>(wv, ldsL, (const bf16_t*)(ws + WS_XB), (const bf16_t*)(ws + WS_W + WO_WIN), L, E, nullptr);
        }
        SEAM(pb + 1);
        if (IN(pb + 2)) {
            const bf16_t* HIN = (const bf16_t*)(ws + WS_HIN); bf16_t* MIX = (bf16_t*)(ws + WS_MIX);
            if (!(SUB & 1)) for (int u = bid; u < 512; u += G) attn_unit(wv, lds, u, HIN, (const int*)args.in[2], (const float*)args.in[5] + l * 16, MIX, (float*)(ws + WS_SSQ), args.rt);
            LruW W; W.conv_w = (const float*)args.in[9] + l * 2048; W.conv_b = (const float*)args.in[10] + l * 512; W.wa = (const float*)args.in[11] + (size_t)l * 32768; W.ba = (const float*)args.in[12] + l * 512;
            W.wx = (const float*)args.in[13] + (size_t)l * 32768; W.bx = (const float*)args.in[14] + l * 512; W.lam = (const float*)args.in[15] + l * 512; W.gain = (const float*)args.in[16] + l * 512;
            if (!(SUB & 2)) for (int u = bid; u < BATCH * NLCH; u += G) lru1_unit(wv, lds, u, HIN, W, (float*)(ws + WS_LRUA), (float*)(ws + WS_LRUH), (float*)(ws + WS_LRUHL), (float*)(ws + WS_LRUPL));
            if (!(SUB & 4)) for (int u = bid; u < 2048; u += G) hg1_unit(wv, lds, u, HIN, (const float*)args.in[7], l, (float*)(ws + WS_SST), (float*)(ws + WS_DV));
        }
        SEAM(pb + 2);
        if (IN(pb + 3)) {
            TIDS();
            const bf16_t* HIN = (const bf16_t*)(ws + WS_HIN); bf16_t* MIX = (bf16_t*)(ws + WS_MIX);
            if (!(SUB & 1)) for (int t = gw; t < T; t += NGW) attn_fin_row(MIX, (const float*)(ws + WS_SSQ), (const float*)args.in[6] + l * 1024, t, lane);
            if (!(SUB & 2)) for (int u = bid; u < 256; u += G) hg2_unit(wv, u, (float*)(ws + WS_SST), (const float*)(ws + WS_DV));
            if (!(SUB & 4)) for (int u = bid; u < BATCH; u += G) lru_carry_unit(wv, u, (const float*)(ws + WS_LRUA), (float*)(ws + WS_LRUH));
        }
        SEAM(pb + 3);
        if (IN(pb + 4)) {
            if (!(SUB & 1)) for (int u = bid; u < BATCH * NLCH; u += G) lru2_unit(wv, lds, u, (const bf16_t*)(ws + WS_HIN), (const float*)args.in[16] + l * 512, (const float*)(ws + WS_LRUH), (const float*)(ws + WS_LRUHL), (const float*)(ws + WS_LRUPL), (bf16_t*)(ws + WS_MIX));
            if (!(SUB & 2))
            for (int u = bid; u < 2048; u += G) hg3_unit(wv, lds, u, (const bf16_t*)(ws + WS_HIN), (const float*)args.in[7], l, (const float*)(ws + WS_SST), (const float*)args.in[8] + l * 512, (bf16_t*)(ws + WS_MIX));
        }
        SEAM(pb + 4);
        if (IN(pb + 5)) {
            pg8::DenseOrder S; S.init(T, D, G, bid, 0);
            const pg8::ListOrder L = pg8::build_list(wv, ulist, ULIST_CAP, S);
            pg8::EpiResid E{(l == 0) ? (const float*)args.in[0] : (const float*)out, out, ALPHA, 0};
            pg8::gemm_phase<D, pg8::EpiResid, pg8::ListOrder, false>(wv, ldsL, (const bf16_t*)(ws + WS_MIX), (const bf16_t*)(ws + WS_W + WO_WOUT), L, E, nullptr);
        }
        SEAM(pb + 5);
        if (IN(pb + 6)) {
            TIDS();
            const float* g1 = (const float*)args.in[17] + l * D; const float* b1 = (const float*)args.in[18] + l * D; bf16_t* XB = (bf16_t*)(ws + WS_XB);
            for (int t = gw; t < T; t += NGW) ln_row<false>(out + (size_t)t * D, g1, b1, XB + (size_t)t * D, nullptr, nullptr, nullptr, lane);
        }
        SEAM(pb + 6);
        if (IN(pb + 7)) {
            if (!(SUB & 1)) { pg8::DenseOrder S; S.init(T, D, G, bid, 0);
              const pg8::ListOrder L = pg8::build_list(wv, ulist, ULIST_CAP, S);
              pg8::EpiStoreBf16 E{(bf16_t*)(ws + WS_U), D, 0};
              pg8::gemm_phase<PLE, pg8::EpiStoreBf16, pg8::ListOrder, false>(wv, ldsL, (const bf16_t*)(ws + WS_PB), (const bf16_t*)(ws + WS_W + WO_PLEW), L, E, nullptr); }
            if (!(SUB & 2)) { pg8::DenseOrder S; S.init(T, 256, G, bid, 0);
              const pg8::ListOrder L = pg8::build_list(wv, ulist, ULIST_CAP, S);
              pg8::EpiRouter E{(float*)(ws + WS_LOGITS)};
              pg8::gemm_phase<D, pg8::EpiRouter, pg8::ListOrder, false>(wv, ldsL, (const bf16_t*)(ws + WS_XB), (const bf16_t*)(ws + WS_W + WO_ROUT), L, E, nullptr); }
        }
        SEAM(pb + 7);
        if (IN(pb + 8)) {
            for (int u = bid; u < NRCHUNK; u += G) route_unit(wv, lds, u, (const float*)(ws + WS_LOGITS), (const float*)args.in[20] + l * 64, (int*)(ws + WS_TKIDX), (float*)(ws + WS_TKGATE), (int*)(ws + WS_CNT));
        }
        SEAM(pb + 8);
        if (IN(pb + 9)) {
            for (int u = bid; u < NRCHUNK; u += G) assign_unit(wv, lds, u, (const int*)(ws + WS_CNT), (const int*)(ws + WS_TKIDX), (const float*)(ws + WS_TKGATE), (int*)(ws + WS_ROWTOK), (int*)(ws + WS_ROWDST), (float*)(ws + WS_ROWGATE), (int*)(ws + WS_TILEE));
        }
        SEAM(pb + 9);
        if (IN(pb + 10)) {
            TIDS();
            const int* TILEE = (const int*)(ws + WS_TILEE); const int* ROWTOK = (const int*)(ws + WS_ROWTOK);
            const int ntiles = TILEE[MAXTILES];
            pg8::UpOrder S2; S2.init(TILEE, ntiles, G, bid, 0);
            const pg8::ListOrder L2 = pg8::build_list(wv, ulist, TAB_BYTES / 1024, S2);
            LAS int* gtab = (LAS int*)(ldsL + TAB_OFF);
            if (tid < 256) for (int j = 0; j < L2.n; ++j) { const int orow = ulist[j * 4 + 2]; int r;
                if (orow < A_PAD) { r = ROWTOK[orow + tid]; r = r < 0 ? 0 : r; } else r = orow - A_PAD + tid;
                gtab[j * 256 + tid] = r; }
            __syncthreads();
            pg8::EpiSwiglu E2{(bf16_t*)(ws + WS_HM)};
            pg8::gemm_phase<D, pg8::EpiSwiglu, pg8::ListOrder, true>(wv, ldsL, (const bf16_t*)(ws + WS_XB), (const bf16_t*)(ws + WS_W + WO_W13), L2, E2, gtab);
        }
        SEAM(pb + 10);
        if (IN(pb + 11)) {
            if (!(SUB & 1)) { pg8::DenseOrder S; S.init(T, D, G, bid, 0);
              const pg8::ListOrder L = pg8::build_list(wv, ulist, ULIST_CAP, S);
              pg8::EpiGate E{(bf16_t*)(ws + WS_U), (const float*)args.in[29] + l * D};
              pg8::gemm_phase<D, pg8::EpiGate, pg8::ListOrder, false>(wv, ldsL, (const bf16_t*)(ws + WS_XB), (const bf16_t*)(ws + WS_W + WO_GATE), L, E, nullptr); }
            if (SUB & 2) return;
            TIDS();
            const int* TILEE = (const int*)(ws + WS_TILEE);
            const int ntiles = TILEE[MAXTILES];
            pg8::DownOrder S3; S3.init(TILEE, ntiles, G, bid);
            const pg8::ListOrder L3 = pg8::build_list(wv, ulist, ULIST_CAP, S3);
            LAS int* tdst = (LAS int*)(ldsL + TAB_OFF); LAS float* tgate = (LAS float*)(ldsL + TAB_OFF + TAB_BYTES / 2);
            if (S3.lo < S3.hi && tid < 256) { const int* ROWDST = (const int*)(ws + WS_ROWDST); const float* ROWGATE = (const float*)(ws + WS_ROWGATE); const int tl = (S3.hi - 1) >> 3;
                for (int tile = S3.t0; tile <= tl && tile - S3.t0 < TAB_BYTES / 2048; ++tile) { tdst[(tile - S3.t0) * 256 + tid] = ROWDST[tile * 256 + tid]; tgate[(tile - S3.t0) * 256 + tid] = ROWGATE[tile * 256 + tid]; } }
            __syncthreads();
            pg8::EpiScatter E3{(bf16_t*)(ws + WS_Y), tdst, tgate};
            pg8::gemm_phase<EF, pg8::EpiScatter, pg8::ListOrder, false>(wv, ldsL, (const bf16_t*)(ws + WS_HM), (const bf16_t*)(ws + WS_W + WO_W2), L3, E3, nullptr);
        }
        SEAM(pb + 11);
        if (IN(pb + 12)) {
            pg8::DenseOrder S; S.init(T, D, G, bid, 0);
            const pg8::ListOrder L = pg8::build_list(wv, ulist, ULIST_CAP, S);
            pg8::EpiStoreBf16 E{(bf16_t*)(ws + WS_XB), D, 0};
            pg8::gemm_phase<EF, pg8::EpiStoreBf16, pg8::ListOrder, false>(wv, ldsL, (const bf16_t*)(ws + WS_HM) + (size_t)A_PAD * EF, (const bf16_t*)(ws + WS_W + WO_W2) + (size_t)64 * D * EF, L, E, nullptr);
        }
        SEAM(pb + 12);
        if (IN(pb + 13)) {
            TIDS();
            const float* g2 = (const float*)args.in[30] + l * D; const float* b2 = (const float*)args.in[31] + l * D; bf16_t* XB = (bf16_t*)(ws + WS_XB); const bf16_t* Y = (const bf16_t*)(ws + WS_Y);
            for (int t = gw; t < T; t += NGW) ln_row<true>(out + (size_t)t * D, g2, b2, XB + (size_t)t * D, Y + (size_t)t * TOPK * D, (const bf16_t*)(ws + WS_U) + (size_t)t * D, XB + (size_t)t * D, lane);
        }

#undef TIDS
#undef IN
#undef SEAM
}

template <int SUB>
__global__ void __launch_bounds__(NTHR, 2) mega_fwd(Args args) {
    extern __shared__ __attribute__((aligned(16))) unsigned char lds[];
    LAS unsigned char* ldsL = (LAS unsigned char*)lds;
    volatile LAS unsigned* MISC = (volatile LAS unsigned*)(ldsL + MISC_OFF);
    unsigned char* ws = args.ws; float* out = args.out;
    if (threadIdx.x < 32) MISC[threadIdx.x] = 0u;
    __syncthreads();
    XcdBarrier bar; bar.bar = (unsigned*)(ws + WS_CTL) + CW_BAR; bar.x = 0; bar.st = nullptr; bar.w0 = 0;
    if (!MK_PER_PHASE) bar = xcd_barrier_post((unsigned*)(ws + WS_CTL) + CW_BAR, MISC + 8);
    const int lo = args.ph_lo, hi = args.ph_hi;
    const int wv = __builtin_amdgcn_readfirstlane(threadIdx.x >> 6);
    layer_program<0, SUB>(wv, args, lds, ws, out, bar, lo, hi);
    if (!MK_PER_PHASE && lo <= PH_PER_LAYER - 1 && hi > PH_PER_LAYER) xcd_barrier(bar);
    layer_program<1, SUB>(wv, args, lds, ws, out, bar, lo, hi);
}

extern "C" void kernel_launch(void* const* d_in, const int* in_sizes, int n_in, void* d_out, int out_size, void* d_ws, size_t ws_size, hipStream_t stream) {
    static int grid = 0;
    if (grid == 0) {
        if (n_in != 32 || out_size != T * D || ws_size < WS_END) { fprintf(stderr, "kernel_launch: unexpected sizes n_in %d out %d ws %zu (need %zu); nothing launched\n", n_in, out_size, ws_size, (size_t)WS_END); grid = -1; return; }
        int dev = 0, cus = 0, per_cu = 0;
        if (hipGetDevice(&dev) != hipSuccess || hipDeviceGetAttribute(&cus, hipDeviceAttributeMultiprocessorCount, dev) != hipSuccess) { grid = -1; return; }
        if (hipFuncSetAttribute((const void*)mega_fwd<0>, hipFuncAttributeMaxDynamicSharedMemorySize, LDS_BYTES) != hipSuccess) { fprintf(stderr, "kernel_launch: hipFuncSetAttribute failed\n"); grid = -1; return; }
        if (hipOccupancyMaxActiveBlocksPerMultiprocessor(&per_cu, (const void*)mega_fwd<0>, NTHR, LDS_BYTES) != hipSuccess || per_cu < 1) { fprintf(stderr, "kernel_launch: occupancy query reports %d blocks per CU\n", per_cu); }
        (void)hipGetLastError();
        grid = cus;
    }
    if (grid < 0) return;
    if (hipMemsetAsync((char*)d_ws + WS_CTL, 0, CTL_ZERO_BYTES, stream) != hipSuccess) { fprintf(stderr, "kernel_launch: memset failed\n"); return; }
    Args a{};
    for (int i = 0; i < 32; ++i) a.in[i] = d_in[i];
    a.out = (float*)d_out; a.ws = (unsigned char*)d_ws;
    for (int i = 0; i < 8; ++i) a.rt.invf[i] = std::pow(500000.0, -(double)i / 8.0);
#if MK_PER_PHASE
    for (int ph = 0; ph < NPHASE; ++ph) { a.ph_lo = ph; a.ph_hi = ph + 1; hipLaunchKernelGGL(mega_fwd<0>, dim3(grid), dim3(NTHR), LDS_BYTES, stream, a); }
#else
    a.ph_lo = 0; a.ph_hi = NPHASE;
    hipLaunchKernelGGL(mega_fwd<0>, dim3(grid), dim3(NTHR), LDS_BYTES, stream, a);
#endif
#ifdef PROBE_PH
    { static bool once = false; if (!once) { (void)hipFuncSetAttribute((const void*)mega_fwd<PROBE_SUB>, hipFuncAttributeMaxDynamicSharedMemorySize, LDS_BYTES); once = true; }
      const int pl[] = {PROBE_PH}; for (unsigned i = 0; i < sizeof(pl) / sizeof(int); ++i) { a.ph_lo = pl[i]; a.ph_hi = pl[i] + 1; hipLaunchKernelGGL(mega_fwd<PROBE_SUB>, dim3(grid), dim3(NTHR), LDS_BYTES, stream, a); } }
#endif
    const hipError_t le = hipPeekAtLastError();
    if (le != hipSuccess) fprintf(stderr, "kernel_launch: launch failed: %s\n", hipGetErrorName(le));
}
```

```cpp
#include <hip/hip_runtime.h>
#include <cstdio>
#include <cmath>

#ifndef MK_PER_PHASE
#define MK_PER_PHASE 0
#endif

typedef unsigned short bf16_t;
typedef short bf16x8 __attribute__((ext_vector_type(8)));
typedef float f32x4 __attribute__((ext_vector_type(4)));
typedef unsigned u32x4 __attribute__((ext_vector_type(4)));
typedef unsigned u32x2 __attribute__((ext_vector_type(2)));
#define LAS __attribute__((address_space(3)))

constexpr int BATCH = 8, SEQ = 4096, T = BATCH * SEQ, D = 2048, DEPTH = 2, PLE = 256;
constexpr int IN_COLS = 4352;
constexpr int C_AQ = 0, C_AK = 1024, C_AV = 1152, C_HQ = 1280, C_HF = 1792, C_HI = 2304, C_HG = 2816, C_LX = 3328, C_LG = 3840;
constexpr int NE = 64, TOPK = 8, EF = 512;
constexpr int A_ROWS = T * TOPK;
constexpr int MAXTILES = A_ROWS / 256 + NE;
constexpr int A_PAD = MAXTILES * 256;
constexpr float ALPHA = 1.41421356237309515f;
constexpr int RCHUNK = 128, NRCHUNK = T / RCHUNK;
constexpr int LCH = 32, NLCH = SEQ / LCH;

constexpr size_t MiB = 1u << 20;
constexpr size_t WS_CTL = 0, CTL_ZERO_BYTES = 256 * 1024;
constexpr size_t WS_CNT = 1 * MiB;
constexpr size_t WS_TILEE = 2 * MiB;
constexpr size_t WS_LOGITS = 4 * MiB;
constexpr size_t WS_TKIDX = 12 * MiB;
constexpr size_t WS_TKGATE = 13 * MiB;
constexpr size_t WS_ROWTOK = 14 * MiB;
constexpr size_t WS_ROWDST = 16 * MiB;
constexpr size_t WS_ROWGATE = 18 * MiB;
constexpr size_t WS_LRUA = 20 * MiB;
constexpr size_t WS_LRUH = 22 * MiB;
constexpr size_t WS_SSQ = 24 * MiB;
constexpr size_t WS_DV = 25 * MiB;
constexpr size_t WS_LRUW = 26 * MiB;
constexpr size_t WS_Y = 32 * MiB;
constexpr size_t WS_HIN = 32 * MiB;
constexpr size_t WS_MIX = 304 * MiB;
constexpr size_t WS_SST = 432 * MiB;
constexpr size_t WS_PB = 560 * MiB;
constexpr size_t WS_LRUHL = 576 * MiB;
constexpr size_t WS_LRUPL = 640 * MiB;
constexpr size_t WS_SPREV = 768 * MiB;
constexpr size_t WS_XB = 1056 * MiB;
constexpr size_t WS_HM = 1184 * MiB;
constexpr size_t WS_U = 1488 * MiB;
constexpr size_t WS_W = 1616 * MiB;
constexpr size_t WO_WIN = 0, WO_WOUT = 17 * MiB, WO_GATE = 25 * MiB, WO_PLEW = 33 * MiB, WO_W2 = 34 * MiB, WO_W13 = 164 * MiB, WO_ROUT = 424 * MiB, WO_END = 425 * MiB;
constexpr size_t WS_END = WS_W + WO_END;
static_assert((size_t)IN_COLS * D * 2 <= WO_WOUT - WO_WIN && (size_t)65 * 2048 * 512 * 2 <= WO_W13 - WO_W2 && (size_t)65 * 1024 * 2048 * 2 <= WO_ROUT - WO_W13, "weight map");
static_assert(WS_PB + (size_t)T * PLE * 2 <= WS_Y + (size_t)A_ROWS * D * 2 && WS_Y + (size_t)A_ROWS * D * 2 <= WS_XB && WS_HM + (size_t)(A_PAD + T) * EF * 2 <= WS_U, "ws map");

__device__ __forceinline__ int lane_id() { return (int)__builtin_amdgcn_mbcnt_hi(~0u, __builtin_amdgcn_mbcnt_lo(~0u, 0u)); }
__device__ __forceinline__ int opaque_tid(int wv) { int l; asm volatile("v_mbcnt_lo_u32_b32 %0, -1, 0\n\tv_mbcnt_hi_u32_b32 %0, -1, %0" : "=v"(l)); return wv * 64 + l; }
__device__ __forceinline__ bf16_t f2bf(float f) { unsigned u = __float_as_uint(f); u += 0x7fffu + ((u >> 16) & 1u); return (bf16_t)(u >> 16); }
__device__ __forceinline__ float bf2f(bf16_t b) { return __uint_as_float(((unsigned)b) << 16); }
__device__ __forceinline__ float bflo(unsigned w) { return __uint_as_float(w << 16); }
__device__ __forceinline__ float bfhi(unsigned w) { return __uint_as_float(w & 0xffff0000u); }
__device__ __forceinline__ unsigned pk2(float lo, float hi) { return (unsigned)f2bf(lo) | ((unsigned)f2bf(hi) << 16); }
__device__ __forceinline__ unsigned cvt_pk_bf16(float lo, float hi) { unsigned r; asm("v_cvt_pk_bf16_f32 %0, %1, %2" : "=v"(r) : "v"(lo), "v"(hi)); return r; }
__device__ __forceinline__ bf16_t f2bf_hw(float f) { return (bf16_t)(cvt_pk_bf16(f, f) & 0xffffu); }
__device__ __forceinline__ float rcpf_(float x) { return __builtin_amdgcn_rcpf(x); }
__device__ __forceinline__ float rsqf_(float x) { return __builtin_amdgcn_rsqf(x); }
__device__ __forceinline__ float sigmoidf_(float x) { return rcpf_(1.0f + __expf(-x)); }
__device__ __forceinline__ float siluf_(float x) { return x * rcpf_(1.0f + __expf(-x)); }
__device__ __forceinline__ float gelu_tanh(float x) { const float u = 0.7978845608028654f * (x + 0.044715f * x * x * x); const float e = __expf(2.0f * u); const float th = 1.0f - 2.0f * rcpf_(e + 1.0f); return 0.5f * x * (1.0f + th); }
__device__ __forceinline__ float wave_sum(float v) {
#pragma unroll
    for (int o = 1; o < 64; o <<= 1) v += __shfl_xor(v, o);
    return v;
}
__device__ __forceinline__ float clamp8(float x) { return fminf(fmaxf(x, -448.f), 448.f); }
__device__ __forceinline__ unsigned cvt4_fp8(float a, float b, float c, float dd) { int p = __builtin_amdgcn_cvt_pk_fp8_f32(clamp8(a), clamp8(b), 0, false); p = __builtin_amdgcn_cvt_pk_fp8_f32(clamp8(c), clamp8(dd), p, true); return (unsigned)p; }
constexpr float W8_SCALE = 64.f;
constexpr float Y8_SCALE = 16.f;
constexpr int W8_E8M0 = 0x7c7c7c7c, A8_E8M0 = 0x7c7c7c7c;
__device__ __forceinline__ void sincos_pos(float pos, double invf, float& s, float& c) {
    const double a = (double)pos * invf;
    const double q = rint(a * 0.63661977236758134308);
    const float r = (float)(a - q * 1.57079632679489661923);
    const int qi = ((int)q) & 3;
    const float r2 = r * r;
    const float sp = r * (1.0f + r2 * (-1.6666667163e-1f + r2 * (8.3333337680e-3f + r2 * (-1.9841270114e-4f + r2 * 2.7557314297e-6f))));
    const float cp = 1.0f + r2 * (-0.5f + r2 * (4.1666667908e-2f + r2 * (-1.3888889225e-3f + r2 * (2.4801587642e-5f + r2 * -2.7557314297e-7f))));
    const float ss = (qi & 1) ? cp : sp, cc = (qi & 1) ? sp : cp;
    s = (qi & 2) ? -ss : ss;
    c = ((qi + 1) & 2) ? -cc : cc;
}
namespace pg8 {
constexpr int BM = 256, BK = 64, HALF = 128, HTB = HALF * BK * 2, STAGE_BYTES = 8 * HTB, NXCD = 8, WGM = 8;
__host__ __device__ __forceinline__ int lds_byte(int r, int c) { const int st = (r >> 4) * 2 + (c >> 5), rr = r & 15, cc = c & 31, ob = rr * 64 + cc * 2; return st * 1024 + (ob ^ (((ob >> 9) & 1) << 5)); }
__host__ __device__ __forceinline__ void stage_rc(int b, int& R, int& C) { const int st = b / 1024, sb = b % 1024, swz = sb ^ (((sb >> 9) & 1) << 5); R = (st >> 1) * 16 + swz / 64; C = (st & 1) * 32 + (swz % 64) / 2; }
__host__ __device__ __forceinline__ int perm32(int rho) { const int n = rho >> 4, i = rho & 15; return 8 * (i >> 2) + 4 * n + (i & 3); }

struct Unit { int brow, pn, orow, tab; };

__device__ __forceinline__ int xcd_remap(int L, int nwg) { const int q = nwg / NXCD, r = nwg % NXCD, xcd = L % NXCD, off = L / NXCD; return (xcd < r ? xcd * (q + 1) : r * (q + 1) + (xcd - r) * q) + off; }

struct DenseOrder {
    int nM, nN, nwg, G, c, start;
    __device__ void init(int M, int N, int G_, int c_, int start_) { nM = M / BM; nN = N / BM; nwg = nM * nN; G = G_; c = c_; start = start_ % G_; }
    __device__ bool next(int i, Unit& u) const {
        const long L = (long)(i + (c < start ? 1 : 0)) * G + c - start; if (L >= nwg) return false;
        const int wgid = xcd_remap((int)L, nwg);
        const int nig = WGM * nN, gid = wgid / nig, fm = gid * WGM, gsz = (nM - fm) < WGM ? (nM - fm) : WGM;
        const int pm = fm + ((wgid % nig) % gsz); u.pn = (wgid % nig) / gsz; u.orow = pm * BM; u.brow = u.pn * BM; u.tab = 0; return true;
    }
};
struct UpOrder {
    const int* tile_e; int ntiles, nwg, G, c, start;
    __device__ void init(const int* te, int nt_, int G_, int c_, int start_) { tile_e = te; ntiles = nt_; nwg = (nt_ + T / BM) * 4; G = G_; c = c_; start = start_ % G_; }
    __device__ bool next(int i, Unit& u) const {
        const long L = (long)(i + (c < start ? 1 : 0)) * G + c - start; if (L >= nwg) return false;
        const int wgid = xcd_remap((int)L, nwg); const int tile = wgid >> 2; u.pn = wgid & 3; u.tab = i;
        if (tile < ntiles) { u.brow = tile_e[tile] * 1024 + u.pn * BM; u.orow = tile * BM; }
        else { u.brow = 64 * 1024 + u.pn * BM; u.orow = A_PAD + (tile - ntiles) * BM; }
        return true;
    }
};
struct DownOrder {
    const int* tile_e; int lo, hi, t0;
    __device__ void init(const int* te, int nt_, int G_, int c_) { tile_e = te; const int n = nt_ * 8; const int vc = (G_ % 8 == 0) ? (c_ % 8) * (G_ / 8) + c_ / 8 : c_;
        lo = (int)(((long)vc * n) / G_); hi = (int)(((long)(vc + 1) * n) / G_); t0 = lo >> 3; }
    __device__ bool next(int i, Unit& u) const {
        const int id = lo + i; if (id >= hi) return false;
        const int tile = id >> 3; u.pn = id & 7; u.orow = tile * BM; u.brow = tile_e[tile] * 2048 + u.pn * BM; u.tab = tile - t0; return true;
    }
};

struct DownOrder2 {
    const int* tile_e; int ntiles, lo, hi, gq, pn;
    __device__ void init(const int* te, int nt_, int G_, int c_) { tile_e = te; ntiles = nt_; const int ntot = nt_ + T / BM, x = c_ % NXCD, j = c_ / NXCD, ngrp = (G_ / NXCD) / 8;
        lo = (int)(((long)x * ntot) / NXCD); hi = (int)(((long)(x + 1) * ntot) / NXCD); gq = j >> 3; pn = j & 7; if (gq >= ngrp) hi = lo; stride = ngrp; }
    int stride;
    __device__ bool next(int i, Unit& u) const {
        const int t = lo + gq + stride * i; if (t >= hi) return false;
        u.pn = pn; u.tab = 0;
        if (t < ntiles) { u.brow = tile_e[t] * 2048 + pn * BM; u.orow = t * BM; } else { u.brow = 64 * 2048 + pn * BM; u.orow = A_PAD + (t - ntiles) * BM; }
        return true;
    }
};
struct ListOrder { const LAS int* tab; int n;
    __device__ __forceinline__ bool next(int i, Unit& u) const { if (i >= n) return false; const LAS int* p = tab + i * 4;
        u.brow = __builtin_amdgcn_readfirstlane(p[0]); u.pn = __builtin_amdgcn_readfirstlane(p[1]); u.orow = __builtin_amdgcn_readfirstlane(p[2]); u.tab = __builtin_amdgcn_readfirstlane(p[3]); return true; } };
template <class Sched> __device__ __forceinline__ ListOrder build_list(const int wv, LAS int* tab, int cap, const Sched& S) {
    __syncthreads();
    int n = 0; Unit u;
    for (; n < cap && S.next(n, u); ++n) if (opaque_tid(wv) == 0) { tab[n * 4 + 0] = u.brow; tab[n * 4 + 1] = u.pn; tab[n * 4 + 2] = u.orow; tab[n * 4 + 3] = u.tab; }
    __syncthreads();
    ListOrder L; L.tab = tab; L.n = n; return L;
}

struct EpiStoreBf16 { static constexpr bool PERM = true; bf16_t* O; int ldo; int pad;
    __device__ __forceinline__ void operator()(const f32x4 (&acc)[2][2][4][2], const Unit& u, int wr, int wc, int fr, int fq) const {
        const int row0 = u.orow + wr * 64 + fr, col0 = u.pn * BM + wc * 32 + 8 * fq;
#pragma unroll
        for (int ai = 0; ai < 2; ++ai)
#pragma unroll
            for (int m = 0; m < 4; ++m) { bf16_t* rowp = O + (size_t)(row0 + ai * HALF + m * 16) * ldo + col0;
#pragma unroll
                for (int bj = 0; bj < 2; ++bj) { const f32x4 v0 = acc[ai][bj][m][0], v1 = acc[ai][bj][m][1];
                    u32x4 w; w.x = cvt_pk_bf16(v0[0], v0[1]); w.y = cvt_pk_bf16(v0[2], v0[3]); w.z = cvt_pk_bf16(v1[0], v1[1]); w.w = cvt_pk_bf16(v1[2], v1[3]);
                    *(u32x4*)(rowp + bj * HALF) = w; } }
    } };
struct EpiStore8 { static constexpr bool PERM = true; unsigned char* O; int ldo; int pad;
    __device__ __forceinline__ void operator()(const f32x4 (&acc)[2][2][4][2], const Unit& u, int wr, int wc, int fr, int fq) const {
        const int row0 = u.orow + wr * 64 + fr, col0 = u.pn * BM + wc * 32 + 8 * fq;
#pragma unroll
        for (int ai = 0; ai < 2; ++ai)
#pragma unroll
            for (int m = 0; m < 4; ++m) { unsigned char* rowp = O + (size_t)(row0 + ai * HALF + m * 16) * ldo + col0;
#pragma unroll
                for (int bj = 0; bj < 2; ++bj) { const f32x4 v0 = acc[ai][bj][m][0], v1 = acc[ai][bj][m][1];
                    u32x2 w; w.x = cvt4_fp8(v0[0], v0[1], v0[2], v0[3]); w.y = cvt4_fp8(v1[0], v1[1], v1[2], v1[3]); *(u32x2*)(rowp + bj * HALF) = w; } }
    } };
struct EpiGate8 { static constexpr bool PERM = true; unsigned char* U; const float* bias;
    __device__ __forceinline__ void operator()(const f32x4 (&acc)[2][2][4][2], const Unit& u, int wr, int wc, int fr, int fq) const {
        typedef float f2_ __attribute__((ext_vector_type(2)));
        const int row0 = u.orow + wr * 64 + fr, col0 = u.pn * BM + wc * 32 + 8 * fq;
        f32x4 bv[2][2];
#pragma unroll
        for (int bj = 0; bj < 2; ++bj)
#pragma unroll
            for (int n = 0; n < 2; ++n) bv[bj][n] = *(const f32x4*)(bias + col0 + bj * HALF + 4 * n);
#pragma unroll
        for (int ai = 0; ai < 2; ++ai)
#pragma unroll
            for (int m = 0; m < 4; ++m) { unsigned char* rowp = U + (size_t)(row0 + ai * HALF + m * 16) * D + col0;
#pragma unroll
                for (int bj = 0; bj < 2; ++bj) { const u32x2 uu = *(const u32x2*)(rowp + bj * HALF);
                    const f2_ u01 = __builtin_amdgcn_cvt_pk_f32_fp8((int)uu.x, false), u23 = __builtin_amdgcn_cvt_pk_f32_fp8((int)uu.x, true), u45 = __builtin_amdgcn_cvt_pk_f32_fp8((int)uu.y, false), u67 = __builtin_amdgcn_cvt_pk_f32_fp8((int)uu.y, true);
                    const f32x4 a0 = acc[ai][bj][m][0] + bv[bj][0], a1 = acc[ai][bj][m][1] + bv[bj][1];
                    u32x2 w; w.x = cvt4_fp8(sigmoidf_(a0[0]) * u01[0] * Y8_SCALE, sigmoidf_(a0[1]) * u01[1] * Y8_SCALE, sigmoidf_(a0[2]) * u23[0] * Y8_SCALE, sigmoidf_(a0[3]) * u23[1] * Y8_SCALE);
                    w.y = cvt4_fp8(sigmoidf_(a1[0]) * u45[0] * Y8_SCALE, sigmoidf_(a1[1]) * u45[1] * Y8_SCALE, sigmoidf_(a1[2]) * u67[0] * Y8_SCALE, sigmoidf_(a1[3]) * u67[1] * Y8_SCALE);
                    *(u32x2*)(rowp + bj * HALF) = w; }
                asm volatile("" ::: "memory"); }
    } };
struct EpiSwiglu { static constexpr bool PERM = true; bf16_t* H;
    __device__ __forceinline__ void operator()(const f32x4 (&acc)[2][2][4][2], const Unit& u, int wr, int wc, int fr, int fq) const {
        const int row0 = u.orow + wr * 64 + fr, col0 = u.pn * HALF + wc * 32 + 8 * fq;
#pragma unroll
        for (int ai = 0; ai < 2; ++ai)
#pragma unroll
            for (int m = 0; m < 4; ++m) { const f32x4 g0 = acc[ai][0][m][0], g1 = acc[ai][0][m][1], u0 = acc[ai][1][m][0], u1 = acc[ai][1][m][1];
                u32x4 w; w.x = cvt_pk_bf16(siluf_(g0[0]) * u0[0], siluf_(g0[1]) * u0[1]); w.y = cvt_pk_bf16(siluf_(g0[2]) * u0[2], siluf_(g0[3]) * u0[3]);
                w.z = cvt_pk_bf16(siluf_(g1[0]) * u1[0], siluf_(g1[1]) * u1[1]); w.w = cvt_pk_bf16(siluf_(g1[2]) * u1[2], siluf_(g1[3]) * u1[3]);
                *(u32x4*)(H + (size_t)(row0 + ai * HALF + m * 16) * EF + col0) = w; }
    } };
struct EpiSwiglu8 { static constexpr bool PERM = true; unsigned char* H;
    __device__ __forceinline__ void operator()(const f32x4 (&acc)[2][2][4][2], const Unit& u, int wr, int wc, int fr, int fq) const {
        const int row0 = u.orow + wr * 64 + fr, col0 = u.pn * HALF + wc * 32 + 8 * fq;
#pragma unroll
        for (int ai = 0; ai < 2; ++ai)
#pragma unroll
            for (int m = 0; m < 4; ++m) { const f32x4 g0 = acc[ai][0][m][0], g1 = acc[ai][0][m][1], u0 = acc[ai][1][m][0], u1 = acc[ai][1][m][1];
                u32x2 w; w.x = cvt4_fp8(siluf_(g0[0]) * u0[0], siluf_(g0[1]) * u0[1], siluf_(g0[2]) * u0[2], siluf_(g0[3]) * u0[3]);
                w.y = cvt4_fp8(siluf_(g1[0]) * u1[0], siluf_(g1[1]) * u1[1], siluf_(g1[2]) * u1[2], siluf_(g1[3]) * u1[3]);
                *(u32x2*)(H + (size_t)(row0 + ai * HALF + m * 16) * EF + col0) = w; }
    } };
struct EpiResid { static constexpr bool PERM = true; const bf16_t* xres; bf16_t* Z; float alpha; int pad;
    __device__ __forceinline__ void operator()(const f32x4 (&acc)[2][2][4][2], const Unit& u, int wr, int wc, int fr, int fq) const {
        const int row0 = u.orow + wr * 64 + fr, col0 = u.pn * BM + wc * 32 + 8 * fq;
#pragma unroll
        for (int ai = 0; ai < 2; ++ai)
#pragma unroll
            for (int m = 0; m < 4; ++m) { const size_t off = (size_t)(row0 + ai * HALF + m * 16) * D + col0;
#pragma unroll
                for (int bj = 0; bj < 2; ++bj) { const u32x4 x = *(const u32x4*)(xres + off + bj * HALF); const f32x4 a0 = acc[ai][bj][m][0], a1 = acc[ai][bj][m][1];
                    u32x4 w; w.x = cvt_pk_bf16(alpha * bflo(x.x) + a0[0], alpha * bfhi(x.x) + a0[1]); w.y = cvt_pk_bf16(alpha * bflo(x.y) + a0[2], alpha * bfhi(x.y) + a0[3]);
                    w.z = cvt_pk_bf16(alpha * bflo(x.z) + a1[0], alpha * bfhi(x.z) + a1[1]); w.w = cvt_pk_bf16(alpha * bflo(x.w) + a1[2], alpha * bfhi(x.w) + a1[3]);
                    *(u32x4*)(Z + off + bj * HALF) = w; }
                asm volatile("" ::: "memory"); }
    } };
struct EpiAccum { static constexpr bool PERM = false; float* xio;
    __device__ __forceinline__ void operator()(const f32x4 (&acc)[2][2][4][2], const Unit& u, int wr, int wc, int fr, int fq) const {
        const int row0 = u.orow + wr * 64 + fr, col0 = u.pn * BM + wc * 32 + 4 * fq;
#pragma unroll
        for (int ai = 0; ai < 2; ++ai)
#pragma unroll
            for (int m = 0; m < 4; ++m) { const size_t off = (size_t)(row0 + ai * HALF + m * 16) * D + col0;
#pragma unroll
                for (int bj = 0; bj < 2; ++bj)
#pragma unroll
                    for (int n = 0; n < 2; ++n) { const f32x4 x = *(const f32x4*)(xio + off + bj * HALF + n * 16); *(f32x4*)(xio + off + bj * HALF + n * 16) = x + acc[ai][bj][m][n]; }
                asm volatile("" ::: "memory"); }
    } };
struct EpiScatter { static constexpr bool PERM = true; bf16_t* Y; const LAS int* tdst; const LAS float* tgate; int nostore; int pad;
    __device__ __forceinline__ void operator()(const f32x4 (&acc)[2][2][4][2], const Unit& u, int wr, int wc, int fr, int fq) const {
        const int r0 = u.tab * BM + wr * 64 + fr, col0 = u.pn * BM + wc * 32 + 8 * fq;
#pragma unroll
        for (int ai = 0; ai < 2; ++ai)
#pragma unroll
            for (int m = 0; m < 4; ++m) { const int dst = tdst[r0 + ai * HALF + m * 16]; const float g = tgate[r0 + ai * HALF + m * 16];
                if (dst >= 0 && !nostore) { bf16_t* rowp = Y + (size_t)dst * D + col0;
#pragma unroll
                    for (int bj = 0; bj < 2; ++bj) { const f32x4 v0 = acc[ai][bj][m][0] * g, v1 = acc[ai][bj][m][1] * g;
                        u32x4 w; w.x = cvt_pk_bf16(v0[0], v0[1]); w.y = cvt_pk_bf16(v0[2], v0[3]); w.z = cvt_pk_bf16(v1[0], v1[1]); w.w = cvt_pk_bf16(v1[2], v1[3]);
                        *(u32x4*)(rowp + bj * HALF) = w; } } }
    } };
struct EpiScatter2 { static constexpr bool PERM = true; bf16_t* Y; bf16_t* YSH; const int* rdst; const float* rgate;
    __device__ __forceinline__ void operator()(const f32x4 (&acc)[2][2][4][2], const Unit& u, int wr, int wc, int fr, int fq) const {
        const int col0 = u.pn * BM + wc * 32 + 8 * fq;
        if (u.orow < A_PAD) {
            const int r0 = u.orow + wr * 64 + fr;
#pragma unroll
            for (int ai = 0; ai < 2; ++ai) {
                int dst[4]; float g[4];
#pragma unroll
                for (int m = 0; m < 4; ++m) { dst[m] = rdst[r0 + ai * HALF + m * 16]; g[m] = rgate[r0 + ai * HALF + m * 16]; }
#pragma unroll
                for (int m = 0; m < 4; ++m) if (dst[m] >= 0) { bf16_t* rowp = Y + (size_t)dst[m] * D + col0;
#pragma unroll
                    for (int bj = 0; bj < 2; ++bj) { const f32x4 v0 = acc[ai][bj][m][0] * g[m], v1 = acc[ai][bj][m][1] * g[m];
                        u32x4 w; w.x = cvt_pk_bf16(v0[0], v0[1]); w.y = cvt_pk_bf16(v0[2], v0[3]); w.z = cvt_pk_bf16(v1[0], v1[1]); w.w = cvt_pk_bf16(v1[2], v1[3]);
                        *(u32x4*)(rowp + bj * HALF) = w; } } }
        } else {
            const int row0 = u.orow - A_PAD + wr * 64 + fr;
#pragma unroll
            for (int ai = 0; ai < 2; ++ai)
#pragma unroll
                for (int m = 0; m < 4; ++m) { bf16_t* rowp = YSH + (size_t)(row0 + ai * HALF + m * 16) * D + col0;
#pragma unroll
                    for (int bj = 0; bj < 2; ++bj) { const f32x4 v0 = acc[ai][bj][m][0], v1 = acc[ai][bj][m][1];
                        u32x4 w; w.x = cvt_pk_bf16(v0[0], v0[1]); w.y = cvt_pk_bf16(v0[2], v0[3]); w.z = cvt_pk_bf16(v1[0], v1[1]); w.w = cvt_pk_bf16(v1[2], v1[3]);
                        *(u32x4*)(rowp + bj * HALF) = w; } }
        }
    } };
struct EpiScatter8 { static constexpr bool PERM = true; unsigned char* Y; const int* rdst; const float* rgate;
    __device__ __forceinline__ void operator()(const f32x4 (&acc)[2][2][4][2], const Unit& u, int wr, int wc, int fr, int fq) const {
        const unsigned col0 = (unsigned)(u.pn * BM + wc * 32 + 8 * fq); const int r0 = u.orow + wr * 64 + fr;
#pragma unroll
        for (int ai = 0; ai < 2; ++ai)
#pragma unroll
            for (int m = 0; m < 4; ++m) { const int dst = rdst[r0 + ai * HALF + m * 16]; const float g = rgate[r0 + ai * HALF + m * 16] * Y8_SCALE;
                if (dst >= 0) { const unsigned off = (unsigned)dst * (unsigned)D + col0;
#pragma unroll
                    for (int bj = 0; bj < 2; ++bj) { const f32x4 v0 = acc[ai][bj][m][0] * g, v1 = acc[ai][bj][m][1] * g;
                        u32x2 w; w.x = cvt4_fp8(v0[0], v0[1], v0[2], v0[3]); w.y = cvt4_fp8(v1[0], v1[1], v1[2], v1[3]); *(u32x2*)(Y + off + bj * HALF) = w; } } }
    } };
struct EpiGate { static constexpr bool PERM = true; bf16_t* U; const float* bias;
    __device__ __forceinline__ void operator()(const f32x4 (&acc)[2][2][4][2], const Unit& u, int wr, int wc, int fr, int fq) const {
        const int row0 = u.orow + wr * 64 + fr, col0 = u.pn * BM + wc * 32 + 8 * fq;
        f32x4 bv[2][2];
#pragma unroll
        for (int bj = 0; bj < 2; ++bj)
#pragma unroll
            for (int n = 0; n < 2; ++n) bv[bj][n] = *(const f32x4*)(bias + col0 + bj * HALF + 4 * n);
#pragma unroll
        for (int ai = 0; ai < 2; ++ai)
#pragma unroll
            for (int m = 0; m < 4; ++m) { bf16_t* rowp = U + (size_t)(row0 + ai * HALF + m * 16) * D + col0;
#pragma unroll
                for (int bj = 0; bj < 2; ++bj) { const u32x4 uu = *(const u32x4*)(rowp + bj * HALF);
                    const f32x4 a0 = acc[ai][bj][m][0] + bv[bj][0], a1 = acc[ai][bj][m][1] + bv[bj][1];
                    u32x4 w; w.x = cvt_pk_bf16(sigmoidf_(a0[0]) * bflo(uu.x), sigmoidf_(a0[1]) * bfhi(uu.x)); w.y = cvt_pk_bf16(sigmoidf_(a0[2]) * bflo(uu.y), sigmoidf_(a0[3]) * bfhi(uu.y));
                    w.z = cvt_pk_bf16(sigmoidf_(a1[0]) * bflo(uu.z), sigmoidf_(a1[1]) * bfhi(uu.z)); w.w = cvt_pk_bf16(sigmoidf_(a1[2]) * bflo(uu.w), sigmoidf_(a1[3]) * bfhi(uu.w));
                    *(u32x4*)(rowp + bj * HALF) = w; }
                asm volatile("" ::: "memory"); }
    } };
struct EpiRouter { static constexpr bool PERM = false; float* LOG;
    __device__ __forceinline__ void operator()(const f32x4 (&acc)[2][2][4][2], const Unit& u, int wr, int wc, int fr, int fq) const {
        if (wc < 2) { const int row0 = u.orow + wr * 64 + fr, col0 = wc * 32 + 4 * fq;
#pragma unroll
            for (int ai = 0; ai < 2; ++ai)
#pragma unroll
                for (int m = 0; m < 4; ++m)
#pragma unroll
                    for (int n = 0; n < 2; ++n) *(f32x4*)(LOG + (size_t)(row0 + ai * HALF + m * 16) * 64 + col0 + n * 16) = acc[ai][0][m][n]; }
    } };

template <class E, class = void> struct epi_has_hooks { static constexpr bool value = false; };
template <class E> struct epi_has_hooks<E, decltype((void)E::HOOKS)> { static constexpr bool value = true; };
template <int K, class Epi, class Sched, bool GATHER, int VAR = 0, bool FP8 = false, int STAG = 0>
__device__ __forceinline__ void gemm_phase(const int wv, LAS unsigned char* lds, const bf16_t* Ap_, const bf16_t* Btp_, const Sched& S, Epi& E, const LAS int* gtab) {
    typedef const __attribute__((address_space(1))) char* gcp;
    gcp Ap = (gcp)Ap_; gcp Btp = (gcp)Btp_; asm volatile("" : "+s"(Ap), "+s"(Btp));
    const int tid = opaque_tid(wv), wid = wv, lane = tid & 63, wr = wid >> 2, wc = wid & 3, fr = lane & 15, fq = lane >> 4;
    constexpr int ES = FP8 ? 1 : 2, KB = K * ES;
    constexpr int nt = KB / 128;
    static_assert(nt >= 4 && nt % 2 == 0, "K-loop needs an even number (>= 4) of 128-byte K-tiles");
    unsigned voffB[2], vc[2][2];
#pragma unroll
    for (int i = 0; i < 2; ++i) { int R, C; stage_rc(tid * 16 + i * 8192, R, C); const int Rb = Epi::PERM ? ((R & ~31) + perm32(R & 31)) : R; voffB[i] = (unsigned)(Rb * KB + C * 2); asm volatile("" : "+v"(voffB[i])); }
    constexpr size_t kstep = (size_t)(BK * 2);
    constexpr size_t hstep = (size_t)HALF * KB;
    constexpr size_t hA = GATHER ? (size_t)0 : hstep;
    const unsigned ldsw = (unsigned)wid * 1024u;
    const int aoff = lds_byte(wr * 64 + fr, fq * 8), boff = lds_byte(wc * 32 + fr, fq * 8);
#define PG8_SA(b, h) (((b) * 2 + (h)) * HTB)
#define PG8_SB(b, h) ((4 + (b) * 2 + (h)) * HTB)
#define PG8_STAGE(bufoff, gbase, voff) do { _Pragma("unroll") for (int _i = 0; _i < 2; ++_i) { unsigned _o = (voff)[_i]; asm volatile("" : "+v"(_o));     \
        __builtin_amdgcn_global_load_lds((const __attribute__((address_space(1))) unsigned*)((gbase) + _o), (LAS unsigned*)(lds + (bufoff) + ldsw + _i * 8192), 16, 0, 0); } } while (0)
#define PG8_SETA(v, slot) do { _Pragma("unroll") for (int _h = 0; _h < 2; ++_h) _Pragma("unroll") for (int _i = 0; _i < 2; ++_i) { int _R, _C; stage_rc(tid * 16 + _i * 8192, _R, _C); \
        (v)[_h][_i] = GATHER ? ((unsigned)gtab[(slot) * BM + _h * HALF + _R] * (unsigned)KB + (unsigned)(_C * 2)) : (unsigned)(_R * KB + _C * 2); asm volatile("" : "+v"((v)[_h][_i])); } } while (0)
#define PG8_LDA(dst, b, h) do { unsigned _ba = (unsigned)(aoff + PG8_SA(b, h)); asm volatile("" : "+v"(_ba)); const LAS unsigned char* _pa = lds + _ba; _Pragma("unroll") for (int m = 0; m < 4; ++m) { \
        if constexpr (FP8) dst##8[m] = __builtin_shufflevector(*(const LAS v4i_*)(_pa + m * 2048), *(const LAS v4i_*)(_pa + m * 2048 + 1024), 0, 1, 2, 3, 4, 5, 6, 7); \
        else { _Pragma("unroll") for (int k = 0; k < 2; ++k) dst[m][k] = *(const LAS bf16x8*)(_pa + m * 2048 + k * 1024); } } } while (0)
#define PG8_LDB(dst, b, h) do { unsigned _bb = (unsigned)(boff + PG8_SB(b, h)); asm volatile("" : "+v"(_bb)); const LAS unsigned char* _pb = lds + _bb; _Pragma("unroll") for (int n = 0; n < 2; ++n) { \
        if constexpr (FP8) dst##8[n] = __builtin_shufflevector(*(const LAS v4i_*)(_pb + n * 2048), *(const LAS v4i_*)(_pb + n * 2048 + 1024), 0, 1, 2, 3, 4, 5, 6, 7); \
        else { _Pragma("unroll") for (int k = 0; k < 2; ++k) dst[n][k] = *(const LAS bf16x8*)(_pb + n * 2048 + k * 1024); } } } while (0)
#define PG8_MMA(ai, bj, At, Bt) do { __builtin_amdgcn_s_setprio(1); _Pragma("unroll") for (int m = 0; m < 4; ++m) _Pragma("unroll") for (int n = 0; n < 2; ++n) { \
        if constexpr (FP8) asm volatile("v_mfma_scale_f32_16x16x128_f8f6f4 %0, %1, %2, %0, %3, %3 op_sel_hi:[0,0,0]" : "+v"(acc[ai][bj][m][n]) : "v"(Bt##8[n]), "v"(At##8[m]), "v"(sc8_)); \
        else { _Pragma("unroll") for (int k = 0; k < 2; ++k) acc[ai][bj][m][n] = __builtin_amdgcn_mfma_f32_16x16x32_bf16(Bt[n][k], At[m][k], acc[ai][bj][m][n], 0, 0, 0); } } \
        __builtin_amdgcn_s_setprio(0); } while (0)
#define PG8_WAIT_V(n) asm volatile("s_waitcnt vmcnt(" #n ")" ::: "memory")
#define PG8_WAIT_L(n) asm volatile("s_waitcnt lgkmcnt(" #n ")" ::: "memory")
#define PG8_BAR __builtin_amdgcn_s_barrier()
#define PG8_SCHED __builtin_amdgcn_sched_barrier(0)
    Unit cur, nxt; int ui = 0;
    if (!S.next(0, cur)) return;
    if constexpr (epi_has_hooks<Epi>::value) E.begin(S, tid);
    if constexpr (STAG > 0) {
        const unsigned long long t0 = __builtin_amdgcn_s_memrealtime(); const unsigned long long dt = (unsigned long long)(((blockIdx.x >> 3) & 7) * STAG);
        while (__builtin_amdgcn_s_memrealtime() - t0 < dt) __builtin_amdgcn_s_sleep(8);
    }
    f32x4 acc[2][2][4][2];
#pragma unroll
    for (int a = 0; a < 2; ++a)
#pragma unroll
        for (int b = 0; b < 2; ++b)
#pragma unroll
            for (int m = 0; m < 4; ++m)
#pragma unroll
                for (int n = 0; n < 2; ++n) acc[a][b][m][n] = (f32x4){0.f, 0.f, 0.f, 0.f};
    typedef int v8i_ __attribute__((ext_vector_type(8))); typedef int v4i_ __attribute__((ext_vector_type(4)));
    const int sc8_ = W8_E8M0;
    bf16x8 At[4][2], B0[2][2], B1[2][2]; v8i_ At8[4], B08[2], B18[2];
    PG8_SETA(vc, cur.tab);
    gcp cA = Ap + (GATHER ? (size_t)0 : (size_t)cur.orow * KB); gcp cB = Btp + (size_t)cur.brow * KB;
    PG8_STAGE(PG8_SB(0, 0), cB, voffB); PG8_STAGE(PG8_SB(0, 1), cB + hstep, voffB); PG8_STAGE(PG8_SA(0, 0), cA, vc[0]); PG8_STAGE(PG8_SA(0, 1), cA + hA, vc[1]);
    if (wr == 1) PG8_BAR;
    PG8_WAIT_V(2); PG8_BAR;
    PG8_STAGE(PG8_SB(1, 0), cB + kstep, voffB); PG8_STAGE(PG8_SA(1, 0), cA + kstep, vc[0]); PG8_STAGE(PG8_SB(1, 1), cB + hstep + kstep, voffB);
    PG8_WAIT_V(6); PG8_BAR;
    for (;;) {
        const bool has_next = S.next(ui + 1, nxt);
        gcp nA = has_next ? Ap + (GATHER ? (size_t)0 : (size_t)nxt.orow * KB) : cA; gcp nB = has_next ? Btp + (size_t)nxt.brow * KB : cB;
#pragma nounroll
        for (int t = 0; t < nt; t += 2) {
            const bool last = (t == nt - 2);
            gcp a1 = cA + (size_t)(t + 1) * kstep;
            gcp a2 = last ? nA : cA + (size_t)(t + 2) * kstep; gcp b2 = last ? nB : cB + (size_t)(t + 2) * kstep;
            gcp a3 = a2 + kstep; gcp b3 = b2 + kstep;
            PG8_LDB(B0, 0, 0); PG8_LDB(B1, 0, 1); PG8_SCHED; PG8_LDA(At, 0, 0); PG8_STAGE(PG8_SA(1, 1), a1 + hA, vc[1]);
            if (GATHER && last && has_next) PG8_SETA(vc, nxt.tab);
            PG8_WAIT_V(8); PG8_WAIT_L(0); PG8_BAR; PG8_MMA(0, 0, At, B0); PG8_MMA(0, 1, At, B1); PG8_BAR; PG8_SCHED;
            PG8_LDA(At, 0, 1); PG8_STAGE(PG8_SB(0, 0), b2, voffB); PG8_STAGE(PG8_SB(0, 1), b2 + hstep, voffB); PG8_STAGE(PG8_SA(0, 0), a2, vc[0]);
            PG8_WAIT_V(8); PG8_WAIT_L(0); PG8_BAR; PG8_MMA(1, 0, At, B0); PG8_MMA(1, 1, At, B1); PG8_BAR; PG8_SCHED;
            PG8_LDB(B0, 1, 0); PG8_LDB(B1, 1, 1); PG8_SCHED; PG8_LDA(At, 1, 0); PG8_STAGE(PG8_SA(0, 1), a2 + hA, vc[1]);
            PG8_WAIT_V(8); PG8_WAIT_L(0); PG8_BAR; PG8_MMA(0, 0, At, B0); PG8_MMA(0, 1, At, B1); PG8_BAR; PG8_SCHED;
            PG8_LDA(At, 1, 1); PG8_STAGE(PG8_SB(1, 0), b3, voffB); PG8_STAGE(PG8_SB(1, 1), b3 + hstep, voffB); PG8_STAGE(PG8_SA(1, 0), a3, vc[0]);
            PG8_WAIT_V(8); PG8_WAIT_L(0); PG8_BAR; PG8_MMA(1, 0, At, B0); PG8_MMA(1, 1, At, B1); PG8_BAR; PG8_SCHED;
        }
        if (!(VAR & 2)) { if (wr == 0) PG8_BAR; }
        if (!(VAR & 1)) { const int t2 = opaque_tid(wv), l2 = t2 & 63;
            if constexpr (epi_has_hooks<Epi>::value) { E.pre(S, ui, t2); E(acc, cur, wr, wc, l2 & 15, l2 >> 4, ui); } else E(acc, cur, wr, wc, l2 & 15, l2 >> 4); }
        if (!has_next) break;
#pragma unroll
        for (int a = 0; a < 2; ++a)
#pragma unroll
            for (int b = 0; b < 2; ++b)
#pragma unroll
                for (int m = 0; m < 4; ++m)
#pragma unroll
                    for (int n = 0; n < 2; ++n) acc[a][b][m][n] = (f32x4){0.f, 0.f, 0.f, 0.f};
        cur = nxt; cA = nA; cB = nB; ++ui;
        if (!(VAR & 2)) { if (wr == 1) PG8_BAR; }
    }
    PG8_WAIT_V(0);
    if (VAR & 2) { if (wr == 0) PG8_BAR; }
    PG8_BAR;
#undef PG8_SA
#undef PG8_SB
#undef PG8_STAGE
#undef PG8_SETA
#undef PG8_LDA
#undef PG8_LDB
#undef PG8_MMA
#undef PG8_WAIT_V
#undef PG8_WAIT_L
#undef PG8_BAR
#undef PG8_SCHED
}
}
constexpr int NWAVES = 8, NTHR = 512;
constexpr int RING_OFF = 0, RING_BYTES = 131072;
constexpr int TAB_OFF = RING_BYTES, TAB_BYTES = 24576;
constexpr int MISC_OFF = TAB_OFF + TAB_BYTES;
constexpr int ULIST_OFF = MISC_OFF + 128, ULIST_CAP = 64;
constexpr int LDS_BYTES = 160 * 1024;
static_assert(ULIST_OFF + ULIST_CAP * 16 <= LDS_BYTES, "LDS map");
constexpr int CW_BAR = 1024;

#define XB_TMO      128
#define XB_XCNT(j)  (256  + 64 * (j))
#define XB_XSUB(j)  (1280 + 64 * (j))
#define XB_XGEN(j)  (2304 + 64 * (j))
#define XB_TOP      3328
#define XB_TOPGEN   3392
#define XCD_BAR_WORDS 3456
#define XB_SPIN_CAP (1u << 22)
static_assert((CW_BAR + XCD_BAR_WORDS) * 4 <= (int)CTL_ZERO_BYTES, "barrier words inside the memset region");

__device__ __forceinline__ unsigned xb_ld(unsigned* p)              { return __hip_atomic_load(p, __ATOMIC_RELAXED, __HIP_MEMORY_SCOPE_AGENT); }
__device__ __forceinline__ unsigned xb_add(unsigned* p, unsigned v) { return __hip_atomic_fetch_add(p, v, __ATOMIC_RELAXED, __HIP_MEMORY_SCOPE_AGENT); }
__device__ __forceinline__ unsigned xb_xcc_id() { return (unsigned)__builtin_amdgcn_s_getreg((3 << 11) | 20) & 0xFu; }
#define XB_SPIN(cond, bar) do { unsigned _sp = 0; while (cond) { __builtin_amdgcn_s_sleep(1); \
    if ((++_sp & 255u) == 0u) { if (xb_ld(&(bar)[XB_TMO])) break; if (_sp > XB_SPIN_CAP) { atomicAdd(&(bar)[XB_TMO], 1u); break; } } } } while (0)

struct XcdBarrier { unsigned* bar; unsigned x; volatile LAS unsigned* st; int w0; };
__device__ __forceinline__ XcdBarrier xcd_barrier_post(unsigned* bar, volatile LAS unsigned* st) {
    XcdBarrier b; b.bar = bar; b.x = xb_xcc_id(); b.st = st; b.w0 = (__builtin_amdgcn_readfirstlane(threadIdx.x >> 6) == 0) ? 1 : 0;
    if (threadIdx.x == 0) (void)xb_add(&bar[XB_XCNT(b.x)], 1u);
    return b;
}
__device__ __forceinline__ void xcd_barrier_complete(unsigned* bar, unsigned x, unsigned& nloc, unsigned& nx) {
    const unsigned G = gridDim.x * gridDim.y * gridDim.z;
    unsigned sum, cnt, mine, sp = 0u;
    for (;;) {
        sum = 0u; cnt = 0u; mine = 0u;
#pragma unroll
        for (unsigned j = 0; j < 16; ++j) { const unsigned c = xb_ld(&bar[XB_XCNT(j)]); sum += c; cnt += (c > 0u) ? 1u : 0u; mine = (j == x) ? c : mine; }
        if (sum == G) break;
        __builtin_amdgcn_s_sleep(1);
        if ((++sp & 255u) == 0u) { if (xb_ld(&bar[XB_TMO])) break; if (sp > XB_SPIN_CAP) { atomicAdd(&bar[XB_TMO], 1u); break; } }
    }
    nloc = mine > 0u ? mine : 1u; nx = cnt > 0u ? cnt : 1u;
}
__device__ __forceinline__ void xcd_barrier(const XcdBarrier& b) {
    asm volatile("s_waitcnt vmcnt(0)" ::: "memory");
    __syncthreads();
    if (b.w0 && lane_id() == 0) {
        unsigned* bar = b.bar;
        __builtin_amdgcn_s_waitcnt(0);
        unsigned nloc = b.st[0], nx = b.st[1];
        if (nloc == 0u) { xcd_barrier_complete(bar, b.x, nloc, nx); b.st[0] = nloc; b.st[1] = nx; }
        const unsigned old = xb_add(&bar[XB_XSUB(b.x)], 1u);
        const unsigned gen = old / nloc;
        if (old + 1u == (gen + 1u) * nloc) {
            __builtin_amdgcn_fence(__ATOMIC_RELEASE, "agent");
            asm volatile("s_waitcnt vmcnt(0)" ::: "memory");
            const unsigned og = xb_add(&bar[XB_TOP], 1u);
            const unsigned tg = og / nx;
            if (og + 1u == (tg + 1u) * nx) xb_add(&bar[XB_TOPGEN], 1u);
            else XB_SPIN(xb_ld(&bar[XB_TOPGEN]) == tg, bar);
            __builtin_amdgcn_fence(__ATOMIC_ACQUIRE, "agent");
            xb_add(&bar[XB_XGEN(b.x)], 1u);
            asm volatile("s_waitcnt vmcnt(0)" ::: "memory");
        } else {
            XB_SPIN(xb_ld(&bar[XB_XGEN(b.x)]) == gen, bar);
            __builtin_amdgcn_fence(__ATOMIC_ACQUIRE, "agent");
            asm volatile("s_waitcnt vmcnt(0)" ::: "memory");
        }
    }
    __syncthreads();
}

struct TItem { const float* W; unsigned char* WT; int K, N, k0, n0, drow, f8; };
__device__ __forceinline__ void ti_load(const TItem& t, float4 (&v)[8], int lane) {
#pragma unroll
    for (int i = 0; i < 8; ++i) v[i] = *(const float4*)(t.W + (size_t)(t.k0 + 8 * i + (lane >> 3)) * t.N + t.n0 + (lane & 7) * 4);
}
__device__ __forceinline__ void ti_store(const TItem& t, const float4 (&v)[8], LAS float* scr, int lane) {
#pragma unroll
    for (int i = 0; i < 8; ++i) { LAS float* p = scr + (8 * i + (lane >> 3)) * 33 + (lane & 7) * 4; p[0] = v[i].x; p[1] = v[i].y; p[2] = v[i].z; p[3] = v[i].w; }
    asm volatile("s_waitcnt lgkmcnt(0)" ::: "memory");
    const int c = lane & 7;
#pragma unroll
    for (int j = 0; j < 4; ++j) { const int n = (lane >> 3) + 8 * j; const LAS float* s = scr + (8 * c) * 33 + n;
        if (t.f8) { u32x2 o; o.x = cvt4_fp8(s[0 * 33] * W8_SCALE, s[1 * 33] * W8_SCALE, s[2 * 33] * W8_SCALE, s[3 * 33] * W8_SCALE); o.y = cvt4_fp8(s[4 * 33] * W8_SCALE, s[5 * 33] * W8_SCALE, s[6 * 33] * W8_SCALE, s[7 * 33] * W8_SCALE);
            *(u32x2*)(t.WT + (size_t)(t.drow + n) * t.K + t.k0 + 8 * c) = o; }
        else { u32x4 o; o.x = pk2(s[0 * 33], s[1 * 33]); o.y = pk2(s[2 * 33], s[3 * 33]); o.z = pk2(s[4 * 33], s[5 * 33]); o.w = pk2(s[6 * 33], s[7 * 33]);
            *(u32x4*)(t.WT + ((size_t)(t.drow + n) * t.K + t.k0 + 8 * c) * 2) = o; } }
    asm volatile("s_waitcnt lgkmcnt(0)" ::: "memory");
}
struct WPtrs { const float *w_in, *w_out, *gate, *plew, *ew1, *ew3, *ew2, *sw1, *sw3, *sw2, *rw, *lwa, *lwx; bf16_t* lru_wg; };
template <bool F8, bool F8DN>
__device__ __forceinline__ void convert_weights(unsigned char* ldsb, const WPtrs& P, unsigned char* wsw, int gw, int NGW, int wave, int lane) {
    LAS float* scr0 = (LAS float*)((LAS unsigned char*)ldsb + wave * 16896); LAS float* scr1 = scr0 + 2112;
    unsigned char* WIN = wsw + WO_WIN; unsigned char* WOUT = wsw + WO_WOUT; unsigned char* GATE = wsw + WO_GATE; unsigned char* PLEW = wsw + WO_PLEW;
    unsigned char* W2 = wsw + WO_W2; unsigned char* W13 = wsw + WO_W13; bf16_t* ROUT = (bf16_t*)(wsw + WO_ROUT);
    constexpr int I_IN = (D / 64) * (IN_COLS / 32), I_OUT = (D / 64) * (D / 32), I_GATE = I_OUT, I_PLE = (PLE / 64) * (D / 32), I_W2 = (EF / 64) * (D / 32), I_W13 = (D / 64) * (EF / 32), I_R = (D / 64) * (NE / 32);
    constexpr int NITEMS = I_R + I_IN + I_OUT + I_GATE + I_PLE + 65 * I_W2 + 65 * 2 * I_W13;
    auto decode = [&](int it) -> TItem { TItem t; int r = it; t.f8 = 0;
        if (r < I_R) { const int nb = NE / 32; t.W = P.rw; t.WT = (unsigned char*)ROUT; t.K = D; t.N = NE; t.k0 = 64 * (r / nb); t.n0 = 32 * (r % nb); t.drow = t.n0; return t; } r -= I_R;
        if (r < I_IN) { const int nb = IN_COLS / 32; t.W = P.w_in; t.WT = WIN; t.K = D; t.N = IN_COLS; t.k0 = 64 * (r / nb); t.n0 = 32 * (r % nb); t.drow = t.n0; return t; } r -= I_IN;
        if (r < I_OUT) { const int nb = D / 32; t.W = P.w_out; t.WT = WOUT; t.K = D; t.N = D; t.k0 = 64 * (r / nb); t.n0 = 32 * (r % nb); t.drow = t.n0; return t; } r -= I_OUT;
        if (r < I_GATE) { const int nb = D / 32; t.W = P.gate; t.WT = GATE; t.K = D; t.N = D; t.k0 = 64 * (r / nb); t.n0 = 32 * (r % nb); t.drow = t.n0; t.f8 = F8 ? 1 : 0; return t; } r -= I_GATE;
        if (r < I_PLE) { const int nb = D / 32; t.W = P.plew; t.WT = PLEW; t.K = PLE; t.N = D; t.k0 = 64 * (r / nb); t.n0 = 32 * (r % nb); t.drow = t.n0; return t; } r -= I_PLE;
        if (r < 65 * I_W2) { const int e = r / I_W2, q = r % I_W2, nb = D / 32; t.W = (e < 64) ? P.ew2 + (size_t)e * EF * D : P.sw2; t.f8 = F8DN ? 1 : 0;
            t.WT = W2 + (size_t)e * D * EF * (F8DN ? 1 : 2); t.K = EF; t.N = D; t.k0 = 64 * (q / nb); t.n0 = 32 * (q % nb); t.drow = t.n0; return t; } r -= 65 * I_W2;
        { const int e = r / (2 * I_W13), q2 = r % (2 * I_W13), mth = q2 / I_W13, q = q2 % I_W13, nb = EF / 32; const int n0 = 32 * (q % nb);
          t.W = (e < 64) ? (mth ? P.ew3 : P.ew1) + (size_t)e * D * EF : (mth ? P.sw3 : P.sw1); t.f8 = F8 ? 1 : 0;
          t.WT = W13 + (size_t)e * 1024 * D * (F8 ? 1 : 2); t.K = D; t.N = EF; t.k0 = 64 * (q / nb); t.n0 = n0; t.drow = 256 * (n0 >> 7) + 128 * mth + (n0 & 127); return t; } };
    for (int it = gw; it < NITEMS; it += 2 * NGW) {
        const TItem t0 = decode(it); const bool two = it + NGW < NITEMS; const TItem t1 = decode(two ? it + NGW : it);
        float4 v0[8], v1[8];
        ti_load(t0, v0, lane); if (two) ti_load(t1, v1, lane);
        ti_store(t0, v0, scr0, lane); if (two) ti_store(t1, v1, scr1, lane);
    }
    for (int i = gw * 64 + lane; i < 8 * 128 * 64; i += NGW * 64) { const int hh = i >> 13, jj = (i >> 6) & 127, ii = i & 63;
        P.lru_wg[i] = f2bf((jj < 64) ? P.lwa[(hh * 64 + ii) * 64 + jj] : P.lwx[(hh * 64 + ii) * 64 + jj - 64]); }
    for (int i = gw * 64 + lane; i < (256 - NE) * D * 2 / 16; i += NGW * 64) ((u32x4*)(ROUT + (size_t)NE * D))[i] = (u32x4){0u, 0u, 0u, 0u};
}
__device__ __forceinline__ void convert_rows(const float* src, bf16_t* dst, size_t n, size_t gtid, size_t nthr) {
    for (size_t i = gtid * 8; i < n; i += nthr * 32) {
        float4 a[4], b[4];
#pragma unroll
        for (int r = 0; r < 4; ++r) { a[r] = *(const float4*)(src + i + r * nthr * 8); b[r] = *(const float4*)(src + i + r * nthr * 8 + 4); }
#pragma unroll
        for (int r = 0; r < 4; ++r) { u32x4 o; o.x = cvt_pk_bf16(a[r].x, a[r].y); o.y = cvt_pk_bf16(a[r].z, a[r].w); o.z = cvt_pk_bf16(b[r].x, b[r].y); o.w = cvt_pk_bf16(b[r].z, b[r].w); *(u32x4*)(dst + i + r * nthr * 8) = o; }
    }
}

__device__ __forceinline__ void acc8(float (&v)[8], const u32x4 a) { v[0] += bflo(a.x); v[1] += bfhi(a.x); v[2] += bflo(a.y); v[3] += bfhi(a.y); v[4] += bflo(a.z); v[5] += bfhi(a.z); v[6] += bflo(a.w); v[7] += bfhi(a.w); }
__device__ __forceinline__ void ln_finish(float (&v)[4][8], const float* gain, const float* bias, float* outf, bf16_t* xb, int lane, unsigned char* x8 = nullptr) {
    float s = 0.f;
#pragma unroll
    for (int j = 0; j < 4; ++j)
#pragma unroll
        for (int e = 0; e < 8; ++e) s += v[j][e];
    const float mean = wave_sum(s) * (1.f / D); float q = 0.f;
#pragma unroll
    for (int j = 0; j < 4; ++j)
#pragma unroll
        for (int e = 0; e < 8; ++e) { v[j][e] -= mean; q += v[j][e] * v[j][e]; }
    const float rstd = rsqf_(wave_sum(q) * (1.f / D) + 1e-5f);
#pragma unroll
    for (int j = 0; j < 4; ++j) { const int c0 = 8 * (lane + 64 * j); const float4 g0 = *(const float4*)(gain + c0), g1 = *(const float4*)(gain + c0 + 4), b0 = *(const float4*)(bias + c0), b1 = *(const float4*)(bias + c0 + 4);
        float4 o0, o1; o0.x = v[j][0] * rstd * g0.x + b0.x; o0.y = v[j][1] * rstd * g0.y + b0.y; o0.z = v[j][2] * rstd * g0.z + b0.z; o0.w = v[j][3] * rstd * g0.w + b0.w;
        o1.x = v[j][4] * rstd * g1.x + b1.x; o1.y = v[j][5] * rstd * g1.y + b1.y; o1.z = v[j][6] * rstd * g1.z + b1.z; o1.w = v[j][7] * rstd * g1.w + b1.w;
        if (outf) { *(float4*)(outf + c0) = o0; *(float4*)(outf + c0 + 4) = o1; }
        if (xb) { u32x4 w; w.x = cvt_pk_bf16(o0.x, o0.y); w.y = cvt_pk_bf16(o0.z, o0.w); w.z = cvt_pk_bf16(o1.x, o1.y); w.w = cvt_pk_bf16(o1.z, o1.w); *(u32x4*)(xb + c0) = w; }
        if (x8) { u32x2 w; w.x = cvt4_fp8(o0.x, o0.y, o0.z, o0.w); w.y = cvt4_fp8(o1.x, o1.y, o1.z, o1.w); *(u32x2*)(x8 + c0) = w; } }
}
__device__ __forceinline__ void ln1_rows2(const bf16_t* z0, const bf16_t* z1, const float* gain, const float* bias, bf16_t* xb0, bf16_t* xb1, int lane, unsigned char* x80 = nullptr, unsigned char* x81 = nullptr) {
    u32x4 a[2][4], x[2][4];
#pragma unroll
    for (int j = 0; j < 4; ++j) { a[0][j] = *(const u32x4*)(z0 + 8 * (lane + 64 * j)); a[1][j] = *(const u32x4*)(z1 + 8 * (lane + 64 * j)); x[0][j] = *(const u32x4*)(xb0 + 8 * (lane + 64 * j)); x[1][j] = *(const u32x4*)(xb1 + 8 * (lane + 64 * j)); }
#pragma unroll
    for (int r = 0; r < 2; ++r) { float v[4][8];
#pragma unroll
        for (int j = 0; j < 4; ++j) {
#pragma unroll
            for (int e = 0; e < 8; ++e) v[j][e] = 0.f;
            acc8(v[j], x[r][j]);
#pragma unroll
            for (int e = 0; e < 8; ++e) v[j][e] *= ALPHA;
            acc8(v[j], a[r][j]); }
        ln_finish(v, gain, bias, nullptr, r ? xb1 : xb0, lane, r ? x81 : x80); }
}
__device__ __forceinline__ void ln2_row(const bf16_t* x1, const float* gain, const float* bias, float* outf, bf16_t* xb, const bf16_t* yrows, const bf16_t* yp, const bf16_t* ysh, int lane) {
    u32x4 a[3][4], y[8][4];
#pragma unroll
    for (int j = 0; j < 4; ++j) { const int c0 = 8 * (lane + 64 * j); a[0][j] = *(const u32x4*)(x1 + c0); a[1][j] = *(const u32x4*)(yp + c0); a[2][j] = *(const u32x4*)(ysh + c0); }
#pragma unroll
    for (int k = 0; k < TOPK; ++k)
#pragma unroll
        for (int j = 0; j < 4; ++j) y[k][j] = *(const u32x4*)(yrows + (size_t)k * D + 8 * (lane + 64 * j));
    float v[4][8];
#pragma unroll
    for (int j = 0; j < 4; ++j) {
#pragma unroll
        for (int e = 0; e < 8; ++e) v[j][e] = 0.f;
        acc8(v[j], a[0][j]);
#pragma unroll
        for (int e = 0; e < 8; ++e) v[j][e] *= ALPHA;
        acc8(v[j], a[1][j]); acc8(v[j], a[2][j]);
#pragma unroll
        for (int k = 0; k < TOPK; ++k) acc8(v[j], y[k][j]); }
    ln_finish(v, gain, bias, outf, xb, lane);
}
__device__ __forceinline__ void acc16_fp8(float (&v)[16], const u32x4 a) {
    const unsigned w[4] = {a.x, a.y, a.z, a.w};
#pragma unroll
    for (int i = 0; i < 4; ++i) { typedef float f2_ __attribute__((ext_vector_type(2))); const f2_ lo = __builtin_amdgcn_cvt_pk_f32_fp8((int)w[i], false), hi = __builtin_amdgcn_cvt_pk_f32_fp8((int)w[i], true);
        v[4 * i] += lo[0]; v[4 * i + 1] += lo[1]; v[4 * i + 2] += hi[0]; v[4 * i + 3] += hi[1]; }
}
__device__ __forceinline__ void ln2_row8(const bf16_t* x1, const float* gain, const float* bias, float* outf, bf16_t* xb, const unsigned char* yrows, const unsigned char* yp, const unsigned char* ysh, int lane_) {
    unsigned lane = (unsigned)lane_; asm volatile("" : "+v"(lane));
    float v[2][16]; float s = 0.f;
#pragma unroll
    for (int j = 0; j < 2; ++j) {
        const unsigned c0 = 16u * (lane + 64u * j);
        u32x4 y[10], xa[2];
        y[0] = *(const u32x4*)(ysh + c0); y[9] = *(const u32x4*)(yp + c0);
#pragma unroll
        for (int k = 0; k < TOPK; ++k) y[1 + k] = *(const u32x4*)(yrows + (size_t)k * D + c0);
        xa[0] = *(const u32x4*)(x1 + c0); xa[1] = *(const u32x4*)(x1 + c0 + 8);
        float e[16];
#pragma unroll
        for (int i = 0; i < 16; ++i) e[i] = 0.f;
#pragma unroll
        for (int k = 0; k < 10; ++k) acc16_fp8(e, y[k]);
#pragma unroll
        for (int hh = 0; hh < 2; ++hh) { float x8[8];
#pragma unroll
            for (int i = 0; i < 8; ++i) x8[i] = 0.f;
            acc8(x8, xa[hh]);
#pragma unroll
            for (int i = 0; i < 8; ++i) { v[j][8 * hh + i] = ALPHA * x8[i] + e[8 * hh + i] * (1.0f / Y8_SCALE); s += v[j][8 * hh + i]; } }
        if (j == 0) asm volatile("" ::: "memory");
    }
    const float mean = wave_sum(s) * (1.f / D); float q = 0.f;
#pragma unroll
    for (int j = 0; j < 2; ++j)
#pragma unroll
        for (int i = 0; i < 16; ++i) { v[j][i] -= mean; q += v[j][i] * v[j][i]; }
    const float rstd = rsqf_(wave_sum(q) * (1.f / D) + 1e-5f);
#pragma unroll
    for (int j = 0; j < 2; ++j) { const unsigned c0 = 16u * (lane + 64u * j); float o[16];
#pragma unroll
        for (int i4 = 0; i4 < 4; ++i4) { const float4 g = *(const float4*)(gain + c0 + 4 * i4), b = *(const float4*)(bias + c0 + 4 * i4);
            o[4 * i4] = v[j][4 * i4] * rstd * g.x + b.x; o[4 * i4 + 1] = v[j][4 * i4 + 1] * rstd * g.y + b.y; o[4 * i4 + 2] = v[j][4 * i4 + 2] * rstd * g.z + b.z; o[4 * i4 + 3] = v[j][4 * i4 + 3] * rstd * g.w + b.w;
            if (outf) *(float4*)(outf + c0 + 4 * i4) = make_float4(o[4 * i4], o[4 * i4 + 1], o[4 * i4 + 2], o[4 * i4 + 3]); }
        if (xb) { u32x4 w0, w1; w0.x = cvt_pk_bf16(o[0], o[1]); w0.y = cvt_pk_bf16(o[2], o[3]); w0.z = cvt_pk_bf16(o[4], o[5]); w0.w = cvt_pk_bf16(o[6], o[7]);
            w1.x = cvt_pk_bf16(o[8], o[9]); w1.y = cvt_pk_bf16(o[10], o[11]); w1.z = cvt_pk_bf16(o[12], o[13]); w1.w = cvt_pk_bf16(o[14], o[15]); *(u32x4*)(xb + c0) = w0; *(u32x4*)(xb + c0 + 8) = w1; } }
}
constexpr int AT_KS = 72, AT_VS = 264, AT_PS = 168;
constexpr int AT_LDS_K = 0, AT_LDS_V = 256 * AT_KS * 2, AT_LDS_P = AT_LDS_V + (64 * AT_VS + 64) * 2, AT_LDS_SS = AT_LDS_P + 8 * 16 * AT_PS * 2, AT_LDS_CS = AT_LDS_SS + 8 * 128 * 4, AT_LDS_BYTES = AT_LDS_CS + 128 * 16 * 4;
static_assert(AT_LDS_BYTES <= RING_BYTES, "attention LDS");
struct RotTab { double invf[8]; };
__device__ __forceinline__ void attn_unit(const int wv, unsigned char* lds, int u, const bf16_t* HIN, const int* positions, const float* sinks, bf16_t* MIX, float* SSQ, const RotTab& rt) {
    bf16_t* Ks = (bf16_t*)(lds + AT_LDS_K); bf16_t* Vt = (bf16_t*)(lds + AT_LDS_V); bf16_t* Ps = (bf16_t*)(lds + AT_LDS_P); float* SS = (float*)(lds + AT_LDS_SS); float* CS = (float*)(lds + AT_LDS_CS);
    const int g = u & 1, n = (u >> 1) & 31, b = u >> 6;
    const int tid = opaque_tid(wv), lane = tid & 63, w = tid >> 6;
    __syncthreads();
    {
        const int j = tid >> 1, half = tid & 1; const int kp = 128 * (n - 1) + j;
        u32x4 kv[4], vv[4];
        if (kp >= 0) {
            const bf16_t* kr = HIN + (size_t)(b * SEQ + kp) * IN_COLS + C_AK + g * 64 + half * 32;
            const bf16_t* vr = HIN + (size_t)(b * SEQ + kp) * IN_COLS + C_AV + g * 64 + half * 32;
#pragma unroll
            for (int i = 0; i < 4; ++i) { kv[i] = *(const u32x4*)(kr + 8 * i); vv[i] = *(const u32x4*)(vr + 8 * i); }
            if (half == 0) {
                const float pos = (float)positions[b * SEQ + kp];
                float t1[8], t2[8];
                t1[0] = bflo(kv[0].x); t1[1] = bfhi(kv[0].x); t1[2] = bflo(kv[0].y); t1[3] = bfhi(kv[0].y); t1[4] = bflo(kv[0].z); t1[5] = bfhi(kv[0].z); t1[6] = bflo(kv[0].w); t1[7] = bfhi(kv[0].w);
                t2[0] = bflo(kv[1].x); t2[1] = bfhi(kv[1].x); t2[2] = bflo(kv[1].y); t2[3] = bfhi(kv[1].y); t2[4] = bflo(kv[1].z); t2[5] = bfhi(kv[1].z); t2[6] = bflo(kv[1].w); t2[7] = bfhi(kv[1].w);
#pragma unroll
                for (int i = 0; i < 8; ++i) { float sn, cs; sincos_pos(pos, rt.invf[i], sn, cs); const float a = t1[i] * cs - t2[i] * sn, bb = t2[i] * cs + t1[i] * sn; t1[i] = a; t2[i] = bb;
                    if (j >= 128) { CS[(j - 128) * 16 + i] = cs; CS[(j - 128) * 16 + 8 + i] = sn; } }
                kv[0].x = cvt_pk_bf16(t1[0], t1[1]); kv[0].y = cvt_pk_bf16(t1[2], t1[3]); kv[0].z = cvt_pk_bf16(t1[4], t1[5]); kv[0].w = cvt_pk_bf16(t1[6], t1[7]);
                kv[1].x = cvt_pk_bf16(t2[0], t2[1]); kv[1].y = cvt_pk_bf16(t2[2], t2[3]); kv[1].z = cvt_pk_bf16(t2[4], t2[5]); kv[1].w = cvt_pk_bf16(t2[6], t2[7]);
            }
        } else {
#pragma unroll
            for (int i = 0; i < 4; ++i) { kv[i] = (u32x4){0u, 0u, 0u, 0u}; vv[i] = (u32x4){0u, 0u, 0u, 0u}; }
        }
#pragma unroll
        for (int i = 0; i < 4; ++i) *(u32x4*)(Ks + j * AT_KS + half * 32 + 8 * i) = kv[i];
#pragma unroll
        for (int i = 0; i < 4; ++i) { const int d = half * 32 + 8 * i;
            Vt[(d + 0) * AT_VS + j] = (bf16_t)(vv[i].x & 0xffff); Vt[(d + 1) * AT_VS + j] = (bf16_t)(vv[i].x >> 16); Vt[(d + 2) * AT_VS + j] = (bf16_t)(vv[i].y & 0xffff); Vt[(d + 3) * AT_VS + j] = (bf16_t)(vv[i].y >> 16);
            Vt[(d + 4) * AT_VS + j] = (bf16_t)(vv[i].z & 0xffff); Vt[(d + 5) * AT_VS + j] = (bf16_t)(vv[i].z >> 16); Vt[(d + 6) * AT_VS + j] = (bf16_t)(vv[i].w & 0xffff); Vt[(d + 7) * AT_VS + j] = (bf16_t)(vv[i].w >> 16); }
        if (tid < 64) {
#pragma unroll
            for (int i = 0; i < 8; ++i) Vt[tid * AT_VS + 256 + i] = 0;
            Vt[64 * AT_VS + tid] = 0;
        }
        for (int i = tid; i < 8 * 16 * 24; i += NTHR) { const int r = i / 24, c = 144 + i % 24; Ps[r * AT_PS + c] = 0; }
    }
    __syncthreads();
    const int hq = g * 8 + w;
    constexpr float LOG2E = 1.4426950408889634f, C2 = 0.125f * LOG2E;
    const float sink2 = sinks[hq] * LOG2E;
    const int lr = lane & 15, lg = lane >> 4;
    bf16_t* Pw = Ps + w * 16 * AT_PS;
    const bf16_t* qbase = HIN + (size_t)(b * SEQ + n * 128 + lr) * IN_COLS + C_AQ + hq * 64 + lg * 8;
    u32x4 nq0 = *(const u32x4*)qbase, nq1 = *(const u32x4*)(qbase + 32);
    for (int qi = 0; qi < 8; ++qi) {
        const int tq = b * SEQ + n * 128 + qi * 16 + lr;
        u32x4 q0 = nq0; const u32x4 q1 = nq1;
        if (qi < 7) { const bf16_t* qn = qbase + (size_t)(qi + 1) * 16 * IN_COLS; nq0 = *(const u32x4*)qn; nq1 = *(const u32x4*)(qn + 32); }
        {
            u32x4 other; other.x = __shfl_xor(q0.x, 16); other.y = __shfl_xor(q0.y, 16); other.z = __shfl_xor(q0.z, 16); other.w = __shfl_xor(q0.w, 16);
            if (lg < 2) {
                const float4 c0 = *(const float4*)(CS + (qi * 16 + lr) * 16), c1 = *(const float4*)(CS + (qi * 16 + lr) * 16 + 4), s0 = *(const float4*)(CS + (qi * 16 + lr) * 16 + 8), s1 = *(const float4*)(CS + (qi * 16 + lr) * 16 + 12);
                const float cs[8] = {c0.x, c0.y, c0.z, c0.w, c1.x, c1.y, c1.z, c1.w}; const float sn[8] = {s0.x, s0.y, s0.z, s0.w, s1.x, s1.y, s1.z, s1.w};
                float mv[8], ov[8];
                mv[0] = bflo(q0.x); mv[1] = bfhi(q0.x); mv[2] = bflo(q0.y); mv[3] = bfhi(q0.y); mv[4] = bflo(q0.z); mv[5] = bfhi(q0.z); mv[6] = bflo(q0.w); mv[7] = bfhi(q0.w);
                ov[0] = bflo(other.x); ov[1] = bfhi(other.x); ov[2] = bflo(other.y); ov[3] = bfhi(other.y); ov[4] = bflo(other.z); ov[5] = bfhi(other.z); ov[6] = bflo(other.w); ov[7] = bfhi(other.w);
                const float sg = (lg == 0) ? -1.f : 1.f;
#pragma unroll
                for (int i = 0; i < 8; ++i) mv[i] = mv[i] * cs[i] + sg * ov[i] * sn[i];
                q0.x = cvt_pk_bf16(mv[0], mv[1]); q0.y = cvt_pk_bf16(mv[2], mv[3]); q0.z = cvt_pk_bf16(mv[4], mv[5]); q0.w = cvt_pk_bf16(mv[6], mv[7]);
            }
        }
        const bf16x8 qa0 = __builtin_bit_cast(bf16x8, q0), qa1 = __builtin_bit_cast(bf16x8, q1);
        f32x4 s[9];
#pragma unroll
        for (int jt = 0; jt < 9; ++jt) {
            const int jr = (qi + jt) * 16 + lr;
            const bf16x8 kb0 = *(const bf16x8*)(Ks + jr * AT_KS + lg * 8), kb1 = *(const bf16x8*)(Ks + jr * AT_KS + 32 + lg * 8);
            f32x4 a = (f32x4){0.f, 0.f, 0.f, 0.f};
            a = __builtin_amdgcn_mfma_f32_16x16x32_bf16(kb0, qa0, a, 0, 0, 0);
            a = __builtin_amdgcn_mfma_f32_16x16x32_bf16(kb1, qa1, a, 0, 0, 0);
            s[jt] = a;
        }
#pragma unroll
        for (int r = 0; r < 4; ++r) { if (!(4 * lg + r > lr)) s[0][r] = -3.0e38f; if (!(4 * lg + r <= lr)) s[8][r] = -3.0e38f; }
        if (n == 0) {
#pragma unroll
            for (int jt = 0; jt < 8; ++jt) if (qi + jt < 8) s[jt] = (f32x4){-3.0e38f, -3.0e38f, -3.0e38f, -3.0e38f};
        }
        float m = -3.0e38f;
#pragma unroll
        for (int jt = 0; jt < 9; ++jt) m = fmaxf(fmaxf(m, fmaxf(s[jt][0], s[jt][1])), fmaxf(s[jt][2], s[jt][3]));
        m = fmaxf(m, __shfl_xor(m, 16)); m = fmaxf(m, __shfl_xor(m, 32));
        const float m2 = fmaxf(m * C2, sink2);
        float sum = 0.f;
#pragma unroll
        for (int jt = 0; jt < 9; ++jt) {
            f32x4 p;
#pragma unroll
            for (int r = 0; r < 4; ++r) { p[r] = __builtin_amdgcn_exp2f(fmaf(s[jt][r], C2, -m2)); sum += p[r]; }
            u32x2 pk; pk.x = cvt_pk_bf16(p[0], p[1]); pk.y = cvt_pk_bf16(p[2], p[3]);
            *(u32x2*)(Pw + lr * AT_PS + jt * 16 + 4 * lg) = pk;
        }
        sum += __shfl_xor(sum, 16); sum += __shfl_xor(sum, 32);
        const float inv = rcpf_(sum + __builtin_amdgcn_exp2f(sink2 - m2));
        asm volatile("s_waitcnt lgkmcnt(0)" ::: "memory");
        f32x4 o[4];
#pragma unroll
        for (int dt = 0; dt < 4; ++dt) o[dt] = (f32x4){0.f, 0.f, 0.f, 0.f};
#pragma unroll
        for (int ks = 0; ks < 5; ++ks) {
            const bf16x8 pa = *(const bf16x8*)(Pw + lr * AT_PS + ks * 32 + lg * 8);
#pragma unroll
            for (int dt = 0; dt < 4; ++dt) { const bf16x8 vb = *(const bf16x8*)(Vt + (dt * 16 + lr) * AT_VS + qi * 16 + ks * 32 + lg * 8); o[dt] = __builtin_amdgcn_mfma_f32_16x16x32_bf16(vb, pa, o[dt], 0, 0, 0); }
        }
        float q = 0.f;
        bf16_t* orow = MIX + (size_t)tq * D + hq * 64 + 4 * lg;
#pragma unroll
        for (int dt = 0; dt < 4; ++dt) { const f32x4 v = o[dt] * inv; q += (v[0] * v[0] + v[1] * v[1]) + (v[2] * v[2] + v[3] * v[3]);
            u32x2 pk; pk.x = cvt_pk_bf16(v[0], v[1]); pk.y = cvt_pk_bf16(v[2], v[3]); *(u32x2*)(orow + dt * 16) = pk; }
        q += __shfl_xor(q, 16); q += __shfl_xor(q, 32);
        if (lg == 0) SS[w * 128 + qi * 16 + lr] = q;
    }
    __syncthreads();
    if (tid < 128) { float q = 0.f;
#pragma unroll
        for (int ww = 0; ww < 8; ++ww) q += SS[ww * 128 + tid];
        SSQ[(size_t)(b * SEQ + n * 128 + tid) * 2 + g] = q; }
}
__device__ __forceinline__ void attn_fin_rows4(bf16_t* MIX, const float* SSQ, const float* gain, int t, int lane) {
    u32x4 v[4][2]; float sc[4];
#pragma unroll
    for (int r = 0; r < 4; ++r) { const u32x4* p = (const u32x4*)(MIX + (size_t)(t + r) * D) + lane * 2; v[r][0] = p[0]; v[r][1] = p[1]; sc[r] = rsqf_((SSQ[(size_t)(t + r) * 2] + SSQ[(size_t)(t + r) * 2 + 1]) * (1.0f / 1024.f) + 1e-6f); }
    const int c = lane * 16; const float4 g0 = *(const float4*)(gain + c), g1 = *(const float4*)(gain + c + 4), g2 = *(const float4*)(gain + c + 8), g3 = *(const float4*)(gain + c + 12);
#pragma unroll
    for (int r = 0; r < 4; ++r) { u32x4 a = v[r][0], b = v[r][1]; const float s = sc[r];
        a.x = cvt_pk_bf16(bflo(a.x) * s * g0.x, bfhi(a.x) * s * g0.y); a.y = cvt_pk_bf16(bflo(a.y) * s * g0.z, bfhi(a.y) * s * g0.w); a.z = cvt_pk_bf16(bflo(a.z) * s * g1.x, bfhi(a.z) * s * g1.y); a.w = cvt_pk_bf16(bflo(a.w) * s * g1.z, bfhi(a.w) * s * g1.w);
        b.x = cvt_pk_bf16(bflo(b.x) * s * g2.x, bfhi(b.x) * s * g2.y); b.y = cvt_pk_bf16(bflo(b.y) * s * g2.z, bfhi(b.y) * s * g2.w); b.z = cvt_pk_bf16(bflo(b.z) * s * g3.x, bfhi(b.z) * s * g3.y); b.w = cvt_pk_bf16(bflo(b.w) * s * g3.z, bfhi(b.w) * s * g3.w);
        u32x4* p = (u32x4*)(MIX + (size_t)(t + r) * D) + lane * 2; p[0] = a; p[1] = b; }
}

constexpr int HG_S72 = 72, HG_S136 = 136;
__device__ __forceinline__ float hg_lb(const float* lbl, int layer, int col) { if (layer == 0) return 0.f; return sigmoidf_(lbl[512 + col] - lbl[col]); }
constexpr int H1_LDS_KT = 0, H1_LDS_VT = 128 * HG_S72 * 2, H1_LDS_TOT = 2 * 128 * HG_S72 * 2, H1_LDS_BYTES = H1_LDS_TOT + 4 * 128 * 4;
__device__ __forceinline__ void hg1_unit(const int wv, unsigned char* lds, int u, const bf16_t* HIN, const float* lbl, int layer, bf16_t* SST, float* DV) {
    bf16_t* KT = (bf16_t*)(lds + H1_LDS_KT); bf16_t* VT = (bf16_t*)(lds + H1_LDS_VT); float* TOT = (float*)(lds + H1_LDS_TOT);
    const int c = u & 63, h = (u >> 6) & 3, b = u >> 8;
    const int tid = opaque_tid(wv), lane = tid & 63, w = tid >> 6, k = tid & 127, tq = tid >> 7;
    const size_t t0 = (size_t)b * SEQ + c * 64;
    const float lb = hg_lb(lbl, layer, h * 128 + k);
    __syncthreads();
    float bl[16], kf[16]; float cum = 0.f;
#pragma unroll
    for (int i = 0; i < 16; ++i) { const size_t row = (t0 + 16 * tq + i) * IN_COLS; const float fp = bf2f(HIN[row + C_HF + h * 128 + k]);
        const float sg = sigmoidf_(fp); const float f = lb + (1.f - lb) * sg; cum += __logf(fmaxf(f, 1e-30f)); bl[i] = cum; kf[i] = (1.f - lb) * (1.f - sg);
        VT[k * HG_S72 + 16 * tq + i] = HIN[row + C_HI + h * 128 + k]; }
    TOT[tq * 128 + k] = cum;
    __syncthreads();
    float pre = 0.f, total = 0.f;
#pragma unroll
    for (int j = 0; j < 4; ++j) { const float tj = TOT[j * 128 + k]; if (j < tq) pre += tj; total += tj; }
#pragma unroll
    for (int i = 0; i < 16; ++i) KT[k * HG_S72 + 16 * tq + i] = f2bf_hw(kf[i] * __expf(total - (pre + bl[i])));
    if (tq == 0) DV[(size_t)u * 128 + k] = __expf(total);
    __syncthreads();
    const int lr = lane & 15, lg = lane >> 4;
    bf16x8 a[2];
#pragma unroll
    for (int ks = 0; ks < 2; ++ks) a[ks] = *(const bf16x8*)(VT + (w * 16 + lr) * HG_S72 + ks * 32 + lg * 8);
    bf16_t* out = SST + (size_t)u * 16384;
#pragma unroll
    for (int kt = 0; kt < 8; ++kt) {
        f32x4 acc = (f32x4){0.f, 0.f, 0.f, 0.f};
#pragma unroll
        for (int ks = 0; ks < 2; ++ks) { const bf16x8 bb = *(const bf16x8*)(KT + (kt * 16 + lr) * HG_S72 + ks * 32 + lg * 8); acc = __builtin_amdgcn_mfma_f32_16x16x32_bf16(bb, a[ks], acc, 0, 0, 0); }
        { u32x2 pk; pk.x = pk2(acc[0], acc[1]); pk.y = pk2(acc[2], acc[3]); *(u32x2*)(out + (w * 16 + lr) * 128 + kt * 16 + 4 * lg) = pk; }
    }
}
__device__ __forceinline__ void hg2_unit(const int wv, int u, const bf16_t* SST, const float* DV, bf16_t* SPREV) {
    const int bh = u >> 3, part = u & 7, e4 = part * 512 + opaque_tid(wv);
    const int k4 = (e4 & 31) * 4;
    float4 S = make_float4(0.f, 0.f, 0.f, 0.f);
    for (int c0 = 0; c0 < 64; c0 += 4) {
        u32x2 ds[4]; float4 dv[4];
#pragma unroll
        for (int i = 0; i < 4; ++i) { const size_t uu = (size_t)bh * 64 + c0 + i; ds[i] = *((const u32x2*)(SST + uu * 16384) + e4); dv[i] = *(const float4*)(DV + uu * 128 + k4); }
#pragma unroll
        for (int i = 0; i < 4; ++i) { const size_t uu = (size_t)bh * 64 + c0 + i; u32x2 o; o.x = cvt_pk_bf16(S.x, S.y); o.y = cvt_pk_bf16(S.z, S.w); *((u32x2*)(SPREV + uu * 16384) + e4) = o;
            S.x = dv[i].x * S.x + bflo(ds[i].x); S.y = dv[i].y * S.y + bfhi(ds[i].x); S.z = dv[i].z * S.z + bflo(ds[i].y); S.w = dv[i].w * S.w + bfhi(ds[i].y); }
    }
}
constexpr int H3_QI = 0, H3_QE = H3_QI + 64 * HG_S136 * 2, H3_KI = H3_QE + 64 * HG_S136 * 2, H3_VT = H3_KI + 160 * HG_S136 * 2, H3_SB = H3_VT + 128 * HG_S72 * 2,
              H3_SC = H3_SB + 128 * HG_S136 * 2, H3_TOT = H3_SC + 64 * HG_S72 * 2, H3_LDS_BYTES = H3_TOT + 4 * 128 * 4;
constexpr int H3_OB = H3_KI, HG_OS = 132;
static_assert(H3_LDS_BYTES <= MISC_OFF, "HGRN2 LDS");
__device__ __forceinline__ void hg3_unit(const int wv, unsigned char* lds, int u, const bf16_t* HIN, const float* lbl, int layer, const bf16_t* SST, const float* gain, bf16_t* MIX) {
    bf16_t* QI = (bf16_t*)(lds + H3_QI); bf16_t* QE = (bf16_t*)(lds + H3_QE); bf16_t* KI = (bf16_t*)(lds + H3_KI); bf16_t* VT = (bf16_t*)(lds + H3_VT);
    bf16_t* SB = (bf16_t*)(lds + H3_SB); bf16_t* SC = (bf16_t*)(lds + H3_SC); float* TOT = (float*)(lds + H3_TOT); float* OB = (float*)(lds + H3_OB);
    const int c = u & 63, h = (u >> 6) & 3, b = u >> 8;
    const int tid = opaque_tid(wv), lane = tid & 63, w = tid >> 6, k = tid & 127, tq = tid >> 7;
    const size_t t0 = (size_t)b * SEQ + c * 64;
    const float lb = hg_lb(lbl, layer, h * 128 + k);
    const u32x4 g0 = *(const u32x4*)(HIN + (t0 + (tid >> 3)) * IN_COLS + C_HG + h * 128 + (tid & 7) * 16), g1 = *(const u32x4*)(HIN + (t0 + (tid >> 3)) * IN_COLS + C_HG + h * 128 + (tid & 7) * 16 + 8);
    __syncthreads();
    float bl[16], kf[16], qf[16]; float cum = 0.f;
#pragma unroll
    for (int i = 0; i < 16; ++i) { const size_t row = (t0 + 16 * tq + i) * IN_COLS; const float fp = bf2f(HIN[row + C_HF + h * 128 + k]);
        const float sg = sigmoidf_(fp); const float f = lb + (1.f - lb) * sg; cum += __logf(fmaxf(f, 1e-30f)); bl[i] = cum; kf[i] = (1.f - lb) * (1.f - sg);
        qf[i] = siluf_(bf2f(HIN[row + C_HQ + h * 128 + k]));
        VT[k * HG_S72 + 16 * tq + i] = HIN[row + C_HI + h * 128 + k]; }
    TOT[tq * 128 + k] = cum;
    { const u32x4* sp = (const u32x4*)(SST + (size_t)u * 16384);
#pragma unroll
      for (int i = 0; i < 4; ++i) { const int e8 = tid + 512 * i; const u32x4 s8 = sp[e8]; const int v = e8 >> 4, k8 = (e8 & 15) * 8; *(u32x4*)(SB + v * HG_S136 + k8) = s8; } }
    for (int i = tid; i < 64 * HG_S72 / 2; i += NTHR) ((unsigned*)SC)[i] = 0u;
    __syncthreads();
    float rs[4]; { float acc = 0.f;
#pragma unroll
        for (int j = 0; j < 4; ++j) { rs[j] = acc; acc += TOT[j * 128 + k]; } }
    float pre = 0.f;
#pragma unroll
    for (int j = 0; j < 4; ++j) pre = (j == tq) ? rs[j] : pre;
    const float epre = __expf(pre);
    float fk[4];
#pragma unroll
    for (int ii = 0; ii < 4; ++ii) fk[ii] = __expf(fminf(rs[ii] - pre, 0.f));
#pragma unroll
    for (int i = 0; i < 16; ++i) {
        const int s = 16 * tq + i; const float e1 = fmaxf(__expf(bl[i]), 1e-30f), inv = rcpf_(e1);
        const float qi = qf[i] * e1, ki = kf[i] * inv;
        QI[s * HG_S136 + k] = f2bf_hw(qi);
        QE[s * HG_S136 + k] = f2bf_hw(qi * epre);
#pragma unroll
        for (int ii = 0; ii < 4; ++ii) if (ii >= tq) KI[((ii == 0 ? 0 : ii == 1 ? 16 : ii == 2 ? 48 : 96) + s) * HG_S136 + k] = f2bf_hw(ki * fk[ii]);
    }
    __syncthreads();
    const int lr = lane & 15, lg = lane >> 4;
    for (int tix = w; tix < 10; tix += 8) {
        int i, j; if (tix == 0) { i = 0; j = 0; } else if (tix < 3) { i = 1; j = tix - 1; } else if (tix < 6) { i = 2; j = tix - 3; } else { i = 3; j = tix - 6; }
        const int kb = (i == 0 ? 0 : i == 1 ? 16 : i == 2 ? 48 : 96);
        f32x4 acc = (f32x4){0.f, 0.f, 0.f, 0.f};
#pragma unroll
        for (int ks = 0; ks < 4; ++ks) { const bf16x8 a = *(const bf16x8*)(QI + (16 * i + lr) * HG_S136 + ks * 32 + lg * 8); const bf16x8 bb = *(const bf16x8*)(KI + (kb + 16 * j + lr) * HG_S136 + ks * 32 + lg * 8);
            acc = __builtin_amdgcn_mfma_f32_16x16x32_bf16(a, bb, acc, 0, 0, 0); }
#pragma unroll
        for (int r = 0; r < 4; ++r) { const int tr = 4 * lg + r; const float v = (i == j && lr > tr) ? 0.f : acc[r]; SC[(16 * i + tr) * HG_S72 + 16 * j + lr] = f2bf_hw(v); }
    }
    __syncthreads();
    f32x4 o[4];
#pragma unroll
    for (int tt = 0; tt < 4; ++tt) o[tt] = (f32x4){0.f, 0.f, 0.f, 0.f};
#pragma unroll
    for (int ks = 0; ks < 2; ++ks) { const bf16x8 vb = *(const bf16x8*)(VT + (w * 16 + lr) * HG_S72 + ks * 32 + lg * 8);
#pragma unroll
        for (int tt = 0; tt < 4; ++tt) { const bf16x8 a = *(const bf16x8*)(SC + (16 * tt + lr) * HG_S72 + ks * 32 + lg * 8); o[tt] = __builtin_amdgcn_mfma_f32_16x16x32_bf16(a, vb, o[tt], 0, 0, 0); } }
#pragma unroll
    for (int ks = 0; ks < 4; ++ks) { const bf16x8 sb = *(const bf16x8*)(SB + (w * 16 + lr) * HG_S136 + ks * 32 + lg * 8);
#pragma unroll
        for (int tt = 0; tt < 4; ++tt) { const bf16x8 a = *(const bf16x8*)(QE + (16 * tt + lr) * HG_S136 + ks * 32 + lg * 8); o[tt] = __builtin_amdgcn_mfma_f32_16x16x32_bf16(a, sb, o[tt], 0, 0, 0); } }
#pragma unroll
    for (int tt = 0; tt < 4; ++tt)
#pragma unroll
        for (int r = 0; r < 4; ++r) OB[(16 * tt + 4 * lg + r) * HG_OS + w * 16 + lr] = o[tt][r];
    __syncthreads();
    { const int t = tid >> 3, vg = tid & 7; float ov[16]; float q = 0.f;
#pragma unroll
      for (int i = 0; i < 4; ++i) { const float4 x = *(const float4*)(OB + t * HG_OS + vg * 16 + 4 * i); ov[4 * i] = x.x; ov[4 * i + 1] = x.y; ov[4 * i + 2] = x.z; ov[4 * i + 3] = x.w; q += (x.x * x.x + x.y * x.y) + (x.z * x.z + x.w * x.w); }
      q += __shfl_xor(q, 1); q += __shfl_xor(q, 2); q += __shfl_xor(q, 4);
      const float rinv = rsqf_(q * (1.0f / 128.f) + 1e-6f);
      const size_t row = t0 + t; const float* gn = gain + h * 128 + vg * 16;
      u32x4 o0, o1;
      o0.x = pk2(ov[0] * rinv * gn[0] * siluf_(bflo(g0.x)), ov[1] * rinv * gn[1] * siluf_(bfhi(g0.x))); o0.y = pk2(ov[2] * rinv * gn[2] * siluf_(bflo(g0.y)), ov[3] * rinv * gn[3] * siluf_(bfhi(g0.y)));
      o0.z = pk2(ov[4] * rinv * gn[4] * siluf_(bflo(g0.z)), ov[5] * rinv * gn[5] * siluf_(bfhi(g0.z))); o0.w = pk2(ov[6] * rinv * gn[6] * siluf_(bflo(g0.w)), ov[7] * rinv * gn[7] * siluf_(bfhi(g0.w)));
      o1.x = pk2(ov[8] * rinv * gn[8] * siluf_(bflo(g1.x)), ov[9] * rinv * gn[9] * siluf_(bfhi(g1.x))); o1.y = pk2(ov[10] * rinv * gn[10] * siluf_(bflo(g1.y)), ov[11] * rinv * gn[11] * siluf_(bfhi(g1.y)));
      o1.z = pk2(ov[12] * rinv * gn[12] * siluf_(bflo(g1.z)), ov[13] * rinv * gn[13] * siluf_(bfhi(g1.z))); o1.w = pk2(ov[14] * rinv * gn[14] * siluf_(bflo(g1.w)), ov[15] * rinv * gn[15] * siluf_(bfhi(g1.w)));
      bf16_t* op = MIX + row * D + 1024 + h * 128 + vg * 16; *(u32x4*)op = o0; *(u32x4*)(op + 8) = o1; }
}

constexpr int LRU_LDS_X = 0, LRU_LDS_MS = LCH * 516 * 4, LRU_LDS_BYTES = LRU_LDS_MS + LCH * 4;
static_assert(LRU_LDS_BYTES <= RING_BYTES, "LRU LDS");
struct LruW { const float *conv_w, *conv_b, *wa, *ba, *wx, *bx, *lam, *gain; };
constexpr int LRU_XS = 520;
__device__ __forceinline__ void lru1_unit(const int wv, unsigned char* lds, int u, const bf16_t* HIN, const LruW& W, const bf16_t* WG16, float* AGA, float* AGH, bf16_t* HL, bf16_t* PL) {
    bf16_t* XB16 = (bf16_t*)lds;
    const int ch = u % NLCH, b = u / NLCH;
    const int c = opaque_tid(wv);
    const size_t t0 = (size_t)b * SEQ + ch * LCH;
    {
        const int cg8 = (c & 63) * 8, tg = c >> 6;
        u32x4 xr[7];
#pragma unroll
        for (int i = 0; i < 7; ++i) { const int tt = ch * LCH + 4 * tg - 3 + i;
            xr[i] = (tt >= 0) ? *(const u32x4*)(HIN + ((size_t)b * SEQ + tt) * IN_COLS + C_LX + cg8) : (u32x4){0u, 0u, 0u, 0u}; }
        float4 wq[4][2], bq[2];
#pragma unroll
        for (int j = 0; j < 4; ++j) { wq[j][0] = *(const float4*)(W.conv_w + j * 512 + cg8); wq[j][1] = *(const float4*)(W.conv_w + j * 512 + cg8 + 4); }
        bq[0] = *(const float4*)(W.conv_b + cg8); bq[1] = *(const float4*)(W.conv_b + cg8 + 4);
        __syncthreads();
#pragma unroll
        for (int i = 0; i < 4; ++i) { float o[8];
#pragma unroll
            for (int e = 0; e < 8; ++e) o[e] = (e < 4) ? ((const float*)&bq[0])[e] : ((const float*)&bq[1])[e - 4];
#pragma unroll
            for (int j = 0; j < 4; ++j) { const u32x4 x = xr[i + j]; const float xv[8] = {bflo(x.x), bfhi(x.x), bflo(x.y), bfhi(x.y), bflo(x.z), bfhi(x.z), bflo(x.w), bfhi(x.w)};
#pragma unroll
                for (int e = 0; e < 8; ++e) o[e] += xv[e] * ((e < 4) ? ((const float*)&wq[j][0])[e] : ((const float*)&wq[j][1])[e - 4]); }
            u32x4 pk; pk.x = cvt_pk_bf16(o[0], o[1]); pk.y = cvt_pk_bf16(o[2], o[3]); pk.z = cvt_pk_bf16(o[4], o[5]); pk.w = cvt_pk_bf16(o[6], o[7]);
            *(u32x4*)(XB16 + (4 * tg + i) * LRU_XS + cg8) = pk; }
    }
    __syncthreads();
    const int lane = c & 63, h = wv, lr = lane & 15, lg = lane >> 4;
    f32x4 acc[2][8];
#pragma unroll
    for (int mt = 0; mt < 2; ++mt)
#pragma unroll
        for (int nt = 0; nt < 8; ++nt) acc[mt][nt] = (f32x4){0.f, 0.f, 0.f, 0.f};
#pragma unroll
    for (int ks = 0; ks < 2; ++ks) {
        bf16x8 a[2];
#pragma unroll
        for (int mt = 0; mt < 2; ++mt) a[mt] = *(const bf16x8*)(XB16 + (mt * 16 + lr) * LRU_XS + h * 64 + ks * 32 + lg * 8);
#pragma unroll
        for (int nt = 0; nt < 8; ++nt) { const bf16x8 bw = *(const bf16x8*)(WG16 + ((size_t)(h * 128 + nt * 16 + lr) * 64 + ks * 32 + lg * 8));
#pragma unroll
            for (int mt = 0; mt < 2; ++mt) acc[mt][nt] = __builtin_amdgcn_mfma_f32_16x16x32_bf16(a[mt], bw, acc[mt][nt], 0, 0, 0); }
    }
#pragma unroll
    for (int jt = 0; jt < 4; ++jt) {
        const int cc = h * 64 + jt * 16 + lr;
        const float bav = W.ba[cc], bxv = W.bx[cc]; const float lm = W.lam[cc]; const float sp = (lm > 15.f) ? __expf(-lm) : __logf(1.0f + __expf(-lm));
        float Pin = 1.f, Hin = 0.f;
#pragma unroll
        for (int mt = 0; mt < 2; ++mt) {
            float a[4], uu[4];
#pragma unroll
            for (int r = 0; r < 4; ++r) { const float rg = sigmoidf_(acc[mt][jt][r] + bav), ig = sigmoidf_(acc[mt][4 + jt][r] + bxv); const float la = -8.0f * rg * sp; a[r] = __expf(la);
                const float xcv = bf2f(XB16[(mt * 16 + 4 * lg + r) * LRU_XS + cc]); uu[r] = __builtin_amdgcn_sqrtf(fmaxf(1.0f - a[r] * a[r], 0.f)) * (ig * xcv); }
            float A = a[0], H = uu[0];
#pragma unroll
            for (int r = 1; r < 4; ++r) { H = a[r] * H + uu[r]; A *= a[r]; }
            float Ai = A, Hi = H;
            { const float Ap = __shfl_up(Ai, 16), Hp = __shfl_up(Hi, 16); if (lg >= 1) { Hi = Ai * Hp + Hi; Ai = Ai * Ap; } }
            { const float Ap = __shfl_up(Ai, 32), Hp = __shfl_up(Hi, 32); if (lg >= 2) { Hi = Ai * Hp + Hi; Ai = Ai * Ap; } }
            float Ae = __shfl_up(Ai, 16), He = __shfl_up(Hi, 16); if (lg == 0) { Ae = 1.f; He = 0.f; }
            float hs = Ae * Hin + He, ps = Ae * Pin;
            float h4[4], p4[4];
#pragma unroll
            for (int r = 0; r < 4; ++r) { hs = a[r] * hs + uu[r]; ps *= a[r]; h4[r] = hs; p4[r] = ps; }
            { const size_t o = (((size_t)b * NLCH + ch) * 512 + cc) * LCH + mt * 16 + 4 * lg;
              u32x2 hw, pw; hw.x = cvt_pk_bf16(h4[0], h4[1]); hw.y = cvt_pk_bf16(h4[2], h4[3]); pw.x = cvt_pk_bf16(p4[0], p4[1]); pw.y = cvt_pk_bf16(p4[2], p4[3]);
              *(u32x2*)(HL + o) = hw; *(u32x2*)(PL + o) = pw; }
            const float At = __shfl(Ai, 48 + lr), Ht = __shfl(Hi, 48 + lr);
            Hin = At * Hin + Ht; Pin = At * Pin;
        }
        if (lg == 0) { AGA[((size_t)b * NLCH + ch) * 512 + cc] = Pin; AGH[((size_t)b * NLCH + ch) * 512 + cc] = Hin; }
    }
}
__device__ __forceinline__ void lru_carry_unit(const int wv, int b, const float* AGA, float* AGH) {
    const int c = opaque_tid(wv); float carry = 0.f;
    for (int c0 = 0; c0 < NLCH; c0 += 16) {
        float a[16], hh[16];
#pragma unroll
        for (int i = 0; i < 16; ++i) { const size_t o = ((size_t)b * NLCH + c0 + i) * 512 + c; a[i] = AGA[o]; hh[i] = AGH[o]; }
#pragma unroll
        for (int i = 0; i < 16; ++i) { const size_t o = ((size_t)b * NLCH + c0 + i) * 512 + c; AGH[o] = carry; carry = a[i] * carry + hh[i]; }
    }
}
__device__ __forceinline__ void lru2_unit(const int wv, unsigned char* lds, int u, const bf16_t* HIN, const float* gain, const float* CAR, const bf16_t* HL, const bf16_t* PL, bf16_t* MIX) {
    float* XS = (float*)(lds + LRU_LDS_X);
    constexpr int XP = 516;
    const int ch = u % NLCH, b = u / NLCH;
    const int c = opaque_tid(wv);
    const size_t t0 = (size_t)b * SEQ + ch * LCH;
    const float carry = CAR[((size_t)b * NLCH + ch) * 512 + c];
    u32x4 hq[LCH / 8], pq[LCH / 8];
    { const u32x4* hp = (const u32x4*)(HL + (((size_t)b * NLCH + ch) * 512 + c) * LCH); const u32x4* pp = (const u32x4*)(PL + (((size_t)b * NLCH + ch) * 512 + c) * LCH);
#pragma unroll
      for (int q = 0; q < LCH / 8; ++q) { hq[q] = hp[q]; pq[q] = pp[q]; } }
    const int tb = c >> 4, cg = (c & 15) * 32;
    u32x4 gq[4]; float4 gn[8];
    { const u32x4* gp = (const u32x4*)(HIN + (t0 + tb) * IN_COLS + C_LG + cg);
#pragma unroll
      for (int q = 0; q < 4; ++q) gq[q] = gp[q];
#pragma unroll
      for (int q = 0; q < 8; ++q) gn[q] = *(const float4*)(gain + cg + 4 * q); }
    __syncthreads();
#pragma unroll
    for (int q = 0; q < LCH / 8; ++q) { const u32x4 h = hq[q], p = pq[q];
        XS[(8 * q + 0) * XP + c] = bflo(h.x) + bflo(p.x) * carry; XS[(8 * q + 1) * XP + c] = bfhi(h.x) + bfhi(p.x) * carry; XS[(8 * q + 2) * XP + c] = bflo(h.y) + bflo(p.y) * carry; XS[(8 * q + 3) * XP + c] = bfhi(h.y) + bfhi(p.y) * carry;
        XS[(8 * q + 4) * XP + c] = bflo(h.z) + bflo(p.z) * carry; XS[(8 * q + 5) * XP + c] = bfhi(h.z) + bfhi(p.z) * carry; XS[(8 * q + 6) * XP + c] = bflo(h.w) + bflo(p.w) * carry; XS[(8 * q + 7) * XP + c] = bfhi(h.w) + bfhi(p.w) * carry; }
    __syncthreads();
    float hv[32]; float q2 = 0.f;
#pragma unroll
    for (int q = 0; q < 8; ++q) { const float4 x = *(const float4*)(XS + tb * XP + cg + 4 * q); hv[4 * q] = x.x; hv[4 * q + 1] = x.y; hv[4 * q + 2] = x.z; hv[4 * q + 3] = x.w; q2 += (x.x * x.x + x.y * x.y) + (x.z * x.z + x.w * x.w); }
    q2 += __shfl_xor(q2, 1); q2 += __shfl_xor(q2, 2); q2 += __shfl_xor(q2, 4); q2 += __shfl_xor(q2, 8);
    const float rinv = rsqf_(q2 * (1.0f / 512.f) + 1e-6f);
    bf16_t* op = MIX + (t0 + tb) * D + 1536 + cg;
#pragma unroll
    for (int q = 0; q < 4; ++q) { const u32x4 g = gq[q]; const float4 n0 = gn[2 * q], n1 = gn[2 * q + 1]; u32x4 o;
        o.x = cvt_pk_bf16(hv[8 * q + 0] * rinv * n0.x * gelu_tanh(bflo(g.x)), hv[8 * q + 1] * rinv * n0.y * gelu_tanh(bfhi(g.x)));
        o.y = cvt_pk_bf16(hv[8 * q + 2] * rinv * n0.z * gelu_tanh(bflo(g.y)), hv[8 * q + 3] * rinv * n0.w * gelu_tanh(bfhi(g.y)));
        o.z = cvt_pk_bf16(hv[8 * q + 4] * rinv * n1.x * gelu_tanh(bflo(g.z)), hv[8 * q + 5] * rinv * n1.y * gelu_tanh(bfhi(g.z)));
        o.w = cvt_pk_bf16(hv[8 * q + 6] * rinv * n1.z * gelu_tanh(bflo(g.w)), hv[8 * q + 7] * rinv * n1.w * gelu_tanh(bfhi(g.w)));
        *(u32x4*)(op + 8 * q) = o; }
}

__device__ __forceinline__ void router_unit(const int wv, unsigned char* lds, int u, const float* X, const float* W, float* LOG) {
    float* xs = (float*)lds; float* ws = xs + 32 * 68;
    const int tid = opaque_tid(wv), tt = tid >> 4, eg = tid & 15; const size_t t0 = (size_t)u * 32;
    float a0 = 0.f, a1 = 0.f, a2 = 0.f, a3 = 0.f;
    for (int k0 = 0; k0 < D; k0 += 64) {
        const float4 xv = *(const float4*)(X + (t0 + (tid >> 4)) * D + k0 + (tid & 15) * 4);
        const float4 wv0 = *(const float4*)(W + (size_t)(k0 + (tid >> 4)) * 64 + (tid & 15) * 4), wv1 = *(const float4*)(W + (size_t)(k0 + 32 + (tid >> 4)) * 64 + (tid & 15) * 4);
        __syncthreads();
        *(float4*)(xs + (tid >> 4) * 68 + (tid & 15) * 4) = xv; *(float4*)(ws + (tid >> 4) * 64 + (tid & 15) * 4) = wv0; *(float4*)(ws + (32 + (tid >> 4)) * 64 + (tid & 15) * 4) = wv1;
        __syncthreads();
#pragma unroll 16
        for (int kk = 0; kk < 64; ++kk) { const float x = xs[tt * 68 + kk]; const float4 wv = *(const float4*)(ws + kk * 64 + eg * 4); a0 += x * wv.x; a1 += x * wv.y; a2 += x * wv.z; a3 += x * wv.w; }
    }
    *(float4*)(LOG + (t0 + tt) * 64 + eg * 4) = make_float4(a0, a1, a2, a3);
}
__device__ __forceinline__ void route_unit(const int wv, unsigned char* lds, int u, const float* LOG, const float* rbias, int* TKIDX, float* TKGATE, int* CNT) {
    int* hist = (int*)lds;
    const int tid = opaque_tid(wv);
    __syncthreads();
    if (tid < 64) hist[tid] = 0;
    __syncthreads();
    if (tid < RCHUNK) {
        const size_t t = (size_t)u * RCHUNK + tid;
        float sc[64], sel[64];
#pragma unroll
        for (int i = 0; i < 16; ++i) { const float4 v = *(const float4*)(LOG + t * 64 + 4 * i); sc[4 * i] = sigmoidf_(v.x); sc[4 * i + 1] = sigmoidf_(v.y); sc[4 * i + 2] = sigmoidf_(v.z); sc[4 * i + 3] = sigmoidf_(v.w); }
#pragma unroll
        for (int e = 0; e < 64; ++e) sel[e] = sc[e] + rbias[e];
        float gs[8];
#pragma unroll
        for (int g = 0; g < 8; ++g) { float m1 = -3.0e38f, m2 = -3.0e38f;
#pragma unroll
            for (int j = 0; j < 8; ++j) { const float v = sel[8 * g + j]; const float lo = fminf(m1, v); m1 = fmaxf(m1, v); m2 = fmaxf(m2, lo); }
            gs[g] = m1 + m2; }
#pragma unroll
        for (int g = 0; g < 8; ++g) { int rank = 0;
#pragma unroll
            for (int g2 = 0; g2 < 8; ++g2) rank += (gs[g2] > gs[g] || (gs[g2] == gs[g] && g2 < g)) ? 1 : 0;
            if (rank >= 4) {
#pragma unroll
                for (int j = 0; j < 8; ++j) sel[8 * g + j] = -1e30f; } }
        int idx[TOPK]; float wsel[TOPK]; float wsum = 0.f;
#pragma unroll
        for (int k = 0; k < TOPK; ++k) { float best = sel[0]; int bi = 0; float bs = sc[0];
#pragma unroll
            for (int e = 1; e < 64; ++e) { const bool gt = sel[e] > best; best = gt ? sel[e] : best; bi = gt ? e : bi; bs = gt ? sc[e] : bs; }
#pragma unroll
            for (int e = 0; e < 64; ++e) sel[e] = (e == bi) ? -3.0e38f : sel[e];
            idx[k] = bi; wsel[k] = bs; wsum += bs; }
        const float inv = 2.5f / wsum;
        int4 i0 = make_int4(idx[0], idx[1], idx[2], idx[3]), i1 = make_int4(idx[4], idx[5], idx[6], idx[7]);
        *(int4*)(TKIDX + t * TOPK) = i0; *(int4*)(TKIDX + t * TOPK + 4) = i1;
        *(float4*)(TKGATE + t * TOPK) = make_float4(wsel[0] * inv, wsel[1] * inv, wsel[2] * inv, wsel[3] * inv); *(float4*)(TKGATE + t * TOPK + 4) = make_float4(wsel[4] * inv, wsel[5] * inv, wsel[6] * inv, wsel[7] * inv);
#pragma unroll
        for (int k = 0; k < TOPK; ++k) atomicAdd(&hist[idx[k]], 1);
    }
    __syncthreads();
    if (tid < 64) CNT[u * 64 + tid] = hist[tid];
}
__device__ __forceinline__ void assign_unit(const int wv, unsigned char* lds, int chunk, const int* CNT, const int* TKIDX, const float* TKGATE, int* ROWTOK, int* ROWDST, float* ROWGATE, int* TILEE) {
    int* total = (int*)lds; int* mybase = total + 64; int* off = mybase + 64; unsigned* mask = (unsigned*)(off + 80); int* part = (int*)(mask + 256);
    const int tid = opaque_tid(wv);
    __syncthreads();
    if (tid < 256) mask[tid] = 0u;
    { const int e = tid & 63, pt = tid >> 6; int tot = 0, base = 0;
#pragma unroll 8
      for (int cc = pt * (NRCHUNK / 8); cc < (pt + 1) * (NRCHUNK / 8); ++cc) { const int v = CNT[cc * 64 + e]; tot += v; if (cc < chunk) base += v; }
      part[pt * 64 + e] = tot; part[512 + pt * 64 + e] = base; }
    __syncthreads();
    if (tid < 64) { int tot = 0, base = 0;
#pragma unroll
        for (int pt = 0; pt < 8; ++pt) { tot += part[pt * 64 + tid]; base += part[512 + pt * 64 + tid]; } total[tid] = tot; mybase[tid] = base; }
    __syncthreads();
    if (tid == 0) { int o = 0; for (int e = 0; e < 64; ++e) { off[e] = o; o += ((total[e] + 255) / 256) * 256; } off[64] = o; }
    __syncthreads();
    int e_[2]; int tt_[2], k_[2];
#pragma unroll
    for (int r = 0; r < 2; ++r) { const int p = tid + 512 * r; tt_[r] = p >> 3; k_[r] = p & 7; e_[r] = TKIDX[((size_t)chunk * RCHUNK + tt_[r]) * TOPK + k_[r]]; atomicOr(&mask[e_[r] * 4 + (tt_[r] >> 5)], 1u << (tt_[r] & 31)); }
    __syncthreads();
#pragma unroll
    for (int r = 0; r < 2; ++r) { const int e = e_[r], tt = tt_[r]; int rank = 0;
        for (int wd = 0; wd < (tt >> 5); ++wd) rank += __builtin_popcount(mask[e * 4 + wd]);
        rank += __builtin_popcount(mask[e * 4 + (tt >> 5)] & ((1u << (tt & 31)) - 1u));
        const int slot = off[e] + mybase[e] + rank; const int t = chunk * RCHUNK + tt;
        ROWTOK[slot] = t; ROWDST[slot] = t * TOPK + k_[r]; ROWGATE[slot] = TKGATE[(size_t)t * TOPK + k_[r]]; }
    if (chunk < 64) { const int e = chunk; const int lo = off[e] + total[e], hi = off[e + 1]; for (int s = lo + tid; s < hi; s += NTHR) { ROWTOK[s] = -1; ROWDST[s] = -1; ROWGATE[s] = 0.f; } }
    for (int t = chunk * RCHUNK + tid; t < (chunk + 1) * RCHUNK; t += NTHR) { ROWDST[A_PAD + t] = T * TOPK + t; ROWGATE[A_PAD + t] = 1.0f; }
    if (chunk == 0) { const int e = tid >> 3; for (int i = off[e] / 256 + (tid & 7); i < off[e + 1] / 256; i += 8) TILEE[i] = e; if (tid == 0) TILEE[MAXTILES] = off[64] / 256; }
}
#ifndef Y8_FIRST_LAYER
#define Y8_FIRST_LAYER 0
#endif
#ifndef DOWN_STAG
#define DOWN_STAG 0
#endif
#ifndef F8DN_FIRST_LAYER
#define F8DN_FIRST_LAYER 0
#endif
#ifndef F8_FIRST_LAYER
#define F8_FIRST_LAYER 0
#endif
constexpr int PH_PER_LAYER = 14, NPHASE = DEPTH * PH_PER_LAYER;
struct Args { const void* in[32]; float* out; unsigned char* ws; RotTab rt; int ph_lo, ph_hi, sub, pad; };
static_assert(sizeof(Args) == 32 * 8 + 8 + 8 + 64 + 16, "Args has no padding");

template <int l, int SUB>
__device__ __forceinline__ void layer_program(const int wv, const Args& args, unsigned char* lds, unsigned char* ws, float* out, const XcdBarrier& bar, const int lo, const int hi) {
    constexpr int pb = l * PH_PER_LAYER;
    constexpr bool Y8 = (l >= Y8_FIRST_LAYER);
    constexpr bool F8DN = (l >= F8DN_FIRST_LAYER);
    constexpr bool F8 = (l >= F8_FIRST_LAYER);
    if (hi <= pb || lo >= pb + PH_PER_LAYER) return;
    LAS unsigned char* ldsL = (LAS unsigned char*)lds;
    const int G = gridDim.x, bid = blockIdx.x;
    const int NGW = G * NWAVES;
    LAS int* ulist = (LAS int*)(ldsL + ULIST_OFF);
#ifndef PHMASK
#define PHMASK 0x3fff
#endif
#define IN(k) (lo <= (k) && (k) < hi && ((PHMASK >> ((k) % PH_PER_LAYER)) & 1))
#define SEAM(k) do { if (!MK_PER_PHASE && IN(k) && IN((k) + 1)) xcd_barrier(bar); } while (0)
#define TIDS() const int tid = opaque_tid(wv), lane = tid & 63, wave = wv, gw = bid * NWAVES + wave; (void)lane; (void)gw
        if (IN(pb + 0)) {
            TIDS();
            WPtrs P; P.w_in = (const float*)args.in[3] + (size_t)l * D * IN_COLS; P.w_out = (const float*)args.in[4] + (size_t)l * D * D; P.gate = (const float*)args.in[28] + (size_t)l * D * D;
            P.plew = (const float*)args.in[27] + (size_t)l * PLE * D; P.ew1 = (const float*)args.in[21] + (size_t)l * NE * D * EF; P.ew3 = (const float*)args.in[22] + (size_t)l * NE * D * EF;
            P.ew2 = (const float*)args.in[23] + (size_t)l * NE * EF * D; P.sw1 = (const float*)args.in[24] + (size_t)l * D * EF; P.sw3 = (const float*)args.in[25] + (size_t)l * D * EF; P.sw2 = (const float*)args.in[26] + (size_t)l * EF * D; P.rw = (const float*)args.in[19] + (size_t)l * D * NE; P.lwa = (const float*)args.in[11] + (size_t)l * 32768; P.lwx = (const float*)args.in[13] + (size_t)l * 32768; P.lru_wg = (bf16_t*)(ws + WS_LRUW);
            convert_weights<F8, F8DN>(lds, P, ws + WS_W, gw, NGW, wave, lane);
            convert_rows((const float*)args.in[1] + (size_t)l * T * PLE, (bf16_t*)(ws + WS_PB), (size_t)T * PLE, (size_t)bid * NTHR + tid, (size_t)G * NTHR);
            if (l == 0) convert_rows((const float*)args.in[0], (bf16_t*)(ws + WS_XB), (size_t)T * D, (size_t)bid * NTHR + tid, (size_t)G * NTHR);
        }
        SEAM(pb + 0);
        if (IN(pb + 1)) {
            pg8::DenseOrder S; S.init(T, IN_COLS, G, bid, 0);
            const pg8::ListOrder L = pg8::build_list(wv, ulist, ULIST_CAP, S);
            pg8::EpiStoreBf16 E{(bf16_t*)(ws + WS_HIN), IN_COLS, 0};
            pg8::gemm_phase<D, pg8::EpiStoreBf16, pg8::ListOrder, false>(wv, ldsL, (const bf16_t*)(ws + WS_XB), (const bf16_t*)(ws + WS_W + WO_WIN), L, E, nullptr);
        }
        SEAM(pb + 1);
        if (IN(pb + 2)) {
            const bf16_t* HIN = (const bf16_t*)(ws + WS_HIN); bf16_t* MIX = (bf16_t*)(ws + WS_MIX);
            if (!(SUB & 1)) for (int u = bid; u < 512; u += G) attn_unit(wv, lds, u, HIN, (const int*)args.in[2], (const float*)args.in[5] + l * 16, MIX, (float*)(ws + WS_SSQ), args.rt);
            LruW W; W.conv_w = (const float*)args.in[9] + l * 2048; W.conv_b = (const float*)args.in[10] + l * 512; W.wa = (const float*)args.in[11] + (size_t)l * 32768; W.ba = (const float*)args.in[12] + l * 512;
            W.wx = (const float*)args.in[13] + (size_t)l * 32768; W.bx = (const float*)args.in[14] + l * 512; W.lam = (const float*)args.in[15] + l * 512; W.gain = (const float*)args.in[16] + l * 512;
            if (!(SUB & 2)) for (int u = bid; u < BATCH * NLCH; u += G) lru1_unit(wv, lds, u, HIN, W, (const bf16_t*)(ws + WS_LRUW), (float*)(ws + WS_LRUA), (float*)(ws + WS_LRUH), (bf16_t*)(ws + WS_LRUHL), (bf16_t*)(ws + WS_LRUPL));
            if (!(SUB & 4)) for (int u = bid; u < 2048; u += G) hg1_unit(wv, lds, u, HIN, (const float*)args.in[7], l, (bf16_t*)(ws + WS_SST), (float*)(ws + WS_DV));
        }
        SEAM(pb + 2);
        if (IN(pb + 3)) {
            TIDS();
            const bf16_t* HIN = (const bf16_t*)(ws + WS_HIN); bf16_t* MIX = (bf16_t*)(ws + WS_MIX);
            if (!(SUB & 1)) for (int t = 4 * gw; t < T; t += 4 * NGW) attn_fin_rows4(MIX, (const float*)(ws + WS_SSQ), (const float*)args.in[6] + l * 1024, t, lane);
            if (!(SUB & 2)) for (int u = bid; u < 256; u += G) hg2_unit(wv, u, (const bf16_t*)(ws + WS_SST), (const float*)(ws + WS_DV), (bf16_t*)(ws + WS_SPREV));
            if (!(SUB & 4)) for (int u = bid; u < BATCH; u += G) lru_carry_unit(wv, u, (const float*)(ws + WS_LRUA), (float*)(ws + WS_LRUH));
        }
        SEAM(pb + 3);
        if (IN(pb + 4)) {
            if (!(SUB & 1)) for (int u = bid; u < BATCH * NLCH; u += G) lru2_unit(wv, lds, u, (const bf16_t*)(ws + WS_HIN), (const float*)args.in[16] + l * 512, (const float*)(ws + WS_LRUH), (const bf16_t*)(ws + WS_LRUHL), (const bf16_t*)(ws + WS_LRUPL), (bf16_t*)(ws + WS_MIX));
            if (!(SUB & 2))
            for (int u = bid; u < 2048; u += G) hg3_unit(wv, lds, u, (const bf16_t*)(ws + WS_HIN), (const float*)args.in[7], l, (const bf16_t*)(ws + WS_SPREV), (const float*)args.in[8] + l * 512, (bf16_t*)(ws + WS_MIX));
        }
        SEAM(pb + 4);
        if (IN(pb + 5)) {
            pg8::DenseOrder S; S.init(T, D, G, bid, 0);
            const pg8::ListOrder L = pg8::build_list(wv, ulist, ULIST_CAP, S);
            pg8::EpiStoreBf16 E{(bf16_t*)(ws + WS_HIN), D, 0};
            pg8::gemm_phase<D, pg8::EpiStoreBf16, pg8::ListOrder, false>(wv, ldsL, (const bf16_t*)(ws + WS_MIX), (const bf16_t*)(ws + WS_W + WO_WOUT), L, E, nullptr);
        }
        SEAM(pb + 5);
        if (IN(pb + 6)) {
            TIDS();
            const float* g1 = (const float*)args.in[17] + l * D; const float* b1 = (const float*)args.in[18] + l * D; bf16_t* XB = (bf16_t*)(ws + WS_XB); const bf16_t* ZB = (const bf16_t*)(ws + WS_HIN);
            unsigned char* X8 = (unsigned char*)(ws + WS_MIX);
            for (int t = 2 * gw; t < T; t += 2 * NGW) ln1_rows2(ZB + (size_t)t * D, ZB + (size_t)(t + 1) * D, g1, b1, XB + (size_t)t * D, XB + (size_t)(t + 1) * D, lane, F8 ? X8 + (size_t)t * D : nullptr, F8 ? X8 + (size_t)(t + 1) * D : nullptr);
        }
        SEAM(pb + 6);
        if (IN(pb + 7)) {
            if (!(SUB & 1)) { pg8::DenseOrder S; S.init(T, D, G, bid, 0);
              const pg8::ListOrder L = pg8::build_list(wv, ulist, ULIST_CAP, S);
              if constexpr (Y8) { pg8::EpiStore8 E{(unsigned char*)(ws + WS_U), D, 0};
                pg8::gemm_phase<PLE, pg8::EpiStore8, pg8::ListOrder, false>(wv, ldsL, (const bf16_t*)(ws + WS_PB), (const bf16_t*)(ws + WS_W + WO_PLEW), L, E, nullptr); }
              else { pg8::EpiStoreBf16 E{(bf16_t*)(ws + WS_U), D, 0};
                pg8::gemm_phase<PLE, pg8::EpiStoreBf16, pg8::ListOrder, false>(wv, ldsL, (const bf16_t*)(ws + WS_PB), (const bf16_t*)(ws + WS_W + WO_PLEW), L, E, nullptr); } }
            if (!(SUB & 2)) { pg8::DenseOrder S; S.init(T, 256, G, bid, 0);
              const pg8::ListOrder L = pg8::build_list(wv, ulist, ULIST_CAP, S);
              pg8::EpiRouter E{(float*)(ws + WS_LOGITS)};
              pg8::gemm_phase<D, pg8::EpiRouter, pg8::ListOrder, false>(wv, ldsL, (const bf16_t*)(ws + WS_XB), (const bf16_t*)(ws + WS_W + WO_ROUT), L, E, nullptr); }
        }
        SEAM(pb + 7);
        if (IN(pb + 8)) {
            for (int u = bid; u < NRCHUNK; u += G) route_unit(wv, lds, u, (const float*)(ws + WS_LOGITS), (const float*)args.in[20] + l * 64, (int*)(ws + WS_TKIDX), (float*)(ws + WS_TKGATE), (int*)(ws + WS_CNT));
        }
        SEAM(pb + 8);
        if (IN(pb + 9)) {
            for (int u = bid; u < NRCHUNK; u += G) assign_unit(wv, lds, u, (const int*)(ws + WS_CNT), (const int*)(ws + WS_TKIDX), (const float*)(ws + WS_TKGATE), (int*)(ws + WS_ROWTOK), (int*)(ws + WS_ROWDST), (float*)(ws + WS_ROWGATE), (int*)(ws + WS_TILEE));
        }
        SEAM(pb + 9);
        if (IN(pb + 10)) {
            TIDS();
            const int* TILEE = (const int*)(ws + WS_TILEE); const int* ROWTOK = (const int*)(ws + WS_ROWTOK);
            const int ntiles = TILEE[MAXTILES];
            pg8::UpOrder S2; S2.init(TILEE, ntiles, G, bid, 0);
            const pg8::ListOrder L2 = pg8::build_list(wv, ulist, TAB_BYTES / 1024, S2);
            LAS int* gtab = (LAS int*)(ldsL + TAB_OFF);
            if (tid < 256) for (int j = 0; j < L2.n; ++j) { const int orow = ulist[j * 4 + 2]; int r;
                if (orow < A_PAD) { r = ROWTOK[orow + tid]; r = r < 0 ? 0 : r; } else r = orow - A_PAD + tid;
                gtab[j * 256 + tid] = r; }
            __syncthreads();
            if constexpr (F8 && F8DN) { pg8::EpiSwiglu8 E2{(unsigned char*)(ws + WS_HM)};
                pg8::gemm_phase<D, pg8::EpiSwiglu8, pg8::ListOrder, true, (SUB >> 3) & 3, true>(wv, ldsL, (const bf16_t*)(ws + WS_MIX), (const bf16_t*)(ws + WS_W + WO_W13), L2, E2, gtab); }
            else if constexpr (F8) { pg8::EpiSwiglu E2{(bf16_t*)(ws + WS_HM)};
                pg8::gemm_phase<D, pg8::EpiSwiglu, pg8::ListOrder, true, 0, true>(wv, ldsL, (const bf16_t*)(ws + WS_MIX), (const bf16_t*)(ws + WS_W + WO_W13), L2, E2, gtab); }
            else { pg8::EpiSwiglu E2{(bf16_t*)(ws + WS_HM)};
                pg8::gemm_phase<D, pg8::EpiSwiglu, pg8::ListOrder, true>(wv, ldsL, (const bf16_t*)(ws + WS_XB), (const bf16_t*)(ws + WS_W + WO_W13), L2, E2, gtab); }
            if (!(SUB & 4)) { pg8::DenseOrder S; S.init(T, D, G, bid, 0);
              const pg8::ListOrder L = pg8::build_list(wv, ulist, ULIST_CAP, S);
              if constexpr (F8 && Y8) { pg8::EpiGate8 E{(unsigned char*)(ws + WS_U), (const float*)args.in[29] + l * D};
                pg8::gemm_phase<D, pg8::EpiGate8, pg8::ListOrder, false, 0, true>(wv, ldsL, (const bf16_t*)(ws + WS_MIX), (const bf16_t*)(ws + WS_W + WO_GATE), L, E, nullptr); }
              else { pg8::EpiGate E{(bf16_t*)(ws + WS_U), (const float*)args.in[29] + l * D};
                if constexpr (F8) pg8::gemm_phase<D, pg8::EpiGate, pg8::ListOrder, false, 0, true>(wv, ldsL, (const bf16_t*)(ws + WS_MIX), (const bf16_t*)(ws + WS_W + WO_GATE), L, E, nullptr);
                else pg8::gemm_phase<D, pg8::EpiGate, pg8::ListOrder, false>(wv, ldsL, (const bf16_t*)(ws + WS_XB), (const bf16_t*)(ws + WS_W + WO_GATE), L, E, nullptr); } }
        }
        SEAM(pb + 10);
        if (IN(pb + 11)) {
            if (SUB & 2) return;
            const int* TILEE = (const int*)(ws + WS_TILEE);
            const int ntiles = TILEE[MAXTILES];
            pg8::DownOrder2 S3; S3.init(TILEE, ntiles, G, bid);
            const pg8::ListOrder L3 = pg8::build_list(wv, ulist, ULIST_CAP, S3);
            if constexpr (Y8) { pg8::EpiScatter8 E3{(unsigned char*)(ws + WS_Y), (const int*)(ws + WS_ROWDST), (const float*)(ws + WS_ROWGATE)};
                pg8::gemm_phase<EF, pg8::EpiScatter8, pg8::ListOrder, false, (SUB >> 3) & 3, F8DN, DOWN_STAG>(wv, ldsL, (const bf16_t*)(ws + WS_HM), (const bf16_t*)(ws + WS_W + WO_W2), L3, E3, nullptr); }
            else { pg8::EpiScatter2 E3{(bf16_t*)(ws + WS_Y), (bf16_t*)(ws + WS_W + WO_W13), (const int*)(ws + WS_ROWDST), (const float*)(ws + WS_ROWGATE)};
                pg8::gemm_phase<EF, pg8::EpiScatter2, pg8::ListOrder, false, (SUB >> 3) & 3, F8DN, DOWN_STAG>(wv, ldsL, (const bf16_t*)(ws + WS_HM), (const bf16_t*)(ws + WS_W + WO_W2), L3, E3, nullptr); }
        }
        SEAM(pb + 11);
        if (IN(pb + 13)) {
            TIDS();
            const float* g2 = (const float*)args.in[30] + l * D; const float* b2 = (const float*)args.in[31] + l * D; bf16_t* XB = (bf16_t*)(ws + WS_XB); const bf16_t* Y = (const bf16_t*)(ws + WS_Y);
            if constexpr (Y8) { for (int t = gw; t < T; t += NGW) ln2_row8(XB + (size_t)t * D, g2, b2, (l == DEPTH - 1) ? out + (size_t)t * D : nullptr, (l == DEPTH - 1) ? nullptr : XB + (size_t)t * D, (const unsigned char*)(ws + WS_Y) + (size_t)t * TOPK * D, (const unsigned char*)(ws + WS_U) + (size_t)t * D, (const unsigned char*)(ws + WS_Y) + ((size_t)T * TOPK + t) * D, lane); }
            else { for (int t = gw; t < T; t += NGW) ln2_row(XB + (size_t)t * D, g2, b2, (l == DEPTH - 1) ? out + (size_t)t * D : nullptr, (l == DEPTH - 1) ? nullptr : XB + (size_t)t * D, Y + (size_t)t * TOPK * D, (const bf16_t*)(ws + WS_U) + (size_t)t * D, (const bf16_t*)(ws + WS_W + WO_W13) + (size_t)t * D, lane); }
        }

#undef TIDS
#undef IN
#undef SEAM
}

template <int SUB>
__global__ void __launch_bounds__(NTHR, 2) mega_fwd(Args args) {
    extern __shared__ __attribute__((aligned(16))) unsigned char lds[];
    LAS unsigned char* ldsL = (LAS unsigned char*)lds;
    volatile LAS unsigned* MISC = (volatile LAS unsigned*)(ldsL + MISC_OFF);
    unsigned char* ws = args.ws; float* out = args.out;
    if (threadIdx.x < 32) MISC[threadIdx.x] = 0u;
    __syncthreads();
    XcdBarrier bar; bar.bar = (unsigned*)(ws + WS_CTL) + CW_BAR; bar.x = 0; bar.st = nullptr; bar.w0 = 0;
    if (!MK_PER_PHASE) bar = xcd_barrier_post((unsigned*)(ws + WS_CTL) + CW_BAR, MISC + 8);
    const int lo = args.ph_lo, hi = args.ph_hi;
    const int wv = __builtin_amdgcn_readfirstlane(threadIdx.x >> 6);
    layer_program<0, SUB>(wv, args, lds, ws, out, bar, lo, hi);
    if (!MK_PER_PHASE && lo <= PH_PER_LAYER - 1 && hi > PH_PER_LAYER) xcd_barrier(bar);
    layer_program<1, SUB>(wv, args, lds, ws, out, bar, lo, hi);
}

extern "C" void kernel_launch(void* const* d_in, const int* in_sizes, int n_in, void* d_out, int out_size, void* d_ws, size_t ws_size, hipStream_t stream) {
    static int grid = 0;
    if (grid == 0) {
        if (n_in != 32 || out_size != T * D || ws_size < WS_END) { fprintf(stderr, "kernel_launch: unexpected sizes n_in %d out %d ws %zu (need %zu); nothing launched\n", n_in, out_size, ws_size, (size_t)WS_END); grid = -1; return; }
        int dev = 0, cus = 0, per_cu = 0;
        if (hipGetDevice(&dev) != hipSuccess || hipDeviceGetAttribute(&cus, hipDeviceAttributeMultiprocessorCount, dev) != hipSuccess) { grid = -1; return; }
        if (hipFuncSetAttribute((const void*)mega_fwd<0>, hipFuncAttributeMaxDynamicSharedMemorySize, LDS_BYTES) != hipSuccess) { fprintf(stderr, "kernel_launch: hipFuncSetAttribute failed\n"); grid = -1; return; }
        if (hipOccupancyMaxActiveBlocksPerMultiprocessor(&per_cu, (const void*)mega_fwd<0>, NTHR, LDS_BYTES) != hipSuccess || per_cu < 1) { fprintf(stderr, "kernel_launch: occupancy query reports %d blocks per CU\n", per_cu); }
        (void)hipGetLastError();
        grid = cus;
    }
    if (grid < 0) return;
    if (hipMemsetAsync((char*)d_ws + WS_CTL, 0, CTL_ZERO_BYTES, stream) != hipSuccess) { fprintf(stderr, "kernel_launch: memset failed\n"); return; }
    Args a{};
    for (int i = 0; i < 32; ++i) a.in[i] = d_in[i];
    a.out = (float*)d_out; a.ws = (unsigned char*)d_ws;
    for (int i = 0; i < 8; ++i) a.rt.invf[i] = std::pow(500000.0, -(double)i / 8.0);
#if MK_PER_PHASE
    for (int ph = 0; ph < NPHASE; ++ph) { a.ph_lo = ph; a.ph_hi = ph + 1; hipLaunchKernelGGL(mega_fwd<0>, dim3(grid), dim3(NTHR), LDS_BYTES, stream, a); }
#else
    a.ph_lo = 0; a.ph_hi = NPHASE;
    hipLaunchKernelGGL(mega_fwd<0>, dim3(grid), dim3(NTHR), LDS_BYTES, stream, a);
#endif
#ifdef PROBE_PH
    { static bool once = false; if (!once) { (void)hipFuncSetAttribute((const void*)mega_fwd<PROBE_SUB>, hipFuncAttributeMaxDynamicSharedMemorySize, LDS_BYTES); once = true; }
      const int pl[] = {PROBE_PH}; for (unsigned i = 0; i < sizeof(pl) / sizeof(int); ++i) { a.ph_lo = pl[i]; a.ph_hi = pl[i] + 1; hipLaunchKernelGGL(mega_fwd<PROBE_SUB>, dim3(grid), dim3(NTHR), LDS_BYTES, stream, a); } }
#endif
    const hipError_t le = hipPeekAtLastError();
    if (le != hipSuccess) fprintf(stderr, "kernel_launch: launch failed: %s\n", hipGetErrorName(le));
}
```

```cpp
#include <hip/hip_runtime.h>
#include <cstdio>
#include <cmath>

#ifndef MK_PER_PHASE
#define MK_PER_PHASE 0
#endif

typedef unsigned short bf16_t;
typedef short bf16x8 __attribute__((ext_vector_type(8)));
typedef float f32x4 __attribute__((ext_vector_type(4)));
typedef unsigned u32x4 __attribute__((ext_vector_type(4)));
typedef unsigned u32x2 __attribute__((ext_vector_type(2)));
#define LAS __attribute__((address_space(3)))

constexpr int BATCH = 8, SEQ = 4096, T = BATCH * SEQ, D = 2048, DEPTH = 2, PLE = 256;
constexpr int IN_COLS = 4352;
constexpr int C_AQ = 0, C_AK = 1024, C_AV = 1152, C_HQ = 1280, C_HF = 1792, C_HI = 2304, C_HG = 2816, C_LX = 3328, C_LG = 3840;
constexpr int NE = 64, TOPK = 8, EF = 512;
constexpr int A_ROWS = T * TOPK;
constexpr int MAXTILES = A_ROWS / 256 + NE;
constexpr int A_PAD = MAXTILES * 256;
constexpr float ALPHA = 1.41421356237309515f;
constexpr int RCHUNK = 128, NRCHUNK = T / RCHUNK;
constexpr int LCH = 32, NLCH = SEQ / LCH;

constexpr size_t MiB = 1u << 20;
constexpr size_t WS_CTL = 0, CTL_ZERO_BYTES = 256 * 1024;
constexpr size_t WS_CNT = 1 * MiB;
constexpr size_t WS_TILEE = 2 * MiB;
constexpr size_t WS_LOGITS = 4 * MiB;
constexpr size_t WS_TKIDX = 12 * MiB;
constexpr size_t WS_TKGATE = 13 * MiB;
constexpr size_t WS_ROWTOK = 14 * MiB;
constexpr size_t WS_ROWDST = 16 * MiB;
constexpr size_t WS_ROWGATE = 18 * MiB;
constexpr size_t WS_LRUA = 20 * MiB;
constexpr size_t WS_LRUH = 22 * MiB;
constexpr size_t WS_SSQ = 24 * MiB;
constexpr size_t WS_DV = 25 * MiB;
constexpr size_t WS_LRUW = 26 * MiB;
constexpr size_t WS_Y = 32 * MiB;
constexpr size_t WS_HIN = 32 * MiB;
constexpr size_t WS_MIX = 304 * MiB;
constexpr size_t WS_SST = 432 * MiB;
constexpr size_t WS_PB = 560 * MiB;
constexpr size_t WS_LRUHL = 576 * MiB;
constexpr size_t WS_LRUPL = 640 * MiB;
constexpr size_t WS_SPREV = 768 * MiB;
constexpr size_t WS_XB = 1056 * MiB;
constexpr size_t WS_HM = 1184 * MiB;
constexpr size_t WS_U = 1488 * MiB;
constexpr size_t WS_W = 1616 * MiB;
constexpr size_t WO_WIN = 0, WO_WOUT = 17 * MiB, WO_GATE = 25 * MiB, WO_PLEW = 33 * MiB, WO_W2 = 34 * MiB, WO_W13 = 164 * MiB, WO_ROUT = 424 * MiB, WO_END = 425 * MiB;
constexpr size_t WS_END = WS_W + WO_END;
static_assert((size_t)IN_COLS * D * 2 <= WO_WOUT - WO_WIN && (size_t)65 * 2048 * 512 * 2 <= WO_W13 - WO_W2 && (size_t)65 * 1024 * 2048 * 2 <= WO_ROUT - WO_W13, "weight map");
static_assert(WS_PB + (size_t)T * PLE * 2 <= WS_Y + (size_t)A_ROWS * D * 2 && WS_Y + (size_t)A_ROWS * D * 2 <= WS_XB && WS_HM + (size_t)(A_PAD + T) * EF * 2 <= WS_U, "ws map");

__device__ __forceinline__ int lane_id() { return (int)__builtin_amdgcn_mbcnt_hi(~0u, __builtin_amdgcn_mbcnt_lo(~0u, 0u)); }
__device__ __forceinline__ int opaque_tid(int wv) { int l; asm volatile("v_mbcnt_lo_u32_b32 %0, -1, 0\n\tv_mbcnt_hi_u32_b32 %0, -1, %0" : "=v"(l)); return wv * 64 + l; }
__device__ __forceinline__ bf16_t f2bf(float f) { unsigned u = __float_as_uint(f); u += 0x7fffu + ((u >> 16) & 1u); return (bf16_t)(u >> 16); }
__device__ __forceinline__ float bf2f(bf16_t b) { return __uint_as_float(((unsigned)b) << 16); }
__device__ __forceinline__ float bflo(unsigned w) { return __uint_as_float(w << 16); }
__device__ __forceinline__ float bfhi(unsigned w) { return __uint_as_float(w & 0xffff0000u); }
__device__ __forceinline__ unsigned pk2(float lo, float hi) { return (unsigned)f2bf(lo) | ((unsigned)f2bf(hi) << 16); }
__device__ __forceinline__ unsigned cvt_pk_bf16(float lo, float hi) { unsigned r; asm("v_cvt_pk_bf16_f32 %0, %1, %2" : "=v"(r) : "v"(lo), "v"(hi)); return r; }
__device__ __forceinline__ bf16_t f2bf_hw(float f) { return (bf16_t)(cvt_pk_bf16(f, f) & 0xffffu); }
__device__ __forceinline__ float rcpf_(float x) { return __builtin_amdgcn_rcpf(x); }
__device__ __forceinline__ float rsqf_(float x) { return __builtin_amdgcn_rsqf(x); }
__device__ __forceinline__ float sigmoidf_(float x) { return rcpf_(1.0f + __expf(-x)); }
__device__ __forceinline__ float siluf_(float x) { return x * rcpf_(1.0f + __expf(-x)); }
__device__ __forceinline__ float gelu_tanh(float x) { const float u = 0.7978845608028654f * (x + 0.044715f * x * x * x); const float e = __expf(2.0f * u); const float th = 1.0f - 2.0f * rcpf_(e + 1.0f); return 0.5f * x * (1.0f + th); }
__device__ __forceinline__ float wave_sum(float v) {
#pragma unroll
    for (int o = 1; o < 64; o <<= 1) v += __shfl_xor(v, o);
    return v;
}
__device__ __forceinline__ float clamp8(float x) { return fminf(fmaxf(x, -448.f), 448.f); }
__device__ __forceinline__ unsigned cvt4_fp8(float a, float b, float c, float dd) { int p = __builtin_amdgcn_cvt_pk_fp8_f32(clamp8(a), clamp8(b), 0, false); p = __builtin_amdgcn_cvt_pk_fp8_f32(clamp8(c), clamp8(dd), p, true); return (unsigned)p; }
constexpr float W8_SCALE = 64.f;
constexpr float Y8_SCALE = 16.f;
constexpr int W8_E8M0 = 0x7c7c7c7c, A8_E8M0 = 0x7c7c7c7c;
__device__ __forceinline__ void sincos_pos(float pos, double invf, float& s, float& c) {
    const double a = (double)pos * invf;
    const double q = rint(a * 0.63661977236758134308);
    const float r = (float)(a - q * 1.57079632679489661923);
    const int qi = ((int)q) & 3;
    const float r2 = r * r;
    const float sp = r * (1.0f + r2 * (-1.6666667163e-1f + r2 * (8.3333337680e-3f + r2 * (-1.9841270114e-4f + r2 * 2.7557314297e-6f))));
    const float cp = 1.0f + r2 * (-0.5f + r2 * (4.1666667908e-2f + r2 * (-1.3888889225e-3f + r2 * (2.4801587642e-5f + r2 * -2.7557314297e-7f))));
    const float ss = (qi & 1) ? cp : sp, cc = (qi & 1) ? sp : cp;
    s = (qi & 2) ? -ss : ss;
    c = ((qi + 1) & 2) ? -cc : cc;
}
namespace pg8 {
constexpr int BM = 256, BK = 64, HALF = 128, HTB = HALF * BK * 2, STAGE_BYTES = 8 * HTB, NXCD = 8, WGM = 8;
__host__ __device__ __forceinline__ int lds_byte(int r, int c) { const int st = (r >> 4) * 2 + (c >> 5), rr = r & 15, cc = c & 31, ob = rr * 64 + cc * 2; return st * 1024 + (ob ^ (((ob >> 9) & 1) << 5)); }
__host__ __device__ __forceinline__ void stage_rc(int b, int& R, int& C) { const int st = b / 1024, sb = b % 1024, swz = sb ^ (((sb >> 9) & 1) << 5); R = (st >> 1) * 16 + swz / 64; C = (st & 1) * 32 + (swz % 64) / 2; }
__host__ __device__ __forceinline__ int perm32(int rho) { const int n = rho >> 4, i = rho & 15; return 8 * (i >> 2) + 4 * n + (i & 3); }

struct Unit { int brow, pn, orow, tab; };

__device__ __forceinline__ int xcd_remap(int L, int nwg) { const int q = nwg / NXCD, r = nwg % NXCD, xcd = L % NXCD, off = L / NXCD; return (xcd < r ? xcd * (q + 1) : r * (q + 1) + (xcd - r) * q) + off; }

struct DenseOrder {
    int nM, nN, nwg, G, c, start;
    __device__ void init(int M, int N, int G_, int c_, int start_) { nM = M / BM; nN = N / BM; nwg = nM * nN; G = G_; c = c_; start = start_ % G_; }
    __device__ bool next(int i, Unit& u) const {
        const long L = (long)(i + (c < start ? 1 : 0)) * G + c - start; if (L >= nwg) return false;
        const int wgid = xcd_remap((int)L, nwg);
        const int nig = WGM * nN, gid = wgid / nig, fm = gid * WGM, gsz = (nM - fm) < WGM ? (nM - fm) : WGM;
        const int pm = fm + ((wgid % nig) % gsz); u.pn = (wgid % nig) / gsz; u.orow = pm * BM; u.brow = u.pn * BM; u.tab = 0; return true;
    }
};
struct UpOrder {
    const int* tile_e; int ntiles, nwg, G, c, start;
    __device__ void init(const int* te, int nt_, int G_, int c_, int start_) { tile_e = te; ntiles = nt_; nwg = (nt_ + T / BM) * 4; G = G_; c = c_; start = start_ % G_; }
    __device__ bool next(int i, Unit& u) const {
        const long L = (long)(i + (c < start ? 1 : 0)) * G + c - start; if (L >= nwg) return false;
        const int wgid = xcd_remap((int)L, nwg); const int tile = wgid >> 2; u.pn = wgid & 3; u.tab = i;
        if (tile < ntiles) { u.brow = tile_e[tile] * 1024 + u.pn * BM; u.orow = tile * BM; }
        else { u.brow = 64 * 1024 + u.pn * BM; u.orow = A_PAD + (tile - ntiles) * BM; }
        return true;
    }
};
struct DownOrder {
    const int* tile_e; int lo, hi, t0;
    __device__ void init(const int* te, int nt_, int G_, int c_) { tile_e = te; const int n = nt_ * 8; const int vc = (G_ % 8 == 0) ? (c_ % 8) * (G_ / 8) + c_ / 8 : c_;
        lo = (int)(((long)vc * n) / G_); hi = (int)(((long)(vc + 1) * n) / G_); t0 = lo >> 3; }
    __device__ bool next(int i, Unit& u) const {
        const int id = lo + i; if (id >= hi) return false;
        const int tile = id >> 3; u.pn = id & 7; u.orow = tile * BM; u.brow = tile_e[tile] * 2048 + u.pn * BM; u.tab = tile - t0; return true;
    }
};

struct DownOrder2 {
    const int* tile_e; int ntiles, lo, hi, gq, pn;
    __device__ void init(const int* te, int nt_, int G_, int c_) { tile_e = te; ntiles = nt_; const int ntot = nt_ + T / BM, x = c_ % NXCD, j = c_ / NXCD, ngrp = (G_ / NXCD) / 8;
        lo = (int)(((long)x * ntot) / NXCD); hi = (int)(((long)(x + 1) * ntot) / NXCD); gq = j >> 3; pn = j & 7; if (gq >= ngrp) hi = lo; stride = ngrp; }
    int stride;
    __device__ bool next(int i, Unit& u) const {
        const int t = lo + gq + stride * i; if (t >= hi) return false;
        u.pn = pn; u.tab = 0;
        if (t < ntiles) { u.brow = tile_e[t] * 2048 + pn * BM; u.orow = t * BM; } else { u.brow = 64 * 2048 + pn * BM; u.orow = A_PAD + (t - ntiles) * BM; }
        return true;
    }
};
struct ListOrder { const LAS int* tab; int n;
    __device__ __forceinline__ bool next(int i, Unit& u) const { if (i >= n) return false; const LAS int* p = tab + i * 4;
        u.brow = __builtin_amdgcn_readfirstlane(p[0]); u.pn = __builtin_amdgcn_readfirstlane(p[1]); u.orow = __builtin_amdgcn_readfirstlane(p[2]); u.tab = __builtin_amdgcn_readfirstlane(p[3]); return true; } };
template <class Sched> __device__ __forceinline__ ListOrder build_list(const int wv, LAS int* tab, int cap, const Sched& S) {
    __syncthreads();
    int n = 0; Unit u;
    for (; n < cap && S.next(n, u); ++n) if (opaque_tid(wv) == 0) { tab[n * 4 + 0] = u.brow; tab[n * 4 + 1] = u.pn; tab[n * 4 + 2] = u.orow; tab[n * 4 + 3] = u.tab; }
    __syncthreads();
    ListOrder L; L.tab = tab; L.n = n; return L;
}

struct EpiStoreBf16 { static constexpr bool PERM = true; bf16_t* O; int ldo; int pad;
    __device__ __forceinline__ void operator()(const f32x4 (&acc)[2][2][4][2], const Unit& u, int wr, int wc, int fr, int fq) const {
        const int row0 = u.orow + wr * 64 + fr, col0 = u.pn * BM + wc * 32 + 8 * fq;
#pragma unroll
        for (int ai = 0; ai < 2; ++ai)
#pragma unroll
            for (int m = 0; m < 4; ++m) { bf16_t* rowp = O + (size_t)(row0 + ai * HALF + m * 16) * ldo + col0;
#pragma unroll
                for (int bj = 0; bj < 2; ++bj) { const f32x4 v0 = acc[ai][bj][m][0], v1 = acc[ai][bj][m][1];
                    u32x4 w; w.x = cvt_pk_bf16(v0[0], v0[1]); w.y = cvt_pk_bf16(v0[2], v0[3]); w.z = cvt_pk_bf16(v1[0], v1[1]); w.w = cvt_pk_bf16(v1[2], v1[3]);
                    *(u32x4*)(rowp + bj * HALF) = w; } }
    } };
struct EpiStore8 { static constexpr bool PERM = true; unsigned char* O; int ldo; int pad;
    __device__ __forceinline__ void operator()(const f32x4 (&acc)[2][2][4][2], const Unit& u, int wr, int wc, int fr, int fq) const {
        const int row0 = u.orow + wr * 64 + fr, col0 = u.pn * BM + wc * 32 + 8 * fq;
#pragma unroll
        for (int ai = 0; ai < 2; ++ai)
#pragma unroll
            for (int m = 0; m < 4; ++m) { unsigned char* rowp = O + (size_t)(row0 + ai * HALF + m * 16) * ldo + col0;
#pragma unroll
                for (int bj = 0; bj < 2; ++bj) { const f32x4 v0 = acc[ai][bj][m][0], v1 = acc[ai][bj][m][1];
                    u32x2 w; w.x = cvt4_fp8(v0[0], v0[1], v0[2], v0[3]); w.y = cvt4_fp8(v1[0], v1[1], v1[2], v1[3]); *(u32x2*)(rowp + bj * HALF) = w; } }
    } };
struct EpiGate8 { static constexpr bool PERM = true; unsigned char* U; const float* bias;
    __device__ __forceinline__ void operator()(const f32x4 (&acc)[2][2][4][2], const Unit& u, int wr, int wc, int fr, int fq) const {
        typedef float f2_ __attribute__((ext_vector_type(2)));
        const int row0 = u.orow + wr * 64 + fr, col0 = u.pn * BM + wc * 32 + 8 * fq;
        f32x4 bv[2][2];
#pragma unroll
        for (int bj = 0; bj < 2; ++bj)
#pragma unroll
            for (int n = 0; n < 2; ++n) bv[bj][n] = *(const f32x4*)(bias + col0 + bj * HALF + 4 * n);
#pragma unroll
        for (int ai = 0; ai < 2; ++ai) {
            u32x2 uu[4][2];
#pragma unroll
            for (int m = 0; m < 4; ++m)
#pragma unroll
                for (int bj = 0; bj < 2; ++bj) uu[m][bj] = *(const u32x2*)(U + (size_t)(row0 + ai * HALF + m * 16) * D + col0 + bj * HALF);
#pragma unroll
            for (int m = 0; m < 4; ++m) { unsigned char* rowp = U + (size_t)(row0 + ai * HALF + m * 16) * D + col0;
#pragma unroll
                for (int bj = 0; bj < 2; ++bj) { const u32x2 ux = uu[m][bj];
                    const f2_ u01 = __builtin_amdgcn_cvt_pk_f32_fp8((int)ux.x, false), u23 = __builtin_amdgcn_cvt_pk_f32_fp8((int)ux.x, true), u45 = __builtin_amdgcn_cvt_pk_f32_fp8((int)ux.y, false), u67 = __builtin_amdgcn_cvt_pk_f32_fp8((int)ux.y, true);
                    const f32x4 a0 = acc[ai][bj][m][0] + bv[bj][0], a1 = acc[ai][bj][m][1] + bv[bj][1];
                    u32x2 w; w.x = cvt4_fp8(sigmoidf_(a0[0]) * u01[0] * Y8_SCALE, sigmoidf_(a0[1]) * u01[1] * Y8_SCALE, sigmoidf_(a0[2]) * u23[0] * Y8_SCALE, sigmoidf_(a0[3]) * u23[1] * Y8_SCALE);
                    w.y = cvt4_fp8(sigmoidf_(a1[0]) * u45[0] * Y8_SCALE, sigmoidf_(a1[1]) * u45[1] * Y8_SCALE, sigmoidf_(a1[2]) * u67[0] * Y8_SCALE, sigmoidf_(a1[3]) * u67[1] * Y8_SCALE);
                    *(u32x2*)(rowp + bj * HALF) = w; } }
            asm volatile("" ::: "memory"); }
    } };
struct EpiSwiglu { static constexpr bool PERM = true; bf16_t* H;
    __device__ __forceinline__ void operator()(const f32x4 (&acc)[2][2][4][2], const Unit& u, int wr, int wc, int fr, int fq) const {
        const int row0 = u.orow + wr * 64 + fr, col0 = u.pn * HALF + wc * 32 + 8 * fq;
#pragma unroll
        for (int ai = 0; ai < 2; ++ai)
#pragma unroll
            for (int m = 0; m < 4; ++m) { const f32x4 g0 = acc[ai][0][m][0], g1 = acc[ai][0][m][1], u0 = acc[ai][1][m][0], u1 = acc[ai][1][m][1];
                u32x4 w; w.x = cvt_pk_bf16(siluf_(g0[0]) * u0[0], siluf_(g0[1]) * u0[1]); w.y = cvt_pk_bf16(siluf_(g0[2]) * u0[2], siluf_(g0[3]) * u0[3]);
                w.z = cvt_pk_bf16(siluf_(g1[0]) * u1[0], siluf_(g1[1]) * u1[1]); w.w = cvt_pk_bf16(siluf_(g1[2]) * u1[2], siluf_(g1[3]) * u1[3]);
                *(u32x4*)(H + (size_t)(row0 + ai * HALF + m * 16) * EF + col0) = w; }
    } };
struct EpiSwiglu8 { static constexpr bool PERM = true; unsigned char* H;
    __device__ __forceinline__ void operator()(const f32x4 (&acc)[2][2][4][2], const Unit& u, int wr, int wc, int fr, int fq) const {
        const int row0 = u.orow + wr * 64 + fr, col0 = u.pn * HALF + wc * 32 + 8 * fq;
#pragma unroll
        for (int ai = 0; ai < 2; ++ai)
#pragma unroll
            for (int m = 0; m < 4; ++m) { const f32x4 g0 = acc[ai][0][m][0], g1 = acc[ai][0][m][1], u0 = acc[ai][1][m][0], u1 = acc[ai][1][m][1];
                u32x2 w; w.x = cvt4_fp8(siluf_(g0[0]) * u0[0], siluf_(g0[1]) * u0[1], siluf_(g0[2]) * u0[2], siluf_(g0[3]) * u0[3]);
                w.y = cvt4_fp8(siluf_(g1[0]) * u1[0], siluf_(g1[1]) * u1[1], siluf_(g1[2]) * u1[2], siluf_(g1[3]) * u1[3]);
                *(u32x2*)(H + (size_t)(row0 + ai * HALF + m * 16) * EF + col0) = w; }
    } };
struct EpiResid { static constexpr bool PERM = true; const bf16_t* xres; bf16_t* Z; float alpha; int pad;
    __device__ __forceinline__ void operator()(const f32x4 (&acc)[2][2][4][2], const Unit& u, int wr, int wc, int fr, int fq) const {
        const int row0 = u.orow + wr * 64 + fr, col0 = u.pn * BM + wc * 32 + 8 * fq;
#pragma unroll
        for (int ai = 0; ai < 2; ++ai)
#pragma unroll
            for (int m = 0; m < 4; ++m) { const size_t off = (size_t)(row0 + ai * HALF + m * 16) * D + col0;
#pragma unroll
                for (int bj = 0; bj < 2; ++bj) { const u32x4 x = *(const u32x4*)(xres + off + bj * HALF); const f32x4 a0 = acc[ai][bj][m][0], a1 = acc[ai][bj][m][1];
                    u32x4 w; w.x = cvt_pk_bf16(alpha * bflo(x.x) + a0[0], alpha * bfhi(x.x) + a0[1]); w.y = cvt_pk_bf16(alpha * bflo(x.y) + a0[2], alpha * bfhi(x.y) + a0[3]);
                    w.z = cvt_pk_bf16(alpha * bflo(x.z) + a1[0], alpha * bfhi(x.z) + a1[1]); w.w = cvt_pk_bf16(alpha * bflo(x.w) + a1[2], alpha * bfhi(x.w) + a1[3]);
                    *(u32x4*)(Z + off + bj * HALF) = w; }
                asm volatile("" ::: "memory"); }
    } };
struct EpiAccum { static constexpr bool PERM = false; float* xio;
    __device__ __forceinline__ void operator()(const f32x4 (&acc)[2][2][4][2], const Unit& u, int wr, int wc, int fr, int fq) const {
        const int row0 = u.orow + wr * 64 + fr, col0 = u.pn * BM + wc * 32 + 4 * fq;
#pragma unroll
        for (int ai = 0; ai < 2; ++ai)
#pragma unroll
            for (int m = 0; m < 4; ++m) { const size_t off = (size_t)(row0 + ai * HALF + m * 16) * D + col0;
#pragma unroll
                for (int bj = 0; bj < 2; ++bj)
#pragma unroll
                    for (int n = 0; n < 2; ++n) { const f32x4 x = *(const f32x4*)(xio + off + bj * HALF + n * 16); *(f32x4*)(xio + off + bj * HALF + n * 16) = x + acc[ai][bj][m][n]; }
                asm volatile("" ::: "memory"); }
    } };
struct EpiScatter { static constexpr bool PERM = true; bf16_t* Y; const LAS int* tdst; const LAS float* tgate; int nostore; int pad;
    __device__ __forceinline__ void operator()(const f32x4 (&acc)[2][2][4][2], const Unit& u, int wr, int wc, int fr, int fq) const {
        const int r0 = u.tab * BM + wr * 64 + fr, col0 = u.pn * BM + wc * 32 + 8 * fq;
#pragma unroll
        for (int ai = 0; ai < 2; ++ai)
#pragma unroll
            for (int m = 0; m < 4; ++m) { const int dst = tdst[r0 + ai * HALF + m * 16]; const float g = tgate[r0 + ai * HALF + m * 16];
                if (dst >= 0 && !nostore) { bf16_t* rowp = Y + (size_t)dst * D + col0;
#pragma unroll
                    for (int bj = 0; bj < 2; ++bj) { const f32x4 v0 = acc[ai][bj][m][0] * g, v1 = acc[ai][bj][m][1] * g;
                        u32x4 w; w.x = cvt_pk_bf16(v0[0], v0[1]); w.y = cvt_pk_bf16(v0[2], v0[3]); w.z = cvt_pk_bf16(v1[0], v1[1]); w.w = cvt_pk_bf16(v1[2], v1[3]);
                        *(u32x4*)(rowp + bj * HALF) = w; } } }
    } };
struct EpiScatter2 { static constexpr bool PERM = true; bf16_t* Y; bf16_t* YSH; const int* rdst; const float* rgate;
    __device__ __forceinline__ void operator()(const f32x4 (&acc)[2][2][4][2], const Unit& u, int wr, int wc, int fr, int fq) const {
        const int col0 = u.pn * BM + wc * 32 + 8 * fq;
        if (u.orow < A_PAD) {
            const int r0 = u.orow + wr * 64 + fr;
#pragma unroll
            for (int ai = 0; ai < 2; ++ai) {
                int dst[4]; float g[4];
#pragma unroll
                for (int m = 0; m < 4; ++m) { dst[m] = rdst[r0 + ai * HALF + m * 16]; g[m] = rgate[r0 + ai * HALF + m * 16]; }
#pragma unroll
                for (int m = 0; m < 4; ++m) if (dst[m] >= 0) { bf16_t* rowp = Y + (size_t)dst[m] * D + col0;
#pragma unroll
                    for (int bj = 0; bj < 2; ++bj) { const f32x4 v0 = acc[ai][bj][m][0] * g[m], v1 = acc[ai][bj][m][1] * g[m];
                        u32x4 w; w.x = cvt_pk_bf16(v0[0], v0[1]); w.y = cvt_pk_bf16(v0[2], v0[3]); w.z = cvt_pk_bf16(v1[0], v1[1]); w.w = cvt_pk_bf16(v1[2], v1[3]);
                        *(u32x4*)(rowp + bj * HALF) = w; } } }
        } else {
            const int row0 = u.orow - A_PAD + wr * 64 + fr;
#pragma unroll
            for (int ai = 0; ai < 2; ++ai)
#pragma unroll
                for (int m = 0; m < 4; ++m) { bf16_t* rowp = YSH + (size_t)(row0 + ai * HALF + m * 16) * D + col0;
#pragma unroll
                    for (int bj = 0; bj < 2; ++bj) { const f32x4 v0 = acc[ai][bj][m][0], v1 = acc[ai][bj][m][1];
                        u32x4 w; w.x = cvt_pk_bf16(v0[0], v0[1]); w.y = cvt_pk_bf16(v0[2], v0[3]); w.z = cvt_pk_bf16(v1[0], v1[1]); w.w = cvt_pk_bf16(v1[2], v1[3]);
                        *(u32x4*)(rowp + bj * HALF) = w; } }
        }
    } };
template <int FAKE = 0> struct EpiScatter8T { static constexpr bool PERM = true; static constexpr bool HOOKS = true; unsigned char* Y; const int* rdst; const float* rgate;
    int dd[2][4]; float gg[2][4];
    __device__ __forceinline__ void load_tab(const Unit& u, int tid) { const int r0 = u.orow + (tid >> 8) * 64 + (tid & 15);
#pragma unroll
        for (int ai = 0; ai < 2; ++ai)
#pragma unroll
            for (int m = 0; m < 4; ++m) { dd[ai][m] = rdst[r0 + ai * HALF + m * 16]; gg[ai][m] = rgate[r0 + ai * HALF + m * 16]; } }
    __device__ __forceinline__ void begin(const Unit& u, int tid) { load_tab(u, tid); }
    __device__ __forceinline__ void post(const Unit& nx, int tid) { load_tab(nx, tid); }
    __device__ __forceinline__ void operator()(const f32x4 (&acc)[2][2][4][2], const Unit& u, int wr, int wc, int fr, int fq) const {
        const unsigned col0 = (unsigned)(u.pn * BM + wc * 32 + 8 * fq);
#pragma unroll
        for (int ai = 0; ai < 2; ++ai)
#pragma unroll
            for (int m = 0; m < 4; ++m) { const int dst = dd[ai][m]; const float g = gg[ai][m] * Y8_SCALE;
                if (dst >= 0) { unsigned off = (unsigned)dst * (unsigned)D + col0;
                    if (FAKE) off = (unsigned)u.orow * (unsigned)D + (unsigned)(u.pn * 65536 + (wr * 4 + wc) * 8192 + (ai * 4 + m) * 1024 + (fq * 16 + fr) * 8);
#pragma unroll
                    for (int bj = 0; bj < 2; ++bj) { const f32x4 v0 = acc[ai][bj][m][0] * g, v1 = acc[ai][bj][m][1] * g;
                        u32x2 w; w.x = cvt4_fp8(v0[0], v0[1], v0[2], v0[3]); w.y = cvt4_fp8(v1[0], v1[1], v1[2], v1[3]); *(u32x2*)(Y + off + bj * (FAKE ? 512 : HALF)) = w; } } }
    } };
typedef EpiScatter8T<0> EpiScatter8;
struct EpiScatter8L { static constexpr bool PERM = true; static constexpr bool HOOKS = true; unsigned char* Y; const int* rdst; const float* rgate; LAS unsigned char* lds;
    int dd[2][4]; float gg[2][4];
    __device__ __forceinline__ void load_tab(const Unit& u, int tid) { const int r0 = u.orow + (tid >> 8) * 64;
#pragma unroll
        for (int ai = 0; ai < 2; ++ai)
#pragma unroll
            for (int m = 0; m < 4; ++m) { gg[ai][m] = rgate[r0 + ai * HALF + m * 16 + (tid & 15)]; dd[ai][m] = rdst[r0 + ai * HALF + ((tid >> 6) & 3) * 16 + m * 4 + ((tid >> 4) & 3)]; } }
    __device__ __forceinline__ void begin(const Unit& u, int tid) { load_tab(u, tid); }
    __device__ __forceinline__ void post(const Unit& nx, int tid) { load_tab(nx, tid); }
    __device__ __forceinline__ void operator()(const f32x4 (&acc)[2][2][4][2], const Unit& u, int wr, int wc, int fr, int fq) const {
        const unsigned col = (unsigned)(u.pn * BM + fr * 16);
        const unsigned wa = (unsigned)(fr * 256 + (((wc * 2 + (fq >> 1)) ^ fr) << 4) + 8 * (fq & 1));
        const unsigned ra = (unsigned)(wc * 4096 + fq * 256);
#pragma unroll
        for (int ai = 0; ai < 2; ++ai) {
#pragma unroll
            for (int m = 0; m < 4; ++m) { const float g = gg[ai][m] * Y8_SCALE;
#pragma unroll
                for (int bj = 0; bj < 2; ++bj) { const f32x4 v0 = acc[ai][bj][m][0] * g, v1 = acc[ai][bj][m][1] * g;
                    u32x2 w; w.x = cvt4_fp8(v0[0], v0[1], v0[2], v0[3]); w.y = cvt4_fp8(v1[0], v1[1], v1[2], v1[3]); *(LAS u32x2*)(lds + (wa ^ (unsigned)(bj * 128)) + m * 4096) = w; } }
            asm volatile("s_waitcnt lgkmcnt(0)" ::: "memory"); __builtin_amdgcn_s_barrier();
            u32x4 rv[4];
#pragma unroll
            for (int i = 0; i < 4; ++i) rv[i] = *(const LAS u32x4*)(lds + ra + i * 1024 + (((fr ^ fq ^ (i << 2)) & 15) << 4));
#pragma unroll
            for (int i = 0; i < 4; ++i) if (dd[ai][i] >= 0) *(u32x4*)(Y + ((unsigned)dd[ai][i] * (unsigned)D + col)) = rv[i];
            asm volatile("s_waitcnt lgkmcnt(0)" ::: "memory"); __builtin_amdgcn_s_barrier();
        }
    } };
struct EpiGate { static constexpr bool PERM = true; bf16_t* U; const float* bias;
    __device__ __forceinline__ void operator()(const f32x4 (&acc)[2][2][4][2], const Unit& u, int wr, int wc, int fr, int fq) const {
        const int row0 = u.orow + wr * 64 + fr, col0 = u.pn * BM + wc * 32 + 8 * fq;
        f32x4 bv[2][2];
#pragma unroll
        for (int bj = 0; bj < 2; ++bj)
#pragma unroll
            for (int n = 0; n < 2; ++n) bv[bj][n] = *(const f32x4*)(bias + col0 + bj * HALF + 4 * n);
#pragma unroll
        for (int ai = 0; ai < 2; ++ai)
#pragma unroll
            for (int m = 0; m < 4; ++m) { bf16_t* rowp = U + (size_t)(row0 + ai * HALF + m * 16) * D + col0;
#pragma unroll
                for (int bj = 0; bj < 2; ++bj) { const u32x4 uu = *(const u32x4*)(rowp + bj * HALF);
                    const f32x4 a0 = acc[ai][bj][m][0] + bv[bj][0], a1 = acc[ai][bj][m][1] + bv[bj][1];
                    u32x4 w; w.x = cvt_pk_bf16(sigmoidf_(a0[0]) * bflo(uu.x), sigmoidf_(a0[1]) * bfhi(uu.x)); w.y = cvt_pk_bf16(sigmoidf_(a0[2]) * bflo(uu.y), sigmoidf_(a0[3]) * bfhi(uu.y));
                    w.z = cvt_pk_bf16(sigmoidf_(a1[0]) * bflo(uu.z), sigmoidf_(a1[1]) * bfhi(uu.z)); w.w = cvt_pk_bf16(sigmoidf_(a1[2]) * bflo(uu.w), sigmoidf_(a1[3]) * bfhi(uu.w));
                    *(u32x4*)(rowp + bj * HALF) = w; }
                asm volatile("" ::: "memory"); }
    } };
struct EpiRouter { static constexpr bool PERM = false; float* LOG;
    __device__ __forceinline__ void operator()(const f32x4 (&acc)[2][2][4][2], const Unit& u, int wr, int wc, int fr, int fq) const {
        if (wc < 2) { const int row0 = u.orow + wr * 64 + fr, col0 = wc * 32 + 4 * fq;
#pragma unroll
            for (int ai = 0; ai < 2; ++ai)
#pragma unroll
                for (int m = 0; m < 4; ++m)
#pragma unroll
                    for (int n = 0; n < 2; ++n) *(f32x4*)(LOG + (size_t)(row0 + ai * HALF + m * 16) * 64 + col0 + n * 16) = acc[ai][0][m][n]; }
    } };

template <class E, class = void> struct epi_has_hooks { static constexpr bool value = false; };
template <class E> struct epi_has_hooks<E, decltype((void)E::HOOKS)> { static constexpr bool value = true; };
template <int K, class Epi, class Sched, bool GATHER, int VAR = 0, bool FP8 = false, int STAG = 0>
__device__ __forceinline__ void gemm_phase(const int wv, LAS unsigned char* lds, const bf16_t* Ap_, const bf16_t* Btp_, const Sched& S, Epi& E, const LAS int* gtab) {
    typedef const __attribute__((address_space(1))) char* gcp;
    gcp Ap = (gcp)Ap_; gcp Btp = (gcp)Btp_; asm volatile("" : "+s"(Ap), "+s"(Btp));
    const int tid = opaque_tid(wv), wid = wv, lane = tid & 63, wr = wid >> 2, wc = wid & 3, fr = lane & 15, fq = lane >> 4;
    constexpr int ES = FP8 ? 1 : 2, KB = K * ES;
    constexpr int nt = KB / 128;
    static_assert(nt >= 4 && nt % 2 == 0, "K-loop needs an even number (>= 4) of 128-byte K-tiles");
    unsigned voffB[2], vc[2][2];
#pragma unroll
    for (int i = 0; i < 2; ++i) { int R, C; stage_rc(tid * 16 + i * 8192, R, C); const int Rb = Epi::PERM ? ((R & ~31) + perm32(R & 31)) : R; voffB[i] = (unsigned)(Rb * KB + C * 2); asm volatile("" : "+v"(voffB[i])); }
    constexpr size_t kstep = (size_t)(BK * 2);
    constexpr size_t hstep = (size_t)HALF * KB;
    constexpr size_t hA = GATHER ? (size_t)0 : hstep;
    const unsigned ldsw = (unsigned)wid * 1024u;
    const int aoff = lds_byte(wr * 64 + fr, fq * 8), boff = lds_byte(wc * 32 + fr, fq * 8);
#define PG8_SA(b, h) (((b) * 2 + (h)) * HTB)
#define PG8_SB(b, h) ((4 + (b) * 2 + (h)) * HTB)
#define PG8_STAGE(bufoff, gbase, voff) do { _Pragma("unroll") for (int _i = 0; _i < 2; ++_i) { unsigned _o = (voff)[_i]; asm volatile("" : "+v"(_o));     \
        __builtin_amdgcn_global_load_lds((const __attribute__((address_space(1))) unsigned*)((gbase) + _o), (LAS unsigned*)(lds + (bufoff) + ldsw + _i * 8192), 16, 0, 0); } } while (0)
#define PG8_SETA(v, slot) do { _Pragma("unroll") for (int _h = 0; _h < 2; ++_h) _Pragma("unroll") for (int _i = 0; _i < 2; ++_i) { int _R, _C; stage_rc(tid * 16 + _i * 8192, _R, _C); \
        (v)[_h][_i] = GATHER ? ((unsigned)gtab[(slot) * BM + _h * HALF + _R] * (unsigned)KB + (unsigned)(_C * 2)) : (unsigned)(_R * KB + _C * 2); asm volatile("" : "+v"((v)[_h][_i])); } } while (0)
#define PG8_LDA(dst, b, h) do { unsigned _ba = (unsigned)(aoff + PG8_SA(b, h)); asm volatile("" : "+v"(_ba)); const LAS unsigned char* _pa = lds + _ba; _Pragma("unroll") for (int m = 0; m < 4; ++m) { \
        if constexpr (FP8) dst##8[m] = __builtin_shufflevector(*(const LAS v4i_*)(_pa + m * 2048), *(const LAS v4i_*)(_pa + m * 2048 + 1024), 0, 1, 2, 3, 4, 5, 6, 7); \
        else { _Pragma("unroll") for (int k = 0; k < 2; ++k) dst[m][k] = *(const LAS bf16x8*)(_pa + m * 2048 + k * 1024); } } } while (0)
#define PG8_LDB(dst, b, h) do { unsigned _bb = (unsigned)(boff + PG8_SB(b, h)); asm volatile("" : "+v"(_bb)); const LAS unsigned char* _pb = lds + _bb; _Pragma("unroll") for (int n = 0; n < 2; ++n) { \
        if constexpr (FP8) dst##8[n] = __builtin_shufflevector(*(const LAS v4i_*)(_pb + n * 2048), *(const LAS v4i_*)(_pb + n * 2048 + 1024), 0, 1, 2, 3, 4, 5, 6, 7); \
        else { _Pragma("unroll") for (int k = 0; k < 2; ++k) dst[n][k] = *(const LAS bf16x8*)(_pb + n * 2048 + k * 1024); } } } while (0)
#define PG8_MMA(ai, bj, At, Bt) do { __builtin_amdgcn_s_setprio(1); _Pragma("unroll") for (int m = 0; m < 4; ++m) _Pragma("unroll") for (int n = 0; n < 2; ++n) { \
        if constexpr (FP8) asm volatile("v_mfma_scale_f32_16x16x128_f8f6f4 %0, %1, %2, %0, %3, %3 op_sel_hi:[0,0,0]" : "+v"(acc[ai][bj][m][n]) : "v"(Bt##8[n]), "v"(At##8[m]), "v"(sc8_)); \
        else { _Pragma("unroll") for (int k = 0; k < 2; ++k) acc[ai][bj][m][n] = __builtin_amdgcn_mfma_f32_16x16x32_bf16(Bt[n][k], At[m][k], acc[ai][bj][m][n], 0, 0, 0); } } \
        __builtin_amdgcn_s_setprio(0); } while (0)
#define PG8_WAIT_V(n) asm volatile("s_waitcnt vmcnt(" #n ")" ::: "memory")
#define PG8_WAIT_L(n) asm volatile("s_waitcnt lgkmcnt(" #n ")" ::: "memory")
#define PG8_BAR __builtin_amdgcn_s_barrier()
#define PG8_SCHED __builtin_amdgcn_sched_barrier(0)
    Unit cur, nxt; int ui = 0;
    if (!S.next(0, cur)) return;
    if constexpr (epi_has_hooks<Epi>::value) E.begin(cur, tid);
    if constexpr (STAG > 0) {
        const unsigned long long t0 = __builtin_amdgcn_s_memrealtime(); const unsigned long long dt = (unsigned long long)(((blockIdx.x >> 3) & 7) * STAG);
        while (__builtin_amdgcn_s_memrealtime() - t0 < dt) __builtin_amdgcn_s_sleep(8);
    }
    f32x4 acc[2][2][4][2];
#pragma unroll
    for (int a = 0; a < 2; ++a)
#pragma unroll
        for (int b = 0; b < 2; ++b)
#pragma unroll
            for (int m = 0; m < 4; ++m)
#pragma unroll
                for (int n = 0; n < 2; ++n) acc[a][b][m][n] = (f32x4){0.f, 0.f, 0.f, 0.f};
    typedef int v8i_ __attribute__((ext_vector_type(8))); typedef int v4i_ __attribute__((ext_vector_type(4)));
    const int sc8_ = W8_E8M0;
    bf16x8 At[4][2], B0[2][2], B1[2][2]; v8i_ At8[4], B08[2], B18[2];
    PG8_SETA(vc, cur.tab);
    gcp cA = Ap + (GATHER ? (size_t)0 : (size_t)cur.orow * KB); gcp cB = Btp + (size_t)cur.brow * KB;
    PG8_STAGE(PG8_SB(0, 0), cB, voffB); PG8_STAGE(PG8_SB(0, 1), cB + hstep, voffB); PG8_STAGE(PG8_SA(0, 0), cA, vc[0]); PG8_STAGE(PG8_SA(0, 1), cA + hA, vc[1]);
    if (wr == 1) PG8_BAR;
    PG8_WAIT_V(2); PG8_BAR;
    PG8_STAGE(PG8_SB(1, 0), cB + kstep, voffB); PG8_STAGE(PG8_SA(1, 0), cA + kstep, vc[0]); PG8_STAGE(PG8_SB(1, 1), cB + hstep + kstep, voffB);
    PG8_WAIT_V(6); PG8_BAR;
    for (;;) {
        const bool has_next = S.next(ui + 1, nxt);
        gcp nA = has_next ? Ap + (GATHER ? (size_t)0 : (size_t)nxt.orow * KB) : cA; gcp nB = has_next ? Btp + (size_t)nxt.brow * KB : cB;
#pragma nounroll
        for (int t = 0; t < nt; t += 2) {
            const bool last = (t == nt - 2);
            gcp a1 = cA + (size_t)(t + 1) * kstep;
            gcp a2 = last ? nA : cA + (size_t)(t + 2) * kstep; gcp b2 = last ? nB : cB + (size_t)(t + 2) * kstep;
            gcp a3 = a2 + kstep; gcp b3 = b2 + kstep;
            PG8_LDB(B0, 0, 0); PG8_LDB(B1, 0, 1); PG8_SCHED; PG8_LDA(At, 0, 0); PG8_STAGE(PG8_SA(1, 1), a1 + hA, vc[1]);
            if (GATHER && last && has_next) PG8_SETA(vc, nxt.tab);
            PG8_WAIT_V(8); PG8_WAIT_L(0); PG8_BAR; PG8_MMA(0, 0, At, B0); PG8_MMA(0, 1, At, B1); PG8_BAR; PG8_SCHED;
            PG8_LDA(At, 0, 1); PG8_STAGE(PG8_SB(0, 0), b2, voffB); PG8_STAGE(PG8_SB(0, 1), b2 + hstep, voffB); PG8_STAGE(PG8_SA(0, 0), a2, vc[0]);
            PG8_WAIT_V(8); PG8_WAIT_L(0); PG8_BAR; PG8_MMA(1, 0, At, B0); PG8_MMA(1, 1, At, B1); PG8_BAR; PG8_SCHED;
            PG8_LDB(B0, 1, 0); PG8_LDB(B1, 1, 1); PG8_SCHED; PG8_LDA(At, 1, 0); PG8_STAGE(PG8_SA(0, 1), a2 + hA, vc[1]);
            PG8_WAIT_V(8); PG8_WAIT_L(0); PG8_BAR; PG8_MMA(0, 0, At, B0); PG8_MMA(0, 1, At, B1); PG8_BAR; PG8_SCHED;
            PG8_LDA(At, 1, 1); PG8_STAGE(PG8_SB(1, 0), b3, voffB); PG8_STAGE(PG8_SB(1, 1), b3 + hstep, voffB); PG8_STAGE(PG8_SA(1, 0), a3, vc[0]);
            PG8_WAIT_V(8); PG8_WAIT_L(0); PG8_BAR; PG8_MMA(1, 0, At, B0); PG8_MMA(1, 1, At, B1); PG8_BAR; PG8_SCHED;
        }
        if (!(VAR & 2)) { if (wr == 0) PG8_BAR; }
        if (!(VAR & 1)) { const int t2 = opaque_tid(wv), l2 = t2 & 63;
            E(acc, cur, wr, wc, l2 & 15, l2 >> 4);
            if constexpr (epi_has_hooks<Epi>::value) { if (has_next) E.post(nxt, t2); } }
        if (!has_next) break;
#pragma unroll
        for (int a = 0; a < 2; ++a)
#pragma unroll
            for (int b = 0; b < 2; ++b)
#pragma unroll
                for (int m = 0; m < 4; ++m)
#pragma unroll
                    for (int n = 0; n < 2; ++n) acc[a][b][m][n] = (f32x4){0.f, 0.f, 0.f, 0.f};
        cur = nxt; cA = nA; cB = nB; ++ui;
        if (!(VAR & 2)) { if (wr == 1) PG8_BAR; }
    }
    PG8_WAIT_V(0);
    if (VAR & 2) { if (wr == 0) PG8_BAR; }
    PG8_BAR;
#undef PG8_SA
#undef PG8_SB
#undef PG8_STAGE
#undef PG8_SETA
#undef PG8_LDA
#undef PG8_LDB
#undef PG8_MMA
#undef PG8_WAIT_V
#undef PG8_WAIT_L
#undef PG8_BAR
#undef PG8_SCHED
}
}
constexpr int NWAVES = 8, NTHR = 512;
constexpr int RING_OFF = 0, RING_BYTES = 131072;
constexpr int TAB_OFF = RING_BYTES, TAB_BYTES = 24576;
constexpr int MISC_OFF = TAB_OFF + TAB_BYTES;
constexpr int ULIST_OFF = MISC_OFF + 128, ULIST_CAP = 64;
constexpr int LDS_BYTES = 160 * 1024;
static_assert(ULIST_OFF + ULIST_CAP * 16 <= LDS_BYTES, "LDS map");
constexpr int CW_BAR = 1024;

#define XB_TMO      128
#define XB_XCNT(j)  (256  + 64 * (j))
#define XB_XSUB(j)  (1280 + 64 * (j))
#define XB_XGEN(j)  (2304 + 64 * (j))
#define XB_TOP      3328
#define XB_TOPGEN   3392
#define XCD_BAR_WORDS 3456
#define XB_SPIN_CAP (1u << 22)
static_assert((CW_BAR + XCD_BAR_WORDS) * 4 <= (int)CTL_ZERO_BYTES, "barrier words inside the memset region");

__device__ __forceinline__ unsigned xb_ld(unsigned* p)              { return __hip_atomic_load(p, __ATOMIC_RELAXED, __HIP_MEMORY_SCOPE_AGENT); }
__device__ __forceinline__ unsigned xb_add(unsigned* p, unsigned v) { return __hip_atomic_fetch_add(p, v, __ATOMIC_RELAXED, __HIP_MEMORY_SCOPE_AGENT); }
__device__ __forceinline__ unsigned xb_xcc_id() { return (unsigned)__builtin_amdgcn_s_getreg((3 << 11) | 20) & 0xFu; }
#define XB_SPIN(cond, bar) do { unsigned _sp = 0; while (cond) { __builtin_amdgcn_s_sleep(1); \
    if ((++_sp & 255u) == 0u) { if (xb_ld(&(bar)[XB_TMO])) break; if (_sp > XB_SPIN_CAP) { atomicAdd(&(bar)[XB_TMO], 1u); break; } } } } while (0)

struct XcdBarrier { unsigned* bar; unsigned x; volatile LAS unsigned* st; int w0; };
__device__ __forceinline__ XcdBarrier xcd_barrier_post(unsigned* bar, volatile LAS unsigned* st) {
    XcdBarrier b; b.bar = bar; b.x = xb_xcc_id(); b.st = st; b.w0 = (__builtin_amdgcn_readfirstlane(threadIdx.x >> 6) == 0) ? 1 : 0;
    if (threadIdx.x == 0) (void)xb_add(&bar[XB_XCNT(b.x)], 1u);
    return b;
}
__device__ __forceinline__ void xcd_barrier_complete(unsigned* bar, unsigned x, unsigned& nloc, unsigned& nx) {
    const unsigned G = gridDim.x * gridDim.y * gridDim.z;
    unsigned sum, cnt, mine, sp = 0u;
    for (;;) {
        sum = 0u; cnt = 0u; mine = 0u;
#pragma unroll
        for (unsigned j = 0; j < 16; ++j) { const unsigned c = xb_ld(&bar[XB_XCNT(j)]); sum += c; cnt += (c > 0u) ? 1u : 0u; mine = (j == x) ? c : mine; }
        if (sum == G) break;
        __builtin_amdgcn_s_sleep(1);
        if ((++sp & 255u) == 0u) { if (xb_ld(&bar[XB_TMO])) break; if (sp > XB_SPIN_CAP) { atomicAdd(&bar[XB_TMO], 1u); break; } }
    }
    nloc = mine > 0u ? mine : 1u; nx = cnt > 0u ? cnt : 1u;
}
__device__ __forceinline__ void xcd_barrier(const XcdBarrier& b) {
    asm volatile("s_waitcnt vmcnt(0)" ::: "memory");
    __syncthreads();
    if (b.w0 && lane_id() == 0) {
        unsigned* bar = b.bar;
        __builtin_amdgcn_s_waitcnt(0);
        unsigned nloc = b.st[0], nx = b.st[1];
        if (nloc == 0u) { xcd_barrier_complete(bar, b.x, nloc, nx); b.st[0] = nloc; b.st[1] = nx; }
        const unsigned old = xb_add(&bar[XB_XSUB(b.x)], 1u);
        const unsigned gen = old / nloc;
        if (old + 1u == (gen + 1u) * nloc) {
            __builtin_amdgcn_fence(__ATOMIC_RELEASE, "agent");
            asm volatile("s_waitcnt vmcnt(0)" ::: "memory");
            const unsigned og = xb_add(&bar[XB_TOP], 1u);
            const unsigned tg = og / nx;
            if (og + 1u == (tg + 1u) * nx) xb_add(&bar[XB_TOPGEN], 1u);
            else XB_SPIN(xb_ld(&bar[XB_TOPGEN]) == tg, bar);
            __builtin_amdgcn_fence(__ATOMIC_ACQUIRE, "agent");
            xb_add(&bar[XB_XGEN(b.x)], 1u);
            asm volatile("s_waitcnt vmcnt(0)" ::: "memory");
        } else {
            XB_SPIN(xb_ld(&bar[XB_XGEN(b.x)]) == gen, bar);
            __builtin_amdgcn_fence(__ATOMIC_ACQUIRE, "agent");
            asm volatile("s_waitcnt vmcnt(0)" ::: "memory");
        }
    }
    __syncthreads();
}

struct TItem { const float* W; unsigned char* WT; int K, N, k0, n0, drow, f8; };
__device__ __forceinline__ void ti_load(const TItem& t, float4 (&v)[8], int lane) {
#pragma unroll
    for (int i = 0; i < 8; ++i) v[i] = *(const float4*)(t.W + (size_t)(t.k0 + 8 * i + (lane >> 3)) * t.N + t.n0 + (lane & 7) * 4);
}
__device__ __forceinline__ void ti_store(const TItem& t, const float4 (&v)[8], LAS float* scr, int lane) {
#pragma unroll
    for (int i = 0; i < 8; ++i) { LAS float* p = scr + (8 * i + (lane >> 3)) * 33 + (lane & 7) * 4; p[0] = v[i].x; p[1] = v[i].y; p[2] = v[i].z; p[3] = v[i].w; }
    asm volatile("s_waitcnt lgkmcnt(0)" ::: "memory");
    const int c = lane & 7;
#pragma unroll
    for (int j = 0; j < 4; ++j) { const int n = (lane >> 3) + 8 * j; const LAS float* s = scr + (8 * c) * 33 + n;
        if (t.f8) { u32x2 o; o.x = cvt4_fp8(s[0 * 33] * W8_SCALE, s[1 * 33] * W8_SCALE, s[2 * 33] * W8_SCALE, s[3 * 33] * W8_SCALE); o.y = cvt4_fp8(s[4 * 33] * W8_SCALE, s[5 * 33] * W8_SCALE, s[6 * 33] * W8_SCALE, s[7 * 33] * W8_SCALE);
            *(u32x2*)(t.WT + (size_t)(t.drow + n) * t.K + t.k0 + 8 * c) = o; }
        else { u32x4 o; o.x = pk2(s[0 * 33], s[1 * 33]); o.y = pk2(s[2 * 33], s[3 * 33]); o.z = pk2(s[4 * 33], s[5 * 33]); o.w = pk2(s[6 * 33], s[7 * 33]);
            *(u32x4*)(t.WT + ((size_t)(t.drow + n) * t.K + t.k0 + 8 * c) * 2) = o; } }
    asm volatile("s_waitcnt lgkmcnt(0)" ::: "memory");
}
struct WPtrs { const float *w_in, *w_out, *gate, *plew, *ew1, *ew3, *ew2, *sw1, *sw3, *sw2, *rw, *lwa, *lwx; bf16_t* lru_wg; };
template <bool F8, bool F8DN>
__device__ __forceinline__ void convert_weights(unsigned char* ldsb, const WPtrs& P, unsigned char* wsw, int gw, int NGW, int wave, int lane) {
    LAS float* scr0 = (LAS float*)((LAS unsigned char*)ldsb + wave * 16896); LAS float* scr1 = scr0 + 2112;
    unsigned char* WIN = wsw + WO_WIN; unsigned char* WOUT = wsw + WO_WOUT; unsigned char* GATE = wsw + WO_GATE; unsigned char* PLEW = wsw + WO_PLEW;
    unsigned char* W2 = wsw + WO_W2; unsigned char* W13 = wsw + WO_W13; bf16_t* ROUT = (bf16_t*)(wsw + WO_ROUT);
    constexpr int I_IN = (D / 64) * (IN_COLS / 32), I_OUT = (D / 64) * (D / 32), I_GATE = I_OUT, I_PLE = (PLE / 64) * (D / 32), I_W2 = (EF / 64) * (D / 32), I_W13 = (D / 64) * (EF / 32), I_R = (D / 64) * (NE / 32);
    constexpr int NITEMS = I_R + I_IN + I_OUT + I_GATE + I_PLE + 65 * I_W2 + 65 * 2 * I_W13;
    auto decode = [&](int it) -> TItem { TItem t; int r = it; t.f8 = 0;
        if (r < I_R) { const int nb = NE / 32; t.W = P.rw; t.WT = (unsigned char*)ROUT; t.K = D; t.N = NE; t.k0 = 64 * (r / nb); t.n0 = 32 * (r % nb); t.drow = t.n0; return t; } r -= I_R;
        if (r < I_IN) { const int nb = IN_COLS / 32; t.W = P.w_in; t.WT = WIN; t.K = D; t.N = IN_COLS; t.k0 = 64 * (r / nb); t.n0 = 32 * (r % nb); t.drow = t.n0; return t; } r -= I_IN;
        if (r < I_OUT) { const int nb = D / 32; t.W = P.w_out; t.WT = WOUT; t.K = D; t.N = D; t.k0 = 64 * (r / nb); t.n0 = 32 * (r % nb); t.drow = t.n0; return t; } r -= I_OUT;
        if (r < I_GATE) { const int nb = D / 32; t.W = P.gate; t.WT = GATE; t.K = D; t.N = D; t.k0 = 64 * (r / nb); t.n0 = 32 * (r % nb); t.drow = t.n0; t.f8 = F8 ? 1 : 0; return t; } r -= I_GATE;
        if (r < I_PLE) { const int nb = D / 32; t.W = P.plew; t.WT = PLEW; t.K = PLE; t.N = D; t.k0 = 64 * (r / nb); t.n0 = 32 * (r % nb); t.drow = t.n0; return t; } r -= I_PLE;
        if (r < 65 * I_W2) { const int e = r / I_W2, q = r % I_W2, nb = D / 32; t.W = (e < 64) ? P.ew2 + (size_t)e * EF * D : P.sw2; t.f8 = F8DN ? 1 : 0;
            t.WT = W2 + (size_t)e * D * EF * (F8DN ? 1 : 2); t.K = EF; t.N = D; t.k0 = 64 * (q / nb); t.n0 = 32 * (q % nb); t.drow = t.n0; return t; } r -= 65 * I_W2;
        { const int e = r / (2 * I_W13), q2 = r % (2 * I_W13), mth = q2 / I_W13, q = q2 % I_W13, nb = EF / 32; const int n0 = 32 * (q % nb);
          t.W = (e < 64) ? (mth ? P.ew3 : P.ew1) + (size_t)e * D * EF : (mth ? P.sw3 : P.sw1); t.f8 = F8 ? 1 : 0;
          t.WT = W13 + (size_t)e * 1024 * D * (F8 ? 1 : 2); t.K = D; t.N = EF; t.k0 = 64 * (q / nb); t.n0 = n0; t.drow = 256 * (n0 >> 7) + 128 * mth + (n0 & 127); return t; } };
    for (int it = gw; it < NITEMS; it += 2 * NGW) {
        const TItem t0 = decode(it); const bool two = it + NGW < NITEMS; const TItem t1 = decode(two ? it + NGW : it);
        float4 v0[8], v1[8];
        ti_load(t0, v0, lane); if (two) ti_load(t1, v1, lane);
        ti_store(t0, v0, scr0, lane); if (two) ti_store(t1, v1, scr1, lane);
    }
    for (int i = gw * 64 + lane; i < 8 * 128 * 64; i += NGW * 64) { const int hh = i >> 13, jj = (i >> 6) & 127, ii = i & 63;
        P.lru_wg[i] = f2bf((jj < 64) ? P.lwa[(hh * 64 + ii) * 64 + jj] : P.lwx[(hh * 64 + ii) * 64 + jj - 64]); }
    for (int i = gw * 64 + lane; i < (256 - NE) * D * 2 / 16; i += NGW * 64) ((u32x4*)(ROUT + (size_t)NE * D))[i] = (u32x4){0u, 0u, 0u, 0u};
}
__device__ __forceinline__ void convert_rows(const float* src, bf16_t* dst, size_t n, size_t gtid, size_t nthr) {
    for (size_t i = gtid * 8; i < n; i += nthr * 32) {
        float4 a[4], b[4];
#pragma unroll
        for (int r = 0; r < 4; ++r) { a[r] = *(const float4*)(src + i + r * nthr * 8); b[r] = *(const float4*)(src + i + r * nthr * 8 + 4); }
#pragma unroll
        for (int r = 0; r < 4; ++r) { u32x4 o; o.x = cvt_pk_bf16(a[r].x, a[r].y); o.y = cvt_pk_bf16(a[r].z, a[r].w); o.z = cvt_pk_bf16(b[r].x, b[r].y); o.w = cvt_pk_bf16(b[r].z, b[r].w); *(u32x4*)(dst + i + r * nthr * 8) = o; }
    }
}

__device__ __forceinline__ void acc8(float (&v)[8], const u32x4 a) { v[0] += bflo(a.x); v[1] += bfhi(a.x); v[2] += bflo(a.y); v[3] += bfhi(a.y); v[4] += bflo(a.z); v[5] += bfhi(a.z); v[6] += bflo(a.w); v[7] += bfhi(a.w); }
__device__ __forceinline__ void ln_finish(float (&v)[4][8], const float* gain, const float* bias, float* outf, bf16_t* xb, int lane, unsigned char* x8 = nullptr) {
    float s = 0.f;
#pragma unroll
    for (int j = 0; j < 4; ++j)
#pragma unroll
        for (int e = 0; e < 8; ++e) s += v[j][e];
    const float mean = wave_sum(s) * (1.f / D); float q = 0.f;
#pragma unroll
    for (int j = 0; j < 4; ++j)
#pragma unroll
        for (int e = 0; e < 8; ++e) { v[j][e] -= mean; q += v[j][e] * v[j][e]; }
    const float rstd = rsqf_(wave_sum(q) * (1.f / D) + 1e-5f);
#pragma unroll
    for (int j = 0; j < 4; ++j) { const int c0 = 8 * (lane + 64 * j); const float4 g0 = *(const float4*)(gain + c0), g1 = *(const float4*)(gain + c0 + 4), b0 = *(const float4*)(bias + c0), b1 = *(const float4*)(bias + c0 + 4);
        float4 o0, o1; o0.x = v[j][0] * rstd * g0.x + b0.x; o0.y = v[j][1] * rstd * g0.y + b0.y; o0.z = v[j][2] * rstd * g0.z + b0.z; o0.w = v[j][3] * rstd * g0.w + b0.w;
        o1.x = v[j][4] * rstd * g1.x + b1.x; o1.y = v[j][5] * rstd * g1.y + b1.y; o1.z = v[j][6] * rstd * g1.z + b1.z; o1.w = v[j][7] * rstd * g1.w + b1.w;
        if (outf) { *(float4*)(outf + c0) = o0; *(float4*)(outf + c0 + 4) = o1; }
        if (xb) { u32x4 w; w.x = cvt_pk_bf16(o0.x, o0.y); w.y = cvt_pk_bf16(o0.z, o0.w); w.z = cvt_pk_bf16(o1.x, o1.y); w.w = cvt_pk_bf16(o1.z, o1.w); *(u32x4*)(xb + c0) = w; }
        if (x8) { u32x2 w; w.x = cvt4_fp8(o0.x, o0.y, o0.z, o0.w); w.y = cvt4_fp8(o1.x, o1.y, o1.z, o1.w); *(u32x2*)(x8 + c0) = w; } }
}
__device__ __forceinline__ void ln1_rows2(const bf16_t* z0, const bf16_t* z1, const float* gain, const float* bias, bf16_t* xb0, bf16_t* xb1, int lane, unsigned char* x80 = nullptr, unsigned char* x81 = nullptr) {
    u32x4 a[2][4], x[2][4];
#pragma unroll
    for (int j = 0; j < 4; ++j) { a[0][j] = *(const u32x4*)(z0 + 8 * (lane + 64 * j)); a[1][j] = *(const u32x4*)(z1 + 8 * (lane + 64 * j)); x[0][j] = *(const u32x4*)(xb0 + 8 * (lane + 64 * j)); x[1][j] = *(const u32x4*)(xb1 + 8 * (lane + 64 * j)); }
#pragma unroll
    for (int r = 0; r < 2; ++r) { float v[4][8];
#pragma unroll
        for (int j = 0; j < 4; ++j) {
#pragma unroll
            for (int e = 0; e < 8; ++e) v[j][e] = 0.f;
            acc8(v[j], x[r][j]);
#pragma unroll
            for (int e = 0; e < 8; ++e) v[j][e] *= ALPHA;
            acc8(v[j], a[r][j]); }
        ln_finish(v, gain, bias, nullptr, r ? xb1 : xb0, lane, r ? x81 : x80); }
}
__device__ __forceinline__ void ln2_row(const bf16_t* x1, const float* gain, const float* bias, float* outf, bf16_t* xb, const bf16_t* yrows, const bf16_t* yp, const bf16_t* ysh, int lane) {
    u32x4 a[3][4], y[8][4];
#pragma unroll
    for (int j = 0; j < 4; ++j) { const int c0 = 8 * (lane + 64 * j); a[0][j] = *(const u32x4*)(x1 + c0); a[1][j] = *(const u32x4*)(yp + c0); a[2][j] = *(const u32x4*)(ysh + c0); }
#pragma unroll
    for (int k = 0; k < TOPK; ++k)
#pragma unroll
        for (int j = 0; j < 4; ++j) y[k][j] = *(const u32x4*)(yrows + (size_t)k * D + 8 * (lane + 64 * j));
    float v[4][8];
#pragma unroll
    for (int j = 0; j < 4; ++j) {
#pragma unroll
        for (int e = 0; e < 8; ++e) v[j][e] = 0.f;
        acc8(v[j], a[0][j]);
#pragma unroll
        for (int e = 0; e < 8; ++e) v[j][e] *= ALPHA;
        acc8(v[j], a[1][j]); acc8(v[j], a[2][j]);
#pragma unroll
        for (int k = 0; k < TOPK; ++k) acc8(v[j], y[k][j]); }
    ln_finish(v, gain, bias, outf, xb, lane);
}
__device__ __forceinline__ void acc16_fp8(float (&v)[16], const u32x4 a) {
    const unsigned w[4] = {a.x, a.y, a.z, a.w};
#pragma unroll
    for (int i = 0; i < 4; ++i) { typedef float f2_ __attribute__((ext_vector_type(2))); const f2_ lo = __builtin_amdgcn_cvt_pk_f32_fp8((int)w[i], false), hi = __builtin_amdgcn_cvt_pk_f32_fp8((int)w[i], true);
        v[4 * i] += lo[0]; v[4 * i + 1] += lo[1]; v[4 * i + 2] += hi[0]; v[4 * i + 3] += hi[1]; }
}
__device__ __forceinline__ void ln2_row8(const bf16_t* x1, const float* gain, const float* bias, float* outf, bf16_t* xb, const unsigned char* yrows, const unsigned char* yp, const unsigned char* ysh, int lane_) {
    unsigned lane = (unsigned)lane_; asm volatile("" : "+v"(lane));
    float v[2][16]; float s = 0.f;
#pragma unroll
    for (int j = 0; j < 2; ++j) {
        const unsigned c0 = 16u * (lane + 64u * j);
        u32x4 y[10], xa[2];
        y[0] = *(const u32x4*)(ysh + c0); y[9] = *(const u32x4*)(yp + c0);
#pragma unroll
        for (int k = 0; k < TOPK; ++k) y[1 + k] = *(const u32x4*)(yrows + (size_t)k * D + c0);
        xa[0] = *(const u32x4*)(x1 + c0); xa[1] = *(const u32x4*)(x1 + c0 + 8);
        float e[16];
#pragma unroll
        for (int i = 0; i < 16; ++i) e[i] = 0.f;
#pragma unroll
        for (int k = 0; k < 10; ++k) acc16_fp8(e, y[k]);
#pragma unroll
        for (int hh = 0; hh < 2; ++hh) { float x8[8];
#pragma unroll
            for (int i = 0; i < 8; ++i) x8[i] = 0.f;
            acc8(x8, xa[hh]);
#pragma unroll
            for (int i = 0; i < 8; ++i) { v[j][8 * hh + i] = ALPHA * x8[i] + e[8 * hh + i] * (1.0f / Y8_SCALE); s += v[j][8 * hh + i]; } }
        if (j == 0) asm volatile("" ::: "memory");
    }
    const float mean = wave_sum(s) * (1.f / D); float q = 0.f;
#pragma unroll
    for (int j = 0; j < 2; ++j)
#pragma unroll
        for (int i = 0; i < 16; ++i) { v[j][i] -= mean; q += v[j][i] * v[j][i]; }
    const float rstd = rsqf_(wave_sum(q) * (1.f / D) + 1e-5f);
#pragma unroll
    for (int j = 0; j < 2; ++j) { const unsigned c0 = 16u * (lane + 64u * j); float o[16];
#pragma unroll
        for (int i4 = 0; i4 < 4; ++i4) { const float4 g = *(const float4*)(gain + c0 + 4 * i4), b = *(const float4*)(bias + c0 + 4 * i4);
            o[4 * i4] = v[j][4 * i4] * rstd * g.x + b.x; o[4 * i4 + 1] = v[j][4 * i4 + 1] * rstd * g.y + b.y; o[4 * i4 + 2] = v[j][4 * i4 + 2] * rstd * g.z + b.z; o[4 * i4 + 3] = v[j][4 * i4 + 3] * rstd * g.w + b.w;
            if (outf) *(float4*)(outf + c0 + 4 * i4) = make_float4(o[4 * i4], o[4 * i4 + 1], o[4 * i4 + 2], o[4 * i4 + 3]); }
        if (xb) { u32x4 w0, w1; w0.x = cvt_pk_bf16(o[0], o[1]); w0.y = cvt_pk_bf16(o[2], o[3]); w0.z = cvt_pk_bf16(o[4], o[5]); w0.w = cvt_pk_bf16(o[6], o[7]);
            w1.x = cvt_pk_bf16(o[8], o[9]); w1.y = cvt_pk_bf16(o[10], o[11]); w1.z = cvt_pk_bf16(o[12], o[13]); w1.w = cvt_pk_bf16(o[14], o[15]); *(u32x4*)(xb + c0) = w0; *(u32x4*)(xb + c0 + 8) = w1; } }
}
constexpr int AT_KS = 72, AT_VS = 264, AT_PS = 168;
constexpr int AT_LDS_K = 0, AT_LDS_V = 256 * AT_KS * 2, AT_LDS_P = AT_LDS_V + (64 * AT_VS + 64) * 2, AT_LDS_SS = AT_LDS_P + 8 * 16 * AT_PS * 2, AT_LDS_CS = AT_LDS_SS + 8 * 128 * 4, AT_LDS_BYTES = AT_LDS_CS + 128 * 16 * 4;
static_assert(AT_LDS_BYTES <= RING_BYTES, "attention LDS");
struct RotTab { double invf[8]; };
__device__ __forceinline__ void attn_unit(const int wv, unsigned char* lds, int u, const bf16_t* HIN, const int* positions, const float* sinks, bf16_t* MIX, float* SSQ, const RotTab& rt) {
    bf16_t* Ks = (bf16_t*)(lds + AT_LDS_K); bf16_t* Vt = (bf16_t*)(lds + AT_LDS_V); bf16_t* Ps = (bf16_t*)(lds + AT_LDS_P); float* SS = (float*)(lds + AT_LDS_SS); float* CS = (float*)(lds + AT_LDS_CS);
    const int g = u & 1, n = (u >> 1) & 31, b = u >> 6;
    const int tid = opaque_tid(wv), lane = tid & 63, w = tid >> 6;
    __syncthreads();
    {
        const int j = tid >> 1, half = tid & 1; const int kp = 128 * (n - 1) + j;
        u32x4 kv[4], vv[4];
        if (kp >= 0) {
            const bf16_t* kr = HIN + (size_t)(b * SEQ + kp) * IN_COLS + C_AK + g * 64 + half * 32;
            const bf16_t* vr = HIN + (size_t)(b * SEQ + kp) * IN_COLS + C_AV + g * 64 + half * 32;
#pragma unroll
            for (int i = 0; i < 4; ++i) { kv[i] = *(const u32x4*)(kr + 8 * i); vv[i] = *(const u32x4*)(vr + 8 * i); }
            if (half == 0) {
                const float pos = (float)positions[b * SEQ + kp];
                float t1[8], t2[8];
                t1[0] = bflo(kv[0].x); t1[1] = bfhi(kv[0].x); t1[2] = bflo(kv[0].y); t1[3] = bfhi(kv[0].y); t1[4] = bflo(kv[0].z); t1[5] = bfhi(kv[0].z); t1[6] = bflo(kv[0].w); t1[7] = bfhi(kv[0].w);
                t2[0] = bflo(kv[1].x); t2[1] = bfhi(kv[1].x); t2[2] = bflo(kv[1].y); t2[3] = bfhi(kv[1].y); t2[4] = bflo(kv[1].z); t2[5] = bfhi(kv[1].z); t2[6] = bflo(kv[1].w); t2[7] = bfhi(kv[1].w);
#pragma unroll
                for (int i = 0; i < 8; ++i) { float sn, cs; sincos_pos(pos, rt.invf[i], sn, cs); const float a = t1[i] * cs - t2[i] * sn, bb = t2[i] * cs + t1[i] * sn; t1[i] = a; t2[i] = bb;
                    if (j >= 128) { CS[(j - 128) * 16 + i] = cs; CS[(j - 128) * 16 + 8 + i] = sn; } }
                kv[0].x = cvt_pk_bf16(t1[0], t1[1]); kv[0].y = cvt_pk_bf16(t1[2], t1[3]); kv[0].z = cvt_pk_bf16(t1[4], t1[5]); kv[0].w = cvt_pk_bf16(t1[6], t1[7]);
                kv[1].x = cvt_pk_bf16(t2[0], t2[1]); kv[1].y = cvt_pk_bf16(t2[2], t2[3]); kv[1].z = cvt_pk_bf16(t2[4], t2[5]); kv[1].w = cvt_pk_bf16(t2[6], t2[7]);
            }
        } else {
#pragma unroll
            for (int i = 0; i < 4; ++i) { kv[i] = (u32x4){0u, 0u, 0u, 0u}; vv[i] = (u32x4){0u, 0u, 0u, 0u}; }
        }
#pragma unroll
        for (int i = 0; i < 4; ++i) *(u32x4*)(Ks + j * AT_KS + half * 32 + 8 * i) = kv[i];
#pragma unroll
        for (int i = 0; i < 4; ++i) { const int d = half * 32 + 8 * i;
            Vt[(d + 0) * AT_VS + j] = (bf16_t)(vv[i].x & 0xffff); Vt[(d + 1) * AT_VS + j] = (bf16_t)(vv[i].x >> 16); Vt[(d + 2) * AT_VS + j] = (bf16_t)(vv[i].y & 0xffff); Vt[(d + 3) * AT_VS + j] = (bf16_t)(vv[i].y >> 16);
            Vt[(d + 4) * AT_VS + j] = (bf16_t)(vv[i].z & 0xffff); Vt[(d + 5) * AT_VS + j] = (bf16_t)(vv[i].z >> 16); Vt[(d + 6) * AT_VS + j] = (bf16_t)(vv[i].w & 0xffff); Vt[(d + 7) * AT_VS + j] = (bf16_t)(vv[i].w >> 16); }
        if (tid < 64) {
#pragma unroll
            for (int i = 0; i < 8; ++i) Vt[tid * AT_VS + 256 + i] = 0;
            Vt[64 * AT_VS + tid] = 0;
        }
        for (int i = tid; i < 8 * 16 * 24; i += NTHR) { const int r = i / 24, c = 144 + i % 24; Ps[r * AT_PS + c] = 0; }
    }
    __syncthreads();
    const int hq = g * 8 + w;
    constexpr float LOG2E = 1.4426950408889634f, C2 = 0.125f * LOG2E;
    const float sink2 = sinks[hq] * LOG2E;
    const int lr = lane & 15, lg = lane >> 4;
    bf16_t* Pw = Ps + w * 16 * AT_PS;
    const bf16_t* qbase = HIN + (size_t)(b * SEQ + n * 128 + lr) * IN_COLS + C_AQ + hq * 64 + lg * 8;
    u32x4 nq0 = *(const u32x4*)qbase, nq1 = *(const u32x4*)(qbase + 32);
    for (int qi = 0; qi < 8; ++qi) {
        const int tq = b * SEQ + n * 128 + qi * 16 + lr;
        u32x4 q0 = nq0; const u32x4 q1 = nq1;
        if (qi < 7) { const bf16_t* qn = qbase + (size_t)(qi + 1) * 16 * IN_COLS; nq0 = *(const u32x4*)qn; nq1 = *(const u32x4*)(qn + 32); }
        {
            u32x4 other; other.x = __shfl_xor(q0.x, 16); other.y = __shfl_xor(q0.y, 16); other.z = __shfl_xor(q0.z, 16); other.w = __shfl_xor(q0.w, 16);
            if (lg < 2) {
                const float4 c0 = *(const float4*)(CS + (qi * 16 + lr) * 16), c1 = *(const float4*)(CS + (qi * 16 + lr) * 16 + 4), s0 = *(const float4*)(CS + (qi * 16 + lr) * 16 + 8), s1 = *(const float4*)(CS + (qi * 16 + lr) * 16 + 12);
                const float cs[8] = {c0.x, c0.y, c0.z, c0.w, c1.x, c1.y, c1.z, c1.w}; const float sn[8] = {s0.x, s0.y, s0.z, s0.w, s1.x, s1.y, s1.z, s1.w};
                float mv[8], ov[8];
                mv[0] = bflo(q0.x); mv[1] = bfhi(q0.x); mv[2] = bflo(q0.y); mv[3] = bfhi(q0.y); mv[4] = bflo(q0.z); mv[5] = bfhi(q0.z); mv[6] = bflo(q0.w); mv[7] = bfhi(q0.w);
                ov[0] = bflo(other.x); ov[1] = bfhi(other.x); ov[2] = bflo(other.y); ov[3] = bfhi(other.y); ov[4] = bflo(other.z); ov[5] = bfhi(other.z); ov[6] = bflo(other.w); ov[7] = bfhi(other.w);
                const float sg = (lg == 0) ? -1.f : 1.f;
#pragma unroll
                for (int i = 0; i < 8; ++i) mv[i] = mv[i] * cs[i] + sg * ov[i] * sn[i];
                q0.x = cvt_pk_bf16(mv[0], mv[1]); q0.y = cvt_pk_bf16(mv[2], mv[3]); q0.z = cvt_pk_bf16(mv[4], mv[5]); q0.w = cvt_pk_bf16(mv[6], mv[7]);
            }
        }
        const bf16x8 qa0 = __builtin_bit_cast(bf16x8, q0), qa1 = __builtin_bit_cast(bf16x8, q1);
        f32x4 s[9];
#pragma unroll
        for (int jt = 0; jt < 9; ++jt) {
            const int jr = (qi + jt) * 16 + lr;
            const bf16x8 kb0 = *(const bf16x8*)(Ks + jr * AT_KS + lg * 8), kb1 = *(const bf16x8*)(Ks + jr * AT_KS + 32 + lg * 8);
            f32x4 a = (f32x4){0.f, 0.f, 0.f, 0.f};
            a = __builtin_amdgcn_mfma_f32_16x16x32_bf16(kb0, qa0, a, 0, 0, 0);
            a = __builtin_amdgcn_mfma_f32_16x16x32_bf16(kb1, qa1, a, 0, 0, 0);
            s[jt] = a;
        }
#pragma unroll
        for (int r = 0; r < 4; ++r) { if (!(4 * lg + r > lr)) s[0][r] = -3.0e38f; if (!(4 * lg + r <= lr)) s[8][r] = -3.0e38f; }
        if (n == 0) {
#pragma unroll
            for (int jt = 0; jt < 8; ++jt) if (qi + jt < 8) s[jt] = (f32x4){-3.0e38f, -3.0e38f, -3.0e38f, -3.0e38f};
        }
        float m = -3.0e38f;
#pragma unroll
        for (int jt = 0; jt < 9; ++jt) m = fmaxf(fmaxf(m, fmaxf(s[jt][0], s[jt][1])), fmaxf(s[jt][2], s[jt][3]));
        m = fmaxf(m, __shfl_xor(m, 16)); m = fmaxf(m, __shfl_xor(m, 32));
        const float m2 = fmaxf(m * C2, sink2);
        float sum = 0.f;
#pragma unroll
        for (int jt = 0; jt < 9; ++jt) {
            f32x4 p;
#pragma unroll
            for (int r = 0; r < 4; ++r) { p[r] = __builtin_amdgcn_exp2f(fmaf(s[jt][r], C2, -m2)); sum += p[r]; }
            u32x2 pk; pk.x = cvt_pk_bf16(p[0], p[1]); pk.y = cvt_pk_bf16(p[2], p[3]);
            *(u32x2*)(Pw + lr * AT_PS + jt * 16 + 4 * lg) = pk;
        }
        sum += __shfl_xor(sum, 16); sum += __shfl_xor(sum, 32);
        const float inv = rcpf_(sum + __builtin_amdgcn_exp2f(sink2 - m2));
        asm volatile("s_waitcnt lgkmcnt(0)" ::: "memory");
        f32x4 o[4];
#pragma unroll
        for (int dt = 0; dt < 4; ++dt) o[dt] = (f32x4){0.f, 0.f, 0.f, 0.f};
#pragma unroll
        for (int ks = 0; ks < 5; ++ks) {
            const bf16x8 pa = *(const bf16x8*)(Pw + lr * AT_PS + ks * 32 + lg * 8);
#pragma unroll
            for (int dt = 0; dt < 4; ++dt) { const bf16x8 vb = *(const bf16x8*)(Vt + (dt * 16 + lr) * AT_VS + qi * 16 + ks * 32 + lg * 8); o[dt] = __builtin_amdgcn_mfma_f32_16x16x32_bf16(vb, pa, o[dt], 0, 0, 0); }
        }
        float q = 0.f;
        bf16_t* orow = MIX + (size_t)tq * D + hq * 64 + 4 * lg;
#pragma unroll
        for (int dt = 0; dt < 4; ++dt) { const f32x4 v = o[dt] * inv; q += (v[0] * v[0] + v[1] * v[1]) + (v[2] * v[2] + v[3] * v[3]);
            u32x2 pk; pk.x = cvt_pk_bf16(v[0], v[1]); pk.y = cvt_pk_bf16(v[2], v[3]); *(u32x2*)(orow + dt * 16) = pk; }
        q += __shfl_xor(q, 16); q += __shfl_xor(q, 32);
        if (lg == 0) SS[w * 128 + qi * 16 + lr] = q;
    }
    __syncthreads();
    if (tid < 128) { float q = 0.f;
#pragma unroll
        for (int ww = 0; ww < 8; ++ww) q += SS[ww * 128 + tid];
        SSQ[(size_t)(b * SEQ + n * 128 + tid) * 2 + g] = q; }
}
__device__ __forceinline__ void attn_fin_rows4(bf16_t* MIX, const float* SSQ, const float* gain, int t, int lane) {
    u32x4 v[4][2]; float sc[4];
#pragma unroll
    for (int r = 0; r < 4; ++r) { const u32x4* p = (const u32x4*)(MIX + (size_t)(t + r) * D) + lane * 2; v[r][0] = p[0]; v[r][1] = p[1]; sc[r] = rsqf_((SSQ[(size_t)(t + r) * 2] + SSQ[(size_t)(t + r) * 2 + 1]) * (1.0f / 1024.f) + 1e-6f); }
    const int c = lane * 16; const float4 g0 = *(const float4*)(gain + c), g1 = *(const float4*)(gain + c + 4), g2 = *(const float4*)(gain + c + 8), g3 = *(const float4*)(gain + c + 12);
#pragma unroll
    for (int r = 0; r < 4; ++r) { u32x4 a = v[r][0], b = v[r][1]; const float s = sc[r];
        a.x = cvt_pk_bf16(bflo(a.x) * s * g0.x, bfhi(a.x) * s * g0.y); a.y = cvt_pk_bf16(bflo(a.y) * s * g0.z, bfhi(a.y) * s * g0.w); a.z = cvt_pk_bf16(bflo(a.z) * s * g1.x, bfhi(a.z) * s * g1.y); a.w = cvt_pk_bf16(bflo(a.w) * s * g1.z, bfhi(a.w) * s * g1.w);
        b.x = cvt_pk_bf16(bflo(b.x) * s * g2.x, bfhi(b.x) * s * g2.y); b.y = cvt_pk_bf16(bflo(b.y) * s * g2.z, bfhi(b.y) * s * g2.w); b.z = cvt_pk_bf16(bflo(b.z) * s * g3.x, bfhi(b.z) * s * g3.y); b.w = cvt_pk_bf16(bflo(b.w) * s * g3.z, bfhi(b.w) * s * g3.w);
        u32x4* p = (u32x4*)(MIX + (size_t)(t + r) * D) + lane * 2; p[0] = a; p[1] = b; }
}

constexpr int HG_S72 = 72, HG_S136 = 136;
__device__ __forceinline__ float hg_lb(const float* lbl, int layer, int col) { if (layer == 0) return 0.f; return sigmoidf_(lbl[512 + col] - lbl[col]); }
constexpr int H1_LDS_KT = 0, H1_LDS_VT = 128 * HG_S72 * 2, H1_LDS_TOT = 2 * 128 * HG_S72 * 2, H1_LDS_BYTES = H1_LDS_TOT + 4 * 128 * 4;
__device__ __forceinline__ void hg1_unit(const int wv, unsigned char* lds, int u, const bf16_t* HIN, const float* lbl, int layer, bf16_t* SST, float* DV) {
    bf16_t* KT = (bf16_t*)(lds + H1_LDS_KT); bf16_t* VT = (bf16_t*)(lds + H1_LDS_VT); float* TOT = (float*)(lds + H1_LDS_TOT);
    const int c = u & 63, h = (u >> 6) & 3, b = u >> 8;
    const int tid = opaque_tid(wv), lane = tid & 63, w = tid >> 6, k = tid & 127, tq = tid >> 7;
    const size_t t0 = (size_t)b * SEQ + c * 64;
    const float lb = hg_lb(lbl, layer, h * 128 + k);
    __syncthreads();
    float bl[16], kf[16]; float cum = 0.f;
#pragma unroll
    for (int i = 0; i < 16; ++i) { const size_t row = (t0 + 16 * tq + i) * IN_COLS; const float fp = bf2f(HIN[row + C_HF + h * 128 + k]);
        const float sg = sigmoidf_(fp); const float f = lb + (1.f - lb) * sg; cum += __logf(fmaxf(f, 1e-30f)); bl[i] = cum; kf[i] = (1.f - lb) * (1.f - sg);
        VT[k * HG_S72 + 16 * tq + i] = HIN[row + C_HI + h * 128 + k]; }
    TOT[tq * 128 + k] = cum;
    __syncthreads();
    float pre = 0.f, total = 0.f;
#pragma unroll
    for (int j = 0; j < 4; ++j) { const float tj = TOT[j * 128 + k]; if (j < tq) pre += tj; total += tj; }
#pragma unroll
    for (int i = 0; i < 16; ++i) KT[k * HG_S72 + 16 * tq + i] = f2bf_hw(kf[i] * __expf(total - (pre + bl[i])));
    if (tq == 0) DV[(size_t)u * 128 + k] = __expf(total);
    __syncthreads();
    const int lr = lane & 15, lg = lane >> 4;
    bf16x8 a[2];
#pragma unroll
    for (int ks = 0; ks < 2; ++ks) a[ks] = *(const bf16x8*)(VT + (w * 16 + lr) * HG_S72 + ks * 32 + lg * 8);
    bf16_t* out = SST + (size_t)u * 16384;
#pragma unroll
    for (int kt = 0; kt < 8; ++kt) {
        f32x4 acc = (f32x4){0.f, 0.f, 0.f, 0.f};
#pragma unroll
        for (int ks = 0; ks < 2; ++ks) { const bf16x8 bb = *(const bf16x8*)(KT + (kt * 16 + lr) * HG_S72 + ks * 32 + lg * 8); acc = __builtin_amdgcn_mfma_f32_16x16x32_bf16(bb, a[ks], acc, 0, 0, 0); }
        { u32x2 pk; pk.x = pk2(acc[0], acc[1]); pk.y = pk2(acc[2], acc[3]); *(u32x2*)(out + (w * 16 + lr) * 128 + kt * 16 + 4 * lg) = pk; }
    }
}
__device__ __forceinline__ void hg2_unit(const int wv, int u, const bf16_t* SST, const float* DV, bf16_t* SPREV) {
    const int bh = u >> 3, part = u & 7, e4 = part * 512 + opaque_tid(wv);
    const int k4 = (e4 & 31) * 4;
    float4 S = make_float4(0.f, 0.f, 0.f, 0.f);
    for (int c0 = 0; c0 < 64; c0 += 4) {
        u32x2 ds[4]; float4 dv[4];
#pragma unroll
        for (int i = 0; i < 4; ++i) { const size_t uu = (size_t)bh * 64 + c0 + i; ds[i] = *((const u32x2*)(SST + uu * 16384) + e4); dv[i] = *(const float4*)(DV + uu * 128 + k4); }
#pragma unroll
        for (int i = 0; i < 4; ++i) { const size_t uu = (size_t)bh * 64 + c0 + i; u32x2 o; o.x = cvt_pk_bf16(S.x, S.y); o.y = cvt_pk_bf16(S.z, S.w); *((u32x2*)(SPREV + uu * 16384) + e4) = o;
            S.x = dv[i].x * S.x + bflo(ds[i].x); S.y = dv[i].y * S.y + bfhi(ds[i].x); S.z = dv[i].z * S.z + bflo(ds[i].y); S.w = dv[i].w * S.w + bfhi(ds[i].y); }
    }
}
constexpr int H3_QI = 0, H3_QE = H3_QI + 64 * HG_S136 * 2, H3_KI = H3_QE + 64 * HG_S136 * 2, H3_VT = H3_KI + 160 * HG_S136 * 2, H3_SB = H3_VT + 128 * HG_S72 * 2,
              H3_SC = H3_SB + 128 * HG_S136 * 2, H3_TOT = H3_SC + 64 * HG_S72 * 2, H3_LDS_BYTES = H3_TOT + 4 * 128 * 4;
constexpr int H3_OB = H3_KI, HG_OS = 132;
static_assert(H3_LDS_BYTES <= MISC_OFF, "HGRN2 LDS");
__device__ __forceinline__ void hg3_unit(const int wv, unsigned char* lds, int u, const bf16_t* HIN, const float* lbl, int layer, const bf16_t* SST, const float* gain, bf16_t* MIX) {
    bf16_t* QI = (bf16_t*)(lds + H3_QI); bf16_t* QE = (bf16_t*)(lds + H3_QE); bf16_t* KI = (bf16_t*)(lds + H3_KI); bf16_t* VT = (bf16_t*)(lds + H3_VT);
    bf16_t* SB = (bf16_t*)(lds + H3_SB); bf16_t* SC = (bf16_t*)(lds + H3_SC); float* TOT = (float*)(lds + H3_TOT); float* OB = (float*)(lds + H3_OB);
    const int c = u & 63, h = (u >> 6) & 3, b = u >> 8;
    const int tid = opaque_tid(wv), lane = tid & 63, w = tid >> 6, k = tid & 127, tq = tid >> 7;
    const size_t t0 = (size_t)b * SEQ + c * 64;
    const float lb = hg_lb(lbl, layer, h * 128 + k);
    const u32x4 g0 = *(const u32x4*)(HIN + (t0 + (tid >> 3)) * IN_COLS + C_HG + h * 128 + (tid & 7) * 16), g1 = *(const u32x4*)(HIN + (t0 + (tid >> 3)) * IN_COLS + C_HG + h * 128 + (tid & 7) * 16 + 8);
    __syncthreads();
    float bl[16], kf[16], qf[16]; float cum = 0.f;
#pragma unroll
    for (int i = 0; i < 16; ++i) { const size_t row = (t0 + 16 * tq + i) * IN_COLS; const float fp = bf2f(HIN[row + C_HF + h * 128 + k]);
        const float sg = sigmoidf_(fp); const float f = lb + (1.f - lb) * sg; cum += __logf(fmaxf(f, 1e-30f)); bl[i] = cum; kf[i] = (1.f - lb) * (1.f - sg);
        qf[i] = siluf_(bf2f(HIN[row + C_HQ + h * 128 + k]));
        VT[k * HG_S72 + 16 * tq + i] = HIN[row + C_HI + h * 128 + k]; }
    TOT[tq * 128 + k] = cum;
    { const u32x4* sp = (const u32x4*)(SST + (size_t)u * 16384);
#pragma unroll
      for (int i = 0; i < 4; ++i) { const int e8 = tid + 512 * i; const u32x4 s8 = sp[e8]; const int v = e8 >> 4, k8 = (e8 & 15) * 8; *(u32x4*)(SB + v * HG_S136 + k8) = s8; } }
    for (int i = tid; i < 64 * HG_S72 / 2; i += NTHR) ((unsigned*)SC)[i] = 0u;
    __syncthreads();
    float rs[4]; { float acc = 0.f;
#pragma unroll
        for (int j = 0; j < 4; ++j) { rs[j] = acc; acc += TOT[j * 128 + k]; } }
    float pre = 0.f;
#pragma unroll
    for (int j = 0; j < 4; ++j) pre = (j == tq) ? rs[j] : pre;
    const float epre = __expf(pre);
    float fk[4];
#pragma unroll
    for (int ii = 0; ii < 4; ++ii) fk[ii] = __expf(fminf(rs[ii] - pre, 0.f));
#pragma unroll
    for (int i = 0; i < 16; ++i) {
        const int s = 16 * tq + i; const float e1 = fmaxf(__expf(bl[i]), 1e-30f), inv = rcpf_(e1);
        const float qi = qf[i] * e1, ki = kf[i] * inv;
        QI[s * HG_S136 + k] = f2bf_hw(qi);
        QE[s * HG_S136 + k] = f2bf_hw(qi * epre);
#pragma unroll
        for (int ii = 0; ii < 4; ++ii) if (ii >= tq) KI[((ii == 0 ? 0 : ii == 1 ? 16 : ii == 2 ? 48 : 96) + s) * HG_S136 + k] = f2bf_hw(ki * fk[ii]);
    }
    __syncthreads();
    const int lr = lane & 15, lg = lane >> 4;
    for (int tix = w; tix < 10; tix += 8) {
        int i, j; if (tix == 0) { i = 0; j = 0; } else if (tix < 3) { i = 1; j = tix - 1; } else if (tix < 6) { i = 2; j = tix - 3; } else { i = 3; j = tix - 6; }
        const int kb = (i == 0 ? 0 : i == 1 ? 16 : i == 2 ? 48 : 96);
        f32x4 acc = (f32x4){0.f, 0.f, 0.f, 0.f};
#pragma unroll
        for (int ks = 0; ks < 4; ++ks) { const bf16x8 a = *(const bf16x8*)(QI + (16 * i + lr) * HG_S136 + ks * 32 + lg * 8); const bf16x8 bb = *(const bf16x8*)(KI + (kb + 16 * j + lr) * HG_S136 + ks * 32 + lg * 8);
            acc = __builtin_amdgcn_mfma_f32_16x16x32_bf16(a, bb, acc, 0, 0, 0); }
#pragma unroll
        for (int r = 0; r < 4; ++r) { const int tr = 4 * lg + r; const float v = (i == j && lr > tr) ? 0.f : acc[r]; SC[(16 * i + tr) * HG_S72 + 16 * j + lr] = f2bf_hw(v); }
    }
    __syncthreads();
    f32x4 o[4];
#pragma unroll
    for (int tt = 0; tt < 4; ++tt) o[tt] = (f32x4){0.f, 0.f, 0.f, 0.f};
#pragma unroll
    for (int ks = 0; ks < 2; ++ks) { const bf16x8 vb = *(const bf16x8*)(VT + (w * 16 + lr) * HG_S72 + ks * 32 + lg * 8);
#pragma unroll
        for (int tt = 0; tt < 4; ++tt) { const bf16x8 a = *(const bf16x8*)(SC + (16 * tt + lr) * HG_S72 + ks * 32 + lg * 8); o[tt] = __builtin_amdgcn_mfma_f32_16x16x32_bf16(a, vb, o[tt], 0, 0, 0); } }
#pragma unroll
    for (int ks = 0; ks < 4; ++ks) { const bf16x8 sb = *(const bf16x8*)(SB + (w * 16 + lr) * HG_S136 + ks * 32 + lg * 8);
#pragma unroll
        for (int tt = 0; tt < 4; ++tt) { const bf16x8 a = *(const bf16x8*)(QE + (16 * tt + lr) * HG_S136 + ks * 32 + lg * 8); o[tt] = __builtin_amdgcn_mfma_f32_16x16x32_bf16(a, sb, o[tt], 0, 0, 0); } }
#pragma unroll
    for (int tt = 0; tt < 4; ++tt)
#pragma unroll
        for (int r = 0; r < 4; ++r) OB[(16 * tt + 4 * lg + r) * HG_OS + w * 16 + lr] = o[tt][r];
    __syncthreads();
    { const int t = tid >> 3, vg = tid & 7; float ov[16]; float q = 0.f;
#pragma unroll
      for (int i = 0; i < 4; ++i) { const float4 x = *(const float4*)(OB + t * HG_OS + vg * 16 + 4 * i); ov[4 * i] = x.x; ov[4 * i + 1] = x.y; ov[4 * i + 2] = x.z; ov[4 * i + 3] = x.w; q += (x.x * x.x + x.y * x.y) + (x.z * x.z + x.w * x.w); }
      q += __shfl_xor(q, 1); q += __shfl_xor(q, 2); q += __shfl_xor(q, 4);
      const float rinv = rsqf_(q * (1.0f / 128.f) + 1e-6f);
      const size_t row = t0 + t; const float* gn = gain + h * 128 + vg * 16;
      u32x4 o0, o1;
      o0.x = pk2(ov[0] * rinv * gn[0] * siluf_(bflo(g0.x)), ov[1] * rinv * gn[1] * siluf_(bfhi(g0.x))); o0.y = pk2(ov[2] * rinv * gn[2] * siluf_(bflo(g0.y)), ov[3] * rinv * gn[3] * siluf_(bfhi(g0.y)));
      o0.z = pk2(ov[4] * rinv * gn[4] * siluf_(bflo(g0.z)), ov[5] * rinv * gn[5] * siluf_(bfhi(g0.z))); o0.w = pk2(ov[6] * rinv * gn[6] * siluf_(bflo(g0.w)), ov[7] * rinv * gn[7] * siluf_(bfhi(g0.w)));
      o1.x = pk2(ov[8] * rinv * gn[8] * siluf_(bflo(g1.x)), ov[9] * rinv * gn[9] * siluf_(bfhi(g1.x))); o1.y = pk2(ov[10] * rinv * gn[10] * siluf_(bflo(g1.y)), ov[11] * rinv * gn[11] * siluf_(bfhi(g1.y)));
      o1.z = pk2(ov[12] * rinv * gn[12] * siluf_(bflo(g1.z)), ov[13] * rinv * gn[13] * siluf_(bfhi(g1.z))); o1.w = pk2(ov[14] * rinv * gn[14] * siluf_(bflo(g1.w)), ov[15] * rinv * gn[15] * siluf_(bfhi(g1.w)));
      bf16_t* op = MIX + row * D + 1024 + h * 128 + vg * 16; *(u32x4*)op = o0; *(u32x4*)(op + 8) = o1; }
}

constexpr int LRU_LDS_X = 0, LRU_LDS_MS = LCH * 516 * 4, LRU_LDS_BYTES = LRU_LDS_MS + LCH * 4;
static_assert(LRU_LDS_BYTES <= RING_BYTES, "LRU LDS");
struct LruW { const float *conv_w, *conv_b, *wa, *ba, *wx, *bx, *lam, *gain; };
constexpr int LRU_XS = 520;
__device__ __forceinline__ void lru1_unit(const int wv, unsigned char* lds, int u, const bf16_t* HIN, const LruW& W, const bf16_t* WG16, float* AGA, float* AGH, bf16_t* HL, bf16_t* PL) {
    bf16_t* XB16 = (bf16_t*)lds;
    const int ch = u % NLCH, b = u / NLCH;
    const int c = opaque_tid(wv);
    const size_t t0 = (size_t)b * SEQ + ch * LCH;
    {
        const int cg8 = (c & 63) * 8, tg = c >> 6;
        u32x4 xr[7];
#pragma unroll
        for (int i = 0; i < 7; ++i) { const int tt = ch * LCH + 4 * tg - 3 + i;
            xr[i] = (tt >= 0) ? *(const u32x4*)(HIN + ((size_t)b * SEQ + tt) * IN_COLS + C_LX + cg8) : (u32x4){0u, 0u, 0u, 0u}; }
        float4 wq[4][2], bq[2];
#pragma unroll
        for (int j = 0; j < 4; ++j) { wq[j][0] = *(const float4*)(W.conv_w + j * 512 + cg8); wq[j][1] = *(const float4*)(W.conv_w + j * 512 + cg8 + 4); }
        bq[0] = *(const float4*)(W.conv_b + cg8); bq[1] = *(const float4*)(W.conv_b + cg8 + 4);
        __syncthreads();
#pragma unroll
        for (int i = 0; i < 4; ++i) { float o[8];
#pragma unroll
            for (int e = 0; e < 8; ++e) o[e] = (e < 4) ? ((const float*)&bq[0])[e] : ((const float*)&bq[1])[e - 4];
#pragma unroll
            for (int j = 0; j < 4; ++j) { const u32x4 x = xr[i + j]; const float xv[8] = {bflo(x.x), bfhi(x.x), bflo(x.y), bfhi(x.y), bflo(x.z), bfhi(x.z), bflo(x.w), bfhi(x.w)};
#pragma unroll
                for (int e = 0; e < 8; ++e) o[e] += xv[e] * ((e < 4) ? ((const float*)&wq[j][0])[e] : ((const float*)&wq[j][1])[e - 4]); }
            u32x4 pk; pk.x = cvt_pk_bf16(o[0], o[1]); pk.y = cvt_pk_bf16(o[2], o[3]); pk.z = cvt_pk_bf16(o[4], o[5]); pk.w = cvt_pk_bf16(o[6], o[7]);
            *(u32x4*)(XB16 + (4 * tg + i) * LRU_XS + cg8) = pk; }
    }
    __syncthreads();
    const int lane = c & 63, h = wv, lr = lane & 15, lg = lane >> 4;
    f32x4 acc[2][8];
#pragma unroll
    for (int mt = 0; mt < 2; ++mt)
#pragma unroll
        for (int nt = 0; nt < 8; ++nt) acc[mt][nt] = (f32x4){0.f, 0.f, 0.f, 0.f};
#pragma unroll
    for (int ks = 0; ks < 2; ++ks) {
        bf16x8 a[2];
#pragma unroll
        for (int mt = 0; mt < 2; ++mt) a[mt] = *(const bf16x8*)(XB16 + (mt * 16 + lr) * LRU_XS + h * 64 + ks * 32 + lg * 8);
#pragma unroll
        for (int nt = 0; nt < 8; ++nt) { const bf16x8 bw = *(const bf16x8*)(WG16 + ((size_t)(h * 128 + nt * 16 + lr) * 64 + ks * 32 + lg * 8));
#pragma unroll
            for (int mt = 0; mt < 2; ++mt) acc[mt][nt] = __builtin_amdgcn_mfma_f32_16x16x32_bf16(a[mt], bw, acc[mt][nt], 0, 0, 0); }
    }
#pragma unroll
    for (int jt = 0; jt < 4; ++jt) {
        const int cc = h * 64 + jt * 16 + lr;
        const float bav = W.ba[cc], bxv = W.bx[cc]; const float lm = W.lam[cc]; const float sp = (lm > 15.f) ? __expf(-lm) : __logf(1.0f + __expf(-lm));
        float Pin = 1.f, Hin = 0.f;
#pragma unroll
        for (int mt = 0; mt < 2; ++mt) {
            float a[4], uu[4];
#pragma unroll
            for (int r = 0; r < 4; ++r) { const float rg = sigmoidf_(acc[mt][jt][r] + bav), ig = sigmoidf_(acc[mt][4 + jt][r] + bxv); const float la = -8.0f * rg * sp; a[r] = __expf(la);
                const float xcv = bf2f(XB16[(mt * 16 + 4 * lg + r) * LRU_XS + cc]); uu[r] = __builtin_amdgcn_sqrtf(fmaxf(1.0f - a[r] * a[r], 0.f)) * (ig * xcv); }
            float A = a[0], H = uu[0];
#pragma unroll
            for (int r = 1; r < 4; ++r) { H = a[r] * H + uu[r]; A *= a[r]; }
            float Ai = A, Hi = H;
            { const float Ap = __shfl_up(Ai, 16), Hp = __shfl_up(Hi, 16); if (lg >= 1) { Hi = Ai * Hp + Hi; Ai = Ai * Ap; } }
            { const float Ap = __shfl_up(Ai, 32), Hp = __shfl_up(Hi, 32); if (lg >= 2) { Hi = Ai * Hp + Hi; Ai = Ai * Ap; } }
            float Ae = __shfl_up(Ai, 16), He = __shfl_up(Hi, 16); if (lg == 0) { Ae = 1.f; He = 0.f; }
            float hs = Ae * Hin + He, ps = Ae * Pin;
            float h4[4], p4[4];
#pragma unroll
            for (int r = 0; r < 4; ++r) { hs = a[r] * hs + uu[r]; ps *= a[r]; h4[r] = hs; p4[r] = ps; }
            { const size_t o = (((size_t)b * NLCH + ch) * 512 + cc) * LCH + mt * 16 + 4 * lg;
              u32x2 hw, pw; hw.x = cvt_pk_bf16(h4[0], h4[1]); hw.y = cvt_pk_bf16(h4[2], h4[3]); pw.x = cvt_pk_bf16(p4[0], p4[1]); pw.y = cvt_pk_bf16(p4[2], p4[3]);
              *(u32x2*)(HL + o) = hw; *(u32x2*)(PL + o) = pw; }
            const float At = __shfl(Ai, 48 + lr), Ht = __shfl(Hi, 48 + lr);
            Hin = At * Hin + Ht; Pin = At * Pin;
        }
        if (lg == 0) { AGA[((size_t)b * NLCH + ch) * 512 + cc] = Pin; AGH[((size_t)b * NLCH + ch) * 512 + cc] = Hin; }
    }
}
__device__ __forceinline__ void lru_carry_unit(const int wv, int b, const float* AGA, float* AGH) {
    const int c = opaque_tid(wv); float carry = 0.f;
    for (int c0 = 0; c0 < NLCH; c0 += 16) {
        float a[16], hh[16];
#pragma unroll
        for (int i = 0; i < 16; ++i) { const size_t o = ((size_t)b * NLCH + c0 + i) * 512 + c; a[i] = AGA[o]; hh[i] = AGH[o]; }
#pragma unroll
        for (int i = 0; i < 16; ++i) { const size_t o = ((size_t)b * NLCH + c0 + i) * 512 + c; AGH[o] = carry; carry = a[i] * carry + hh[i]; }
    }
}
__device__ __forceinline__ void lru2_unit(const int wv, unsigned char* lds, int u, const bf16_t* HIN, const float* gain, const float* CAR, const bf16_t* HL, const bf16_t* PL, bf16_t* MIX) {
    float* XS = (float*)(lds + LRU_LDS_X);
    constexpr int XP = 516;
    const int ch = u % NLCH, b = u / NLCH;
    const int c = opaque_tid(wv);
    const size_t t0 = (size_t)b * SEQ + ch * LCH;
    const float carry = CAR[((size_t)b * NLCH + ch) * 512 + c];
    u32x4 hq[LCH / 8], pq[LCH / 8];
    { const u32x4* hp = (const u32x4*)(HL + (((size_t)b * NLCH + ch) * 512 + c) * LCH); const u32x4* pp = (const u32x4*)(PL + (((size_t)b * NLCH + ch) * 512 + c) * LCH);
#pragma unroll
      for (int q = 0; q < LCH / 8; ++q) { hq[q] = hp[q]; pq[q] = pp[q]; } }
    const int tb = c >> 4, cg = (c & 15) * 32;
    u32x4 gq[4]; float4 gn[8];
    { const u32x4* gp = (const u32x4*)(HIN + (t0 + tb) * IN_COLS + C_LG + cg);
#pragma unroll
      for (int q = 0; q < 4; ++q) gq[q] = gp[q];
#pragma unroll
      for (int q = 0; q < 8; ++q) gn[q] = *(const float4*)(gain + cg + 4 * q); }
    __syncthreads();
#pragma unroll
    for (int q = 0; q < LCH / 8; ++q) { const u32x4 h = hq[q], p = pq[q];
        XS[(8 * q + 0) * XP + c] = bflo(h.x) + bflo(p.x) * carry; XS[(8 * q + 1) * XP + c] = bfhi(h.x) + bfhi(p.x) * carry; XS[(8 * q + 2) * XP + c] = bflo(h.y) + bflo(p.y) * carry; XS[(8 * q + 3) * XP + c] = bfhi(h.y) + bfhi(p.y) * carry;
        XS[(8 * q + 4) * XP + c] = bflo(h.z) + bflo(p.z) * carry; XS[(8 * q + 5) * XP + c] = bfhi(h.z) + bfhi(p.z) * carry; XS[(8 * q + 6) * XP + c] = bflo(h.w) + bflo(p.w) * carry; XS[(8 * q + 7) * XP + c] = bfhi(h.w) + bfhi(p.w) * carry; }
    __syncthreads();
    float hv[32]; float q2 = 0.f;
#pragma unroll
    for (int q = 0; q < 8; ++q) { const float4 x = *(const float4*)(XS + tb * XP + cg + 4 * q); hv[4 * q] = x.x; hv[4 * q + 1] = x.y; hv[4 * q + 2] = x.z; hv[4 * q + 3] = x.w; q2 += (x.x * x.x + x.y * x.y) + (x.z * x.z + x.w * x.w); }
    q2 += __shfl_xor(q2, 1); q2 += __shfl_xor(q2, 2); q2 += __shfl_xor(q2, 4); q2 += __shfl_xor(q2, 8);
    const float rinv = rsqf_(q2 * (1.0f / 512.f) + 1e-6f);
    bf16_t* op = MIX + (t0 + tb) * D + 1536 + cg;
#pragma unroll
    for (int q = 0; q < 4; ++q) { const u32x4 g = gq[q]; const float4 n0 = gn[2 * q], n1 = gn[2 * q + 1]; u32x4 o;
        o.x = cvt_pk_bf16(hv[8 * q + 0] * rinv * n0.x * gelu_tanh(bflo(g.x)), hv[8 * q + 1] * rinv * n0.y * gelu_tanh(bfhi(g.x)));
        o.y = cvt_pk_bf16(hv[8 * q + 2] * rinv * n0.z * gelu_tanh(bflo(g.y)), hv[8 * q + 3] * rinv * n0.w * gelu_tanh(bfhi(g.y)));
        o.z = cvt_pk_bf16(hv[8 * q + 4] * rinv * n1.x * gelu_tanh(bflo(g.z)), hv[8 * q + 5] * rinv * n1.y * gelu_tanh(bfhi(g.z)));
        o.w = cvt_pk_bf16(hv[8 * q + 6] * rinv * n1.z * gelu_tanh(bflo(g.w)), hv[8 * q + 7] * rinv * n1.w * gelu_tanh(bfhi(g.w)));
        *(u32x4*)(op + 8 * q) = o; }
}

__device__ __forceinline__ void router_unit(const int wv, unsigned char* lds, int u, const float* X, const float* W, float* LOG) {
    float* xs = (float*)lds; float* ws = xs + 32 * 68;
    const int tid = opaque_tid(wv), tt = tid >> 4, eg = tid & 15; const size_t t0 = (size_t)u * 32;
    float a0 = 0.f, a1 = 0.f, a2 = 0.f, a3 = 0.f;
    for (int k0 = 0; k0 < D; k0 += 64) {
        const float4 xv = *(const float4*)(X + (t0 + (tid >> 4)) * D + k0 + (tid & 15) * 4);
        const float4 wv0 = *(const float4*)(W + (size_t)(k0 + (tid >> 4)) * 64 + (tid & 15) * 4), wv1 = *(const float4*)(W + (size_t)(k0 + 32 + (tid >> 4)) * 64 + (tid & 15) * 4);
        __syncthreads();
        *(float4*)(xs + (tid >> 4) * 68 + (tid & 15) * 4) = xv; *(float4*)(ws + (tid >> 4) * 64 + (tid & 15) * 4) = wv0; *(float4*)(ws + (32 + (tid >> 4)) * 64 + (tid & 15) * 4) = wv1;
        __syncthreads();
#pragma unroll 16
        for (int kk = 0; kk < 64; ++kk) { const float x = xs[tt * 68 + kk]; const float4 wv = *(const float4*)(ws + kk * 64 + eg * 4); a0 += x * wv.x; a1 += x * wv.y; a2 += x * wv.z; a3 += x * wv.w; }
    }
    *(float4*)(LOG + (t0 + tt) * 64 + eg * 4) = make_float4(a0, a1, a2, a3);
}
__device__ __forceinline__ void route_unit(const int wv, unsigned char* lds, int u, const float* LOG, const float* rbias, int* TKIDX, float* TKGATE, int* CNT) {
    int* hist = (int*)lds;
    const int tid = opaque_tid(wv);
    __syncthreads();
    if (tid < 64) hist[tid] = 0;
    __syncthreads();
    if (tid < RCHUNK) {
        const size_t t = (size_t)u * RCHUNK + tid;
        float sc[64], sel[64];
#pragma unroll
        for (int i = 0; i < 16; ++i) { const float4 v = *(const float4*)(LOG + t * 64 + 4 * i); sc[4 * i] = sigmoidf_(v.x); sc[4 * i + 1] = sigmoidf_(v.y); sc[4 * i + 2] = sigmoidf_(v.z); sc[4 * i + 3] = sigmoidf_(v.w); }
#pragma unroll
        for (int e = 0; e < 64; ++e) sel[e] = sc[e] + rbias[e];
        float gs[8];
#pragma unroll
        for (int g = 0; g < 8; ++g) { float m1 = -3.0e38f, m2 = -3.0e38f;
#pragma unroll
            for (int j = 0; j < 8; ++j) { const float v = sel[8 * g + j]; const float lo = fminf(m1, v); m1 = fmaxf(m1, v); m2 = fmaxf(m2, lo); }
            gs[g] = m1 + m2; }
#pragma unroll
        for (int g = 0; g < 8; ++g) { int rank = 0;
#pragma unroll
            for (int g2 = 0; g2 < 8; ++g2) rank += (gs[g2] > gs[g] || (gs[g2] == gs[g] && g2 < g)) ? 1 : 0;
            if (rank >= 4) {
#pragma unroll
                for (int j = 0; j < 8; ++j) sel[8 * g + j] = -1e30f; } }
        int idx[TOPK]; float wsel[TOPK]; float wsum = 0.f;
#pragma unroll
        for (int k = 0; k < TOPK; ++k) { float best = sel[0]; int bi = 0; float bs = sc[0];
#pragma unroll
            for (int e = 1; e < 64; ++e) { const bool gt = sel[e] > best; best = gt ? sel[e] : best; bi = gt ? e : bi; bs = gt ? sc[e] : bs; }
#pragma unroll
            for (int e = 0; e < 64; ++e) sel[e] = (e == bi) ? -3.0e38f : sel[e];
            idx[k] = bi; wsel[k] = bs; wsum += bs; }
        const float inv = 2.5f / wsum;
        int4 i0 = make_int4(idx[0], idx[1], idx[2], idx[3]), i1 = make_int4(idx[4], idx[5], idx[6], idx[7]);
        *(int4*)(TKIDX + t * TOPK) = i0; *(int4*)(TKIDX + t * TOPK + 4) = i1;
        *(float4*)(TKGATE + t * TOPK) = make_float4(wsel[0] * inv, wsel[1] * inv, wsel[2] * inv, wsel[3] * inv); *(float4*)(TKGATE + t * TOPK + 4) = make_float4(wsel[4] * inv, wsel[5] * inv, wsel[6] * inv, wsel[7] * inv);
#pragma unroll
        for (int k = 0; k < TOPK; ++k) atomicAdd(&hist[idx[k]], 1);
    }
    __syncthreads();
    if (tid < 64) CNT[u * 64 + tid] = hist[tid];
}
__device__ __forceinline__ void assign_unit(const int wv, unsigned char* lds, int chunk, const int* CNT, const int* TKIDX, const float* TKGATE, int* ROWTOK, int* ROWDST, float* ROWGATE, int* TILEE) {
    int* total = (int*)lds; int* mybase = total + 64; int* off = mybase + 64; unsigned* mask = (unsigned*)(off + 80); int* part = (int*)(mask + 256);
    const int tid = opaque_tid(wv);
    __syncthreads();
    if (tid < 256) mask[tid] = 0u;
    { const int e = tid & 63, pt = tid >> 6; int tot = 0, base = 0;
#pragma unroll 8
      for (int cc = pt * (NRCHUNK / 8); cc < (pt + 1) * (NRCHUNK / 8); ++cc) { const int v = CNT[cc * 64 + e]; tot += v; if (cc < chunk) base += v; }
      part[pt * 64 + e] = tot; part[512 + pt * 64 + e] = base; }
    __syncthreads();
    if (tid < 64) { int tot = 0, base = 0;
#pragma unroll
        for (int pt = 0; pt < 8; ++pt) { tot += part[pt * 64 + tid]; base += part[512 + pt * 64 + tid]; } total[tid] = tot; mybase[tid] = base; }
    __syncthreads();
    if (tid == 0) { int o = 0; for (int e = 0; e < 64; ++e) { off[e] = o; o += ((total[e] + 255) / 256) * 256; } off[64] = o; }
    __syncthreads();
    int e_[2]; int tt_[2], k_[2];
#pragma unroll
    for (int r = 0; r < 2; ++r) { const int p = tid + 512 * r; tt_[r] = p >> 3; k_[r] = p & 7; e_[r] = TKIDX[((size_t)chunk * RCHUNK + tt_[r]) * TOPK + k_[r]]; atomicOr(&mask[e_[r] * 4 + (tt_[r] >> 5)], 1u << (tt_[r] & 31)); }
    __syncthreads();
#pragma unroll
    for (int r = 0; r < 2; ++r) { const int e = e_[r], tt = tt_[r]; int rank = 0;
        for (int wd = 0; wd < (tt >> 5); ++wd) rank += __builtin_popcount(mask[e * 4 + wd]);
        rank += __builtin_popcount(mask[e * 4 + (tt >> 5)] & ((1u << (tt & 31)) - 1u));
        const int slot = off[e] + mybase[e] + rank; const int t = chunk * RCHUNK + tt;
        ROWTOK[slot] = t; ROWDST[slot] = t * TOPK + k_[r]; ROWGATE[slot] = TKGATE[(size_t)t * TOPK + k_[r]]; }
    if (chunk < 64) { const int e = chunk; const int lo = off[e] + total[e], hi = off[e + 1]; for (int s = lo + tid; s < hi; s += NTHR) { ROWTOK[s] = -1; ROWDST[s] = -1; ROWGATE[s] = 0.f; } }
    for (int t = chunk * RCHUNK + tid; t < (chunk + 1) * RCHUNK; t += NTHR) { ROWDST[A_PAD + t] = T * TOPK + t; ROWGATE[A_PAD + t] = 1.0f; }
    if (chunk == 0) { const int e = tid >> 3; for (int i = off[e] / 256 + (tid & 7); i < off[e + 1] / 256; i += 8) TILEE[i] = e; if (tid == 0) TILEE[MAXTILES] = off[64] / 256; }
}
#ifndef Y8_FIRST_LAYER
#define Y8_FIRST_LAYER 0
#endif
#ifndef DOWN_STAG
#define DOWN_STAG 0
#endif
#ifndef F8DN_FIRST_LAYER
#define F8DN_FIRST_LAYER 0
#endif
#ifndef F8_FIRST_LAYER
#define F8_FIRST_LAYER 0
#endif
constexpr int PH_PER_LAYER = 14, NPHASE = DEPTH * PH_PER_LAYER;
struct Args { const void* in[32]; float* out; unsigned char* ws; RotTab rt; int ph_lo, ph_hi, sub, pad; };
static_assert(sizeof(Args) == 32 * 8 + 8 + 8 + 64 + 16, "Args has no padding");

template <int l, int SUB>
__device__ __forceinline__ void layer_program(const int wv, const Args& args, unsigned char* lds, unsigned char* ws, float* out, const XcdBarrier& bar, const int lo, const int hi) {
    constexpr int pb = l * PH_PER_LAYER;
    constexpr bool Y8 = (l >= Y8_FIRST_LAYER);
    constexpr bool F8DN = (l >= F8DN_FIRST_LAYER);
    constexpr bool F8 = (l >= F8_FIRST_LAYER);
    if (hi <= pb || lo >= pb + PH_PER_LAYER) return;
    LAS unsigned char* ldsL = (LAS unsigned char*)lds;
    const int G = gridDim.x, bid = blockIdx.x;
    const int NGW = G * NWAVES;
    LAS int* ulist = (LAS int*)(ldsL + ULIST_OFF);
#ifndef PHMASK
#define PHMASK 0x3fff
#endif
#define IN(k) (lo <= (k) && (k) < hi && ((PHMASK >> ((k) % PH_PER_LAYER)) & 1))
#define SEAM(k) do { if (!MK_PER_PHASE && IN(k) && IN((k) + 1)) xcd_barrier(bar); } while (0)
#define TIDS() const int tid = opaque_tid(wv), lane = tid & 63, wave = wv, gw = bid * NWAVES + wave; (void)lane; (void)gw
        if (IN(pb + 0)) {
            TIDS();
            WPtrs P; P.w_in = (const float*)args.in[3] + (size_t)l * D * IN_COLS; P.w_out = (const float*)args.in[4] + (size_t)l * D * D; P.gate = (const float*)args.in[28] + (size_t)l * D * D;
            P.plew = (const float*)args.in[27] + (size_t)l * PLE * D; P.ew1 = (const float*)args.in[21] + (size_t)l * NE * D * EF; P.ew3 = (const float*)args.in[22] + (size_t)l * NE * D * EF;
            P.ew2 = (const float*)args.in[23] + (size_t)l * NE * EF * D; P.sw1 = (const float*)args.in[24] + (size_t)l * D * EF; P.sw3 = (const float*)args.in[25] + (size_t)l * D * EF; P.sw2 = (const float*)args.in[26] + (size_t)l * EF * D; P.rw = (const float*)args.in[19] + (size_t)l * D * NE; P.lwa = (const float*)args.in[11] + (size_t)l * 32768; P.lwx = (const float*)args.in[13] + (size_t)l * 32768; P.lru_wg = (bf16_t*)(ws + WS_LRUW);
            convert_weights<F8, F8DN>(lds, P, ws + WS_W, gw, NGW, wave, lane);
            convert_rows((const float*)args.in[1] + (size_t)l * T * PLE, (bf16_t*)(ws + WS_PB), (size_t)T * PLE, (size_t)bid * NTHR + tid, (size_t)G * NTHR);
            if (l == 0) convert_rows((const float*)args.in[0], (bf16_t*)(ws + WS_XB), (size_t)T * D, (size_t)bid * NTHR + tid, (size_t)G * NTHR);
        }
        SEAM(pb + 0);
        if (IN(pb + 1)) {
            pg8::DenseOrder S; S.init(T, IN_COLS, G, bid, 0);
            const pg8::ListOrder L = pg8::build_list(wv, ulist, ULIST_CAP, S);
            pg8::EpiStoreBf16 E{(bf16_t*)(ws + WS_HIN), IN_COLS, 0};
            pg8::gemm_phase<D, pg8::EpiStoreBf16, pg8::ListOrder, false>(wv, ldsL, (const bf16_t*)(ws + WS_XB), (const bf16_t*)(ws + WS_W + WO_WIN), L, E, nullptr);
        }
        SEAM(pb + 1);
        if (IN(pb + 2)) {
            const bf16_t* HIN = (const bf16_t*)(ws + WS_HIN); bf16_t* MIX = (bf16_t*)(ws + WS_MIX);
            if (!(SUB & 1)) for (int u = bid; u < 512; u += G) attn_unit(wv, lds, u, HIN, (const int*)args.in[2], (const float*)args.in[5] + l * 16, MIX, (float*)(ws + WS_SSQ), args.rt);
            LruW W; W.conv_w = (const float*)args.in[9] + l * 2048; W.conv_b = (const float*)args.in[10] + l * 512; W.wa = (const float*)args.in[11] + (size_t)l * 32768; W.ba = (const float*)args.in[12] + l * 512;
            W.wx = (const float*)args.in[13] + (size_t)l * 32768; W.bx = (const float*)args.in[14] + l * 512; W.lam = (const float*)args.in[15] + l * 512; W.gain = (const float*)args.in[16] + l * 512;
            if (!(SUB & 2)) for (int u = bid; u < BATCH * NLCH; u += G) lru1_unit(wv, lds, u, HIN, W, (const bf16_t*)(ws + WS_LRUW), (float*)(ws + WS_LRUA), (float*)(ws + WS_LRUH), (bf16_t*)(ws + WS_LRUHL), (bf16_t*)(ws + WS_LRUPL));
            if (!(SUB & 4)) for (int u = bid; u < 2048; u += G) hg1_unit(wv, lds, u, HIN, (const float*)args.in[7], l, (bf16_t*)(ws + WS_SST), (float*)(ws + WS_DV));
        }
        SEAM(pb + 2);
        if (IN(pb + 3)) {
            TIDS();
            const bf16_t* HIN = (const bf16_t*)(ws + WS_HIN); bf16_t* MIX = (bf16_t*)(ws + WS_MIX);
            if (!(SUB & 1)) for (int t = 4 * gw; t < T; t += 4 * NGW) attn_fin_rows4(MIX, (const float*)(ws + WS_SSQ), (const float*)args.in[6] + l * 1024, t, lane);
            if (!(SUB & 2)) for (int u = bid; u < 256; u += G) hg2_unit(wv, u, (const bf16_t*)(ws + WS_SST), (const float*)(ws + WS_DV), (bf16_t*)(ws + WS_SPREV));
            if (!(SUB & 4)) for (int u = bid; u < BATCH; u += G) lru_carry_unit(wv, u, (const float*)(ws + WS_LRUA), (float*)(ws + WS_LRUH));
        }
        SEAM(pb + 3);
        if (IN(pb + 4)) {
            if (!(SUB & 1)) for (int u = bid; u < BATCH * NLCH; u += G) lru2_unit(wv, lds, u, (const bf16_t*)(ws + WS_HIN), (const float*)args.in[16] + l * 512, (const float*)(ws + WS_LRUH), (const bf16_t*)(ws + WS_LRUHL), (const bf16_t*)(ws + WS_LRUPL), (bf16_t*)(ws + WS_MIX));
            if (!(SUB & 2))
            for (int u = bid; u < 2048; u += G) hg3_unit(wv, lds, u, (const bf16_t*)(ws + WS_HIN), (const float*)args.in[7], l, (const bf16_t*)(ws + WS_SPREV), (const float*)args.in[8] + l * 512, (bf16_t*)(ws + WS_MIX));
        }
        SEAM(pb + 4);
        if (IN(pb + 5)) {
            pg8::DenseOrder S; S.init(T, D, G, bid, 0);
            const pg8::ListOrder L = pg8::build_list(wv, ulist, ULIST_CAP, S);
            pg8::EpiStoreBf16 E{(bf16_t*)(ws + WS_HIN), D, 0};
            pg8::gemm_phase<D, pg8::EpiStoreBf16, pg8::ListOrder, false>(wv, ldsL, (const bf16_t*)(ws + WS_MIX), (const bf16_t*)(ws + WS_W + WO_WOUT), L, E, nullptr);
        }
        SEAM(pb + 5);
        if (IN(pb + 6)) {
            TIDS();
            const float* g1 = (const float*)args.in[17] + l * D; const float* b1 = (const float*)args.in[18] + l * D; bf16_t* XB = (bf16_t*)(ws + WS_XB); const bf16_t* ZB = (const bf16_t*)(ws + WS_HIN);
            unsigned char* X8 = (unsigned char*)(ws + WS_MIX);
            for (int t = 2 * gw; t < T; t += 2 * NGW) ln1_rows2(ZB + (size_t)t * D, ZB + (size_t)(t + 1) * D, g1, b1, XB + (size_t)t * D, XB + (size_t)(t + 1) * D, lane, F8 ? X8 + (size_t)t * D : nullptr, F8 ? X8 + (size_t)(t + 1) * D : nullptr);
        }
        SEAM(pb + 6);
        if (IN(pb + 7)) {
            if (!(SUB & 1)) { pg8::DenseOrder S; S.init(T, D, G, bid, 0);
              const pg8::ListOrder L = pg8::build_list(wv, ulist, ULIST_CAP, S);
              if constexpr (Y8) { pg8::EpiStore8 E{(unsigned char*)(ws + WS_U), D, 0};
                pg8::gemm_phase<PLE, pg8::EpiStore8, pg8::ListOrder, false>(wv, ldsL, (const bf16_t*)(ws + WS_PB), (const bf16_t*)(ws + WS_W + WO_PLEW), L, E, nullptr); }
              else { pg8::EpiStoreBf16 E{(bf16_t*)(ws + WS_U), D, 0};
                pg8::gemm_phase<PLE, pg8::EpiStoreBf16, pg8::ListOrder, false>(wv, ldsL, (const bf16_t*)(ws + WS_PB), (const bf16_t*)(ws + WS_W + WO_PLEW), L, E, nullptr); } }
            if (!(SUB & 2)) { pg8::DenseOrder S; S.init(T, 256, G, bid, 0);
              const pg8::ListOrder L = pg8::build_list(wv, ulist, ULIST_CAP, S);
              pg8::EpiRouter E{(float*)(ws + WS_LOGITS)};
              pg8::gemm_phase<D, pg8::EpiRouter, pg8::ListOrder, false>(wv, ldsL, (const bf16_t*)(ws + WS_XB), (const bf16_t*)(ws + WS_W + WO_ROUT), L, E, nullptr); }
        }
        SEAM(pb + 7);
        if (IN(pb + 8)) {
            for (int u = bid; u < NRCHUNK; u += G) route_unit(wv, lds, u, (const float*)(ws + WS_LOGITS), (const float*)args.in[20] + l * 64, (int*)(ws + WS_TKIDX), (float*)(ws + WS_TKGATE), (int*)(ws + WS_CNT));
        }
        SEAM(pb + 8);
        if (IN(pb + 9)) {
            for (int u = bid; u < NRCHUNK; u += G) assign_unit(wv, lds, u, (const int*)(ws + WS_CNT), (const int*)(ws + WS_TKIDX), (const float*)(ws + WS_TKGATE), (int*)(ws + WS_ROWTOK), (int*)(ws + WS_ROWDST), (float*)(ws + WS_ROWGATE), (int*)(ws + WS_TILEE));
        }
        SEAM(pb + 9);
        if (IN(pb + 10)) {
            TIDS();
            const int* TILEE = (const int*)(ws + WS_TILEE); const int* ROWTOK = (const int*)(ws + WS_ROWTOK);
            const int ntiles = TILEE[MAXTILES];
            pg8::UpOrder S2; S2.init(TILEE, ntiles, G, bid, 0);
            const pg8::ListOrder L2 = pg8::build_list(wv, ulist, TAB_BYTES / 1024, S2);
            LAS int* gtab = (LAS int*)(ldsL + TAB_OFF);
            if (tid < 256) for (int j = 0; j < L2.n; ++j) { const int orow = ulist[j * 4 + 2]; int r;
                if (orow < A_PAD) { r = ROWTOK[orow + tid]; r = r < 0 ? 0 : r; } else r = orow - A_PAD + tid;
                gtab[j * 256 + tid] = r; }
            __syncthreads();
            if constexpr (F8 && F8DN) { pg8::EpiSwiglu8 E2{(unsigned char*)(ws + WS_HM)};
                pg8::gemm_phase<D, pg8::EpiSwiglu8, pg8::ListOrder, true, (SUB >> 3) & 3, true>(wv, ldsL, (const bf16_t*)(ws + WS_MIX), (const bf16_t*)(ws + WS_W + WO_W13), L2, E2, gtab); }
            else if constexpr (F8) { pg8::EpiSwiglu E2{(bf16_t*)(ws + WS_HM)};
                pg8::gemm_phase<D, pg8::EpiSwiglu, pg8::ListOrder, true, 0, true>(wv, ldsL, (const bf16_t*)(ws + WS_MIX), (const bf16_t*)(ws + WS_W + WO_W13), L2, E2, gtab); }
            else { pg8::EpiSwiglu E2{(bf16_t*)(ws + WS_HM)};
                pg8::gemm_phase<D, pg8::EpiSwiglu, pg8::ListOrder, true>(wv, ldsL, (const bf16_t*)(ws + WS_XB), (const bf16_t*)(ws + WS_W + WO_W13), L2, E2, gtab); }
            if (!(SUB & 4)) { pg8::DenseOrder S; S.init(T, D, G, bid, 0);
              const pg8::ListOrder L = pg8::build_list(wv, ulist, ULIST_CAP, S);
              if constexpr (F8 && Y8) { pg8::EpiGate8 E{(unsigned char*)(ws + WS_U), (const float*)args.in[29] + l * D};
                pg8::gemm_phase<D, pg8::EpiGate8, pg8::ListOrder, false, 0, true>(wv, ldsL, (const bf16_t*)(ws + WS_MIX), (const bf16_t*)(ws + WS_W + WO_GATE), L, E, nullptr); }
              else { pg8::EpiGate E{(bf16_t*)(ws + WS_U), (const float*)args.in[29] + l * D};
                if constexpr (F8) pg8::gemm_phase<D, pg8::EpiGate, pg8::ListOrder, false, 0, true>(wv, ldsL, (const bf16_t*)(ws + WS_MIX), (const bf16_t*)(ws + WS_W + WO_GATE), L, E, nullptr);
                else pg8::gemm_phase<D, pg8::EpiGate, pg8::ListOrder, false>(wv, ldsL, (const bf16_t*)(ws + WS_XB), (const bf16_t*)(ws + WS_W + WO_GATE), L, E, nullptr); } }
        }
        SEAM(pb + 10);
        if (IN(pb + 11)) {
            if (SUB & 2) return;
            const int* TILEE = (const int*)(ws + WS_TILEE);
            const int ntiles = TILEE[MAXTILES];
            pg8::DownOrder2 S3; S3.init(TILEE, ntiles, G, bid);
            const pg8::ListOrder L3 = pg8::build_list(wv, ulist, ULIST_CAP, S3);
            if constexpr (Y8 && F8DN) { pg8::EpiScatter8L E3{(unsigned char*)(ws + WS_Y), (const int*)(ws + WS_ROWDST), (const float*)(ws + WS_ROWGATE), ldsL + ((wv >> 2) ? TAB_OFF : 3 * pg8::HTB)};
                pg8::gemm_phase<EF, pg8::EpiScatter8L, pg8::ListOrder, false, (SUB >> 3) & 3, true, DOWN_STAG>(wv, ldsL, (const bf16_t*)(ws + WS_HM), (const bf16_t*)(ws + WS_W + WO_W2), L3, E3, nullptr); }
            else if constexpr (Y8) { pg8::EpiScatter8 E3{(unsigned char*)(ws + WS_Y), (const int*)(ws + WS_ROWDST), (const float*)(ws + WS_ROWGATE)};
                pg8::gemm_phase<EF, pg8::EpiScatter8, pg8::ListOrder, false, (SUB >> 3) & 3, F8DN, DOWN_STAG>(wv, ldsL, (const bf16_t*)(ws + WS_HM), (const bf16_t*)(ws + WS_W + WO_W2), L3, E3, nullptr); }
            else { pg8::EpiScatter2 E3{(bf16_t*)(ws + WS_Y), (bf16_t*)(ws + WS_W + WO_W13), (const int*)(ws + WS_ROWDST), (const float*)(ws + WS_ROWGATE)};
                pg8::gemm_phase<EF, pg8::EpiScatter2, pg8::ListOrder, false, (SUB >> 3) & 3, F8DN, DOWN_STAG>(wv, ldsL, (const bf16_t*)(ws + WS_HM), (const bf16_t*)(ws + WS_W + WO_W2), L3, E3, nullptr); }
        }
        SEAM(pb + 11);
        if (IN(pb + 13)) {
            TIDS();
            const float* g2 = (const float*)args.in[30] + l * D; const float* b2 = (const float*)args.in[31] + l * D; bf16_t* XB = (bf16_t*)(ws + WS_XB); const bf16_t* Y = (const bf16_t*)(ws + WS_Y);
            if constexpr (Y8) { for (int t = gw; t < T; t += NGW) ln2_row8(XB + (size_t)t * D, g2, b2, (l == DEPTH - 1) ? out + (size_t)t * D : nullptr, (l == DEPTH - 1) ? nullptr : XB + (size_t)t * D, (const unsigned char*)(ws + WS_Y) + (size_t)t * TOPK * D, (const unsigned char*)(ws + WS_U) + (size_t)t * D, (const unsigned char*)(ws + WS_Y) + ((size_t)T * TOPK + t) * D, lane); }
            else { for (int t = gw; t < T; t += NGW) ln2_row(XB + (size_t)t * D, g2, b2, (l == DEPTH - 1) ? out + (size_t)t * D : nullptr, (l == DEPTH - 1) ? nullptr : XB + (size_t)t * D, Y + (size_t)t * TOPK * D, (const bf16_t*)(ws + WS_U) + (size_t)t * D, (const bf16_t*)(ws + WS_W + WO_W13) + (size_t)t * D, lane); }
        }

#undef TIDS
#undef IN
#undef SEAM
}

template <int SUB>
__global__ void __launch_bounds__(NTHR, 2) mega_fwd(Args args) {
    extern __shared__ __attribute__((aligned(16))) unsigned char lds[];
    LAS unsigned char* ldsL = (LAS unsigned char*)lds;
    volatile LAS unsigned* MISC = (volatile LAS unsigned*)(ldsL + MISC_OFF);
    unsigned char* ws = args.ws; float* out = args.out;
    if (threadIdx.x < 32) MISC[threadIdx.x] = 0u;
    __syncthreads();
    XcdBarrier bar; bar.bar = (unsigned*)(ws + WS_CTL) + CW_BAR; bar.x = 0; bar.st = nullptr; bar.w0 = 0;
    if (!MK_PER_PHASE) bar = xcd_barrier_post((unsigned*)(ws + WS_CTL) + CW_BAR, MISC + 8);
    const int lo = args.ph_lo, hi = args.ph_hi;
    const int wv = __builtin_amdgcn_readfirstlane(threadIdx.x >> 6);
    layer_program<0, SUB>(wv, args, lds, ws, out, bar, lo, hi);
    if (!MK_PER_PHASE && lo <= PH_PER_LAYER - 1 && hi > PH_PER_LAYER) xcd_barrier(bar);
    layer_program<1, SUB>(wv, args, lds, ws, out, bar, lo, hi);
}

extern "C" void kernel_launch(void* const* d_in, const int* in_sizes, int n_in, void* d_out, int out_size, void* d_ws, size_t ws_size, hipStream_t stream) {
    static int grid = 0;
    if (grid == 0) {
        if (n_in != 32 || out_size != T * D || ws_size < WS_END) { fprintf(stderr, "kernel_launch: unexpected sizes n_in %d out %d ws %zu (need %zu); nothing launched\n", n_in, out_size, ws_size, (size_t)WS_END); grid = -1; return; }
        int dev = 0, cus = 0, per_cu = 0;
        if (hipGetDevice(&dev) != hipSuccess || hipDeviceGetAttribute(&cus, hipDeviceAttributeMultiprocessorCount, dev) != hipSuccess) { grid = -1; return; }
        if (hipFuncSetAttribute((const void*)mega_fwd<0>, hipFuncAttributeMaxDynamicSharedMemorySize, LDS_BYTES) != hipSuccess) { fprintf(stderr, "kernel_launch: hipFuncSetAttribute failed\n"); grid = -1; return; }
        if (hipOccupancyMaxActiveBlocksPerMultiprocessor(&per_cu, (const void*)mega_fwd<0>, NTHR, LDS_BYTES) != hipSuccess || per_cu < 1) { fprintf(stderr, "kernel_launch: occupancy query reports %d blocks per CU\n", per_cu); }
        (void)hipGetLastError();
        grid = cus;
    }
    if (grid < 0) return;
    if (hipMemsetAsync((char*)d_ws + WS_CTL, 0, CTL_ZERO_BYTES, stream) != hipSuccess) { fprintf(stderr, "kernel_launch: memset failed\n"); return; }
    Args a{};
    for (int i = 0; i < 32; ++i) a.in[i] = d_in[i];
    a.out = (float*)d_out; a.ws = (unsigned char*)d_ws;
    for (int i = 0; i < 8; ++i) a.rt.invf[i] = std::pow(500000.0, -(double)i / 8.0);
#if MK_PER_PHASE
    for (int ph = 0; ph < NPHASE; ++ph) { a.ph_lo = ph; a.ph_hi = ph + 1; hipLaunchKernelGGL(mega_fwd<0>, dim3(grid), dim3(NTHR), LDS_BYTES, stream, a); }
#else
    a.ph_lo = 0; a.ph_hi = NPHASE;
    hipLaunchKernelGGL(mega_fwd<0>, dim3(grid), dim3(NTHR), LDS_BYTES, stream, a);
#endif
#ifdef PROBE_PH
    { static bool once = false; if (!once) { (void)hipFuncSetAttribute((const void*)mega_fwd<PROBE_SUB>, hipFuncAttributeMaxDynamicSharedMemorySize, LDS_BYTES); once = true; }
      const int pl[] = {PROBE_PH}; for (unsigned i = 0; i < sizeof(pl) / sizeof(int); ++i) { a.ph_lo = pl[i]; a.ph_hi = pl[i] + 1; hipLaunchKernelGGL(mega_fwd<PROBE_SUB>, dim3(grid), dim3(NTHR), LDS_BYTES, stream, a); } }
#endif
    const hipError_t le = hipPeekAtLastError();
    if (le != hipSuccess) fprintf(stderr, "kernel_launch: launch failed: %s\n", hipGetErrorName(le));
}
```

```cpp
#include <hip/hip_runtime.h>
#include <cstdio>
#include <cmath>

#ifndef MK_PER_PHASE
#define MK_PER_PHASE 0
#endif

typedef unsigned short bf16_t;
typedef short bf16x8 __attribute__((ext_vector_type(8)));
typedef float f32x4 __attribute__((ext_vector_type(4)));
typedef unsigned u32x4 __attribute__((ext_vector_type(4)));
typedef unsigned u32x2 __attribute__((ext_vector_type(2)));
#define LAS __attribute__((address_space(3)))

constexpr int BATCH = 8, SEQ = 4096, T = BATCH * SEQ, D = 2048, DEPTH = 2, PLE = 256;
constexpr int IN_COLS = 4352;
constexpr int C_AQ = 0, C_AK = 1024, C_AV = 1152, C_HQ = 1280, C_HF = 1792, C_HI = 2304, C_HG = 2816, C_LX = 3328, C_LG = 3840;
constexpr int NE = 64, TOPK = 8, EF = 512;
constexpr int A_ROWS = T * TOPK;
constexpr int MAXTILES = A_ROWS / 256 + NE;
constexpr int A_PAD = MAXTILES * 256;
constexpr float ALPHA = 1.41421356237309515f;
constexpr int RCHUNK = 128, NRCHUNK = T / RCHUNK;
constexpr int LCH = 32, NLCH = SEQ / LCH;

constexpr size_t MiB = 1u << 20;
constexpr size_t WS_CTL = 0, CTL_ZERO_BYTES = 256 * 1024;
constexpr size_t WS_CNT = 1 * MiB;
constexpr size_t WS_TILEE = 2 * MiB;
constexpr size_t WS_LOGITS = 840 * MiB;
constexpr size_t WS_TKIDX = 12 * MiB;
constexpr size_t WS_TKGATE = 13 * MiB;
constexpr size_t WS_ROWTOK = 14 * MiB;
constexpr size_t WS_ROWDST = 16 * MiB;
constexpr size_t WS_ROWGATE = 18 * MiB;
constexpr size_t WS_LRUA = 20 * MiB;
constexpr size_t WS_LRUH = 22 * MiB;
constexpr size_t WS_SSQ = 24 * MiB;
constexpr size_t WS_DV = 25 * MiB;
constexpr size_t WS_LRUW = 26 * MiB;
constexpr size_t WS_Y = 32 * MiB;
constexpr size_t WS_HIN = 32 * MiB;
constexpr size_t WS_MIX = 304 * MiB;
constexpr size_t WS_SST = 432 * MiB;
constexpr size_t WS_PB = 560 * MiB;
constexpr size_t WS_LRUHL = 576 * MiB;
constexpr size_t WS_LRUPL = 640 * MiB;
constexpr size_t WS_SPREV = 768 * MiB;
constexpr size_t WS_XB = 1056 * MiB;
constexpr size_t WS_HM = 1184 * MiB;
constexpr size_t WS_U = 1488 * MiB;
constexpr size_t WS_W = 1616 * MiB;
constexpr size_t WO_WIN = 0, WO_WOUT = 17 * MiB, WO_GATE = 25 * MiB, WO_PLEW = 33 * MiB, WO_W2 = 34 * MiB, WO_W13 = 164 * MiB, WO_ROUT = 424 * MiB, WO_END = 425 * MiB;
constexpr size_t WS_END = WS_W + WO_END;
static_assert((size_t)IN_COLS * D * 2 <= WO_WOUT - WO_WIN && (size_t)65 * 2048 * 512 * 2 <= WO_W13 - WO_W2 && (size_t)65 * 1024 * 2048 * 2 <= WO_ROUT - WO_W13, "weight map");
static_assert(WS_PB + (size_t)T * PLE * 2 <= WS_Y + (size_t)A_ROWS * D * 2 && WS_Y + (size_t)A_ROWS * D * 2 <= WS_XB && WS_HM + (size_t)(A_PAD + T) * EF * 2 <= WS_U, "ws map");

__device__ __forceinline__ int lane_id() { return (int)__builtin_amdgcn_mbcnt_hi(~0u, __builtin_amdgcn_mbcnt_lo(~0u, 0u)); }
__device__ __forceinline__ int opaque_tid(int wv) { int l; asm volatile("v_mbcnt_lo_u32_b32 %0, -1, 0\n\tv_mbcnt_hi_u32_b32 %0, -1, %0" : "=v"(l)); return wv * 64 + l; }
__device__ __forceinline__ bf16_t f2bf(float f) { unsigned u = __float_as_uint(f); u += 0x7fffu + ((u >> 16) & 1u); return (bf16_t)(u >> 16); }
__device__ __forceinline__ float bf2f(bf16_t b) { return __uint_as_float(((unsigned)b) << 16); }
__device__ __forceinline__ float bflo(unsigned w) { return __uint_as_float(w << 16); }
__device__ __forceinline__ float bfhi(unsigned w) { return __uint_as_float(w & 0xffff0000u); }
__device__ __forceinline__ unsigned pk2(float lo, float hi) { return (unsigned)f2bf(lo) | ((unsigned)f2bf(hi) << 16); }
__device__ __forceinline__ unsigned cvt_pk_bf16(float lo, float hi) { unsigned r; asm("v_cvt_pk_bf16_f32 %0, %1, %2" : "=v"(r) : "v"(lo), "v"(hi)); return r; }
__device__ __forceinline__ bf16_t f2bf_hw(float f) { return (bf16_t)(cvt_pk_bf16(f, f) & 0xffffu); }
__device__ __forceinline__ float rcpf_(float x) { return __builtin_amdgcn_rcpf(x); }
__device__ __forceinline__ float rsqf_(float x) { return __builtin_amdgcn_rsqf(x); }
__device__ __forceinline__ float sigmoidf_(float x) { return rcpf_(1.0f + __expf(-x)); }
__device__ __forceinline__ float siluf_(float x) { return x * rcpf_(1.0f + __expf(-x)); }
__device__ __forceinline__ float gelu_tanh(float x) { const float u = 0.7978845608028654f * (x + 0.044715f * x * x * x); const float e = __expf(2.0f * u); const float th = 1.0f - 2.0f * rcpf_(e + 1.0f); return 0.5f * x * (1.0f + th); }
__device__ __forceinline__ float wave_sum(float v) {
#pragma unroll
    for (int o = 1; o < 64; o <<= 1) v += __shfl_xor(v, o);
    return v;
}
__device__ __forceinline__ float clamp8(float x) { return fminf(fmaxf(x, -448.f), 448.f); }
__device__ __forceinline__ unsigned cvt4_fp8(float a, float b, float c, float dd) { int p = __builtin_amdgcn_cvt_pk_fp8_f32(clamp8(a), clamp8(b), 0, false); p = __builtin_amdgcn_cvt_pk_fp8_f32(clamp8(c), clamp8(dd), p, true); return (unsigned)p; }
constexpr float W8_SCALE = 64.f;
constexpr float Y8_SCALE = 16.f;
constexpr int W8_E8M0 = 0x7c7c7c7c, A8_E8M0 = 0x7c7c7c7c;
__device__ __forceinline__ void sincos_pos(float pos, double invf, float& s, float& c) {
    const double a = (double)pos * invf;
    const double q = rint(a * 0.63661977236758134308);
    const float r = (float)(a - q * 1.57079632679489661923);
    const int qi = ((int)q) & 3;
    const float r2 = r * r;
    const float sp = r * (1.0f + r2 * (-1.6666667163e-1f + r2 * (8.3333337680e-3f + r2 * (-1.9841270114e-4f + r2 * 2.7557314297e-6f))));
    const float cp = 1.0f + r2 * (-0.5f + r2 * (4.1666667908e-2f + r2 * (-1.3888889225e-3f + r2 * (2.4801587642e-5f + r2 * -2.7557314297e-7f))));
    const float ss = (qi & 1) ? cp : sp, cc = (qi & 1) ? sp : cp;
    s = (qi & 2) ? -ss : ss;
    c = ((qi + 1) & 2) ? -cc : cc;
}
namespace pg8 {
constexpr int BM = 256, BK = 64, HALF = 128, HTB = HALF * BK * 2, STAGE_BYTES = 8 * HTB, NXCD = 8, WGM = 8;
__host__ __device__ __forceinline__ int lds_byte(int r, int c) { const int st = (r >> 4) * 2 + (c >> 5), rr = r & 15, cc = c & 31, ob = rr * 64 + cc * 2; return st * 1024 + (ob ^ (((ob >> 9) & 1) << 5)); }
__host__ __device__ __forceinline__ void stage_rc(int b, int& R, int& C) { const int st = b / 1024, sb = b % 1024, swz = sb ^ (((sb >> 9) & 1) << 5); R = (st >> 1) * 16 + swz / 64; C = (st & 1) * 32 + (swz % 64) / 2; }
__host__ __device__ __forceinline__ int perm32(int rho) { const int n = rho >> 4, i = rho & 15; return 8 * (i >> 2) + 4 * n + (i & 3); }

struct Unit { int brow, pn, orow, tab; };

__device__ __forceinline__ int xcd_remap(int L, int nwg) { const int q = nwg / NXCD, r = nwg % NXCD, xcd = L % NXCD, off = L / NXCD; return (xcd < r ? xcd * (q + 1) : r * (q + 1) + (xcd - r) * q) + off; }

struct DenseOrder {
    int nM, nN, nwg, G, c, start;
    __device__ void init(int M, int N, int G_, int c_, int start_) { nM = M / BM; nN = N / BM; nwg = nM * nN; G = G_; c = c_; start = start_ % G_; }
    __device__ bool next(int i, Unit& u) const {
        const long L = (long)(i + (c < start ? 1 : 0)) * G + c - start; if (L >= nwg) return false;
        const int wgid = xcd_remap((int)L, nwg);
        const int nig = WGM * nN, gid = wgid / nig, fm = gid * WGM, gsz = (nM - fm) < WGM ? (nM - fm) : WGM;
        const int pm = fm + ((wgid % nig) % gsz); u.pn = (wgid % nig) / gsz; u.orow = pm * BM; u.brow = u.pn * BM; u.tab = 0; return true;
    }
};
struct RouterSplitOrder {
    int G, c;
    __device__ void init(int G_, int c_) { G = G_; c = c_; }
    __device__ bool next(int i, Unit& u) const { const long L = (long)i * G + c; if (L >= 2 * (T / BM)) return false;
        u.orow = (int)(L >> 1) * BM; u.brow = 0; u.pn = 0; u.tab = (int)(L & 1); return true; }
};
struct UpOrder {
    const int* tile_e; int ntiles, nwg, G, c, start;
    __device__ void init(const int* te, int nt_, int G_, int c_, int start_) { tile_e = te; ntiles = nt_; nwg = (nt_ + T / BM) * 4; G = G_; c = c_; start = start_ % G_; }
    __device__ bool next(int i, Unit& u) const {
        const long L = (long)(i + (c < start ? 1 : 0)) * G + c - start; if (L >= nwg) return false;
        const int wgid = xcd_remap((int)L, nwg); const int tile = wgid >> 2; u.pn = wgid & 3; u.tab = i;
        if (tile < ntiles) { u.brow = tile_e[tile] * 1024 + u.pn * BM; u.orow = tile * BM; }
        else { u.brow = 64 * 1024 + u.pn * BM; u.orow = A_PAD + (tile - ntiles) * BM; }
        return true;
    }
};
struct DownOrder {
    const int* tile_e; int lo, hi, t0;
    __device__ void init(const int* te, int nt_, int G_, int c_) { tile_e = te; const int n = nt_ * 8; const int vc = (G_ % 8 == 0) ? (c_ % 8) * (G_ / 8) + c_ / 8 : c_;
        lo = (int)(((long)vc * n) / G_); hi = (int)(((long)(vc + 1) * n) / G_); t0 = lo >> 3; }
    __device__ bool next(int i, Unit& u) const {
        const int id = lo + i; if (id >= hi) return false;
        const int tile = id >> 3; u.pn = id & 7; u.orow = tile * BM; u.brow = tile_e[tile] * 2048 + u.pn * BM; u.tab = tile - t0; return true;
    }
};

struct DownOrder2 {
    const int* tile_e; int ntiles, lo, hi, gq, pn;
    __device__ void init(const int* te, int nt_, int G_, int c_) { tile_e = te; ntiles = nt_; const int ntot = nt_ + T / BM, x = c_ % NXCD, j = c_ / NXCD, ngrp = (G_ / NXCD) / 8;
        lo = (int)(((long)x * ntot) / NXCD); hi = (int)(((long)(x + 1) * ntot) / NXCD); gq = j >> 3; pn = j & 7; if (gq >= ngrp) hi = lo; stride = ngrp; }
    int stride;
    __device__ bool next(int i, Unit& u) const {
        const int t = lo + gq + stride * i; if (t >= hi) return false;
        u.pn = pn; u.tab = 0;
        if (t < ntiles) { u.brow = tile_e[t] * 2048 + pn * BM; u.orow = t * BM; } else { u.brow = 64 * 2048 + pn * BM; u.orow = A_PAD + (t - ntiles) * BM; }
        return true;
    }
};
struct ListOrder { const LAS int* tab; int n;
    __device__ __forceinline__ bool next(int i, Unit& u) const { if (i >= n) return false; const LAS int* p = tab + i * 4;
        u.brow = __builtin_amdgcn_readfirstlane(p[0]); u.pn = __builtin_amdgcn_readfirstlane(p[1]); u.orow = __builtin_amdgcn_readfirstlane(p[2]); u.tab = __builtin_amdgcn_readfirstlane(p[3]); return true; } };
template <class Sched> __device__ __forceinline__ ListOrder build_list(const int wv, LAS int* tab, int cap, const Sched& S) {
    __syncthreads();
    int n = 0; Unit u;
    for (; n < cap && S.next(n, u); ++n) if (opaque_tid(wv) == 0) { tab[n * 4 + 0] = u.brow; tab[n * 4 + 1] = u.pn; tab[n * 4 + 2] = u.orow; tab[n * 4 + 3] = u.tab; }
    __syncthreads();
    ListOrder L; L.tab = tab; L.n = n; return L;
}

struct EpiStoreBf16 { static constexpr bool PERM = true; bf16_t* O; int ldo; int pad;
    __device__ __forceinline__ void operator()(const f32x4 (&acc)[2][2][4][2], const Unit& u, int wr, int wc, int fr, int fq) const {
        const int row0 = u.orow + wr * 64 + fr, col0 = u.pn * BM + wc * 32 + 8 * fq;
#pragma unroll
        for (int ai = 0; ai < 2; ++ai)
#pragma unroll
            for (int m = 0; m < 4; ++m) { bf16_t* rowp = O + (size_t)(row0 + ai * HALF + m * 16) * ldo + col0;
#pragma unroll
                for (int bj = 0; bj < 2; ++bj) { const f32x4 v0 = acc[ai][bj][m][0], v1 = acc[ai][bj][m][1];
                    u32x4 w; w.x = cvt_pk_bf16(v0[0], v0[1]); w.y = cvt_pk_bf16(v0[2], v0[3]); w.z = cvt_pk_bf16(v1[0], v1[1]); w.w = cvt_pk_bf16(v1[2], v1[3]);
                    *(u32x4*)(rowp + bj * HALF) = w; } }
    } };
struct EpiStoreBf16L { static constexpr bool PERM = true; bf16_t* O; LAS unsigned char* lds; int ldo;
    __device__ __forceinline__ void operator()(const f32x4 (&acc)[2][2][4][2], const Unit& u, int wr, int wc, int fr, int fq) const {
        const int lane = fq * 16 + fr, rr = wc * 8 + (lane >> 5);
        const unsigned wa = (unsigned)(fr * 512 + (((wc * 4 + fq) ^ fr) << 4));
        bf16_t* op = O + (size_t)(u.orow + wr * 64 + rr) * ldo + u.pn * BM + (lane & 31) * 8;
#pragma unroll
        for (int ai = 0; ai < 2; ++ai)
#pragma unroll
            for (int mh = 0; mh < 2; ++mh) {
#pragma unroll
                for (int mp = 0; mp < 2; ++mp)
#pragma unroll
                    for (int bj = 0; bj < 2; ++bj) { const f32x4 v0 = acc[ai][bj][2 * mh + mp][0], v1 = acc[ai][bj][2 * mh + mp][1];
                        u32x4 w; w.x = cvt_pk_bf16(v0[0], v0[1]); w.y = cvt_pk_bf16(v0[2], v0[3]); w.z = cvt_pk_bf16(v1[0], v1[1]); w.w = cvt_pk_bf16(v1[2], v1[3]);
                        *(LAS u32x4*)(lds + (wa ^ (unsigned)((bj ^ mp) << 8)) + mp * 8192) = w; }
                asm volatile("s_waitcnt lgkmcnt(0)" ::: "memory"); __builtin_amdgcn_s_barrier();
                u32x4 rv[4];
#pragma unroll
                for (int i = 0; i < 4; ++i) { const int row = rr + 2 * i; rv[i] = *(const LAS u32x4*)(lds + row * 512 + ((((lane & 31) ^ row) & 31) << 4)); }
#pragma unroll
                for (int i = 0; i < 4; ++i) *(u32x4*)(op + (size_t)(ai * HALF + mh * 32 + 2 * i) * ldo) = rv[i];
                asm volatile("s_waitcnt lgkmcnt(0)" ::: "memory"); __builtin_amdgcn_s_barrier();
            }
    } };
struct EpiStore8 { static constexpr bool PERM = true; unsigned char* O; int ldo; int pad;
    __device__ __forceinline__ void operator()(const f32x4 (&acc)[2][2][4][2], const Unit& u, int wr, int wc, int fr, int fq) const {
        const int row0 = u.orow + wr * 64 + fr, col0 = u.pn * BM + wc * 32 + 8 * fq;
#pragma unroll
        for (int ai = 0; ai < 2; ++ai)
#pragma unroll
            for (int m = 0; m < 4; ++m) { unsigned char* rowp = O + (size_t)(row0 + ai * HALF + m * 16) * ldo + col0;
#pragma unroll
                for (int bj = 0; bj < 2; ++bj) { const f32x4 v0 = acc[ai][bj][m][0], v1 = acc[ai][bj][m][1];
                    u32x2 w; w.x = cvt4_fp8(v0[0], v0[1], v0[2], v0[3]); w.y = cvt4_fp8(v1[0], v1[1], v1[2], v1[3]); *(u32x2*)(rowp + bj * HALF) = w; } }
    } };
struct EpiStore8L { static constexpr bool PERM = true; unsigned char* O; LAS unsigned char* lds; int ldo;
    __device__ __forceinline__ void operator()(const f32x4 (&acc)[2][2][4][2], const Unit& u, int wr, int wc, int fr, int fq) const {
        const unsigned wa = (unsigned)(fr * 256 + (((wc * 2 + (fq >> 1)) ^ fr) << 4) + 8 * (fq & 1));
        const unsigned ra = (unsigned)(wc * 4096 + fq * 256);
        unsigned char* op = O + (size_t)(u.orow + wr * 64 + wc * 16 + fq) * ldo + u.pn * BM + fr * 16;
#pragma unroll
        for (int ai = 0; ai < 2; ++ai) {
#pragma unroll
            for (int m = 0; m < 4; ++m)
#pragma unroll
                for (int bj = 0; bj < 2; ++bj) { const f32x4 v0 = acc[ai][bj][m][0], v1 = acc[ai][bj][m][1];
                    u32x2 w; w.x = cvt4_fp8(v0[0], v0[1], v0[2], v0[3]); w.y = cvt4_fp8(v1[0], v1[1], v1[2], v1[3]); *(LAS u32x2*)(lds + (wa ^ (unsigned)(bj * 128)) + m * 4096) = w; }
            asm volatile("s_waitcnt lgkmcnt(0)" ::: "memory"); __builtin_amdgcn_s_barrier();
            u32x4 rv[4];
#pragma unroll
            for (int i = 0; i < 4; ++i) rv[i] = *(const LAS u32x4*)(lds + ra + i * 1024 + (((fr ^ fq ^ (i << 2)) & 15) << 4));
#pragma unroll
            for (int i = 0; i < 4; ++i) *(u32x4*)(op + (size_t)(ai * HALF + i * 4) * ldo) = rv[i];
            asm volatile("s_waitcnt lgkmcnt(0)" ::: "memory"); __builtin_amdgcn_s_barrier();
        }
    } };
struct EpiGate8 { static constexpr bool PERM = true; unsigned char* U; const float* bias;
    __device__ __forceinline__ void operator()(const f32x4 (&acc)[2][2][4][2], const Unit& u, int wr, int wc, int fr, int fq) const {
        typedef float f2_ __attribute__((ext_vector_type(2)));
        const int row0 = u.orow + wr * 64 + fr, col0 = u.pn * BM + wc * 32 + 8 * fq;
        f32x4 bv[2][2];
#pragma unroll
        for (int bj = 0; bj < 2; ++bj)
#pragma unroll
            for (int n = 0; n < 2; ++n) bv[bj][n] = *(const f32x4*)(bias + col0 + bj * HALF + 4 * n);
#pragma unroll
        for (int ai = 0; ai < 2; ++ai) {
            u32x2 uu[4][2];
#pragma unroll
            for (int m = 0; m < 4; ++m)
#pragma unroll
                for (int bj = 0; bj < 2; ++bj) uu[m][bj] = *(const u32x2*)(U + (size_t)(row0 + ai * HALF + m * 16) * D + col0 + bj * HALF);
#pragma unroll
            for (int m = 0; m < 4; ++m) { unsigned char* rowp = U + (size_t)(row0 + ai * HALF + m * 16) * D + col0;
#pragma unroll
                for (int bj = 0; bj < 2; ++bj) { const u32x2 ux = uu[m][bj];
                    const f2_ u01 = __builtin_amdgcn_cvt_pk_f32_fp8((int)ux.x, false), u23 = __builtin_amdgcn_cvt_pk_f32_fp8((int)ux.x, true), u45 = __builtin_amdgcn_cvt_pk_f32_fp8((int)ux.y, false), u67 = __builtin_amdgcn_cvt_pk_f32_fp8((int)ux.y, true);
                    const f32x4 a0 = acc[ai][bj][m][0] + bv[bj][0], a1 = acc[ai][bj][m][1] + bv[bj][1];
                    u32x2 w; w.x = cvt4_fp8(sigmoidf_(a0[0]) * u01[0] * Y8_SCALE, sigmoidf_(a0[1]) * u01[1] * Y8_SCALE, sigmoidf_(a0[2]) * u23[0] * Y8_SCALE, sigmoidf_(a0[3]) * u23[1] * Y8_SCALE);
                    w.y = cvt4_fp8(sigmoidf_(a1[0]) * u45[0] * Y8_SCALE, sigmoidf_(a1[1]) * u45[1] * Y8_SCALE, sigmoidf_(a1[2]) * u67[0] * Y8_SCALE, sigmoidf_(a1[3]) * u67[1] * Y8_SCALE);
                    *(u32x2*)(rowp + bj * HALF) = w; } }
            asm volatile("" ::: "memory"); }
    } };
struct EpiSwiglu { static constexpr bool PERM = true; bf16_t* H;
    __device__ __forceinline__ void operator()(const f32x4 (&acc)[2][2][4][2], const Unit& u, int wr, int wc, int fr, int fq) const {
        const int row0 = u.orow + wr * 64 + fr, col0 = u.pn * HALF + wc * 32 + 8 * fq;
#pragma unroll
        for (int ai = 0; ai < 2; ++ai)
#pragma unroll
            for (int m = 0; m < 4; ++m) { const f32x4 g0 = acc[ai][0][m][0], g1 = acc[ai][0][m][1], u0 = acc[ai][1][m][0], u1 = acc[ai][1][m][1];
                u32x4 w; w.x = cvt_pk_bf16(siluf_(g0[0]) * u0[0], siluf_(g0[1]) * u0[1]); w.y = cvt_pk_bf16(siluf_(g0[2]) * u0[2], siluf_(g0[3]) * u0[3]);
                w.z = cvt_pk_bf16(siluf_(g1[0]) * u1[0], siluf_(g1[1]) * u1[1]); w.w = cvt_pk_bf16(siluf_(g1[2]) * u1[2], siluf_(g1[3]) * u1[3]);
                *(u32x4*)(H + (size_t)(row0 + ai * HALF + m * 16) * EF + col0) = w; }
    } };
struct EpiSwiglu8 { static constexpr bool PERM = true; unsigned char* H;
    __device__ __forceinline__ void operator()(const f32x4 (&acc)[2][2][4][2], const Unit& u, int wr, int wc, int fr, int fq) const {
        const int row0 = u.orow + wr * 64 + fr, col0 = u.pn * HALF + wc * 32 + 8 * fq;
#pragma unroll
        for (int ai = 0; ai < 2; ++ai)
#pragma unroll
            for (int m = 0; m < 4; ++m) { const f32x4 g0 = acc[ai][0][m][0], g1 = acc[ai][0][m][1], u0 = acc[ai][1][m][0], u1 = acc[ai][1][m][1];
                u32x2 w; w.x = cvt4_fp8(siluf_(g0[0]) * u0[0], siluf_(g0[1]) * u0[1], siluf_(g0[2]) * u0[2], siluf_(g0[3]) * u0[3]);
                w.y = cvt4_fp8(siluf_(g1[0]) * u1[0], siluf_(g1[1]) * u1[1], siluf_(g1[2]) * u1[2], siluf_(g1[3]) * u1[3]);
                *(u32x2*)(H + (size_t)(row0 + ai * HALF + m * 16) * EF + col0) = w; }
    } };
struct EpiSwiglu8L { static constexpr bool PERM = true; unsigned char* H; LAS unsigned char* lds;
    __device__ __forceinline__ void operator()(const f32x4 (&acc)[2][2][4][2], const Unit& u, int wr, int wc, int fr, int fq) const {
        const unsigned wa = (unsigned)((wr * 64 + fr) * 128 + (((wc * 2 + (fq >> 1)) ^ (fr & 7)) << 4) + 8 * (fq & 1));
        const int lane = fq * 16 + fr, rr = (wr * 4 + wc) * 16 + (lane >> 3);
        const unsigned ra = (unsigned)(rr * 128 + (((lane ^ (lane >> 3)) & 7) << 4));
        unsigned char* hp = H + (size_t)(u.orow + rr) * EF + u.pn * HALF + (lane & 7) * 16;
#pragma unroll
        for (int ai = 0; ai < 2; ++ai) {
#pragma unroll
            for (int m = 0; m < 4; ++m) { const f32x4 g0 = acc[ai][0][m][0], g1 = acc[ai][0][m][1], u0 = acc[ai][1][m][0], u1 = acc[ai][1][m][1];
                u32x2 w; w.x = cvt4_fp8(siluf_(g0[0]) * u0[0], siluf_(g0[1]) * u0[1], siluf_(g0[2]) * u0[2], siluf_(g0[3]) * u0[3]);
                w.y = cvt4_fp8(siluf_(g1[0]) * u1[0], siluf_(g1[1]) * u1[1], siluf_(g1[2]) * u1[2], siluf_(g1[3]) * u1[3]);
                *(LAS u32x2*)(lds + wa + m * 2048) = w; }
            asm volatile("s_waitcnt lgkmcnt(0)" ::: "memory"); __builtin_amdgcn_s_barrier();
            const u32x4 r0 = *(const LAS u32x4*)(lds + ra), r1 = *(const LAS u32x4*)(lds + ra + 1024);
            *(u32x4*)(hp + (size_t)(ai * HALF) * EF) = r0; *(u32x4*)(hp + (size_t)(ai * HALF + 8) * EF) = r1;
            asm volatile("s_waitcnt lgkmcnt(0)" ::: "memory"); __builtin_amdgcn_s_barrier();
        }
    } };
struct EpiResid { static constexpr bool PERM = true; const bf16_t* xres; bf16_t* Z; float alpha; int pad;
    __device__ __forceinline__ void operator()(const f32x4 (&acc)[2][2][4][2], const Unit& u, int wr, int wc, int fr, int fq) const {
        const int row0 = u.orow + wr * 64 + fr, col0 = u.pn * BM + wc * 32 + 8 * fq;
#pragma unroll
        for (int ai = 0; ai < 2; ++ai)
#pragma unroll
            for (int m = 0; m < 4; ++m) { const size_t off = (size_t)(row0 + ai * HALF + m * 16) * D + col0;
#pragma unroll
                for (int bj = 0; bj < 2; ++bj) { const u32x4 x = *(const u32x4*)(xres + off + bj * HALF); const f32x4 a0 = acc[ai][bj][m][0], a1 = acc[ai][bj][m][1];
                    u32x4 w; w.x = cvt_pk_bf16(alpha * bflo(x.x) + a0[0], alpha * bfhi(x.x) + a0[1]); w.y = cvt_pk_bf16(alpha * bflo(x.y) + a0[2], alpha * bfhi(x.y) + a0[3]);
                    w.z = cvt_pk_bf16(alpha * bflo(x.z) + a1[0], alpha * bfhi(x.z) + a1[1]); w.w = cvt_pk_bf16(alpha * bflo(x.w) + a1[2], alpha * bfhi(x.w) + a1[3]);
                    *(u32x4*)(Z + off + bj * HALF) = w; }
                asm volatile("" ::: "memory"); }
    } };
struct EpiAccum { static constexpr bool PERM = false; float* xio;
    __device__ __forceinline__ void operator()(const f32x4 (&acc)[2][2][4][2], const Unit& u, int wr, int wc, int fr, int fq) const {
        const int row0 = u.orow + wr * 64 + fr, col0 = u.pn * BM + wc * 32 + 4 * fq;
#pragma unroll
        for (int ai = 0; ai < 2; ++ai)
#pragma unroll
            for (int m = 0; m < 4; ++m) { const size_t off = (size_t)(row0 + ai * HALF + m * 16) * D + col0;
#pragma unroll
                for (int bj = 0; bj < 2; ++bj)
#pragma unroll
                    for (int n = 0; n < 2; ++n) { const f32x4 x = *(const f32x4*)(xio + off + bj * HALF + n * 16); *(f32x4*)(xio + off + bj * HALF + n * 16) = x + acc[ai][bj][m][n]; }
                asm volatile("" ::: "memory"); }
    } };
struct EpiScatter { static constexpr bool PERM = true; bf16_t* Y; const LAS int* tdst; const LAS float* tgate; int nostore; int pad;
    __device__ __forceinline__ void operator()(const f32x4 (&acc)[2][2][4][2], const Unit& u, int wr, int wc, int fr, int fq) const {
        const int r0 = u.tab * BM + wr * 64 + fr, col0 = u.pn * BM + wc * 32 + 8 * fq;
#pragma unroll
        for (int ai = 0; ai < 2; ++ai)
#pragma unroll
            for (int m = 0; m < 4; ++m) { const int dst = tdst[r0 + ai * HALF + m * 16]; const float g = tgate[r0 + ai * HALF + m * 16];
                if (dst >= 0 && !nostore) { bf16_t* rowp = Y + (size_t)dst * D + col0;
#pragma unroll
                    for (int bj = 0; bj < 2; ++bj) { const f32x4 v0 = acc[ai][bj][m][0] * g, v1 = acc[ai][bj][m][1] * g;
                        u32x4 w; w.x = cvt_pk_bf16(v0[0], v0[1]); w.y = cvt_pk_bf16(v0[2], v0[3]); w.z = cvt_pk_bf16(v1[0], v1[1]); w.w = cvt_pk_bf16(v1[2], v1[3]);
                        *(u32x4*)(rowp + bj * HALF) = w; } } }
    } };
struct EpiScatter2 { static constexpr bool PERM = true; bf16_t* Y; bf16_t* YSH; const int* rdst; const float* rgate;
    __device__ __forceinline__ void operator()(const f32x4 (&acc)[2][2][4][2], const Unit& u, int wr, int wc, int fr, int fq) const {
        const int col0 = u.pn * BM + wc * 32 + 8 * fq;
        if (u.orow < A_PAD) {
            const int r0 = u.orow + wr * 64 + fr;
#pragma unroll
            for (int ai = 0; ai < 2; ++ai) {
                int dst[4]; float g[4];
#pragma unroll
                for (int m = 0; m < 4; ++m) { dst[m] = rdst[r0 + ai * HALF + m * 16]; g[m] = rgate[r0 + ai * HALF + m * 16]; }
#pragma unroll
                for (int m = 0; m < 4; ++m) if (dst[m] >= 0) { bf16_t* rowp = Y + (size_t)dst[m] * D + col0;
#pragma unroll
                    for (int bj = 0; bj < 2; ++bj) { const f32x4 v0 = acc[ai][bj][m][0] * g[m], v1 = acc[ai][bj][m][1] * g[m];
                        u32x4 w; w.x = cvt_pk_bf16(v0[0], v0[1]); w.y = cvt_pk_bf16(v0[2], v0[3]); w.z = cvt_pk_bf16(v1[0], v1[1]); w.w = cvt_pk_bf16(v1[2], v1[3]);
                        *(u32x4*)(rowp + bj * HALF) = w; } } }
        } else {
            const int row0 = u.orow - A_PAD + wr * 64 + fr;
#pragma unroll
            for (int ai = 0; ai < 2; ++ai)
#pragma unroll
                for (int m = 0; m < 4; ++m) { bf16_t* rowp = YSH + (size_t)(row0 + ai * HALF + m * 16) * D + col0;
#pragma unroll
                    for (int bj = 0; bj < 2; ++bj) { const f32x4 v0 = acc[ai][bj][m][0], v1 = acc[ai][bj][m][1];
                        u32x4 w; w.x = cvt_pk_bf16(v0[0], v0[1]); w.y = cvt_pk_bf16(v0[2], v0[3]); w.z = cvt_pk_bf16(v1[0], v1[1]); w.w = cvt_pk_bf16(v1[2], v1[3]);
                        *(u32x4*)(rowp + bj * HALF) = w; } }
        }
    } };
template <int FAKE = 0> struct EpiScatter8T { static constexpr bool PERM = true; static constexpr bool HOOKS = true; unsigned char* Y; const int* rdst; const float* rgate;
    int dd[2][4]; float gg[2][4];
    __device__ __forceinline__ void load_tab(const Unit& u, int tid) { const int r0 = u.orow + (tid >> 8) * 64 + (tid & 15);
#pragma unroll
        for (int ai = 0; ai < 2; ++ai)
#pragma unroll
            for (int m = 0; m < 4; ++m) { dd[ai][m] = rdst[r0 + ai * HALF + m * 16]; gg[ai][m] = rgate[r0 + ai * HALF + m * 16]; } }
    __device__ __forceinline__ void begin(const Unit& u, int tid) { load_tab(u, tid); }
    __device__ __forceinline__ void post(const Unit& nx, int tid) { load_tab(nx, tid); }
    __device__ __forceinline__ void operator()(const f32x4 (&acc)[2][2][4][2], const Unit& u, int wr, int wc, int fr, int fq) const {
        const unsigned col0 = (unsigned)(u.pn * BM + wc * 32 + 8 * fq);
#pragma unroll
        for (int ai = 0; ai < 2; ++ai)
#pragma unroll
            for (int m = 0; m < 4; ++m) { const int dst = dd[ai][m]; const float g = gg[ai][m] * Y8_SCALE;
                if (dst >= 0) { unsigned off = (unsigned)dst * (unsigned)D + col0;
                    if (FAKE) off = (unsigned)u.orow * (unsigned)D + (unsigned)(u.pn * 65536 + (wr * 4 + wc) * 8192 + (ai * 4 + m) * 1024 + (fq * 16 + fr) * 8);
#pragma unroll
                    for (int bj = 0; bj < 2; ++bj) { const f32x4 v0 = acc[ai][bj][m][0] * g, v1 = acc[ai][bj][m][1] * g;
                        u32x2 w; w.x = cvt4_fp8(v0[0], v0[1], v0[2], v0[3]); w.y = cvt4_fp8(v1[0], v1[1], v1[2], v1[3]); *(u32x2*)(Y + off + bj * (FAKE ? 512 : HALF)) = w; } } }
    } };
typedef EpiScatter8T<0> EpiScatter8;
struct EpiScatter8L { static constexpr bool PERM = true; static constexpr bool HOOKS = true; unsigned char* Y; const int* rdst; const float* rgate; LAS unsigned char* lds;
    int dd[2][4]; float gg[2][4];
    __device__ __forceinline__ void load_tab(const Unit& u, int tid) { const int r0 = u.orow + (tid >> 8) * 64;
#pragma unroll
        for (int ai = 0; ai < 2; ++ai)
#pragma unroll
            for (int m = 0; m < 4; ++m) { gg[ai][m] = rgate[r0 + ai * HALF + m * 16 + (tid & 15)]; dd[ai][m] = rdst[r0 + ai * HALF + ((tid >> 6) & 3) * 16 + m * 4 + ((tid >> 4) & 3)]; } }
    __device__ __forceinline__ void begin(const Unit& u, int tid) { load_tab(u, tid); }
    __device__ __forceinline__ void post(const Unit& nx, int tid) { load_tab(nx, tid); }
    __device__ __forceinline__ void operator()(const f32x4 (&acc)[2][2][4][2], const Unit& u, int wr, int wc, int fr, int fq) const {
        const unsigned col = (unsigned)(u.pn * BM + fr * 16);
        const unsigned wa = (unsigned)(fr * 256 + (((wc * 2 + (fq >> 1)) ^ fr) << 4) + 8 * (fq & 1));
        const unsigned ra = (unsigned)(wc * 4096 + fq * 256);
#pragma unroll
        for (int ai = 0; ai < 2; ++ai) {
#pragma unroll
            for (int m = 0; m < 4; ++m) { const float g = gg[ai][m] * Y8_SCALE;
#pragma unroll
                for (int bj = 0; bj < 2; ++bj) { const f32x4 v0 = acc[ai][bj][m][0] * g, v1 = acc[ai][bj][m][1] * g;
                    u32x2 w; w.x = cvt4_fp8(v0[0], v0[1], v0[2], v0[3]); w.y = cvt4_fp8(v1[0], v1[1], v1[2], v1[3]); *(LAS u32x2*)(lds + (wa ^ (unsigned)(bj * 128)) + m * 4096) = w; } }
            asm volatile("s_waitcnt lgkmcnt(0)" ::: "memory"); __builtin_amdgcn_s_barrier();
            u32x4 rv[4];
#pragma unroll
            for (int i = 0; i < 4; ++i) rv[i] = *(const LAS u32x4*)(lds + ra + i * 1024 + (((fr ^ fq ^ (i << 2)) & 15) << 4));
#pragma unroll
            for (int i = 0; i < 4; ++i) if (dd[ai][i] >= 0) *(u32x4*)(Y + ((unsigned)dd[ai][i] * (unsigned)D + col)) = rv[i];
            asm volatile("s_waitcnt lgkmcnt(0)" ::: "memory"); __builtin_amdgcn_s_barrier();
        }
    } };
struct EpiGate { static constexpr bool PERM = true; bf16_t* U; const float* bias;
    __device__ __forceinline__ void operator()(const f32x4 (&acc)[2][2][4][2], const Unit& u, int wr, int wc, int fr, int fq) const {
        const int row0 = u.orow + wr * 64 + fr, col0 = u.pn * BM + wc * 32 + 8 * fq;
        f32x4 bv[2][2];
#pragma unroll
        for (int bj = 0; bj < 2; ++bj)
#pragma unroll
            for (int n = 0; n < 2; ++n) bv[bj][n] = *(const f32x4*)(bias + col0 + bj * HALF + 4 * n);
#pragma unroll
        for (int ai = 0; ai < 2; ++ai)
#pragma unroll
            for (int m = 0; m < 4; ++m) { bf16_t* rowp = U + (size_t)(row0 + ai * HALF + m * 16) * D + col0;
#pragma unroll
                for (int bj = 0; bj < 2; ++bj) { const u32x4 uu = *(const u32x4*)(rowp + bj * HALF);
                    const f32x4 a0 = acc[ai][bj][m][0] + bv[bj][0], a1 = acc[ai][bj][m][1] + bv[bj][1];
                    u32x4 w; w.x = cvt_pk_bf16(sigmoidf_(a0[0]) * bflo(uu.x), sigmoidf_(a0[1]) * bfhi(uu.x)); w.y = cvt_pk_bf16(sigmoidf_(a0[2]) * bflo(uu.y), sigmoidf_(a0[3]) * bfhi(uu.y));
                    w.z = cvt_pk_bf16(sigmoidf_(a1[0]) * bflo(uu.z), sigmoidf_(a1[1]) * bfhi(uu.z)); w.w = cvt_pk_bf16(sigmoidf_(a1[2]) * bflo(uu.w), sigmoidf_(a1[3]) * bfhi(uu.w));
                    *(u32x4*)(rowp + bj * HALF) = w; }
                asm volatile("" ::: "memory"); }
    } };
struct EpiRouter { static constexpr bool PERM = false; float* LOG;
    __device__ __forceinline__ void operator()(const f32x4 (&acc)[2][2][4][2], const Unit& u, int wr, int wc, int fr, int fq) const {
        if (wc < 2) { const int row0 = u.tab * T + u.orow + wr * 64 + fr, col0 = wc * 32 + 4 * fq;
#pragma unroll
            for (int ai = 0; ai < 2; ++ai)
#pragma unroll
                for (int m = 0; m < 4; ++m)
#pragma unroll
                    for (int n = 0; n < 2; ++n) *(f32x4*)(LOG + (size_t)(row0 + ai * HALF + m * 16) * 64 + col0 + n * 16) = acc[ai][0][m][n]; }
    } };

template <class E, class = void> struct epi_has_hooks { static constexpr bool value = false; };
template <class E> struct epi_has_hooks<E, decltype((void)E::HOOKS)> { static constexpr bool value = true; };
template <int K, class Epi, class Sched, bool GATHER, int VAR = 0, bool FP8 = false, int STAG = 0, int KP = K>
__device__ __forceinline__ void gemm_phase(const int wv, LAS unsigned char* lds, const bf16_t* Ap_, const bf16_t* Btp_, const Sched& S, Epi& E, const LAS int* gtab) {
    typedef const __attribute__((address_space(1))) char* gcp;
    gcp Ap = (gcp)Ap_; gcp Btp = (gcp)Btp_; asm volatile("" : "+s"(Ap), "+s"(Btp));
    const int tid = opaque_tid(wv), wid = wv, lane = tid & 63, wr = wid >> 2, wc = wid & 3, fr = lane & 15, fq = lane >> 4;
    constexpr int ES = FP8 ? 1 : 2, KB = KP * ES;
    constexpr int nt = K * ES / 128; constexpr bool SPLITK = (KP != K);
    static_assert(!(SPLITK && GATHER), "split-K uses Unit::tab as the K-slice index");
    static_assert(nt >= 4 && nt % 2 == 0, "K-loop needs an even number (>= 4) of 128-byte K-tiles");
    unsigned voffB[2], vc[2][2];
#pragma unroll
    for (int i = 0; i < 2; ++i) { int R, C; stage_rc(tid * 16 + i * 8192, R, C); const int Rb = Epi::PERM ? ((R & ~31) + perm32(R & 31)) : R; voffB[i] = (unsigned)(Rb * KB + C * 2); asm volatile("" : "+v"(voffB[i])); }
    constexpr size_t kstep = (size_t)(BK * 2);
    constexpr size_t hstep = (size_t)HALF * KB;
    constexpr size_t hA = GATHER ? (size_t)0 : hstep;
    const unsigned ldsw = (unsigned)wid * 1024u;
    const int aoff = lds_byte(wr * 64 + fr, fq * 8), boff = lds_byte(wc * 32 + fr, fq * 8);
#define PG8_SA(b, h) (((b) * 2 + (h)) * HTB)
#define PG8_SB(b, h) ((4 + (b) * 2 + (h)) * HTB)
#define PG8_STAGE(bufoff, gbase, voff) do { _Pragma("unroll") for (int _i = 0; _i < 2; ++_i) { unsigned _o = (voff)[_i]; asm volatile("" : "+v"(_o));     \
        __builtin_amdgcn_global_load_lds((const __attribute__((address_space(1))) unsigned*)((gbase) + _o), (LAS unsigned*)(lds + (bufoff) + ldsw + _i * 8192), 16, 0, 0); } } while (0)
#define PG8_SETA(v, slot) do { _Pragma("unroll") for (int _h = 0; _h < 2; ++_h) _Pragma("unroll") for (int _i = 0; _i < 2; ++_i) { int _R, _C; stage_rc(tid * 16 + _i * 8192, _R, _C); \
        (v)[_h][_i] = GATHER ? ((unsigned)gtab[(slot) * BM + _h * HALF + _R] * (unsigned)KB + (unsigned)(_C * 2)) : (unsigned)(_R * KB + _C * 2); asm volatile("" : "+v"((v)[_h][_i])); } } while (0)
#define PG8_LDA(dst, b, h) do { unsigned _ba = (unsigned)(aoff + PG8_SA(b, h)); asm volatile("" : "+v"(_ba)); const LAS unsigned char* _pa = lds + _ba; _Pragma("unroll") for (int m = 0; m < 4; ++m) { \
        if constexpr (FP8) dst##8[m] = __builtin_shufflevector(*(const LAS v4i_*)(_pa + m * 2048), *(const LAS v4i_*)(_pa + m * 2048 + 1024), 0, 1, 2, 3, 4, 5, 6, 7); \
        else { _Pragma("unroll") for (int k = 0; k < 2; ++k) dst[m][k] = *(const LAS bf16x8*)(_pa + m * 2048 + k * 1024); } } } while (0)
#define PG8_LDB(dst, b, h) do { unsigned _bb = (unsigned)(boff + PG8_SB(b, h)); asm volatile("" : "+v"(_bb)); const LAS unsigned char* _pb = lds + _bb; _Pragma("unroll") for (int n = 0; n < 2; ++n) { \
        if constexpr (FP8) dst##8[n] = __builtin_shufflevector(*(const LAS v4i_*)(_pb + n * 2048), *(const LAS v4i_*)(_pb + n * 2048 + 1024), 0, 1, 2, 3, 4, 5, 6, 7); \
        else { _Pragma("unroll") for (int k = 0; k < 2; ++k) dst[n][k] = *(const LAS bf16x8*)(_pb + n * 2048 + k * 1024); } } } while (0)
#define PG8_MMA(ai, bj, At, Bt) do { __builtin_amdgcn_s_setprio(1); _Pragma("unroll") for (int m = 0; m < 4; ++m) _Pragma("unroll") for (int n = 0; n < 2; ++n) { \
        if constexpr (FP8) asm volatile("v_mfma_scale_f32_16x16x128_f8f6f4 %0, %1, %2, %0, %3, %3 op_sel_hi:[0,0,0]" : "+v"(acc[ai][bj][m][n]) : "v"(Bt##8[n]), "v"(At##8[m]), "v"(sc8_)); \
        else { _Pragma("unroll") for (int k = 0; k < 2; ++k) acc[ai][bj][m][n] = __builtin_amdgcn_mfma_f32_16x16x32_bf16(Bt[n][k], At[m][k], acc[ai][bj][m][n], 0, 0, 0); } } \
        __builtin_amdgcn_s_setprio(0); } while (0)
#define PG8_WAIT_V(n) asm volatile("s_waitcnt vmcnt(" #n ")" ::: "memory")
#define PG8_WAIT_L(n) asm volatile("s_waitcnt lgkmcnt(" #n ")" ::: "memory")
#define PG8_BAR __builtin_amdgcn_s_barrier()
#define PG8_SCHED __builtin_amdgcn_sched_barrier(0)
    Unit cur, nxt; int ui = 0;
    if (!S.next(0, cur)) return;
    if constexpr (epi_has_hooks<Epi>::value) E.begin(cur, tid);
    if constexpr (STAG > 0) {
        const unsigned long long t0 = __builtin_amdgcn_s_memrealtime(); const unsigned long long dt = (unsigned long long)(((blockIdx.x >> 3) & 7) * STAG);
        while (__builtin_amdgcn_s_memrealtime() - t0 < dt) __builtin_amdgcn_s_sleep(8);
    }
    f32x4 acc[2][2][4][2];
#pragma unroll
    for (int a = 0; a < 2; ++a)
#pragma unroll
        for (int b = 0; b < 2; ++b)
#pragma unroll
            for (int m = 0; m < 4; ++m)
#pragma unroll
                for (int n = 0; n < 2; ++n) acc[a][b][m][n] = (f32x4){0.f, 0.f, 0.f, 0.f};
    typedef int v8i_ __attribute__((ext_vector_type(8))); typedef int v4i_ __attribute__((ext_vector_type(4)));
    const int sc8_ = W8_E8M0;
    bf16x8 At[4][2], B0[2][2], B1[2][2]; v8i_ At8[4], B08[2], B18[2];
    PG8_SETA(vc, cur.tab);
    gcp cA = Ap + (GATHER ? (size_t)0 : (size_t)cur.orow * KB) + (SPLITK ? (size_t)cur.tab * (K * ES) : (size_t)0); gcp cB = Btp + (size_t)cur.brow * KB + (SPLITK ? (size_t)cur.tab * (K * ES) : (size_t)0);
    PG8_STAGE(PG8_SB(0, 0), cB, voffB); PG8_STAGE(PG8_SB(0, 1), cB + hstep, voffB); PG8_STAGE(PG8_SA(0, 0), cA, vc[0]); PG8_STAGE(PG8_SA(0, 1), cA + hA, vc[1]);
    if (wr == 1) PG8_BAR;
    PG8_WAIT_V(2); PG8_BAR;
    PG8_STAGE(PG8_SB(1, 0), cB + kstep, voffB); PG8_STAGE(PG8_SA(1, 0), cA + kstep, vc[0]); PG8_STAGE(PG8_SB(1, 1), cB + hstep + kstep, voffB);
    PG8_WAIT_V(6); PG8_BAR;
    for (;;) {
        const bool has_next = S.next(ui + 1, nxt);
        gcp nA = has_next ? Ap + (GATHER ? (size_t)0 : (size_t)nxt.orow * KB) + (SPLITK ? (size_t)nxt.tab * (K * ES) : (size_t)0) : cA; gcp nB = has_next ? Btp + (size_t)nxt.brow * KB + (SPLITK ? (size_t)nxt.tab * (K * ES) : (size_t)0) : cB;
#pragma nounroll
        for (int t = 0; t < nt; t += 2) {
            const bool last = (t == nt - 2);
            gcp a1 = cA + (size_t)(t + 1) * kstep;
            gcp a2 = last ? nA : cA + (size_t)(t + 2) * kstep; gcp b2 = last ? nB : cB + (size_t)(t + 2) * kstep;
            gcp a3 = a2 + kstep; gcp b3 = b2 + kstep;
            PG8_LDB(B0, 0, 0); PG8_LDB(B1, 0, 1); PG8_SCHED; PG8_LDA(At, 0, 0); PG8_STAGE(PG8_SA(1, 1), a1 + hA, vc[1]);
            if (GATHER && last && has_next) PG8_SETA(vc, nxt.tab);
            PG8_WAIT_V(8); PG8_WAIT_L(0); PG8_BAR; PG8_MMA(0, 0, At, B0); PG8_MMA(0, 1, At, B1); PG8_BAR; PG8_SCHED;
            PG8_LDA(At, 0, 1); PG8_STAGE(PG8_SB(0, 0), b2, voffB); PG8_STAGE(PG8_SB(0, 1), b2 + hstep, voffB); PG8_STAGE(PG8_SA(0, 0), a2, vc[0]);
            PG8_WAIT_V(8); PG8_WAIT_L(0); PG8_BAR; PG8_MMA(1, 0, At, B0); PG8_MMA(1, 1, At, B1); PG8_BAR; PG8_SCHED;
            PG8_LDB(B0, 1, 0); PG8_LDB(B1, 1, 1); PG8_SCHED; PG8_LDA(At, 1, 0); PG8_STAGE(PG8_SA(0, 1), a2 + hA, vc[1]);
            PG8_WAIT_V(8); PG8_WAIT_L(0); PG8_BAR; PG8_MMA(0, 0, At, B0); PG8_MMA(0, 1, At, B1); PG8_BAR; PG8_SCHED;
            PG8_LDA(At, 1, 1); PG8_STAGE(PG8_SB(1, 0), b3, voffB); PG8_STAGE(PG8_SB(1, 1), b3 + hstep, voffB); PG8_STAGE(PG8_SA(1, 0), a3, vc[0]);
            PG8_WAIT_V(8); PG8_WAIT_L(0); PG8_BAR; PG8_MMA(1, 0, At, B0); PG8_MMA(1, 1, At, B1); PG8_BAR; PG8_SCHED;
        }
        if (!(VAR & 2)) { if (wr == 0) PG8_BAR; }
        if (!(VAR & 1)) { const int t2 = opaque_tid(wv), l2 = t2 & 63;
            E(acc, cur, wr, wc, l2 & 15, l2 >> 4);
            if constexpr (epi_has_hooks<Epi>::value) { if (has_next) E.post(nxt, t2); } }
        if (!has_next) break;
#pragma unroll
        for (int a = 0; a < 2; ++a)
#pragma unroll
            for (int b = 0; b < 2; ++b)
#pragma unroll
                for (int m = 0; m < 4; ++m)
#pragma unroll
                    for (int n = 0; n < 2; ++n) acc[a][b][m][n] = (f32x4){0.f, 0.f, 0.f, 0.f};
        cur = nxt; cA = nA; cB = nB; ++ui;
        if (!(VAR & 2)) { if (wr == 1) PG8_BAR; }
    }
    PG8_WAIT_V(0);
    if (VAR & 2) { if (wr == 0) PG8_BAR; }
    PG8_BAR;
#undef PG8_SA
#undef PG8_SB
#undef PG8_STAGE
#undef PG8_SETA
#undef PG8_LDA
#undef PG8_LDB
#undef PG8_MMA
#undef PG8_WAIT_V
#undef PG8_WAIT_L
#undef PG8_BAR
#undef PG8_SCHED
}
}
constexpr int NWAVES = 8, NTHR = 512;
constexpr int RING_OFF = 0, RING_BYTES = 131072;
constexpr int TAB_OFF = RING_BYTES, TAB_BYTES = 24576;
constexpr int MISC_OFF = TAB_OFF + TAB_BYTES;
constexpr int ULIST_OFF = MISC_OFF + 128, ULIST_CAP = 64;
constexpr int LDS_BYTES = 160 * 1024;
static_assert(ULIST_OFF + ULIST_CAP * 16 <= LDS_BYTES, "LDS map");
constexpr int CW_BAR = 1024;

#define XB_TMO      128
#define XB_XCNT(j)  (256  + 64 * (j))
#define XB_XSUB(j)  (1280 + 64 * (j))
#define XB_XGEN(j)  (2304 + 64 * (j))
#define XB_TOP      3328
#define XB_TOPGEN   3392
#define XCD_BAR_WORDS 3456
#define XB_SPIN_CAP (1u << 22)
static_assert((CW_BAR + XCD_BAR_WORDS) * 4 <= (int)CTL_ZERO_BYTES, "barrier words inside the memset region");

__device__ __forceinline__ unsigned xb_ld(unsigned* p)              { return __hip_atomic_load(p, __ATOMIC_RELAXED, __HIP_MEMORY_SCOPE_AGENT); }
__device__ __forceinline__ unsigned xb_add(unsigned* p, unsigned v) { return __hip_atomic_fetch_add(p, v, __ATOMIC_RELAXED, __HIP_MEMORY_SCOPE_AGENT); }
__device__ __forceinline__ unsigned xb_xcc_id() { return (unsigned)__builtin_amdgcn_s_getreg((3 << 11) | 20) & 0xFu; }
#define XB_SPIN(cond, bar) do { unsigned _sp = 0; while (cond) { __builtin_amdgcn_s_sleep(1); \
    if ((++_sp & 255u) == 0u) { if (xb_ld(&(bar)[XB_TMO])) break; if (_sp > XB_SPIN_CAP) { atomicAdd(&(bar)[XB_TMO], 1u); break; } } } } while (0)

struct XcdBarrier { unsigned* bar; unsigned x; volatile LAS unsigned* st; int w0; };
__device__ __forceinline__ XcdBarrier xcd_barrier_post(unsigned* bar, volatile LAS unsigned* st) {
    XcdBarrier b; b.bar = bar; b.x = xb_xcc_id(); b.st = st; b.w0 = (__builtin_amdgcn_readfirstlane(threadIdx.x >> 6) == 0) ? 1 : 0;
    if (threadIdx.x == 0) (void)xb_add(&bar[XB_XCNT(b.x)], 1u);
    return b;
}
__device__ __forceinline__ void xcd_barrier_complete(unsigned* bar, unsigned x, unsigned& nloc, unsigned& nx) {
    const unsigned G = gridDim.x * gridDim.y * gridDim.z;
    unsigned sum, cnt, mine, sp = 0u;
    for (;;) {
        sum = 0u; cnt = 0u; mine = 0u;
#pragma unroll
        for (unsigned j = 0; j < 16; ++j) { const unsigned c = xb_ld(&bar[XB_XCNT(j)]); sum += c; cnt += (c > 0u) ? 1u : 0u; mine = (j == x) ? c : mine; }
        if (sum == G) break;
        __builtin_amdgcn_s_sleep(1);
        if ((++sp & 255u) == 0u) { if (xb_ld(&bar[XB_TMO])) break; if (sp > XB_SPIN_CAP) { atomicAdd(&bar[XB_TMO], 1u); break; } }
    }
    nloc = mine > 0u ? mine : 1u; nx = cnt > 0u ? cnt : 1u;
}
__device__ __forceinline__ void xcd_barrier(const XcdBarrier& b) {
    asm volatile("s_waitcnt vmcnt(0)" ::: "memory");
    __syncthreads();
    if (b.w0 && lane_id() == 0) {
        unsigned* bar = b.bar;
        __builtin_amdgcn_s_waitcnt(0);
        unsigned nloc = b.st[0], nx = b.st[1];
        if (nloc == 0u) { xcd_barrier_complete(bar, b.x, nloc, nx); b.st[0] = nloc; b.st[1] = nx; }
        const unsigned old = xb_add(&bar[XB_XSUB(b.x)], 1u);
        const unsigned gen = old / nloc;
        if (old + 1u == (gen + 1u) * nloc) {
            __builtin_amdgcn_fence(__ATOMIC_RELEASE, "agent");
            asm volatile("s_waitcnt vmcnt(0)" ::: "memory");
            const unsigned og = xb_add(&bar[XB_TOP], 1u);
            const unsigned tg = og / nx;
            if (og + 1u == (tg + 1u) * nx) xb_add(&bar[XB_TOPGEN], 1u);
            else XB_SPIN(xb_ld(&bar[XB_TOPGEN]) == tg, bar);
            __builtin_amdgcn_fence(__ATOMIC_ACQUIRE, "agent");
            xb_add(&bar[XB_XGEN(b.x)], 1u);
            asm volatile("s_waitcnt vmcnt(0)" ::: "memory");
        } else {
            XB_SPIN(xb_ld(&bar[XB_XGEN(b.x)]) == gen, bar);
            __builtin_amdgcn_fence(__ATOMIC_ACQUIRE, "agent");
            asm volatile("s_waitcnt vmcnt(0)" ::: "memory");
        }
    }
    __syncthreads();
}

struct TItem { const float* W; unsigned char* WT; int K, N, k0, n0, drow, f8; };
__device__ __forceinline__ void ti_load(const TItem& t, float4 (&v)[8], int lane) {
#pragma unroll
    for (int i = 0; i < 8; ++i) v[i] = *(const float4*)(t.W + (size_t)(t.k0 + 8 * i + (lane >> 3)) * t.N + t.n0 + (lane & 7) * 4);
}
__device__ __forceinline__ void ti_store(const TItem& t, const float4 (&v)[8], LAS float* scr, int lane) {
#pragma unroll
    for (int i = 0; i < 8; ++i) { LAS float* p = scr + (8 * i + (lane >> 3)) * 33 + (lane & 7) * 4; p[0] = v[i].x; p[1] = v[i].y; p[2] = v[i].z; p[3] = v[i].w; }
    asm volatile("s_waitcnt lgkmcnt(0)" ::: "memory");
    const int c = lane & 7;
#pragma unroll
    for (int j = 0; j < 4; ++j) { const int n = (lane >> 3) + 8 * j; const LAS float* s = scr + (8 * c) * 33 + n;
        if (t.f8) { u32x2 o; o.x = cvt4_fp8(s[0 * 33] * W8_SCALE, s[1 * 33] * W8_SCALE, s[2 * 33] * W8_SCALE, s[3 * 33] * W8_SCALE); o.y = cvt4_fp8(s[4 * 33] * W8_SCALE, s[5 * 33] * W8_SCALE, s[6 * 33] * W8_SCALE, s[7 * 33] * W8_SCALE);
            *(u32x2*)(t.WT + (size_t)(t.drow + n) * t.K + t.k0 + 8 * c) = o; }
        else { u32x4 o; o.x = pk2(s[0 * 33], s[1 * 33]); o.y = pk2(s[2 * 33], s[3 * 33]); o.z = pk2(s[4 * 33], s[5 * 33]); o.w = pk2(s[6 * 33], s[7 * 33]);
            *(u32x4*)(t.WT + ((size_t)(t.drow + n) * t.K + t.k0 + 8 * c) * 2) = o; } }
    asm volatile("s_waitcnt lgkmcnt(0)" ::: "memory");
}
struct WPtrs { const float *w_in, *w_out, *gate, *plew, *ew1, *ew3, *ew2, *sw1, *sw3, *sw2, *rw, *lwa, *lwx; bf16_t* lru_wg; };
template <bool F8, bool F8DN>
__device__ __forceinline__ void convert_weights(unsigned char* ldsb, const WPtrs& P, unsigned char* wsw, int gw, int NGW, int wave, int lane) {
    LAS float* scr0 = (LAS float*)((LAS unsigned char*)ldsb + wave * 16896); LAS float* scr1 = scr0 + 2112;
    unsigned char* WIN = wsw + WO_WIN; unsigned char* WOUT = wsw + WO_WOUT; unsigned char* GATE = wsw + WO_GATE; unsigned char* PLEW = wsw + WO_PLEW;
    unsigned char* W2 = wsw + WO_W2; unsigned char* W13 = wsw + WO_W13; bf16_t* ROUT = (bf16_t*)(wsw + WO_ROUT);
    constexpr int I_IN = (D / 64) * (IN_COLS / 32), I_OUT = (D / 64) * (D / 32), I_GATE = I_OUT, I_PLE = (PLE / 64) * (D / 32), I_W2 = (EF / 64) * (D / 32), I_W13 = (D / 64) * (EF / 32), I_R = (D / 64) * (NE / 32);
    constexpr int NITEMS = I_R + I_IN + I_OUT + I_GATE + I_PLE + 65 * I_W2 + 65 * 2 * I_W13;
    auto decode = [&](int it) -> TItem { TItem t; int r = it; t.f8 = 0;
        if (r < I_R) { const int nb = NE / 32; t.W = P.rw; t.WT = (unsigned char*)ROUT; t.K = D; t.N = NE; t.k0 = 64 * (r / nb); t.n0 = 32 * (r % nb); t.drow = t.n0; return t; } r -= I_R;
        if (r < I_IN) { const int nb = IN_COLS / 32; t.W = P.w_in; t.WT = WIN; t.K = D; t.N = IN_COLS; t.k0 = 64 * (r / nb); t.n0 = 32 * (r % nb); t.drow = t.n0; return t; } r -= I_IN;
        if (r < I_OUT) { const int nb = D / 32; t.W = P.w_out; t.WT = WOUT; t.K = D; t.N = D; t.k0 = 64 * (r / nb); t.n0 = 32 * (r % nb); t.drow = t.n0; return t; } r -= I_OUT;
        if (r < I_GATE) { const int nb = D / 32; t.W = P.gate; t.WT = GATE; t.K = D; t.N = D; t.k0 = 64 * (r / nb); t.n0 = 32 * (r % nb); t.drow = t.n0; t.f8 = F8 ? 1 : 0; return t; } r -= I_GATE;
        if (r < I_PLE) { const int nb = D / 32; t.W = P.plew; t.WT = PLEW; t.K = PLE; t.N = D; t.k0 = 64 * (r / nb); t.n0 = 32 * (r % nb); t.drow = t.n0; return t; } r -= I_PLE;
        if (r < 65 * I_W2) { const int e = r / I_W2, q = r % I_W2, nb = D / 32; t.W = (e < 64) ? P.ew2 + (size_t)e * EF * D : P.sw2; t.f8 = F8DN ? 1 : 0;
            t.WT = W2 + (size_t)e * D * EF * (F8DN ? 1 : 2); t.K = EF; t.N = D; t.k0 = 64 * (q / nb); t.n0 = 32 * (q % nb); t.drow = t.n0; return t; } r -= 65 * I_W2;
        { const int e = r / (2 * I_W13), q2 = r % (2 * I_W13), mth = q2 / I_W13, q = q2 % I_W13, nb = EF / 32; const int n0 = 32 * (q % nb);
          t.W = (e < 64) ? (mth ? P.ew3 : P.ew1) + (size_t)e * D * EF : (mth ? P.sw3 : P.sw1); t.f8 = F8 ? 1 : 0;
          t.WT = W13 + (size_t)e * 1024 * D * (F8 ? 1 : 2); t.K = D; t.N = EF; t.k0 = 64 * (q / nb); t.n0 = n0; t.drow = 256 * (n0 >> 7) + 128 * mth + (n0 & 127); return t; } };
    {
        int it = gw; bool ha = it < NITEMS, hb = it + NGW < NITEMS;
        float4 v0[8], v1[8]; TItem ta = decode(ha ? it : 0), tb = decode(hb ? it + NGW : 0);
        if (ha) ti_load(ta, v0, lane);
        if (hb) ti_load(tb, v1, lane);
        while (ha) {
            ti_store(ta, v0, scr0, lane); it += 2 * NGW; ha = it < NITEMS;
            if (ha) { ta = decode(it); ti_load(ta, v0, lane); }
            if (hb) { ti_store(tb, v1, scr1, lane); hb = it + NGW < NITEMS; if (hb) { tb = decode(it + NGW); ti_load(tb, v1, lane); } }
        }
    }
    for (int i = gw * 64 + lane; i < 8 * 128 * 64; i += NGW * 64) { const int hh = i >> 13, jj = (i >> 6) & 127, ii = i & 63;
        P.lru_wg[i] = f2bf((jj < 64) ? P.lwa[(hh * 64 + ii) * 64 + jj] : P.lwx[(hh * 64 + ii) * 64 + jj - 64]); }
    for (int i = gw * 64 + lane; i < (256 - NE) * D * 2 / 16; i += NGW * 64) ((u32x4*)(ROUT + (size_t)NE * D))[i] = (u32x4){0u, 0u, 0u, 0u};
}
__device__ __forceinline__ void convert_rows(const float* src, bf16_t* dst, size_t n, size_t gtid, size_t nthr) {
    for (size_t i = gtid * 8; i < n; i += nthr * 32) {
        float4 a[4], b[4];
#pragma unroll
        for (int r = 0; r < 4; ++r) { a[r] = *(const float4*)(src + i + r * nthr * 8); b[r] = *(const float4*)(src + i + r * nthr * 8 + 4); }
#pragma unroll
        for (int r = 0; r < 4; ++r) { u32x4 o; o.x = cvt_pk_bf16(a[r].x, a[r].y); o.y = cvt_pk_bf16(a[r].z, a[r].w); o.z = cvt_pk_bf16(b[r].x, b[r].y); o.w = cvt_pk_bf16(b[r].z, b[r].w); *(u32x4*)(dst + i + r * nthr * 8) = o; }
    }
}

__device__ __forceinline__ void acc8(float (&v)[8], const u32x4 a) { v[0] += bflo(a.x); v[1] += bfhi(a.x); v[2] += bflo(a.y); v[3] += bfhi(a.y); v[4] += bflo(a.z); v[5] += bfhi(a.z); v[6] += bflo(a.w); v[7] += bfhi(a.w); }
__device__ __forceinline__ void ln_finish(float (&v)[4][8], const float* gain, const float* bias, float* outf, bf16_t* xb, int lane, unsigned char* x8 = nullptr) {
    float s = 0.f;
#pragma unroll
    for (int j = 0; j < 4; ++j)
#pragma unroll
        for (int e = 0; e < 8; ++e) s += v[j][e];
    const float mean = wave_sum(s) * (1.f / D); float q = 0.f;
#pragma unroll
    for (int j = 0; j < 4; ++j)
#pragma unroll
        for (int e = 0; e < 8; ++e) { v[j][e] -= mean; q += v[j][e] * v[j][e]; }
    const float rstd = rsqf_(wave_sum(q) * (1.f / D) + 1e-5f);
#pragma unroll
    for (int j = 0; j < 4; ++j) { const int c0 = 8 * (lane + 64 * j); const float4 g0 = *(const float4*)(gain + c0), g1 = *(const float4*)(gain + c0 + 4), b0 = *(const float4*)(bias + c0), b1 = *(const float4*)(bias + c0 + 4);
        float4 o0, o1; o0.x = v[j][0] * rstd * g0.x + b0.x; o0.y = v[j][1] * rstd * g0.y + b0.y; o0.z = v[j][2] * rstd * g0.z + b0.z; o0.w = v[j][3] * rstd * g0.w + b0.w;
        o1.x = v[j][4] * rstd * g1.x + b1.x; o1.y = v[j][5] * rstd * g1.y + b1.y; o1.z = v[j][6] * rstd * g1.z + b1.z; o1.w = v[j][7] * rstd * g1.w + b1.w;
        if (outf) { *(float4*)(outf + c0) = o0; *(float4*)(outf + c0 + 4) = o1; }
        if (xb) { u32x4 w; w.x = cvt_pk_bf16(o0.x, o0.y); w.y = cvt_pk_bf16(o0.z, o0.w); w.z = cvt_pk_bf16(o1.x, o1.y); w.w = cvt_pk_bf16(o1.z, o1.w); *(u32x4*)(xb + c0) = w; }
        if (x8) { u32x2 w; w.x = cvt4_fp8(o0.x, o0.y, o0.z, o0.w); w.y = cvt4_fp8(o1.x, o1.y, o1.z, o1.w); *(u32x2*)(x8 + c0) = w; } }
}
__device__ __forceinline__ void ln1_rows2(const bf16_t* z0, const bf16_t* z1, const float* gain, const float* bias, bf16_t* xb0, bf16_t* xb1, int lane, unsigned char* x80 = nullptr, unsigned char* x81 = nullptr) {
    u32x4 a[2][4], x[2][4];
#pragma unroll
    for (int j = 0; j < 4; ++j) { a[0][j] = *(const u32x4*)(z0 + 8 * (lane + 64 * j)); a[1][j] = *(const u32x4*)(z1 + 8 * (lane + 64 * j)); x[0][j] = *(const u32x4*)(xb0 + 8 * (lane + 64 * j)); x[1][j] = *(const u32x4*)(xb1 + 8 * (lane + 64 * j)); }
#pragma unroll
    for (int r = 0; r < 2; ++r) { float v[4][8];
#pragma unroll
        for (int j = 0; j < 4; ++j) {
#pragma unroll
            for (int e = 0; e < 8; ++e) v[j][e] = 0.f;
            acc8(v[j], x[r][j]);
#pragma unroll
            for (int e = 0; e < 8; ++e) v[j][e] *= ALPHA;
            acc8(v[j], a[r][j]); }
        ln_finish(v, gain, bias, nullptr, r ? xb1 : xb0, lane, r ? x81 : x80); }
}
__device__ __forceinline__ void ln2_row(const bf16_t* x1, const float* gain, const float* bias, float* outf, bf16_t* xb, const bf16_t* yrows, const bf16_t* yp, const bf16_t* ysh, int lane) {
    u32x4 a[3][4], y[8][4];
#pragma unroll
    for (int j = 0; j < 4; ++j) { const int c0 = 8 * (lane + 64 * j); a[0][j] = *(const u32x4*)(x1 + c0); a[1][j] = *(const u32x4*)(yp + c0); a[2][j] = *(const u32x4*)(ysh + c0); }
#pragma unroll
    for (int k = 0; k < TOPK; ++k)
#pragma unroll
        for (int j = 0; j < 4; ++j) y[k][j] = *(const u32x4*)(yrows + (size_t)k * D + 8 * (lane + 64 * j));
    float v[4][8];
#pragma unroll
    for (int j = 0; j < 4; ++j) {
#pragma unroll
        for (int e = 0; e < 8; ++e) v[j][e] = 0.f;
        acc8(v[j], a[0][j]);
#pragma unroll
        for (int e = 0; e < 8; ++e) v[j][e] *= ALPHA;
        acc8(v[j], a[1][j]); acc8(v[j], a[2][j]);
#pragma unroll
        for (int k = 0; k < TOPK; ++k) acc8(v[j], y[k][j]); }
    ln_finish(v, gain, bias, outf, xb, lane);
}
__device__ __forceinline__ void acc16_fp8(float (&v)[16], const u32x4 a) {
    const unsigned w[4] = {a.x, a.y, a.z, a.w};
#pragma unroll
    for (int i = 0; i < 4; ++i) { typedef float f2_ __attribute__((ext_vector_type(2))); const f2_ lo = __builtin_amdgcn_cvt_pk_f32_fp8((int)w[i], false), hi = __builtin_amdgcn_cvt_pk_f32_fp8((int)w[i], true);
        v[4 * i] += lo[0]; v[4 * i + 1] += lo[1]; v[4 * i + 2] += hi[0]; v[4 * i + 3] += hi[1]; }
}
__device__ __forceinline__ void ln2_row8(const bf16_t* x1, const float* gain, const float* bias, float* outf, bf16_t* xb, const unsigned char* yrows, const unsigned char* yp, const unsigned char* ysh, int lane_) {
    unsigned lane = (unsigned)lane_; asm volatile("" : "+v"(lane));
    float v[2][16]; float s = 0.f;
#pragma unroll
    for (int j = 0; j < 2; ++j) {
        const unsigned c0 = 16u * (lane + 64u * j);
        u32x4 y[10], xa[2];
        y[0] = *(const u32x4*)(ysh + c0); y[9] = *(const u32x4*)(yp + c0);
#pragma unroll
        for (int k = 0; k < TOPK; ++k) y[1 + k] = *(const u32x4*)(yrows + (size_t)k * D + c0);
        xa[0] = *(const u32x4*)(x1 + c0); xa[1] = *(const u32x4*)(x1 + c0 + 8);
        float e[16];
#pragma unroll
        for (int i = 0; i < 16; ++i) e[i] = 0.f;
#pragma unroll
        for (int k = 0; k < 10; ++k) acc16_fp8(e, y[k]);
#pragma unroll
        for (int hh = 0; hh < 2; ++hh) { float x8[8];
#pragma unroll
            for (int i = 0; i < 8; ++i) x8[i] = 0.f;
            acc8(x8, xa[hh]);
#pragma unroll
            for (int i = 0; i < 8; ++i) { v[j][8 * hh + i] = ALPHA * x8[i] + e[8 * hh + i] * (1.0f / Y8_SCALE); s += v[j][8 * hh + i]; } }
        if (j == 0) asm volatile("" ::: "memory");
    }
    const float mean = wave_sum(s) * (1.f / D); float q = 0.f;
#pragma unroll
    for (int j = 0; j < 2; ++j)
#pragma unroll
        for (int i = 0; i < 16; ++i) { v[j][i] -= mean; q += v[j][i] * v[j][i]; }
    const float rstd = rsqf_(wave_sum(q) * (1.f / D) + 1e-5f);
#pragma unroll
    for (int j = 0; j < 2; ++j) { const unsigned c0 = 16u * (lane + 64u * j); float o[16];
#pragma unroll
        for (int i4 = 0; i4 < 4; ++i4) { const float4 g = *(const float4*)(gain + c0 + 4 * i4), b = *(const float4*)(bias + c0 + 4 * i4);
            o[4 * i4] = v[j][4 * i4] * rstd * g.x + b.x; o[4 * i4 + 1] = v[j][4 * i4 + 1] * rstd * g.y + b.y; o[4 * i4 + 2] = v[j][4 * i4 + 2] * rstd * g.z + b.z; o[4 * i4 + 3] = v[j][4 * i4 + 3] * rstd * g.w + b.w;
            if (outf) *(float4*)(outf + c0 + 4 * i4) = make_float4(o[4 * i4], o[4 * i4 + 1], o[4 * i4 + 2], o[4 * i4 + 3]); }
        if (xb) { u32x4 w0, w1; w0.x = cvt_pk_bf16(o[0], o[1]); w0.y = cvt_pk_bf16(o[2], o[3]); w0.z = cvt_pk_bf16(o[4], o[5]); w0.w = cvt_pk_bf16(o[6], o[7]);
            w1.x = cvt_pk_bf16(o[8], o[9]); w1.y = cvt_pk_bf16(o[10], o[11]); w1.z = cvt_pk_bf16(o[12], o[13]); w1.w = cvt_pk_bf16(o[14], o[15]); *(u32x4*)(xb + c0) = w0; *(u32x4*)(xb + c0 + 8) = w1; } }
}
constexpr int AT_KS = 72, AT_VS = 264, AT_PS = 168;
constexpr int AT_LDS_K = 0, AT_LDS_V = 256 * AT_KS * 2, AT_LDS_P = AT_LDS_V + (64 * AT_VS + 64) * 2, AT_LDS_SS = AT_LDS_P + 8 * 16 * AT_PS * 2, AT_LDS_CS = AT_LDS_SS + 8 * 128 * 4, AT_LDS_BYTES = AT_LDS_CS + 128 * 16 * 4;
static_assert(AT_LDS_BYTES <= RING_BYTES, "attention LDS");
struct RotTab { double invf[8]; };
__device__ __forceinline__ void attn_unit(const int wv, unsigned char* lds, int u, const bf16_t* HIN, const int* positions, const float* sinks, bf16_t* MIX, float* SSQ, const RotTab& rt) {
    bf16_t* Ks = (bf16_t*)(lds + AT_LDS_K); bf16_t* Vt = (bf16_t*)(lds + AT_LDS_V); bf16_t* Ps = (bf16_t*)(lds + AT_LDS_P); float* SS = (float*)(lds + AT_LDS_SS); float* CS = (float*)(lds + AT_LDS_CS);
    const int g = u & 1, n = (u >> 1) & 31, b = u >> 6;
    const int tid = opaque_tid(wv), lane = tid & 63, w = tid >> 6;
    __syncthreads();
    {
        const int j = tid >> 1, half = tid & 1; const int kp = 128 * (n - 1) + j;
        u32x4 kv[4], vv[4];
        if (kp >= 0) {
            const bf16_t* kr = HIN + (size_t)(b * SEQ + kp) * IN_COLS + C_AK + g * 64 + half * 32;
            const bf16_t* vr = HIN + (size_t)(b * SEQ + kp) * IN_COLS + C_AV + g * 64 + half * 32;
#pragma unroll
            for (int i = 0; i < 4; ++i) { kv[i] = *(const u32x4*)(kr + 8 * i); vv[i] = *(const u32x4*)(vr + 8 * i); }
            if (half == 0) {
                const float pos = (float)positions[b * SEQ + kp];
                float t1[8], t2[8];
                t1[0] = bflo(kv[0].x); t1[1] = bfhi(kv[0].x); t1[2] = bflo(kv[0].y); t1[3] = bfhi(kv[0].y); t1[4] = bflo(kv[0].z); t1[5] = bfhi(kv[0].z); t1[6] = bflo(kv[0].w); t1[7] = bfhi(kv[0].w);
                t2[0] = bflo(kv[1].x); t2[1] = bfhi(kv[1].x); t2[2] = bflo(kv[1].y); t2[3] = bfhi(kv[1].y); t2[4] = bflo(kv[1].z); t2[5] = bfhi(kv[1].z); t2[6] = bflo(kv[1].w); t2[7] = bfhi(kv[1].w);
#pragma unroll
                for (int i = 0; i < 8; ++i) { float sn, cs; sincos_pos(pos, rt.invf[i], sn, cs); const float a = t1[i] * cs - t2[i] * sn, bb = t2[i] * cs + t1[i] * sn; t1[i] = a; t2[i] = bb;
                    if (j >= 128) { CS[(j - 128) * 16 + i] = cs; CS[(j - 128) * 16 + 8 + i] = sn; } }
                kv[0].x = cvt_pk_bf16(t1[0], t1[1]); kv[0].y = cvt_pk_bf16(t1[2], t1[3]); kv[0].z = cvt_pk_bf16(t1[4], t1[5]); kv[0].w = cvt_pk_bf16(t1[6], t1[7]);
                kv[1].x = cvt_pk_bf16(t2[0], t2[1]); kv[1].y = cvt_pk_bf16(t2[2], t2[3]); kv[1].z = cvt_pk_bf16(t2[4], t2[5]); kv[1].w = cvt_pk_bf16(t2[6], t2[7]);
            }
        } else {
#pragma unroll
            for (int i = 0; i < 4; ++i) { kv[i] = (u32x4){0u, 0u, 0u, 0u}; vv[i] = (u32x4){0u, 0u, 0u, 0u}; }
        }
#pragma unroll
        for (int i = 0; i < 4; ++i) *(u32x4*)(Ks + j * AT_KS + half * 32 + 8 * i) = kv[i];
#pragma unroll
        for (int i = 0; i < 4; ++i) { const int d = half * 32 + 8 * i;
            Vt[(d + 0) * AT_VS + j] = (bf16_t)(vv[i].x & 0xffff); Vt[(d + 1) * AT_VS + j] = (bf16_t)(vv[i].x >> 16); Vt[(d + 2) * AT_VS + j] = (bf16_t)(vv[i].y & 0xffff); Vt[(d + 3) * AT_VS + j] = (bf16_t)(vv[i].y >> 16);
            Vt[(d + 4) * AT_VS + j] = (bf16_t)(vv[i].z & 0xffff); Vt[(d + 5) * AT_VS + j] = (bf16_t)(vv[i].z >> 16); Vt[(d + 6) * AT_VS + j] = (bf16_t)(vv[i].w & 0xffff); Vt[(d + 7) * AT_VS + j] = (bf16_t)(vv[i].w >> 16); }
        if (tid < 64) {
#pragma unroll
            for (int i = 0; i < 8; ++i) Vt[tid * AT_VS + 256 + i] = 0;
            Vt[64 * AT_VS + tid] = 0;
        }
        for (int i = tid; i < 8 * 16 * 24; i += NTHR) { const int r = i / 24, c = 144 + i % 24; Ps[r * AT_PS + c] = 0; }
    }
    __syncthreads();
    const int hq = g * 8 + w;
    constexpr float LOG2E = 1.4426950408889634f, C2 = 0.125f * LOG2E;
    const float sink2 = sinks[hq] * LOG2E;
    const int lr = lane & 15, lg = lane >> 4;
    bf16_t* Pw = Ps + w * 16 * AT_PS;
    const bf16_t* qbase = HIN + (size_t)(b * SEQ + n * 128 + lr) * IN_COLS + C_AQ + hq * 64 + lg * 8;
    u32x4 nq0 = *(const u32x4*)qbase, nq1 = *(const u32x4*)(qbase + 32);
    for (int qi = 0; qi < 8; ++qi) {
        const int tq = b * SEQ + n * 128 + qi * 16 + lr;
        u32x4 q0 = nq0; const u32x4 q1 = nq1;
        if (qi < 7) { const bf16_t* qn = qbase + (size_t)(qi + 1) * 16 * IN_COLS; nq0 = *(const u32x4*)qn; nq1 = *(const u32x4*)(qn + 32); }
        {
            u32x4 other; other.x = __shfl_xor(q0.x, 16); other.y = __shfl_xor(q0.y, 16); other.z = __shfl_xor(q0.z, 16); other.w = __shfl_xor(q0.w, 16);
            if (lg < 2) {
                const float4 c0 = *(const float4*)(CS + (qi * 16 + lr) * 16), c1 = *(const float4*)(CS + (qi * 16 + lr) * 16 + 4), s0 = *(const float4*)(CS + (qi * 16 + lr) * 16 + 8), s1 = *(const float4*)(CS + (qi * 16 + lr) * 16 + 12);
                const float cs[8] = {c0.x, c0.y, c0.z, c0.w, c1.x, c1.y, c1.z, c1.w}; const float sn[8] = {s0.x, s0.y, s0.z, s0.w, s1.x, s1.y, s1.z, s1.w};
                float mv[8], ov[8];
                mv[0] = bflo(q0.x); mv[1] = bfhi(q0.x); mv[2] = bflo(q0.y); mv[3] = bfhi(q0.y); mv[4] = bflo(q0.z); mv[5] = bfhi(q0.z); mv[6] = bflo(q0.w); mv[7] = bfhi(q0.w);
                ov[0] = bflo(other.x); ov[1] = bfhi(other.x); ov[2] = bflo(other.y); ov[3] = bfhi(other.y); ov[4] = bflo(other.z); ov[5] = bfhi(other.z); ov[6] = bflo(other.w); ov[7] = bfhi(other.w);
                const float sg = (lg == 0) ? -1.f : 1.f;
#pragma unroll
                for (int i = 0; i < 8; ++i) mv[i] = mv[i] * cs[i] + sg * ov[i] * sn[i];
                q0.x = cvt_pk_bf16(mv[0], mv[1]); q0.y = cvt_pk_bf16(mv[2], mv[3]); q0.z = cvt_pk_bf16(mv[4], mv[5]); q0.w = cvt_pk_bf16(mv[6], mv[7]);
            }
        }
        const bf16x8 qa0 = __builtin_bit_cast(bf16x8, q0), qa1 = __builtin_bit_cast(bf16x8, q1);
        f32x4 s[9];
#pragma unroll
        for (int jt = 0; jt < 9; ++jt) {
            const int jr = (qi + jt) * 16 + lr;
            const bf16x8 kb0 = *(const bf16x8*)(Ks + jr * AT_KS + lg * 8), kb1 = *(const bf16x8*)(Ks + jr * AT_KS + 32 + lg * 8);
            f32x4 a = (f32x4){0.f, 0.f, 0.f, 0.f};
            a = __builtin_amdgcn_mfma_f32_16x16x32_bf16(kb0, qa0, a, 0, 0, 0);
            a = __builtin_amdgcn_mfma_f32_16x16x32_bf16(kb1, qa1, a, 0, 0, 0);
            s[jt] = a;
        }
#pragma unroll
        for (int r = 0; r < 4; ++r) { if (!(4 * lg + r > lr)) s[0][r] = -3.0e38f; if (!(4 * lg + r <= lr)) s[8][r] = -3.0e38f; }
        if (n == 0) {
#pragma unroll
            for (int jt = 0; jt < 8; ++jt) if (qi + jt < 8) s[jt] = (f32x4){-3.0e38f, -3.0e38f, -3.0e38f, -3.0e38f};
        }
        float m = -3.0e38f;
#pragma unroll
        for (int jt = 0; jt < 9; ++jt) m = fmaxf(fmaxf(m, fmaxf(s[jt][0], s[jt][1])), fmaxf(s[jt][2], s[jt][3]));
        m = fmaxf(m, __shfl_xor(m, 16)); m = fmaxf(m, __shfl_xor(m, 32));
        const float m2 = fmaxf(m * C2, sink2);
        float sum = 0.f;
#pragma unroll
        for (int jt = 0; jt < 9; ++jt) {
            f32x4 p;
#pragma unroll
            for (int r = 0; r < 4; ++r) { p[r] = __builtin_amdgcn_exp2f(fmaf(s[jt][r], C2, -m2)); sum += p[r]; }
            u32x2 pk; pk.x = cvt_pk_bf16(p[0], p[1]); pk.y = cvt_pk_bf16(p[2], p[3]);
            *(u32x2*)(Pw + lr * AT_PS + jt * 16 + 4 * lg) = pk;
        }
        sum += __shfl_xor(sum, 16); sum += __shfl_xor(sum, 32);
        const float inv = rcpf_(sum + __builtin_amdgcn_exp2f(sink2 - m2));
        asm volatile("s_waitcnt lgkmcnt(0)" ::: "memory");
        f32x4 o[4];
#pragma unroll
        for (int dt = 0; dt < 4; ++dt) o[dt] = (f32x4){0.f, 0.f, 0.f, 0.f};
#pragma unroll
        for (int ks = 0; ks < 5; ++ks) {
            const bf16x8 pa = *(const bf16x8*)(Pw + lr * AT_PS + ks * 32 + lg * 8);
#pragma unroll
            for (int dt = 0; dt < 4; ++dt) { const bf16x8 vb = *(const bf16x8*)(Vt + (dt * 16 + lr) * AT_VS + qi * 16 + ks * 32 + lg * 8); o[dt] = __builtin_amdgcn_mfma_f32_16x16x32_bf16(vb, pa, o[dt], 0, 0, 0); }
        }
        float q = 0.f;
        bf16_t* orow = MIX + (size_t)tq * D + hq * 64 + 4 * lg;
#pragma unroll
        for (int dt = 0; dt < 4; ++dt) { const f32x4 v = o[dt] * inv; q += (v[0] * v[0] + v[1] * v[1]) + (v[2] * v[2] + v[3] * v[3]);
            u32x2 pk; pk.x = cvt_pk_bf16(v[0], v[1]); pk.y = cvt_pk_bf16(v[2], v[3]); *(u32x2*)(orow + dt * 16) = pk; }
        q += __shfl_xor(q, 16); q += __shfl_xor(q, 32);
        if (lg == 0) SS[w * 128 + qi * 16 + lr] = q;
    }
    __syncthreads();
    if (tid < 128) { float q = 0.f;
#pragma unroll
        for (int ww = 0; ww < 8; ++ww) q += SS[ww * 128 + tid];
        SSQ[(size_t)(b * SEQ + n * 128 + tid) * 2 + g] = q; }
}
__device__ __forceinline__ void attn_fin_rows4(bf16_t* MIX, const float* SSQ, const float* gain, int t, int lane) {
    u32x4 v[4][2]; float sc[4];
#pragma unroll
    for (int r = 0; r < 4; ++r) { const u32x4* p = (const u32x4*)(MIX + (size_t)(t + r) * D) + lane * 2; v[r][0] = p[0]; v[r][1] = p[1]; sc[r] = rsqf_((SSQ[(size_t)(t + r) * 2] + SSQ[(size_t)(t + r) * 2 + 1]) * (1.0f / 1024.f) + 1e-6f); }
    const int c = lane * 16; const float4 g0 = *(const float4*)(gain + c), g1 = *(const float4*)(gain + c + 4), g2 = *(const float4*)(gain + c + 8), g3 = *(const float4*)(gain + c + 12);
#pragma unroll
    for (int r = 0; r < 4; ++r) { u32x4 a = v[r][0], b = v[r][1]; const float s = sc[r];
        a.x = cvt_pk_bf16(bflo(a.x) * s * g0.x, bfhi(a.x) * s * g0.y); a.y = cvt_pk_bf16(bflo(a.y) * s * g0.z, bfhi(a.y) * s * g0.w); a.z = cvt_pk_bf16(bflo(a.z) * s * g1.x, bfhi(a.z) * s * g1.y); a.w = cvt_pk_bf16(bflo(a.w) * s * g1.z, bfhi(a.w) * s * g1.w);
        b.x = cvt_pk_bf16(bflo(b.x) * s * g2.x, bfhi(b.x) * s * g2.y); b.y = cvt_pk_bf16(bflo(b.y) * s * g2.z, bfhi(b.y) * s * g2.w); b.z = cvt_pk_bf16(bflo(b.z) * s * g3.x, bfhi(b.z) * s * g3.y); b.w = cvt_pk_bf16(bflo(b.w) * s * g3.z, bfhi(b.w) * s * g3.w);
        u32x4* p = (u32x4*)(MIX + (size_t)(t + r) * D) + lane * 2; p[0] = a; p[1] = b; }
}

constexpr int HG_S72 = 72, HG_S136 = 136;
__device__ __forceinline__ float hg_lb(const float* lbl, int layer, int col) { if (layer == 0) return 0.f; return sigmoidf_(lbl[512 + col] - lbl[col]); }
constexpr int H1_LDS_KT = 0, H1_LDS_VT = 128 * HG_S72 * 2, H1_LDS_TOT = 2 * 128 * HG_S72 * 2, H1_LDS_BYTES = H1_LDS_TOT + 4 * 128 * 4;
__device__ __forceinline__ void hg1_unit(const int wv, unsigned char* lds, int u, const bf16_t* HIN, const float* lbl, int layer, bf16_t* SST, float* DV) {
    bf16_t* KT = (bf16_t*)(lds + H1_LDS_KT); bf16_t* VT = (bf16_t*)(lds + H1_LDS_VT); float* TOT = (float*)(lds + H1_LDS_TOT);
    const int c = u & 63, h = (u >> 6) & 3, b = u >> 8;
    const int tid = opaque_tid(wv), lane = tid & 63, w = tid >> 6, k = tid & 127, tq = tid >> 7;
    const size_t t0 = (size_t)b * SEQ + c * 64;
    const float lb = hg_lb(lbl, layer, h * 128 + k);
    __syncthreads();
    float bl[16], kf[16]; float cum = 0.f;
#pragma unroll
    for (int i = 0; i < 16; ++i) { const size_t row = (t0 + 16 * tq + i) * IN_COLS; const float fp = bf2f(HIN[row + C_HF + h * 128 + k]);
        const float sg = sigmoidf_(fp); const float f = lb + (1.f - lb) * sg; cum += __logf(fmaxf(f, 1e-30f)); bl[i] = cum; kf[i] = (1.f - lb) * (1.f - sg);
        VT[k * HG_S72 + 16 * tq + i] = HIN[row + C_HI + h * 128 + k]; }
    TOT[tq * 128 + k] = cum;
    __syncthreads();
    float pre = 0.f, total = 0.f;
#pragma unroll
    for (int j = 0; j < 4; ++j) { const float tj = TOT[j * 128 + k]; if (j < tq) pre += tj; total += tj; }
#pragma unroll
    for (int i = 0; i < 16; ++i) KT[k * HG_S72 + 16 * tq + i] = f2bf_hw(kf[i] * __expf(total - (pre + bl[i])));
    if (tq == 0) DV[(size_t)u * 128 + k] = __expf(total);
    __syncthreads();
    const int lr = lane & 15, lg = lane >> 4;
    bf16x8 a[2];
#pragma unroll
    for (int ks = 0; ks < 2; ++ks) a[ks] = *(const bf16x8*)(VT + (w * 16 + lr) * HG_S72 + ks * 32 + lg * 8);
    bf16_t* out = SST + (size_t)u * 16384;
#pragma unroll
    for (int kt = 0; kt < 8; ++kt) {
        f32x4 acc = (f32x4){0.f, 0.f, 0.f, 0.f};
#pragma unroll
        for (int ks = 0; ks < 2; ++ks) { const bf16x8 bb = *(const bf16x8*)(KT + (kt * 16 + lr) * HG_S72 + ks * 32 + lg * 8); acc = __builtin_amdgcn_mfma_f32_16x16x32_bf16(bb, a[ks], acc, 0, 0, 0); }
        { u32x2 pk; pk.x = pk2(acc[0], acc[1]); pk.y = pk2(acc[2], acc[3]); *(u32x2*)(out + (w * 16 + lr) * 128 + kt * 16 + 4 * lg) = pk; }
    }
}
__device__ __forceinline__ void hg2_unit(const int wv, int u, const bf16_t* SST, const float* DV, bf16_t* SPREV) {
    const int bh = u >> 3, part = u & 7, e4 = part * 512 + opaque_tid(wv);
    const int k4 = (e4 & 31) * 4;
    float4 S = make_float4(0.f, 0.f, 0.f, 0.f);
    for (int c0 = 0; c0 < 64; c0 += 4) {
        u32x2 ds[4]; float4 dv[4];
#pragma unroll
        for (int i = 0; i < 4; ++i) { const size_t uu = (size_t)bh * 64 + c0 + i; ds[i] = *((const u32x2*)(SST + uu * 16384) + e4); dv[i] = *(const float4*)(DV + uu * 128 + k4); }
#pragma unroll
        for (int i = 0; i < 4; ++i) { const size_t uu = (size_t)bh * 64 + c0 + i; u32x2 o; o.x = cvt_pk_bf16(S.x, S.y); o.y = cvt_pk_bf16(S.z, S.w); *((u32x2*)(SPREV + uu * 16384) + e4) = o;
            S.x = dv[i].x * S.x + bflo(ds[i].x); S.y = dv[i].y * S.y + bfhi(ds[i].x); S.z = dv[i].z * S.z + bflo(ds[i].y); S.w = dv[i].w * S.w + bfhi(ds[i].y); }
    }
}
constexpr int H3_QI = 0, H3_QE = H3_QI + 64 * HG_S136 * 2, H3_KI = H3_QE + 64 * HG_S136 * 2, H3_VT = H3_KI + 160 * HG_S136 * 2, H3_SB = H3_VT + 128 * HG_S72 * 2,
              H3_SC = H3_SB + 128 * HG_S136 * 2, H3_TOT = H3_SC + 64 * HG_S72 * 2, H3_LDS_BYTES = H3_TOT + 4 * 128 * 4;
constexpr int H3_OB = H3_KI, HG_OS = 132;
static_assert(H3_LDS_BYTES <= MISC_OFF, "HGRN2 LDS");
__device__ __forceinline__ void hg3_unit(const int wv, unsigned char* lds, int u, const bf16_t* HIN, const float* lbl, int layer, const bf16_t* SST, const float* gain, bf16_t* MIX) {
    bf16_t* QI = (bf16_t*)(lds + H3_QI); bf16_t* QE = (bf16_t*)(lds + H3_QE); bf16_t* KI = (bf16_t*)(lds + H3_KI); bf16_t* VT = (bf16_t*)(lds + H3_VT);
    bf16_t* SB = (bf16_t*)(lds + H3_SB); bf16_t* SC = (bf16_t*)(lds + H3_SC); float* TOT = (float*)(lds + H3_TOT); float* OB = (float*)(lds + H3_OB);
    const int c = u & 63, h = (u >> 6) & 3, b = u >> 8;
    const int tid = opaque_tid(wv), lane = tid & 63, w = tid >> 6, k = tid & 127, tq = tid >> 7;
    const size_t t0 = (size_t)b * SEQ + c * 64;
    const float lb = hg_lb(lbl, layer, h * 128 + k);
    const u32x4 g0 = *(const u32x4*)(HIN + (t0 + (tid >> 3)) * IN_COLS + C_HG + h * 128 + (tid & 7) * 16), g1 = *(const u32x4*)(HIN + (t0 + (tid >> 3)) * IN_COLS + C_HG + h * 128 + (tid & 7) * 16 + 8);
    __syncthreads();
    float bl[16], kf[16], qf[16]; float cum = 0.f;
#pragma unroll
    for (int i = 0; i < 16; ++i) { const size_t row = (t0 + 16 * tq + i) * IN_COLS; const float fp = bf2f(HIN[row + C_HF + h * 128 + k]);
        const float sg = sigmoidf_(fp); const float f = lb + (1.f - lb) * sg; cum += __logf(fmaxf(f, 1e-30f)); bl[i] = cum; kf[i] = (1.f - lb) * (1.f - sg);
        qf[i] = siluf_(bf2f(HIN[row + C_HQ + h * 128 + k]));
        VT[k * HG_S72 + 16 * tq + i] = HIN[row + C_HI + h * 128 + k]; }
    TOT[tq * 128 + k] = cum;
    { const u32x4* sp = (const u32x4*)(SST + (size_t)u * 16384);
#pragma unroll
      for (int i = 0; i < 4; ++i) { const int e8 = tid + 512 * i; const u32x4 s8 = sp[e8]; const int v = e8 >> 4, k8 = (e8 & 15) * 8; *(u32x4*)(SB + v * HG_S136 + k8) = s8; } }
    for (int i = tid; i < 64 * HG_S72 / 2; i += NTHR) ((unsigned*)SC)[i] = 0u;
    __syncthreads();
    float rs[4]; { float acc = 0.f;
#pragma unroll
        for (int j = 0; j < 4; ++j) { rs[j] = acc; acc += TOT[j * 128 + k]; } }
    float pre = 0.f;
#pragma unroll
    for (int j = 0; j < 4; ++j) pre = (j == tq) ? rs[j] : pre;
    const float epre = __expf(pre);
    float fk[4];
#pragma unroll
    for (int ii = 0; ii < 4; ++ii) fk[ii] = __expf(fminf(rs[ii] - pre, 0.f));
#pragma unroll
    for (int i = 0; i < 16; ++i) {
        const int s = 16 * tq + i; const float e1 = fmaxf(__expf(bl[i]), 1e-30f), inv = rcpf_(e1);
        const float qi = qf[i] * e1, ki = kf[i] * inv;
        QI[s * HG_S136 + k] = f2bf_hw(qi);
        QE[s * HG_S136 + k] = f2bf_hw(qi * epre);
#pragma unroll
        for (int ii = 0; ii < 4; ++ii) if (ii >= tq) KI[((ii == 0 ? 0 : ii == 1 ? 16 : ii == 2 ? 48 : 96) + s) * HG_S136 + k] = f2bf_hw(ki * fk[ii]);
    }
    __syncthreads();
    const int lr = lane & 15, lg = lane >> 4;
    for (int tix = w; tix < 10; tix += 8) {
        int i, j; if (tix == 0) { i = 0; j = 0; } else if (tix < 3) { i = 1; j = tix - 1; } else if (tix < 6) { i = 2; j = tix - 3; } else { i = 3; j = tix - 6; }
        const int kb = (i == 0 ? 0 : i == 1 ? 16 : i == 2 ? 48 : 96);
        f32x4 acc = (f32x4){0.f, 0.f, 0.f, 0.f};
#pragma unroll
        for (int ks = 0; ks < 4; ++ks) { const bf16x8 a = *(const bf16x8*)(QI + (16 * i + lr) * HG_S136 + ks * 32 + lg * 8); const bf16x8 bb = *(const bf16x8*)(KI + (kb + 16 * j + lr) * HG_S136 + ks * 32 + lg * 8);
            acc = __builtin_amdgcn_mfma_f32_16x16x32_bf16(a, bb, acc, 0, 0, 0); }
#pragma unroll
        for (int r = 0; r < 4; ++r) { const int tr = 4 * lg + r; const float v = (i == j && lr > tr) ? 0.f : acc[r]; SC[(16 * i + tr) * HG_S72 + 16 * j + lr] = f2bf_hw(v); }
    }
    __syncthreads();
    f32x4 o[4];
#pragma unroll
    for (int tt = 0; tt < 4; ++tt) o[tt] = (f32x4){0.f, 0.f, 0.f, 0.f};
#pragma unroll
    for (int ks = 0; ks < 2; ++ks) { const bf16x8 vb = *(const bf16x8*)(VT + (w * 16 + lr) * HG_S72 + ks * 32 + lg * 8);
#pragma unroll
        for (int tt = 0; tt < 4; ++tt) { const bf16x8 a = *(const bf16x8*)(SC + (16 * tt + lr) * HG_S72 + ks * 32 + lg * 8); o[tt] = __builtin_amdgcn_mfma_f32_16x16x32_bf16(a, vb, o[tt], 0, 0, 0); } }
#pragma unroll
    for (int ks = 0; ks < 4; ++ks) { const bf16x8 sb = *(const bf16x8*)(SB + (w * 16 + lr) * HG_S136 + ks * 32 + lg * 8);
#pragma unroll
        for (int tt = 0; tt < 4; ++tt) { const bf16x8 a = *(const bf16x8*)(QE + (16 * tt + lr) * HG_S136 + ks * 32 + lg * 8); o[tt] = __builtin_amdgcn_mfma_f32_16x16x32_bf16(a, sb, o[tt], 0, 0, 0); } }
#pragma unroll
    for (int tt = 0; tt < 4; ++tt)
#pragma unroll
        for (int r = 0; r < 4; ++r) OB[(16 * tt + 4 * lg + r) * HG_OS + w * 16 + lr] = o[tt][r];
    __syncthreads();
    { const int t = tid >> 3, vg = tid & 7; float ov[16]; float q = 0.f;
#pragma unroll
      for (int i = 0; i < 4; ++i) { const float4 x = *(const float4*)(OB + t * HG_OS + vg * 16 + 4 * i); ov[4 * i] = x.x; ov[4 * i + 1] = x.y; ov[4 * i + 2] = x.z; ov[4 * i + 3] = x.w; q += (x.x * x.x + x.y * x.y) + (x.z * x.z + x.w * x.w); }
      q += __shfl_xor(q, 1); q += __shfl_xor(q, 2); q += __shfl_xor(q, 4);
      const float rinv = rsqf_(q * (1.0f / 128.f) + 1e-6f);
      const size_t row = t0 + t; const float* gn = gain + h * 128 + vg * 16;
      u32x4 o0, o1;
      o0.x = pk2(ov[0] * rinv * gn[0] * siluf_(bflo(g0.x)), ov[1] * rinv * gn[1] * siluf_(bfhi(g0.x))); o0.y = pk2(ov[2] * rinv * gn[2] * siluf_(bflo(g0.y)), ov[3] * rinv * gn[3] * siluf_(bfhi(g0.y)));
      o0.z = pk2(ov[4] * rinv * gn[4] * siluf_(bflo(g0.z)), ov[5] * rinv * gn[5] * siluf_(bfhi(g0.z))); o0.w = pk2(ov[6] * rinv * gn[6] * siluf_(bflo(g0.w)), ov[7] * rinv * gn[7] * siluf_(bfhi(g0.w)));
      o1.x = pk2(ov[8] * rinv * gn[8] * siluf_(bflo(g1.x)), ov[9] * rinv * gn[9] * siluf_(bfhi(g1.x))); o1.y = pk2(ov[10] * rinv * gn[10] * siluf_(bflo(g1.y)), ov[11] * rinv * gn[11] * siluf_(bfhi(g1.y)));
      o1.z = pk2(ov[12] * rinv * gn[12] * siluf_(bflo(g1.z)), ov[13] * rinv * gn[13] * siluf_(bfhi(g1.z))); o1.w = pk2(ov[14] * rinv * gn[14] * siluf_(bflo(g1.w)), ov[15] * rinv * gn[15] * siluf_(bfhi(g1.w)));
      bf16_t* op = MIX + row * D + 1024 + h * 128 + vg * 16; *(u32x4*)op = o0; *(u32x4*)(op + 8) = o1; }
}

constexpr int LRU_LDS_X = 0, LRU_LDS_MS = LCH * 516 * 4, LRU_LDS_BYTES = LRU_LDS_MS + LCH * 4;
static_assert(LRU_LDS_BYTES <= RING_BYTES, "LRU LDS");
struct LruW { const float *conv_w, *conv_b, *wa, *ba, *wx, *bx, *lam, *gain; };
constexpr int LRU_XS = 520;
__device__ __forceinline__ void lru1_unit(const int wv, unsigned char* lds, int u, const bf16_t* HIN, const LruW& W, const bf16_t* WG16, float* AGA, float* AGH, bf16_t* HL, bf16_t* PL) {
    bf16_t* XB16 = (bf16_t*)lds;
    const int ch = u % NLCH, b = u / NLCH;
    const int c = opaque_tid(wv);
    const size_t t0 = (size_t)b * SEQ + ch * LCH;
    {
        const int cg8 = (c & 63) * 8, tg = c >> 6;
        u32x4 xr[7];
#pragma unroll
        for (int i = 0; i < 7; ++i) { const int tt = ch * LCH + 4 * tg - 3 + i;
            xr[i] = (tt >= 0) ? *(const u32x4*)(HIN + ((size_t)b * SEQ + tt) * IN_COLS + C_LX + cg8) : (u32x4){0u, 0u, 0u, 0u}; }
        float4 wq[4][2], bq[2];
#pragma unroll
        for (int j = 0; j < 4; ++j) { wq[j][0] = *(const float4*)(W.conv_w + j * 512 + cg8); wq[j][1] = *(const float4*)(W.conv_w + j * 512 + cg8 + 4); }
        bq[0] = *(const float4*)(W.conv_b + cg8); bq[1] = *(const float4*)(W.conv_b + cg8 + 4);
        __syncthreads();
#pragma unroll
        for (int i = 0; i < 4; ++i) { float o[8];
#pragma unroll
            for (int e = 0; e < 8; ++e) o[e] = (e < 4) ? ((const float*)&bq[0])[e] : ((const float*)&bq[1])[e - 4];
#pragma unroll
            for (int j = 0; j < 4; ++j) { const u32x4 x = xr[i + j]; const float xv[8] = {bflo(x.x), bfhi(x.x), bflo(x.y), bfhi(x.y), bflo(x.z), bfhi(x.z), bflo(x.w), bfhi(x.w)};
#pragma unroll
                for (int e = 0; e < 8; ++e) o[e] += xv[e] * ((e < 4) ? ((const float*)&wq[j][0])[e] : ((const float*)&wq[j][1])[e - 4]); }
            u32x4 pk; pk.x = cvt_pk_bf16(o[0], o[1]); pk.y = cvt_pk_bf16(o[2], o[3]); pk.z = cvt_pk_bf16(o[4], o[5]); pk.w = cvt_pk_bf16(o[6], o[7]);
            *(u32x4*)(XB16 + (4 * tg + i) * LRU_XS + cg8) = pk; }
    }
    __syncthreads();
    const int lane = c & 63, h = wv, lr = lane & 15, lg = lane >> 4;
    f32x4 acc[2][8];
#pragma unroll
    for (int mt = 0; mt < 2; ++mt)
#pragma unroll
        for (int nt = 0; nt < 8; ++nt) acc[mt][nt] = (f32x4){0.f, 0.f, 0.f, 0.f};
#pragma unroll
    for (int ks = 0; ks < 2; ++ks) {
        bf16x8 a[2];
#pragma unroll
        for (int mt = 0; mt < 2; ++mt) a[mt] = *(const bf16x8*)(XB16 + (mt * 16 + lr) * LRU_XS + h * 64 + ks * 32 + lg * 8);
#pragma unroll
        for (int nt = 0; nt < 8; ++nt) { const bf16x8 bw = *(const bf16x8*)(WG16 + ((size_t)(h * 128 + nt * 16 + lr) * 64 + ks * 32 + lg * 8));
#pragma unroll
            for (int mt = 0; mt < 2; ++mt) acc[mt][nt] = __builtin_amdgcn_mfma_f32_16x16x32_bf16(a[mt], bw, acc[mt][nt], 0, 0, 0); }
    }
#pragma unroll
    for (int jt = 0; jt < 4; ++jt) {
        const int cc = h * 64 + jt * 16 + lr;
        const float bav = W.ba[cc], bxv = W.bx[cc]; const float lm = W.lam[cc]; const float sp = (lm > 15.f) ? __expf(-lm) : __logf(1.0f + __expf(-lm));
        float Pin = 1.f, Hin = 0.f;
#pragma unroll
        for (int mt = 0; mt < 2; ++mt) {
            float a[4], uu[4];
#pragma unroll
            for (int r = 0; r < 4; ++r) { const float rg = sigmoidf_(acc[mt][jt][r] + bav), ig = sigmoidf_(acc[mt][4 + jt][r] + bxv); const float la = -8.0f * rg * sp; a[r] = __expf(la);
                const float xcv = bf2f(XB16[(mt * 16 + 4 * lg + r) * LRU_XS + cc]); uu[r] = __builtin_amdgcn_sqrtf(fmaxf(1.0f - a[r] * a[r], 0.f)) * (ig * xcv); }
            float A = a[0], H = uu[0];
#pragma unroll
            for (int r = 1; r < 4; ++r) { H = a[r] * H + uu[r]; A *= a[r]; }
            float Ai = A, Hi = H;
            { const float Ap = __shfl_up(Ai, 16), Hp = __shfl_up(Hi, 16); if (lg >= 1) { Hi = Ai * Hp + Hi; Ai = Ai * Ap; } }
            { const float Ap = __shfl_up(Ai, 32), Hp = __shfl_up(Hi, 32); if (lg >= 2) { Hi = Ai * Hp + Hi; Ai = Ai * Ap; } }
            float Ae = __shfl_up(Ai, 16), He = __shfl_up(Hi, 16); if (lg == 0) { Ae = 1.f; He = 0.f; }
            float hs = Ae * Hin + He, ps = Ae * Pin;
            float h4[4], p4[4];
#pragma unroll
            for (int r = 0; r < 4; ++r) { hs = a[r] * hs + uu[r]; ps *= a[r]; h4[r] = hs; p4[r] = ps; }
            { const size_t o = (((size_t)b * NLCH + ch) * 512 + cc) * LCH + mt * 16 + 4 * lg;
              u32x2 hw, pw; hw.x = cvt_pk_bf16(h4[0], h4[1]); hw.y = cvt_pk_bf16(h4[2], h4[3]); pw.x = cvt_pk_bf16(p4[0], p4[1]); pw.y = cvt_pk_bf16(p4[2], p4[3]);
              *(u32x2*)(HL + o) = hw; *(u32x2*)(PL + o) = pw; }
            const float At = __shfl(Ai, 48 + lr), Ht = __shfl(Hi, 48 + lr);
            Hin = At * Hin + Ht; Pin = At * Pin;
        }
        if (lg == 0) { AGA[((size_t)b * NLCH + ch) * 512 + cc] = Pin; AGH[((size_t)b * NLCH + ch) * 512 + cc] = Hin; }
    }
}
__device__ __forceinline__ void lru_carry_unit(const int wv, int b, const float* AGA, float* AGH) {
    const int c = opaque_tid(wv); float carry = 0.f;
    for (int c0 = 0; c0 < NLCH; c0 += 16) {
        float a[16], hh[16];
#pragma unroll
        for (int i = 0; i < 16; ++i) { const size_t o = ((size_t)b * NLCH + c0 + i) * 512 + c; a[i] = AGA[o]; hh[i] = AGH[o]; }
#pragma unroll
        for (int i = 0; i < 16; ++i) { const size_t o = ((size_t)b * NLCH + c0 + i) * 512 + c; AGH[o] = carry; carry = a[i] * carry + hh[i]; }
    }
}
__device__ __forceinline__ void lru2_unit(const int wv, unsigned char* lds, int u, const bf16_t* HIN, const float* gain, const float* CAR, const bf16_t* HL, const bf16_t* PL, bf16_t* MIX) {
    float* XS = (float*)(lds + LRU_LDS_X);
    constexpr int XP = 516;
    const int ch = u % NLCH, b = u / NLCH;
    const int c = opaque_tid(wv);
    const size_t t0 = (size_t)b * SEQ + ch * LCH;
    const float carry = CAR[((size_t)b * NLCH + ch) * 512 + c];
    u32x4 hq[LCH / 8], pq[LCH / 8];
    { const u32x4* hp = (const u32x4*)(HL + (((size_t)b * NLCH + ch) * 512 + c) * LCH); const u32x4* pp = (const u32x4*)(PL + (((size_t)b * NLCH + ch) * 512 + c) * LCH);
#pragma unroll
      for (int q = 0; q < LCH / 8; ++q) { hq[q] = hp[q]; pq[q] = pp[q]; } }
    const int tb = c >> 4, cg = (c & 15) * 32;
    u32x4 gq[4]; float4 gn[8];
    { const u32x4* gp = (const u32x4*)(HIN + (t0 + tb) * IN_COLS + C_LG + cg);
#pragma unroll
      for (int q = 0; q < 4; ++q) gq[q] = gp[q];
#pragma unroll
      for (int q = 0; q < 8; ++q) gn[q] = *(const float4*)(gain + cg + 4 * q); }
    __syncthreads();
#pragma unroll
    for (int q = 0; q < LCH / 8; ++q) { const u32x4 h = hq[q], p = pq[q];
        XS[(8 * q + 0) * XP + c] = bflo(h.x) + bflo(p.x) * carry; XS[(8 * q + 1) * XP + c] = bfhi(h.x) + bfhi(p.x) * carry; XS[(8 * q + 2) * XP + c] = bflo(h.y) + bflo(p.y) * carry; XS[(8 * q + 3) * XP + c] = bfhi(h.y) + bfhi(p.y) * carry;
        XS[(8 * q + 4) * XP + c] = bflo(h.z) + bflo(p.z) * carry; XS[(8 * q + 5) * XP + c] = bfhi(h.z) + bfhi(p.z) * carry; XS[(8 * q + 6) * XP + c] = bflo(h.w) + bflo(p.w) * carry; XS[(8 * q + 7) * XP + c] = bfhi(h.w) + bfhi(p.w) * carry; }
    __syncthreads();
    float hv[32]; float q2 = 0.f;
#pragma unroll
    for (int q = 0; q < 8; ++q) { const float4 x = *(const float4*)(XS + tb * XP + cg + 4 * q); hv[4 * q] = x.x; hv[4 * q + 1] = x.y; hv[4 * q + 2] = x.z; hv[4 * q + 3] = x.w; q2 += (x.x * x.x + x.y * x.y) + (x.z * x.z + x.w * x.w); }
    q2 += __shfl_xor(q2, 1); q2 += __shfl_xor(q2, 2); q2 += __shfl_xor(q2, 4); q2 += __shfl_xor(q2, 8);
    const float rinv = rsqf_(q2 * (1.0f / 512.f) + 1e-6f);
    bf16_t* op = MIX + (t0 + tb) * D + 1536 + cg;
#pragma unroll
    for (int q = 0; q < 4; ++q) { const u32x4 g = gq[q]; const float4 n0 = gn[2 * q], n1 = gn[2 * q + 1]; u32x4 o;
        o.x = cvt_pk_bf16(hv[8 * q + 0] * rinv * n0.x * gelu_tanh(bflo(g.x)), hv[8 * q + 1] * rinv * n0.y * gelu_tanh(bfhi(g.x)));
        o.y = cvt_pk_bf16(hv[8 * q + 2] * rinv * n0.z * gelu_tanh(bflo(g.y)), hv[8 * q + 3] * rinv * n0.w * gelu_tanh(bfhi(g.y)));
        o.z = cvt_pk_bf16(hv[8 * q + 4] * rinv * n1.x * gelu_tanh(bflo(g.z)), hv[8 * q + 5] * rinv * n1.y * gelu_tanh(bfhi(g.z)));
        o.w = cvt_pk_bf16(hv[8 * q + 6] * rinv * n1.z * gelu_tanh(bflo(g.w)), hv[8 * q + 7] * rinv * n1.w * gelu_tanh(bfhi(g.w)));
        *(u32x4*)(op + 8 * q) = o; }
}

__device__ __forceinline__ void router_unit(const int wv, unsigned char* lds, int u, const float* X, const float* W, float* LOG) {
    float* xs = (float*)lds; float* ws = xs + 32 * 68;
    const int tid = opaque_tid(wv), tt = tid >> 4, eg = tid & 15; const size_t t0 = (size_t)u * 32;
    float a0 = 0.f, a1 = 0.f, a2 = 0.f, a3 = 0.f;
    for (int k0 = 0; k0 < D; k0 += 64) {
        const float4 xv = *(const float4*)(X + (t0 + (tid >> 4)) * D + k0 + (tid & 15) * 4);
        const float4 wv0 = *(const float4*)(W + (size_t)(k0 + (tid >> 4)) * 64 + (tid & 15) * 4), wv1 = *(const float4*)(W + (size_t)(k0 + 32 + (tid >> 4)) * 64 + (tid & 15) * 4);
        __syncthreads();
        *(float4*)(xs + (tid >> 4) * 68 + (tid & 15) * 4) = xv; *(float4*)(ws + (tid >> 4) * 64 + (tid & 15) * 4) = wv0; *(float4*)(ws + (32 + (tid >> 4)) * 64 + (tid & 15) * 4) = wv1;
        __syncthreads();
#pragma unroll 16
        for (int kk = 0; kk < 64; ++kk) { const float x = xs[tt * 68 + kk]; const float4 wv = *(const float4*)(ws + kk * 64 + eg * 4); a0 += x * wv.x; a1 += x * wv.y; a2 += x * wv.z; a3 += x * wv.w; }
    }
    *(float4*)(LOG + (t0 + tt) * 64 + eg * 4) = make_float4(a0, a1, a2, a3);
}
__device__ __forceinline__ void route_unit(const int wv, unsigned char* lds, int u, const float* LOG, const float* rbias, int* TKIDX, float* TKGATE, int* CNT) {
    int* hist = (int*)lds;
    const int tid = opaque_tid(wv);
    __syncthreads();
    if (tid < 64) hist[tid] = 0;
    __syncthreads();
    if (tid < RCHUNK) {
        const size_t t = (size_t)u * RCHUNK + tid;
        float sc[64], sel[64];
#pragma unroll
        for (int i = 0; i < 16; ++i) { const float4 va = *(const float4*)(LOG + t * 64 + 4 * i), vb = *(const float4*)(LOG + ((size_t)T + t) * 64 + 4 * i); const float4 v = make_float4(va.x + vb.x, va.y + vb.y, va.z + vb.z, va.w + vb.w);     sc[4 * i] = sigmoidf_(v.x); sc[4 * i + 1] = sigmoidf_(v.y); sc[4 * i + 2] = sigmoidf_(v.z); sc[4 * i + 3] = sigmoidf_(v.w); }
#pragma unroll
        for (int e = 0; e < 64; ++e) sel[e] = sc[e] + rbias[e];
        float gs[8];
#pragma unroll
        for (int g = 0; g < 8; ++g) { float m1 = -3.0e38f, m2 = -3.0e38f;
#pragma unroll
            for (int j = 0; j < 8; ++j) { const float v = sel[8 * g + j]; const float lo = fminf(m1, v); m1 = fmaxf(m1, v); m2 = fmaxf(m2, lo); }
            gs[g] = m1 + m2; }
#pragma unroll
        for (int g = 0; g < 8; ++g) { int rank = 0;
#pragma unroll
            for (int g2 = 0; g2 < 8; ++g2) rank += (gs[g2] > gs[g] || (gs[g2] == gs[g] && g2 < g)) ? 1 : 0;
            if (rank >= 4) {
#pragma unroll
                for (int j = 0; j < 8; ++j) sel[8 * g + j] = -1e30f; } }
        int idx[TOPK]; float wsel[TOPK]; float wsum = 0.f;
#pragma unroll
        for (int k = 0; k < TOPK; ++k) { float best = sel[0]; int bi = 0; float bs = sc[0];
#pragma unroll
            for (int e = 1; e < 64; ++e) { const bool gt = sel[e] > best; best = gt ? sel[e] : best; bi = gt ? e : bi; bs = gt ? sc[e] : bs; }
#pragma unroll
            for (int e = 0; e < 64; ++e) sel[e] = (e == bi) ? -3.0e38f : sel[e];
            idx[k] = bi; wsel[k] = bs; wsum += bs; }
        const float inv = 2.5f / wsum;
        int4 i0 = make_int4(idx[0], idx[1], idx[2], idx[3]), i1 = make_int4(idx[4], idx[5], idx[6], idx[7]);
        *(int4*)(TKIDX + t * TOPK) = i0; *(int4*)(TKIDX + t * TOPK + 4) = i1;
        *(float4*)(TKGATE + t * TOPK) = make_float4(wsel[0] * inv, wsel[1] * inv, wsel[2] * inv, wsel[3] * inv); *(float4*)(TKGATE + t * TOPK + 4) = make_float4(wsel[4] * inv, wsel[5] * inv, wsel[6] * inv, wsel[7] * inv);
#pragma unroll
        for (int k = 0; k < TOPK; ++k) atomicAdd(&hist[idx[k]], 1);
    }
    __syncthreads();
    if (tid < 64) CNT[u * 64 + tid] = hist[tid];
}
__device__ __forceinline__ void assign_unit(const int wv, unsigned char* lds, int chunk, const int* CNT, const int* TKIDX, const float* TKGATE, int* ROWTOK, int* ROWDST, float* ROWGATE, int* TILEE) {
    int* total = (int*)lds; int* mybase = total + 64; int* off = mybase + 64; unsigned* mask = (unsigned*)(off + 80); int* part = (int*)(mask + 256);
    const int tid = opaque_tid(wv);
    __syncthreads();
    if (tid < 256) mask[tid] = 0u;
    { const int e = tid & 63, pt = tid >> 6; int tot = 0, base = 0;
#pragma unroll 8
      for (int cc = pt * (NRCHUNK / 8); cc < (pt + 1) * (NRCHUNK / 8); ++cc) { const int v = CNT[cc * 64 + e]; tot += v; if (cc < chunk) base += v; }
      part[pt * 64 + e] = tot; part[512 + pt * 64 + e] = base; }
    __syncthreads();
    if (tid < 64) { int tot = 0, base = 0;
#pragma unroll
        for (int pt = 0; pt < 8; ++pt) { tot += part[pt * 64 + tid]; base += part[512 + pt * 64 + tid]; } total[tid] = tot; mybase[tid] = base; }
    __syncthreads();
    if (tid == 0) { int o = 0; for (int e = 0; e < 64; ++e) { off[e] = o; o += ((total[e] + 255) / 256) * 256; } off[64] = o; }
    __syncthreads();
    int e_[2]; int tt_[2], k_[2];
#pragma unroll
    for (int r = 0; r < 2; ++r) { const int p = tid + 512 * r; tt_[r] = p >> 3; k_[r] = p & 7; e_[r] = TKIDX[((size_t)chunk * RCHUNK + tt_[r]) * TOPK + k_[r]]; atomicOr(&mask[e_[r] * 4 + (tt_[r] >> 5)], 1u << (tt_[r] & 31)); }
    __syncthreads();
#pragma unroll
    for (int r = 0; r < 2; ++r) { const int e = e_[r], tt = tt_[r]; int rank = 0;
        for (int wd = 0; wd < (tt >> 5); ++wd) rank += __builtin_popcount(mask[e * 4 + wd]);
        rank += __builtin_popcount(mask[e * 4 + (tt >> 5)] & ((1u << (tt & 31)) - 1u));
        const int slot = off[e] + mybase[e] + rank; const int t = chunk * RCHUNK + tt;
        ROWTOK[slot] = t; ROWDST[slot] = t * TOPK + k_[r]; ROWGATE[slot] = TKGATE[(size_t)t * TOPK + k_[r]]; }
    if (chunk < 64) { const int e = chunk; const int lo = off[e] + total[e], hi = off[e + 1]; for (int s = lo + tid; s < hi; s += NTHR) { ROWTOK[s] = -1; ROWDST[s] = -1; ROWGATE[s] = 0.f; } }
    for (int t = chunk * RCHUNK + tid; t < (chunk + 1) * RCHUNK; t += NTHR) { ROWDST[A_PAD + t] = T * TOPK + t; ROWGATE[A_PAD + t] = 1.0f; }
    if (chunk == 0) { const int e = tid >> 3; for (int i = off[e] / 256 + (tid & 7); i < off[e + 1] / 256; i += 8) TILEE[i] = e; if (tid == 0) TILEE[MAXTILES] = off[64] / 256; }
}
#ifndef Y8_FIRST_LAYER
#define Y8_FIRST_LAYER 0
#endif
#ifndef DOWN_STAG
#define DOWN_STAG 0
#endif
#ifndef F8DN_FIRST_LAYER
#define F8DN_FIRST_LAYER 0
#endif
#ifndef F8_FIRST_LAYER
#define F8_FIRST_LAYER 0
#endif
constexpr int PH_PER_LAYER = 14, NPHASE = DEPTH * PH_PER_LAYER;
struct Args { const void* in[32]; float* out; unsigned char* ws; RotTab rt; int ph_lo, ph_hi, sub, pad; };
static_assert(sizeof(Args) == 32 * 8 + 8 + 8 + 64 + 16, "Args has no padding");

template <int l, int SUB>
__device__ __forceinline__ void layer_program(const int wv, const Args& args, unsigned char* lds, unsigned char* ws, float* out, const XcdBarrier& bar, const int lo, const int hi) {
    constexpr int pb = l * PH_PER_LAYER;
    constexpr bool Y8 = (l >= Y8_FIRST_LAYER);
    constexpr bool F8DN = (l >= F8DN_FIRST_LAYER);
    constexpr bool F8 = (l >= F8_FIRST_LAYER);
    if (hi <= pb || lo >= pb + PH_PER_LAYER) return;
    LAS unsigned char* ldsL = (LAS unsigned char*)lds;
    const int G = gridDim.x, bid = blockIdx.x;
    const int NGW = G * NWAVES;
    LAS int* ulist = (LAS int*)(ldsL + ULIST_OFF);
#ifndef PHMASK
#define PHMASK 0x3fff
#endif
#define IN(k) (lo <= (k) && (k) < hi && ((PHMASK >> ((k) % PH_PER_LAYER)) & 1))
#define SEAM(k) do { if (!MK_PER_PHASE && IN(k) && IN((k) + 1)) xcd_barrier(bar); } while (0)
#define TIDS() const int tid = opaque_tid(wv), lane = tid & 63, wave = wv, gw = bid * NWAVES + wave; (void)lane; (void)gw
        if (IN(pb + 0)) {
            TIDS();
            WPtrs P; P.w_in = (const float*)args.in[3] + (size_t)l * D * IN_COLS; P.w_out = (const float*)args.in[4] + (size_t)l * D * D; P.gate = (const float*)args.in[28] + (size_t)l * D * D;
            P.plew = (const float*)args.in[27] + (size_t)l * PLE * D; P.ew1 = (const float*)args.in[21] + (size_t)l * NE * D * EF; P.ew3 = (const float*)args.in[22] + (size_t)l * NE * D * EF;
            P.ew2 = (const float*)args.in[23] + (size_t)l * NE * EF * D; P.sw1 = (const float*)args.in[24] + (size_t)l * D * EF; P.sw3 = (const float*)args.in[25] + (size_t)l * D * EF; P.sw2 = (const float*)args.in[26] + (size_t)l * EF * D; P.rw = (const float*)args.in[19] + (size_t)l * D * NE; P.lwa = (const float*)args.in[11] + (size_t)l * 32768; P.lwx = (const float*)args.in[13] + (size_t)l * 32768; P.lru_wg = (bf16_t*)(ws + WS_LRUW);
            convert_weights<F8, F8DN>(lds, P, ws + WS_W, gw, NGW, wave, lane);
            convert_rows((const float*)args.in[1] + (size_t)l * T * PLE, (bf16_t*)(ws + WS_PB), (size_t)T * PLE, (size_t)bid * NTHR + tid, (size_t)G * NTHR);
            if (l == 0) convert_rows((const float*)args.in[0], (bf16_t*)(ws + WS_XB), (size_t)T * D, (size_t)bid * NTHR + tid, (size_t)G * NTHR);
        }
        SEAM(pb + 0);
        if (IN(pb + 1)) {
            pg8::DenseOrder S; S.init(T, IN_COLS, G, bid, 0);
            const pg8::ListOrder L = pg8::build_list(wv, ulist, ULIST_CAP, S);
            pg8::EpiStoreBf16L E{(bf16_t*)(ws + WS_HIN), ldsL + ((wv >> 2) ? TAB_OFF : 3 * pg8::HTB), IN_COLS};
            pg8::gemm_phase<D, pg8::EpiStoreBf16L, pg8::ListOrder, false>(wv, ldsL, (const bf16_t*)(ws + WS_XB), (const bf16_t*)(ws + WS_W + WO_WIN), L, E, nullptr);
        }
        SEAM(pb + 1);
        if (IN(pb + 2)) {
            const bf16_t* HIN = (const bf16_t*)(ws + WS_HIN); bf16_t* MIX = (bf16_t*)(ws + WS_MIX);
            if (!(SUB & 1)) for (int u = bid; u < 512; u += G) attn_unit(wv, lds, u, HIN, (const int*)args.in[2], (const float*)args.in[5] + l * 16, MIX, (float*)(ws + WS_SSQ), args.rt);
            LruW W; W.conv_w = (const float*)args.in[9] + l * 2048; W.conv_b = (const float*)args.in[10] + l * 512; W.wa = (const float*)args.in[11] + (size_t)l * 32768; W.ba = (const float*)args.in[12] + l * 512;
            W.wx = (const float*)args.in[13] + (size_t)l * 32768; W.bx = (const float*)args.in[14] + l * 512; W.lam = (const float*)args.in[15] + l * 512; W.gain = (const float*)args.in[16] + l * 512;
            if (!(SUB & 2)) for (int u = bid; u < BATCH * NLCH; u += G) lru1_unit(wv, lds, u, HIN, W, (const bf16_t*)(ws + WS_LRUW), (float*)(ws + WS_LRUA), (float*)(ws + WS_LRUH), (bf16_t*)(ws + WS_LRUHL), (bf16_t*)(ws + WS_LRUPL));
            if (!(SUB & 4)) for (int u = bid; u < 2048; u += G) hg1_unit(wv, lds, u, HIN, (const float*)args.in[7], l, (bf16_t*)(ws + WS_SST), (float*)(ws + WS_DV));
        }
        SEAM(pb + 2);
        if (IN(pb + 3)) {
            TIDS();
            const bf16_t* HIN = (const bf16_t*)(ws + WS_HIN); bf16_t* MIX = (bf16_t*)(ws + WS_MIX);
            if (!(SUB & 1)) for (int t = 4 * gw; t < T; t += 4 * NGW) attn_fin_rows4(MIX, (const float*)(ws + WS_SSQ), (const float*)args.in[6] + l * 1024, t, lane);
            if (!(SUB & 2)) for (int u = bid; u < 256; u += G) hg2_unit(wv, u, (const bf16_t*)(ws + WS_SST), (const float*)(ws + WS_DV), (bf16_t*)(ws + WS_SPREV));
            if (!(SUB & 4)) for (int u = bid; u < BATCH; u += G) lru_carry_unit(wv, u, (const float*)(ws + WS_LRUA), (float*)(ws + WS_LRUH));
        }
        SEAM(pb + 3);
        if (IN(pb + 4)) {
            if (!(SUB & 1)) for (int u = bid; u < BATCH * NLCH; u += G) lru2_unit(wv, lds, u, (const bf16_t*)(ws + WS_HIN), (const float*)args.in[16] + l * 512, (const float*)(ws + WS_LRUH), (const bf16_t*)(ws + WS_LRUHL), (const bf16_t*)(ws + WS_LRUPL), (bf16_t*)(ws + WS_MIX));
            if (!(SUB & 2))
            for (int u = bid; u < 2048; u += G) hg3_unit(wv, lds, u, (const bf16_t*)(ws + WS_HIN), (const float*)args.in[7], l, (const bf16_t*)(ws + WS_SPREV), (const float*)args.in[8] + l * 512, (bf16_t*)(ws + WS_MIX));
        }
        SEAM(pb + 4);
        if (IN(pb + 5)) {
            pg8::DenseOrder S; S.init(T, D, G, bid, 0);
            const pg8::ListOrder L = pg8::build_list(wv, ulist, ULIST_CAP, S);
            pg8::EpiStoreBf16L E{(bf16_t*)(ws + WS_HIN), ldsL + ((wv >> 2) ? TAB_OFF : 3 * pg8::HTB), D};
            pg8::gemm_phase<D, pg8::EpiStoreBf16L, pg8::ListOrder, false>(wv, ldsL, (const bf16_t*)(ws + WS_MIX), (const bf16_t*)(ws + WS_W + WO_WOUT), L, E, nullptr);
        }
        SEAM(pb + 5);
        if (IN(pb + 6)) {
            TIDS();
            const float* g1 = (const float*)args.in[17] + l * D; const float* b1 = (const float*)args.in[18] + l * D; bf16_t* XB = (bf16_t*)(ws + WS_XB); const bf16_t* ZB = (const bf16_t*)(ws + WS_HIN);
            unsigned char* X8 = (unsigned char*)(ws + WS_MIX);
            for (int t = 2 * gw; t < T; t += 2 * NGW) ln1_rows2(ZB + (size_t)t * D, ZB + (size_t)(t + 1) * D, g1, b1, XB + (size_t)t * D, XB + (size_t)(t + 1) * D, lane, F8 ? X8 + (size_t)t * D : nullptr, F8 ? X8 + (size_t)(t + 1) * D : nullptr);
        }
        SEAM(pb + 6);
        if (IN(pb + 7)) {
            if (!(SUB & 1)) { pg8::DenseOrder S; S.init(T, D, G, bid, 0);
              const pg8::ListOrder L = pg8::build_list(wv, ulist, ULIST_CAP, S);
              if constexpr (Y8) { pg8::EpiStore8L E{(unsigned char*)(ws + WS_U), ldsL + ((wv >> 2) ? TAB_OFF : 3 * pg8::HTB), D};
                pg8::gemm_phase<PLE, pg8::EpiStore8L, pg8::ListOrder, false>(wv, ldsL, (const bf16_t*)(ws + WS_PB), (const bf16_t*)(ws + WS_W + WO_PLEW), L, E, nullptr); }
              else { pg8::EpiStoreBf16 E{(bf16_t*)(ws + WS_U), D, 0};
                pg8::gemm_phase<PLE, pg8::EpiStoreBf16, pg8::ListOrder, false>(wv, ldsL, (const bf16_t*)(ws + WS_PB), (const bf16_t*)(ws + WS_W + WO_PLEW), L, E, nullptr); } }
            if (!(SUB & 2)) { pg8::RouterSplitOrder S; S.init(G, bid);
              const pg8::ListOrder L = pg8::build_list(wv, ulist, ULIST_CAP, S);
              pg8::EpiRouter E{(float*)(ws + WS_LOGITS)};
              pg8::gemm_phase<D / 2, pg8::EpiRouter, pg8::ListOrder, false, 0, false, 0, D>(wv, ldsL, (const bf16_t*)(ws + WS_XB), (const bf16_t*)(ws + WS_W + WO_ROUT), L, E, nullptr); }
        }
        SEAM(pb + 7);
        if (IN(pb + 8)) {
            for (int u = bid; u < NRCHUNK; u += G) route_unit(wv, lds, u, (const float*)(ws + WS_LOGITS), (const float*)args.in[20] + l * 64, (int*)(ws + WS_TKIDX), (float*)(ws + WS_TKGATE), (int*)(ws + WS_CNT));
        }
        SEAM(pb + 8);
        if (IN(pb + 9)) {
            for (int u = bid; u < NRCHUNK; u += G) assign_unit(wv, lds, u, (const int*)(ws + WS_CNT), (const int*)(ws + WS_TKIDX), (const float*)(ws + WS_TKGATE), (int*)(ws + WS_ROWTOK), (int*)(ws + WS_ROWDST), (float*)(ws + WS_ROWGATE), (int*)(ws + WS_TILEE));
        }
        SEAM(pb + 9);
        if (IN(pb + 10)) {
            TIDS();
            const int* TILEE = (const int*)(ws + WS_TILEE); const int* ROWTOK = (const int*)(ws + WS_ROWTOK);
            const int ntiles = TILEE[MAXTILES];
            pg8::UpOrder S2; S2.init(TILEE, ntiles, G, bid, 0);
            const pg8::ListOrder L2 = pg8::build_list(wv, ulist, TAB_BYTES / 1024, S2);
            LAS int* gtab = (LAS int*)(ldsL + TAB_OFF);
            if (tid < 256) for (int j = 0; j < L2.n; ++j) { const int orow = ulist[j * 4 + 2]; int r;
                if (orow < A_PAD) { r = ROWTOK[orow + tid]; r = r < 0 ? 0 : r; } else r = orow - A_PAD + tid;
                gtab[j * 256 + tid] = r; }
            __syncthreads();
            if constexpr (F8 && F8DN) { pg8::EpiSwiglu8 E2{(unsigned char*)(ws + WS_HM)};
                pg8::gemm_phase<D, pg8::EpiSwiglu8, pg8::ListOrder, true, (SUB >> 3) & 3, true>(wv, ldsL, (const bf16_t*)(ws + WS_MIX), (const bf16_t*)(ws + WS_W + WO_W13), L2, E2, gtab); }
            else if constexpr (F8) { pg8::EpiSwiglu E2{(bf16_t*)(ws + WS_HM)};
                pg8::gemm_phase<D, pg8::EpiSwiglu, pg8::ListOrder, true, 0, true>(wv, ldsL, (const bf16_t*)(ws + WS_MIX), (const bf16_t*)(ws + WS_W + WO_W13), L2, E2, gtab); }
            else { pg8::EpiSwiglu E2{(bf16_t*)(ws + WS_HM)};
                pg8::gemm_phase<D, pg8::EpiSwiglu, pg8::ListOrder, true>(wv, ldsL, (const bf16_t*)(ws + WS_XB), (const bf16_t*)(ws + WS_W + WO_W13), L2, E2, gtab); }
            if (!(SUB & 4)) { pg8::DenseOrder S; S.init(T, D, G, bid, 0);
              const pg8::ListOrder L = pg8::build_list(wv, ulist, ULIST_CAP, S);
              if constexpr (F8 && Y8) { pg8::EpiGate8 E{(unsigned char*)(ws + WS_U), (const float*)args.in[29] + l * D};
                pg8::gemm_phase<D, pg8::EpiGate8, pg8::ListOrder, false, 0, true>(wv, ldsL, (const bf16_t*)(ws + WS_MIX), (const bf16_t*)(ws + WS_W + WO_GATE), L, E, nullptr); }
              else { pg8::EpiGate E{(bf16_t*)(ws + WS_U), (const float*)args.in[29] + l * D};
                if constexpr (F8) pg8::gemm_phase<D, pg8::EpiGate, pg8::ListOrder, false, 0, true>(wv, ldsL, (const bf16_t*)(ws + WS_MIX), (const bf16_t*)(ws + WS_W + WO_GATE), L, E, nullptr);
                else pg8::gemm_phase<D, pg8::EpiGate, pg8::ListOrder, false>(wv, ldsL, (const bf16_t*)(ws + WS_XB), (const bf16_t*)(ws + WS_W + WO_GATE), L, E, nullptr); } }
        }
        SEAM(pb + 10);
        if (IN(pb + 11)) {
            if (SUB & 2) return;
            const int* TILEE = (const int*)(ws + WS_TILEE);
            const int ntiles = TILEE[MAXTILES];
            pg8::DownOrder2 S3; S3.init(TILEE, ntiles, G, bid);
            const pg8::ListOrder L3 = pg8::build_list(wv, ulist, ULIST_CAP, S3);
            if constexpr (Y8 && F8DN) { pg8::EpiScatter8L E3{(unsigned char*)(ws + WS_Y), (const int*)(ws + WS_ROWDST), (const float*)(ws + WS_ROWGATE), ldsL + ((wv >> 2) ? TAB_OFF : 3 * pg8::HTB)};
                pg8::gemm_phase<EF, pg8::EpiScatter8L, pg8::ListOrder, false, (SUB >> 3) & 3, true, DOWN_STAG>(wv, ldsL, (const bf16_t*)(ws + WS_HM), (const bf16_t*)(ws + WS_W + WO_W2), L3, E3, nullptr); }
            else if constexpr (Y8) { pg8::EpiScatter8 E3{(unsigned char*)(ws + WS_Y), (const int*)(ws + WS_ROWDST), (const float*)(ws + WS_ROWGATE)};
                pg8::gemm_phase<EF, pg8::EpiScatter8, pg8::ListOrder, false, (SUB >> 3) & 3, F8DN, DOWN_STAG>(wv, ldsL, (const bf16_t*)(ws + WS_HM), (const bf16_t*)(ws + WS_W + WO_W2), L3, E3, nullptr); }
            else { pg8::EpiScatter2 E3{(bf16_t*)(ws + WS_Y), (bf16_t*)(ws + WS_W + WO_W13), (const int*)(ws + WS_ROWDST), (const float*)(ws + WS_ROWGATE)};
                pg8::gemm_phase<EF, pg8::EpiScatter2, pg8::ListOrder, false, (SUB >> 3) & 3, F8DN, DOWN_STAG>(wv, ldsL, (const bf16_t*)(ws + WS_HM), (const bf16_t*)(ws + WS_W + WO_W2), L3, E3, nullptr); }
        }
        SEAM(pb + 11);
        if (IN(pb + 13)) {
            TIDS();
            const float* g2 = (const float*)args.in[30] + l * D; const float* b2 = (const float*)args.in[31] + l * D; bf16_t* XB = (bf16_t*)(ws + WS_XB); const bf16_t* Y = (const bf16_t*)(ws + WS_Y);
            if constexpr (Y8) { for (int t = gw; t < T; t += NGW) ln2_row8(XB + (size_t)t * D, g2, b2, (l == DEPTH - 1) ? out + (size_t)t * D : nullptr, (l == DEPTH - 1) ? nullptr : XB + (size_t)t * D, (const unsigned char*)(ws + WS_Y) + (size_t)t * TOPK * D, (const unsigned char*)(ws + WS_U) + (size_t)t * D, (const unsigned char*)(ws + WS_Y) + ((size_t)T * TOPK + t) * D, lane); }
            else { for (int t = gw; t < T; t += NGW) ln2_row(XB + (size_t)t * D, g2, b2, (l == DEPTH - 1) ? out + (size_t)t * D : nullptr, (l == DEPTH - 1) ? nullptr : XB + (size_t)t * D, Y + (size_t)t * TOPK * D, (const bf16_t*)(ws + WS_U) + (size_t)t * D, (const bf16_t*)(ws + WS_W + WO_W13) + (size_t)t * D, lane); }
        }

#undef TIDS
#undef IN
#undef SEAM
}

template <int SUB>
__global__ void __launch_bounds__(NTHR, 2) mega_fwd(Args args) {
    extern __shared__ __attribute__((aligned(16))) unsigned char lds[];
    LAS unsigned char* ldsL = (LAS unsigned char*)lds;
    volatile LAS unsigned* MISC = (volatile LAS unsigned*)(ldsL + MISC_OFF);
    unsigned char* ws = args.ws; float* out = args.out;
    if (threadIdx.x < 32) MISC[threadIdx.x] = 0u;
    __syncthreads();
    XcdBarrier bar; bar.bar = (unsigned*)(ws + WS_CTL) + CW_BAR; bar.x = 0; bar.st = nullptr; bar.w0 = 0;
    if (!MK_PER_PHASE) bar = xcd_barrier_post((unsigned*)(ws + WS_CTL) + CW_BAR, MISC + 8);
    const int lo = args.ph_lo, hi = args.ph_hi;
    const int wv = __builtin_amdgcn_readfirstlane(threadIdx.x >> 6);
    layer_program<0, SUB>(wv, args, lds, ws, out, bar, lo, hi);
    if (!MK_PER_PHASE && lo <= PH_PER_LAYER - 1 && hi > PH_PER_LAYER) xcd_barrier(bar);
    layer_program<1, SUB>(wv, args, lds, ws, out, bar, lo, hi);
}

extern "C" void kernel_launch(void* const* d_in, const int* in_sizes, int n_in, void* d_out, int out_size, void* d_ws, size_t ws_size, hipStream_t stream) {
    static int grid = 0;
    if (grid == 0) {
        if (n_in != 32 || out_size != T * D || ws_size < WS_END) { fprintf(stderr, "kernel_launch: unexpected sizes n_in %d out %d ws %zu (need %zu); nothing launched\n", n_in, out_size, ws_size, (size_t)WS_END); grid = -1; return; }
        int dev = 0, cus = 0, per_cu = 0;
        if (hipGetDevice(&dev) != hipSuccess || hipDeviceGetAttribute(&cus, hipDeviceAttributeMultiprocessorCount, dev) != hipSuccess) { grid = -1; return; }
        if (hipFuncSetAttribute((const void*)mega_fwd<0>, hipFuncAttributeMaxDynamicSharedMemorySize, LDS_BYTES) != hipSuccess) { fprintf(stderr, "kernel_launch: hipFuncSetAttribute failed\n"); grid = -1; return; }
        if (hipOccupancyMaxActiveBlocksPerMultiprocessor(&per_cu, (const void*)mega_fwd<0>, NTHR, LDS_BYTES) != hipSuccess || per_cu < 1) { fprintf(stderr, "kernel_launch: occupancy query reports %d blocks per CU\n", per_cu); }
        (void)hipGetLastError();
        grid = cus;
    }
    if (grid < 0) return;
    if (hipMemsetAsync((char*)d_ws + WS_CTL, 0, CTL_ZERO_BYTES, stream) != hipSuccess) { fprintf(stderr, "kernel_launch: memset failed\n"); return; }
    Args a{};
    for (int i = 0; i < 32; ++i) a.in[i] = d_in[i];
    a.out = (float*)d_out; a.ws = (unsigned char*)d_ws;
    for (int i = 0; i < 8; ++i) a.rt.invf[i] = std::pow(500000.0, -(double)i / 8.0);
#if MK_PER_PHASE
    for (int ph = 0; ph < NPHASE; ++ph) { a.ph_lo = ph; a.ph_hi = ph + 1; hipLaunchKernelGGL(mega_fwd<0>, dim3(grid), dim3(NTHR), LDS_BYTES, stream, a); }
#else
    a.ph_lo = 0; a.ph_hi = NPHASE;
    hipLaunchKernelGGL(mega_fwd<0>, dim3(grid), dim3(NTHR), LDS_BYTES, stream, a);
#endif
#ifdef PROBE_PH
    { static bool once = false; if (!once) { (void)hipFuncSetAttribute((const void*)mega_fwd<PROBE_SUB>, hipFuncAttributeMaxDynamicSharedMemorySize, LDS_BYTES); once = true; }
      const int pl[] = {PROBE_PH}; for (unsigned i = 0; i < sizeof(pl) / sizeof(int); ++i) { a.ph_lo = pl[i]; a.ph_hi = pl[i] + 1; hipLaunchKernelGGL(mega_fwd<PROBE_SUB>, dim3(grid), dim3(NTHR), LDS_BYTES, stream, a); } }
#endif
    const hipError_t le = hipPeekAtLastError();
    if (le != hipSuccess) fprintf(stderr, "kernel_launch: launch failed: %s\n", hipGetErrorName(le));
}
```

```cpp
#include <hip/hip_runtime.h>
#include <cstdio>
#include <cmath>

#ifndef MK_PER_PHASE
#define MK_PER_PHASE 0
#endif

typedef unsigned short bf16_t;
typedef short bf16x8 __attribute__((ext_vector_type(8)));
typedef float f32x4 __attribute__((ext_vector_type(4)));
typedef unsigned u32x4 __attribute__((ext_vector_type(4)));
typedef unsigned u32x2 __attribute__((ext_vector_type(2)));
#define LAS __attribute__((address_space(3)))

constexpr int BATCH = 8, SEQ = 4096, T = BATCH * SEQ, D = 2048, DEPTH = 2, PLE = 256;
constexpr int IN_COLS = 4352;
constexpr int C_AQ = 0, C_AK = 1024, C_AV = 1152, C_HQ = 1280, C_HF = 1792, C_HI = 2304, C_HG = 2816, C_LX = 3328, C_LG = 3840;
constexpr int NE = 64, TOPK = 8, EF = 512;
constexpr int A_ROWS = T * TOPK;
constexpr int MAXTILES = A_ROWS / 256 + NE;
constexpr int A_PAD = MAXTILES * 256;
constexpr float ALPHA = 1.41421356237309515f;
constexpr int RCHUNK = 128, NRCHUNK = T / RCHUNK;
constexpr int LCH = 32, NLCH = SEQ / LCH;

constexpr size_t MiB = 1u << 20;
constexpr size_t WS_CTL = 0, CTL_ZERO_BYTES = 256 * 1024;
constexpr size_t WS_CNT = 1 * MiB;
constexpr size_t WS_TILEE = 2 * MiB;
constexpr size_t WS_LOGITS = 840 * MiB;
constexpr size_t WS_TKIDX = 12 * MiB;
constexpr size_t WS_TKGATE = 13 * MiB;
constexpr size_t WS_ROWTOK = 14 * MiB;
constexpr size_t WS_ROWDST = 16 * MiB;
constexpr size_t WS_ROWGATE = 18 * MiB;
constexpr size_t WS_LRUA = 20 * MiB;
constexpr size_t WS_LRUH = 22 * MiB;
constexpr size_t WS_SSQ = 24 * MiB;
constexpr size_t WS_DV = 25 * MiB;
constexpr size_t WS_LRUW = 26 * MiB;
constexpr size_t WS_Y = 32 * MiB;
constexpr size_t WS_HIN = 32 * MiB;
constexpr size_t WS_MIX = 304 * MiB;
constexpr size_t WS_SST = 432 * MiB;
constexpr size_t WS_PB = 560 * MiB;
constexpr size_t WS_LRUHL = 576 * MiB;
constexpr size_t WS_LRUPL = 640 * MiB;
constexpr size_t WS_SPREV = 768 * MiB;
constexpr size_t WS_XB = 1056 * MiB;
constexpr size_t WS_HM = 1184 * MiB;
constexpr size_t WS_U = 1488 * MiB;
constexpr size_t WS_W = 1616 * MiB;
constexpr size_t WO_WIN = 0, WO_WOUT = 17 * MiB, WO_GATE = 25 * MiB, WO_PLEW = 33 * MiB, WO_W2 = 34 * MiB, WO_W13 = 164 * MiB, WO_ROUT = 424 * MiB, WO_END = 425 * MiB;
constexpr size_t WS_END = WS_W + WO_END;
static_assert((size_t)IN_COLS * D * 2 <= WO_WOUT - WO_WIN && (size_t)65 * 2048 * 512 * 2 <= WO_W13 - WO_W2 && (size_t)65 * 1024 * 2048 * 2 <= WO_ROUT - WO_W13, "weight map");
static_assert(WS_PB + (size_t)T * PLE * 2 <= WS_Y + (size_t)A_ROWS * D * 2 && WS_Y + (size_t)A_ROWS * D * 2 <= WS_XB && WS_HM + (size_t)(A_PAD + T) * EF * 2 <= WS_U, "ws map");

__device__ __forceinline__ int lane_id() { return (int)__builtin_amdgcn_mbcnt_hi(~0u, __builtin_amdgcn_mbcnt_lo(~0u, 0u)); }
__device__ __forceinline__ int opaque_tid(int wv) { int l; asm volatile("v_mbcnt_lo_u32_b32 %0, -1, 0\n\tv_mbcnt_hi_u32_b32 %0, -1, %0" : "=v"(l)); return wv * 64 + l; }
__device__ __forceinline__ bf16_t f2bf(float f) { unsigned u = __float_as_uint(f); u += 0x7fffu + ((u >> 16) & 1u); return (bf16_t)(u >> 16); }
__device__ __forceinline__ float bf2f(bf16_t b) { return __uint_as_float(((unsigned)b) << 16); }
__device__ __forceinline__ float bflo(unsigned w) { return __uint_as_float(w << 16); }
__device__ __forceinline__ float bfhi(unsigned w) { return __uint_as_float(w & 0xffff0000u); }
__device__ __forceinline__ unsigned pk2(float lo, float hi) { return (unsigned)f2bf(lo) | ((unsigned)f2bf(hi) << 16); }
__device__ __forceinline__ unsigned cvt_pk_bf16(float lo, float hi) { unsigned r; asm("v_cvt_pk_bf16_f32 %0, %1, %2" : "=v"(r) : "v"(lo), "v"(hi)); return r; }
__device__ __forceinline__ bf16_t f2bf_hw(float f) { return (bf16_t)(cvt_pk_bf16(f, f) & 0xffffu); }
__device__ __forceinline__ float rcpf_(float x) { return __builtin_amdgcn_rcpf(x); }
__device__ __forceinline__ float rsqf_(float x) { return __builtin_amdgcn_rsqf(x); }
__device__ __forceinline__ float sigmoidf_(float x) { return rcpf_(1.0f + __expf(-x)); }
__device__ __forceinline__ float siluf_(float x) { return x * rcpf_(1.0f + __expf(-x)); }
__device__ __forceinline__ float gelu_tanh(float x) { const float u = 0.7978845608028654f * (x + 0.044715f * x * x * x); const float e = __expf(2.0f * u); const float th = 1.0f - 2.0f * rcpf_(e + 1.0f); return 0.5f * x * (1.0f + th); }
__device__ __forceinline__ float wave_sum(float v) {
#pragma unroll
    for (int o = 1; o < 64; o <<= 1) v += __shfl_xor(v, o);
    return v;
}
__device__ __forceinline__ float clamp8(float x) { return fminf(fmaxf(x, -448.f), 448.f); }
__device__ __forceinline__ unsigned cvt4_fp8(float a, float b, float c, float dd) { int p = __builtin_amdgcn_cvt_pk_fp8_f32(clamp8(a), clamp8(b), 0, false); p = __builtin_amdgcn_cvt_pk_fp8_f32(clamp8(c), clamp8(dd), p, true); return (unsigned)p; }
constexpr float W8_SCALE = 64.f;
constexpr float Y8_SCALE = 16.f;
constexpr int W8_E8M0 = 0x7c7c7c7c, A8_E8M0 = 0x7c7c7c7c;
__device__ __forceinline__ void sincos_pos(float pos, double invf, float& s, float& c) {
    const double a = (double)pos * invf;
    const double q = rint(a * 0.63661977236758134308);
    const float r = (float)(a - q * 1.57079632679489661923);
    const int qi = ((int)q) & 3;
    const float r2 = r * r;
    const float sp = r * (1.0f + r2 * (-1.6666667163e-1f + r2 * (8.3333337680e-3f + r2 * (-1.9841270114e-4f + r2 * 2.7557314297e-6f))));
    const float cp = 1.0f + r2 * (-0.5f + r2 * (4.1666667908e-2f + r2 * (-1.3888889225e-3f + r2 * (2.4801587642e-5f + r2 * -2.7557314297e-7f))));
    const float ss = (qi & 1) ? cp : sp, cc = (qi & 1) ? sp : cp;
    s = (qi & 2) ? -ss : ss;
    c = ((qi + 1) & 2) ? -cc : cc;
}
namespace pg8 {
constexpr int BM = 256, BK = 64, HALF = 128, HTB = HALF * BK * 2, STAGE_BYTES = 8 * HTB, NXCD = 8, WGM = 8;
__host__ __device__ __forceinline__ int lds_byte(int r, int c) { const int st = (r >> 4) * 2 + (c >> 5), rr = r & 15, cc = c & 31, ob = rr * 64 + cc * 2; return st * 1024 + (ob ^ (((ob >> 9) & 1) << 5)); }
__host__ __device__ __forceinline__ void stage_rc(int b, int& R, int& C) { const int st = b / 1024, sb = b % 1024, swz = sb ^ (((sb >> 9) & 1) << 5); R = (st >> 1) * 16 + swz / 64; C = (st & 1) * 32 + (swz % 64) / 2; }
__host__ __device__ __forceinline__ int perm32(int rho) { const int n = rho >> 4, i = rho & 15; return 8 * (i >> 2) + 4 * n + (i & 3); }

struct Unit { int brow, pn, orow, tab; };

__device__ __forceinline__ int xcd_remap(int L, int nwg) { const int q = nwg / NXCD, r = nwg % NXCD, xcd = L % NXCD, off = L / NXCD; return (xcd < r ? xcd * (q + 1) : r * (q + 1) + (xcd - r) * q) + off; }

struct DenseOrder {
    int nM, nN, nwg, G, c, start;
    __device__ void init(int M, int N, int G_, int c_, int start_) { nM = M / BM; nN = N / BM; nwg = nM * nN; G = G_; c = c_; start = start_ % G_; }
    __device__ bool next(int i, Unit& u) const {
        const long L = (long)(i + (c < start ? 1 : 0)) * G + c - start; if (L >= nwg) return false;
        const int wgid = xcd_remap((int)L, nwg);
        const int nig = WGM * nN, gid = wgid / nig, fm = gid * WGM, gsz = (nM - fm) < WGM ? (nM - fm) : WGM;
        const int pm = fm + ((wgid % nig) % gsz); u.pn = (wgid % nig) / gsz; u.orow = pm * BM; u.brow = u.pn * BM; u.tab = 0; return true;
    }
};
struct RouterSplitOrder {
    int G, c;
    __device__ void init(int G_, int c_) { G = G_; c = c_; }
    __device__ bool next(int i, Unit& u) const { const long L = (long)i * G + c; if (L >= 2 * (T / BM)) return false;
        u.orow = (int)(L >> 1) * BM; u.brow = 0; u.pn = 0; u.tab = (int)(L & 1); return true; }
};
struct UpOrder {
    const int* tile_e; int ntiles, nwg, G, c, start;
    __device__ void init(const int* te, int nt_, int G_, int c_, int start_) { tile_e = te; ntiles = nt_; nwg = (nt_ + T / BM) * 4; G = G_; c = c_; start = start_ % G_; }
    __device__ bool next(int i, Unit& u) const {
        const long L = (long)(i + (c < start ? 1 : 0)) * G + c - start; if (L >= nwg) return false;
        const int wgid = xcd_remap((int)L, nwg); const int tile = wgid >> 2; u.pn = wgid & 3; u.tab = i;
        if (tile < ntiles) { u.brow = tile_e[tile] * 1024 + u.pn * BM; u.orow = tile * BM; }
        else { u.brow = 64 * 1024 + u.pn * BM; u.orow = A_PAD + (tile - ntiles) * BM; }
        return true;
    }
};
struct DownOrder {
    const int* tile_e; int lo, hi, t0;
    __device__ void init(const int* te, int nt_, int G_, int c_) { tile_e = te; const int n = nt_ * 8; const int vc = (G_ % 8 == 0) ? (c_ % 8) * (G_ / 8) + c_ / 8 : c_;
        lo = (int)(((long)vc * n) / G_); hi = (int)(((long)(vc + 1) * n) / G_); t0 = lo >> 3; }
    __device__ bool next(int i, Unit& u) const {
        const int id = lo + i; if (id >= hi) return false;
        const int tile = id >> 3; u.pn = id & 7; u.orow = tile * BM; u.brow = tile_e[tile] * 2048 + u.pn * BM; u.tab = tile - t0; return true;
    }
};

struct DownOrder2 {
    const int* tile_e; int ntiles, lo, hi, gq, pn;
    __device__ void init(const int* te, int nt_, int G_, int c_) { tile_e = te; ntiles = nt_; const int ntot = nt_ + T / BM, x = c_ % NXCD, j = c_ / NXCD, ngrp = (G_ / NXCD) / 8;
        lo = (int)(((long)x * ntot) / NXCD); hi = (int)(((long)(x + 1) * ntot) / NXCD); gq = j >> 3; pn = j & 7; if (gq >= ngrp) hi = lo; stride = ngrp; }
    int stride;
    __device__ bool next(int i, Unit& u) const {
        const int t = lo + gq + stride * i; if (t >= hi) return false;
        u.pn = pn; u.tab = 0;
        if (t < ntiles) { u.brow = tile_e[t] * 2048 + pn * BM; u.orow = t * BM; } else { u.brow = 64 * 2048 + pn * BM; u.orow = A_PAD + (t - ntiles) * BM; }
        return true;
    }
};
struct ListOrder { const LAS int* tab; int n;
    __device__ __forceinline__ bool next(int i, Unit& u) const { if (i >= n) return false; const LAS int* p = tab + i * 4;
        u.brow = __builtin_amdgcn_readfirstlane(p[0]); u.pn = __builtin_amdgcn_readfirstlane(p[1]); u.orow = __builtin_amdgcn_readfirstlane(p[2]); u.tab = __builtin_amdgcn_readfirstlane(p[3]); return true; } };
template <class Sched> __device__ __forceinline__ ListOrder build_list(const int wv, LAS int* tab, int cap, const Sched& S) {
    __syncthreads();
    if (wv == 0) { const int i = opaque_tid(wv); Unit u; const bool ok = (i < cap) && S.next(i, u);
        if (ok) { tab[i * 4 + 0] = u.brow; tab[i * 4 + 1] = u.pn; tab[i * 4 + 2] = u.orow; tab[i * 4 + 3] = u.tab; }
        const int n = __builtin_popcountll(__ballot(ok)); if (i == 0) tab[-16] = n; }
    __syncthreads();
    ListOrder L; L.tab = tab; L.n = __builtin_amdgcn_readfirstlane(tab[-16]); return L;
}

struct EpiStoreBf16 { static constexpr bool PERM = true; bf16_t* O; int ldo; int pad;
    __device__ __forceinline__ void operator()(const f32x4 (&acc)[2][2][4][2], const Unit& u, int wr, int wc, int fr, int fq) const {
        const int row0 = u.orow + wr * 64 + fr, col0 = u.pn * BM + wc * 32 + 8 * fq;
#pragma unroll
        for (int ai = 0; ai < 2; ++ai)
#pragma unroll
            for (int m = 0; m < 4; ++m) { bf16_t* rowp = O + (size_t)(row0 + ai * HALF + m * 16) * ldo + col0;
#pragma unroll
                for (int bj = 0; bj < 2; ++bj) { const f32x4 v0 = acc[ai][bj][m][0], v1 = acc[ai][bj][m][1];
                    u32x4 w; w.x = cvt_pk_bf16(v0[0], v0[1]); w.y = cvt_pk_bf16(v0[2], v0[3]); w.z = cvt_pk_bf16(v1[0], v1[1]); w.w = cvt_pk_bf16(v1[2], v1[3]);
                    *(u32x4*)(rowp + bj * HALF) = w; } }
    } };
struct EpiStoreBf16L { static constexpr bool PERM = true; bf16_t* O; LAS unsigned char* lds; int ldo;
    __device__ __forceinline__ void operator()(const f32x4 (&acc)[2][2][4][2], const Unit& u, int wr, int wc, int fr, int fq) const {
        const int lane = fq * 16 + fr, rr = wc * 8 + (lane >> 5);
        const unsigned wa = (unsigned)(fr * 512 + (((wc * 4 + fq) ^ fr) << 4));
        bf16_t* op = O + (size_t)(u.orow + wr * 64 + rr) * ldo + u.pn * BM + (lane & 31) * 8;
#pragma unroll
        for (int ai = 0; ai < 2; ++ai)
#pragma unroll
            for (int mh = 0; mh < 2; ++mh) {
#pragma unroll
                for (int mp = 0; mp < 2; ++mp)
#pragma unroll
                    for (int bj = 0; bj < 2; ++bj) { const f32x4 v0 = acc[ai][bj][2 * mh + mp][0], v1 = acc[ai][bj][2 * mh + mp][1];
                        u32x4 w; w.x = cvt_pk_bf16(v0[0], v0[1]); w.y = cvt_pk_bf16(v0[2], v0[3]); w.z = cvt_pk_bf16(v1[0], v1[1]); w.w = cvt_pk_bf16(v1[2], v1[3]);
                        *(LAS u32x4*)(lds + (wa ^ (unsigned)((bj ^ mp) << 8)) + mp * 8192) = w; }
                asm volatile("s_waitcnt lgkmcnt(0)" ::: "memory"); __builtin_amdgcn_s_barrier();
                u32x4 rv[4];
#pragma unroll
                for (int i = 0; i < 4; ++i) { const int row = rr + 2 * i; rv[i] = *(const LAS u32x4*)(lds + row * 512 + ((((lane & 31) ^ row) & 31) << 4)); }
#pragma unroll
                for (int i = 0; i < 4; ++i) *(u32x4*)(op + (size_t)(ai * HALF + mh * 32 + 2 * i) * ldo) = rv[i];
                asm volatile("s_waitcnt lgkmcnt(0)" ::: "memory"); __builtin_amdgcn_s_barrier();
            }
    } };
struct EpiStore8 { static constexpr bool PERM = true; unsigned char* O; int ldo; int pad;
    __device__ __forceinline__ void operator()(const f32x4 (&acc)[2][2][4][2], const Unit& u, int wr, int wc, int fr, int fq) const {
        const int row0 = u.orow + wr * 64 + fr, col0 = u.pn * BM + wc * 32 + 8 * fq;
#pragma unroll
        for (int ai = 0; ai < 2; ++ai)
#pragma unroll
            for (int m = 0; m < 4; ++m) { unsigned char* rowp = O + (size_t)(row0 + ai * HALF + m * 16) * ldo + col0;
#pragma unroll
                for (int bj = 0; bj < 2; ++bj) { const f32x4 v0 = acc[ai][bj][m][0], v1 = acc[ai][bj][m][1];
                    u32x2 w; w.x = cvt4_fp8(v0[0], v0[1], v0[2], v0[3]); w.y = cvt4_fp8(v1[0], v1[1], v1[2], v1[3]); *(u32x2*)(rowp + bj * HALF) = w; } }
    } };
struct EpiStore8L { static constexpr bool PERM = true; unsigned char* O; LAS unsigned char* lds; int ldo;
    __device__ __forceinline__ void operator()(const f32x4 (&acc)[2][2][4][2], const Unit& u, int wr, int wc, int fr, int fq) const {
        const unsigned wa = (unsigned)(fr * 256 + (((wc * 2 + (fq >> 1)) ^ fr) << 4) + 8 * (fq & 1));
        const unsigned ra = (unsigned)(wc * 4096 + fq * 256);
        unsigned char* op = O + (size_t)(u.orow + wr * 64 + wc * 16 + fq) * ldo + u.pn * BM + fr * 16;
#pragma unroll
        for (int ai = 0; ai < 2; ++ai) {
#pragma unroll
            for (int m = 0; m < 4; ++m)
#pragma unroll
                for (int bj = 0; bj < 2; ++bj) { const f32x4 v0 = acc[ai][bj][m][0], v1 = acc[ai][bj][m][1];
                    u32x2 w; w.x = cvt4_fp8(v0[0], v0[1], v0[2], v0[3]); w.y = cvt4_fp8(v1[0], v1[1], v1[2], v1[3]); *(LAS u32x2*)(lds + (wa ^ (unsigned)(bj * 128)) + m * 4096) = w; }
            asm volatile("s_waitcnt lgkmcnt(0)" ::: "memory"); __builtin_amdgcn_s_barrier();
            u32x4 rv[4];
#pragma unroll
            for (int i = 0; i < 4; ++i) rv[i] = *(const LAS u32x4*)(lds + ra + i * 1024 + (((fr ^ fq ^ (i << 2)) & 15) << 4));
#pragma unroll
            for (int i = 0; i < 4; ++i) *(u32x4*)(op + (size_t)(ai * HALF + i * 4) * ldo) = rv[i];
            asm volatile("s_waitcnt lgkmcnt(0)" ::: "memory"); __builtin_amdgcn_s_barrier();
        }
    } };
struct EpiGate8 { static constexpr bool PERM = true; unsigned char* U; const float* bias;
    __device__ __forceinline__ void operator()(const f32x4 (&acc)[2][2][4][2], const Unit& u, int wr, int wc, int fr, int fq) const {
        typedef float f2_ __attribute__((ext_vector_type(2)));
        const int row0 = u.orow + wr * 64 + fr, col0 = u.pn * BM + wc * 32 + 8 * fq;
        f32x4 bv[2][2];
#pragma unroll
        for (int bj = 0; bj < 2; ++bj)
#pragma unroll
            for (int n = 0; n < 2; ++n) bv[bj][n] = *(const f32x4*)(bias + col0 + bj * HALF + 4 * n);
#pragma unroll
        for (int ai = 0; ai < 2; ++ai) {
            u32x2 uu[4][2];
#pragma unroll
            for (int m = 0; m < 4; ++m)
#pragma unroll
                for (int bj = 0; bj < 2; ++bj) uu[m][bj] = *(const u32x2*)(U + (size_t)(row0 + ai * HALF + m * 16) * D + col0 + bj * HALF);
#pragma unroll
            for (int m = 0; m < 4; ++m) { unsigned char* rowp = U + (size_t)(row0 + ai * HALF + m * 16) * D + col0;
#pragma unroll
                for (int bj = 0; bj < 2; ++bj) { const u32x2 ux = uu[m][bj];
                    const f2_ u01 = __builtin_amdgcn_cvt_pk_f32_fp8((int)ux.x, false), u23 = __builtin_amdgcn_cvt_pk_f32_fp8((int)ux.x, true), u45 = __builtin_amdgcn_cvt_pk_f32_fp8((int)ux.y, false), u67 = __builtin_amdgcn_cvt_pk_f32_fp8((int)ux.y, true);
                    const f32x4 a0 = acc[ai][bj][m][0] + bv[bj][0], a1 = acc[ai][bj][m][1] + bv[bj][1];
                    u32x2 w; w.x = cvt4_fp8(sigmoidf_(a0[0]) * u01[0] * Y8_SCALE, sigmoidf_(a0[1]) * u01[1] * Y8_SCALE, sigmoidf_(a0[2]) * u23[0] * Y8_SCALE, sigmoidf_(a0[3]) * u23[1] * Y8_SCALE);
                    w.y = cvt4_fp8(sigmoidf_(a1[0]) * u45[0] * Y8_SCALE, sigmoidf_(a1[1]) * u45[1] * Y8_SCALE, sigmoidf_(a1[2]) * u67[0] * Y8_SCALE, sigmoidf_(a1[3]) * u67[1] * Y8_SCALE);
                    *(u32x2*)(rowp + bj * HALF) = w; } }
            asm volatile("" ::: "memory"); }
    } };
struct EpiSwiglu { static constexpr bool PERM = true; bf16_t* H;
    __device__ __forceinline__ void operator()(const f32x4 (&acc)[2][2][4][2], const Unit& u, int wr, int wc, int fr, int fq) const {
        const int row0 = u.orow + wr * 64 + fr, col0 = u.pn * HALF + wc * 32 + 8 * fq;
#pragma unroll
        for (int ai = 0; ai < 2; ++ai)
#pragma unroll
            for (int m = 0; m < 4; ++m) { const f32x4 g0 = acc[ai][0][m][0], g1 = acc[ai][0][m][1], u0 = acc[ai][1][m][0], u1 = acc[ai][1][m][1];
                u32x4 w; w.x = cvt_pk_bf16(siluf_(g0[0]) * u0[0], siluf_(g0[1]) * u0[1]); w.y = cvt_pk_bf16(siluf_(g0[2]) * u0[2], siluf_(g0[3]) * u0[3]);
                w.z = cvt_pk_bf16(siluf_(g1[0]) * u1[0], siluf_(g1[1]) * u1[1]); w.w = cvt_pk_bf16(siluf_(g1[2]) * u1[2], siluf_(g1[3]) * u1[3]);
                *(u32x4*)(H + (size_t)(row0 + ai * HALF + m * 16) * EF + col0) = w; }
    } };
struct EpiSwiglu8 { static constexpr bool PERM = true; unsigned char* H;
    __device__ __forceinline__ void operator()(const f32x4 (&acc)[2][2][4][2], const Unit& u, int wr, int wc, int fr, int fq) const {
        const int row0 = u.orow + wr * 64 + fr, col0 = u.pn * HALF + wc * 32 + 8 * fq;
#pragma unroll
        for (int ai = 0; ai < 2; ++ai)
#pragma unroll
            for (int m = 0; m < 4; ++m) { const f32x4 g0 = acc[ai][0][m][0], g1 = acc[ai][0][m][1], u0 = acc[ai][1][m][0], u1 = acc[ai][1][m][1];
                u32x2 w; w.x = cvt4_fp8(siluf_(g0[0]) * u0[0], siluf_(g0[1]) * u0[1], siluf_(g0[2]) * u0[2], siluf_(g0[3]) * u0[3]);
                w.y = cvt4_fp8(siluf_(g1[0]) * u1[0], siluf_(g1[1]) * u1[1], siluf_(g1[2]) * u1[2], siluf_(g1[3]) * u1[3]);
                *(u32x2*)(H + (size_t)(row0 + ai * HALF + m * 16) * EF + col0) = w; }
    } };
struct EpiSwiglu8L { static constexpr bool PERM = true; unsigned char* H; LAS unsigned char* lds;
    __device__ __forceinline__ void operator()(const f32x4 (&acc)[2][2][4][2], const Unit& u, int wr, int wc, int fr, int fq) const {
        const unsigned wa = (unsigned)((wr * 64 + fr) * 128 + (((wc * 2 + (fq >> 1)) ^ (fr & 7)) << 4) + 8 * (fq & 1));
        const int lane = fq * 16 + fr, rr = (wr * 4 + wc) * 16 + (lane >> 3);
        const unsigned ra = (unsigned)(rr * 128 + (((lane ^ (lane >> 3)) & 7) << 4));
        unsigned char* hp = H + (size_t)(u.orow + rr) * EF + u.pn * HALF + (lane & 7) * 16;
#pragma unroll
        for (int ai = 0; ai < 2; ++ai) {
#pragma unroll
            for (int m = 0; m < 4; ++m) { const f32x4 g0 = acc[ai][0][m][0], g1 = acc[ai][0][m][1], u0 = acc[ai][1][m][0], u1 = acc[ai][1][m][1];
                u32x2 w; w.x = cvt4_fp8(siluf_(g0[0]) * u0[0], siluf_(g0[1]) * u0[1], siluf_(g0[2]) * u0[2], siluf_(g0[3]) * u0[3]);
                w.y = cvt4_fp8(siluf_(g1[0]) * u1[0], siluf_(g1[1]) * u1[1], siluf_(g1[2]) * u1[2], siluf_(g1[3]) * u1[3]);
                *(LAS u32x2*)(lds + wa + m * 2048) = w; }
            asm volatile("s_waitcnt lgkmcnt(0)" ::: "memory"); __builtin_amdgcn_s_barrier();
            const u32x4 r0 = *(const LAS u32x4*)(lds + ra), r1 = *(const LAS u32x4*)(lds + ra + 1024);
            *(u32x4*)(hp + (size_t)(ai * HALF) * EF) = r0; *(u32x4*)(hp + (size_t)(ai * HALF + 8) * EF) = r1;
            asm volatile("s_waitcnt lgkmcnt(0)" ::: "memory"); __builtin_amdgcn_s_barrier();
        }
    } };
struct EpiResid { static constexpr bool PERM = true; const bf16_t* xres; bf16_t* Z; float alpha; int pad;
    __device__ __forceinline__ void operator()(const f32x4 (&acc)[2][2][4][2], const Unit& u, int wr, int wc, int fr, int fq) const {
        const int row0 = u.orow + wr * 64 + fr, col0 = u.pn * BM + wc * 32 + 8 * fq;
#pragma unroll
        for (int ai = 0; ai < 2; ++ai)
#pragma unroll
            for (int m = 0; m < 4; ++m) { const size_t off = (size_t)(row0 + ai * HALF + m * 16) * D + col0;
#pragma unroll
                for (int bj = 0; bj < 2; ++bj) { const u32x4 x = *(const u32x4*)(xres + off + bj * HALF); const f32x4 a0 = acc[ai][bj][m][0], a1 = acc[ai][bj][m][1];
                    u32x4 w; w.x = cvt_pk_bf16(alpha * bflo(x.x) + a0[0], alpha * bfhi(x.x) + a0[1]); w.y = cvt_pk_bf16(alpha * bflo(x.y) + a0[2], alpha * bfhi(x.y) + a0[3]);
                    w.z = cvt_pk_bf16(alpha * bflo(x.z) + a1[0], alpha * bfhi(x.z) + a1[1]); w.w = cvt_pk_bf16(alpha * bflo(x.w) + a1[2], alpha * bfhi(x.w) + a1[3]);
                    *(u32x4*)(Z + off + bj * HALF) = w; }
                asm volatile("" ::: "memory"); }
    } };
struct EpiAccum { static constexpr bool PERM = false; float* xio;
    __device__ __forceinline__ void operator()(const f32x4 (&acc)[2][2][4][2], const Unit& u, int wr, int wc, int fr, int fq) const {
        const int row0 = u.orow + wr * 64 + fr, col0 = u.pn * BM + wc * 32 + 4 * fq;
#pragma unroll
        for (int ai = 0; ai < 2; ++ai)
#pragma unroll
            for (int m = 0; m < 4; ++m) { const size_t off = (size_t)(row0 + ai * HALF + m * 16) * D + col0;
#pragma unroll
                for (int bj = 0; bj < 2; ++bj)
#pragma unroll
                    for (int n = 0; n < 2; ++n) { const f32x4 x = *(const f32x4*)(xio + off + bj * HALF + n * 16); *(f32x4*)(xio + off + bj * HALF + n * 16) = x + acc[ai][bj][m][n]; }
                asm volatile("" ::: "memory"); }
    } };
struct EpiScatter { static constexpr bool PERM = true; bf16_t* Y; const LAS int* tdst; const LAS float* tgate; int nostore; int pad;
    __device__ __forceinline__ void operator()(const f32x4 (&acc)[2][2][4][2], const Unit& u, int wr, int wc, int fr, int fq) const {
        const int r0 = u.tab * BM + wr * 64 + fr, col0 = u.pn * BM + wc * 32 + 8 * fq;
#pragma unroll
        for (int ai = 0; ai < 2; ++ai)
#pragma unroll
            for (int m = 0; m < 4; ++m) { const int dst = tdst[r0 + ai * HALF + m * 16]; const float g = tgate[r0 + ai * HALF + m * 16];
                if (dst >= 0 && !nostore) { bf16_t* rowp = Y + (size_t)dst * D + col0;
#pragma unroll
                    for (int bj = 0; bj < 2; ++bj) { const f32x4 v0 = acc[ai][bj][m][0] * g, v1 = acc[ai][bj][m][1] * g;
                        u32x4 w; w.x = cvt_pk_bf16(v0[0], v0[1]); w.y = cvt_pk_bf16(v0[2], v0[3]); w.z = cvt_pk_bf16(v1[0], v1[1]); w.w = cvt_pk_bf16(v1[2], v1[3]);
                        *(u32x4*)(rowp + bj * HALF) = w; } } }
    } };
struct EpiScatter2 { static constexpr bool PERM = true; bf16_t* Y; bf16_t* YSH; const int* rdst; const float* rgate;
    __device__ __forceinline__ void operator()(const f32x4 (&acc)[2][2][4][2], const Unit& u, int wr, int wc, int fr, int fq) const {
        const int col0 = u.pn * BM + wc * 32 + 8 * fq;
        if (u.orow < A_PAD) {
            const int r0 = u.orow + wr * 64 + fr;
#pragma unroll
            for (int ai = 0; ai < 2; ++ai) {
                int dst[4]; float g[4];
#pragma unroll
                for (int m = 0; m < 4; ++m) { dst[m] = rdst[r0 + ai * HALF + m * 16]; g[m] = rgate[r0 + ai * HALF + m * 16]; }
#pragma unroll
                for (int m = 0; m < 4; ++m) if (dst[m] >= 0) { bf16_t* rowp = Y + (size_t)dst[m] * D + col0;
#pragma unroll
                    for (int bj = 0; bj < 2; ++bj) { const f32x4 v0 = acc[ai][bj][m][0] * g[m], v1 = acc[ai][bj][m][1] * g[m];
                        u32x4 w; w.x = cvt_pk_bf16(v0[0], v0[1]); w.y = cvt_pk_bf16(v0[2], v0[3]); w.z = cvt_pk_bf16(v1[0], v1[1]); w.w = cvt_pk_bf16(v1[2], v1[3]);
                        *(u32x4*)(rowp + bj * HALF) = w; } } }
        } else {
            const int row0 = u.orow - A_PAD + wr * 64 + fr;
#pragma unroll
            for (int ai = 0; ai < 2; ++ai)
#pragma unroll
                for (int m = 0; m < 4; ++m) { bf16_t* rowp = YSH + (size_t)(row0 + ai * HALF + m * 16) * D + col0;
#pragma unroll
                    for (int bj = 0; bj < 2; ++bj) { const f32x4 v0 = acc[ai][bj][m][0], v1 = acc[ai][bj][m][1];
                        u32x4 w; w.x = cvt_pk_bf16(v0[0], v0[1]); w.y = cvt_pk_bf16(v0[2], v0[3]); w.z = cvt_pk_bf16(v1[0], v1[1]); w.w = cvt_pk_bf16(v1[2], v1[3]);
                        *(u32x4*)(rowp + bj * HALF) = w; } }
        }
    } };
template <int FAKE = 0> struct EpiScatter8T { static constexpr bool PERM = true; static constexpr bool HOOKS = true; unsigned char* Y; const int* rdst; const float* rgate;
    int dd[2][4]; float gg[2][4];
    __device__ __forceinline__ void load_tab(const Unit& u, int tid) { const int r0 = u.orow + (tid >> 8) * 64 + (tid & 15);
#pragma unroll
        for (int ai = 0; ai < 2; ++ai)
#pragma unroll
            for (int m = 0; m < 4; ++m) { dd[ai][m] = rdst[r0 + ai * HALF + m * 16]; gg[ai][m] = rgate[r0 + ai * HALF + m * 16]; } }
    __device__ __forceinline__ void begin(const Unit& u, int tid) { load_tab(u, tid); }
    __device__ __forceinline__ void post(const Unit& nx, int tid) { load_tab(nx, tid); }
    __device__ __forceinline__ void operator()(const f32x4 (&acc)[2][2][4][2], const Unit& u, int wr, int wc, int fr, int fq) const {
        const unsigned col0 = (unsigned)(u.pn * BM + wc * 32 + 8 * fq);
#pragma unroll
        for (int ai = 0; ai < 2; ++ai)
#pragma unroll
            for (int m = 0; m < 4; ++m) { const int dst = dd[ai][m]; const float g = gg[ai][m] * Y8_SCALE;
                if (dst >= 0) { unsigned off = (unsigned)dst * (unsigned)D + col0;
                    if (FAKE) off = (unsigned)u.orow * (unsigned)D + (unsigned)(u.pn * 65536 + (wr * 4 + wc) * 8192 + (ai * 4 + m) * 1024 + (fq * 16 + fr) * 8);
#pragma unroll
                    for (int bj = 0; bj < 2; ++bj) { const f32x4 v0 = acc[ai][bj][m][0] * g, v1 = acc[ai][bj][m][1] * g;
                        u32x2 w; w.x = cvt4_fp8(v0[0], v0[1], v0[2], v0[3]); w.y = cvt4_fp8(v1[0], v1[1], v1[2], v1[3]); *(u32x2*)(Y + off + bj * (FAKE ? 512 : HALF)) = w; } } }
    } };
typedef EpiScatter8T<0> EpiScatter8;
struct EpiScatter8L { static constexpr bool PERM = true; static constexpr bool HOOKS = true; unsigned char* Y; const int* rdst; const float* rgate; LAS unsigned char* lds;
    int dd[2][4]; float gg[2][4];
    __device__ __forceinline__ void load_tab(const Unit& u, int tid) { const int r0 = u.orow + (tid >> 8) * 64;
#pragma unroll
        for (int ai = 0; ai < 2; ++ai)
#pragma unroll
            for (int m = 0; m < 4; ++m) { gg[ai][m] = rgate[r0 + ai * HALF + m * 16 + (tid & 15)]; dd[ai][m] = rdst[r0 + ai * HALF + ((tid >> 6) & 3) * 16 + m * 4 + ((tid >> 4) & 3)]; } }
    __device__ __forceinline__ void begin(const Unit& u, int tid) { load_tab(u, tid); }
    __device__ __forceinline__ void post(const Unit& nx, int tid) { load_tab(nx, tid); }
    __device__ __forceinline__ void operator()(const f32x4 (&acc)[2][2][4][2], const Unit& u, int wr, int wc, int fr, int fq) const {
        const unsigned col = (unsigned)(u.pn * BM + fr * 16);
        const unsigned wa = (unsigned)(fr * 256 + (((wc * 2 + (fq >> 1)) ^ fr) << 4) + 8 * (fq & 1));
        const unsigned ra = (unsigned)(wc * 4096 + fq * 256);
#pragma unroll
        for (int ai = 0; ai < 2; ++ai) {
#pragma unroll
            for (int m = 0; m < 4; ++m) { const float g = gg[ai][m] * Y8_SCALE;
#pragma unroll
                for (int bj = 0; bj < 2; ++bj) { const f32x4 v0 = acc[ai][bj][m][0] * g, v1 = acc[ai][bj][m][1] * g;
                    u32x2 w; w.x = cvt4_fp8(v0[0], v0[1], v0[2], v0[3]); w.y = cvt4_fp8(v1[0], v1[1], v1[2], v1[3]); *(LAS u32x2*)(lds + (wa ^ (unsigned)(bj * 128)) + m * 4096) = w; } }
            asm volatile("s_waitcnt lgkmcnt(0)" ::: "memory"); __builtin_amdgcn_s_barrier();
            u32x4 rv[4];
#pragma unroll
            for (int i = 0; i < 4; ++i) rv[i] = *(const LAS u32x4*)(lds + ra + i * 1024 + (((fr ^ fq ^ (i << 2)) & 15) << 4));
#pragma unroll
            for (int i = 0; i < 4; ++i) if (dd[ai][i] >= 0) *(u32x4*)(Y + ((unsigned)dd[ai][i] * (unsigned)D + col)) = rv[i];
            asm volatile("s_waitcnt lgkmcnt(0)" ::: "memory"); __builtin_amdgcn_s_barrier();
        }
    } };
struct EpiGate { static constexpr bool PERM = true; bf16_t* U; const float* bias;
    __device__ __forceinline__ void operator()(const f32x4 (&acc)[2][2][4][2], const Unit& u, int wr, int wc, int fr, int fq) const {
        const int row0 = u.orow + wr * 64 + fr, col0 = u.pn * BM + wc * 32 + 8 * fq;
        f32x4 bv[2][2];
#pragma unroll
        for (int bj = 0; bj < 2; ++bj)
#pragma unroll
            for (int n = 0; n < 2; ++n) bv[bj][n] = *(const f32x4*)(bias + col0 + bj * HALF + 4 * n);
#pragma unroll
        for (int ai = 0; ai < 2; ++ai)
#pragma unroll
            for (int m = 0; m < 4; ++m) { bf16_t* rowp = U + (size_t)(row0 + ai * HALF + m * 16) * D + col0;
#pragma unroll
                for (int bj = 0; bj < 2; ++bj) { const u32x4 uu = *(const u32x4*)(rowp + bj * HALF);
                    const f32x4 a0 = acc[ai][bj][m][0] + bv[bj][0], a1 = acc[ai][bj][m][1] + bv[bj][1];
                    u32x4 w; w.x = cvt_pk_bf16(sigmoidf_(a0[0]) * bflo(uu.x), sigmoidf_(a0[1]) * bfhi(uu.x)); w.y = cvt_pk_bf16(sigmoidf_(a0[2]) * bflo(uu.y), sigmoidf_(a0[3]) * bfhi(uu.y));
                    w.z = cvt_pk_bf16(sigmoidf_(a1[0]) * bflo(uu.z), sigmoidf_(a1[1]) * bfhi(uu.z)); w.w = cvt_pk_bf16(sigmoidf_(a1[2]) * bflo(uu.w), sigmoidf_(a1[3]) * bfhi(uu.w));
                    *(u32x4*)(rowp + bj * HALF) = w; }
                asm volatile("" ::: "memory"); }
    } };
struct EpiRouter { static constexpr bool PERM = false; float* LOG;
    __device__ __forceinline__ void operator()(const f32x4 (&acc)[2][2][4][2], const Unit& u, int wr, int wc, int fr, int fq) const {
        if (wc < 2) { const int row0 = u.tab * T + u.orow + wr * 64 + fr, col0 = wc * 32 + 4 * fq;
#pragma unroll
            for (int ai = 0; ai < 2; ++ai)
#pragma unroll
                for (int m = 0; m < 4; ++m)
#pragma unroll
                    for (int n = 0; n < 2; ++n) *(f32x4*)(LOG + (size_t)(row0 + ai * HALF + m * 16) * 64 + col0 + n * 16) = acc[ai][0][m][n]; }
    } };

template <class E, class = void> struct epi_has_hooks { static constexpr bool value = false; };
template <class E> struct epi_has_hooks<E, decltype((void)E::HOOKS)> { static constexpr bool value = true; };
template <int K, class Epi, class Sched, bool GATHER, int VAR = 0, bool FP8 = false, int STAG = 0, int KP = K>
__device__ __forceinline__ void gemm_phase(const int wv, LAS unsigned char* lds, const bf16_t* Ap_, const bf16_t* Btp_, const Sched& S, Epi& E, const LAS int* gtab) {
    typedef const __attribute__((address_space(1))) char* gcp;
    gcp Ap = (gcp)Ap_; gcp Btp = (gcp)Btp_; asm volatile("" : "+s"(Ap), "+s"(Btp));
    const int tid = opaque_tid(wv), wid = wv, lane = tid & 63, wr = wid >> 2, wc = wid & 3, fr = lane & 15, fq = lane >> 4;
    constexpr int ES = FP8 ? 1 : 2, KB = KP * ES;
    constexpr int nt = K * ES / 128; constexpr bool SPLITK = (KP != K);
    static_assert(!(SPLITK && GATHER), "split-K uses Unit::tab as the K-slice index");
    static_assert(nt >= 4 && nt % 2 == 0, "K-loop needs an even number (>= 4) of 128-byte K-tiles");
    unsigned voffB[2], vc[2][2];
#pragma unroll
    for (int i = 0; i < 2; ++i) { int R, C; stage_rc(tid * 16 + i * 8192, R, C); const int Rb = Epi::PERM ? ((R & ~31) + perm32(R & 31)) : R; voffB[i] = (unsigned)(Rb * KB + C * 2); asm volatile("" : "+v"(voffB[i])); }
    constexpr size_t kstep = (size_t)(BK * 2);
    constexpr size_t hstep = (size_t)HALF * KB;
    constexpr size_t hA = GATHER ? (size_t)0 : hstep;
    const unsigned ldsw = (unsigned)wid * 1024u;
    const int aoff = lds_byte(wr * 64 + fr, fq * 8), boff = lds_byte(wc * 32 + fr, fq * 8);
#define PG8_SA(b, h) (((b) * 2 + (h)) * HTB)
#define PG8_SB(b, h) ((4 + (b) * 2 + (h)) * HTB)
#define PG8_STAGE(bufoff, gbase, voff) do { _Pragma("unroll") for (int _i = 0; _i < 2; ++_i) { unsigned _o = (voff)[_i]; asm volatile("" : "+v"(_o));     \
        __builtin_amdgcn_global_load_lds((const __attribute__((address_space(1))) unsigned*)((gbase) + _o), (LAS unsigned*)(lds + (bufoff) + ldsw + _i * 8192), 16, 0, 0); } } while (0)
#define PG8_SETA(v, slot) do { _Pragma("unroll") for (int _h = 0; _h < 2; ++_h) _Pragma("unroll") for (int _i = 0; _i < 2; ++_i) { int _R, _C; stage_rc(tid * 16 + _i * 8192, _R, _C); \
        (v)[_h][_i] = GATHER ? ((unsigned)gtab[(slot) * BM + _h * HALF + _R] * (unsigned)KB + (unsigned)(_C * 2)) : (unsigned)(_R * KB + _C * 2); asm volatile("" : "+v"((v)[_h][_i])); } } while (0)
#define PG8_LDA(dst, b, h) do { unsigned _ba = (unsigned)(aoff + PG8_SA(b, h)); asm volatile("" : "+v"(_ba)); const LAS unsigned char* _pa = lds + _ba; _Pragma("unroll") for (int m = 0; m < 4; ++m) { \
        if constexpr (FP8) dst##8[m] = __builtin_shufflevector(*(const LAS v4i_*)(_pa + m * 2048), *(const LAS v4i_*)(_pa + m * 2048 + 1024), 0, 1, 2, 3, 4, 5, 6, 7); \
        else { _Pragma("unroll") for (int k = 0; k < 2; ++k) dst[m][k] = *(const LAS bf16x8*)(_pa + m * 2048 + k * 1024); } } } while (0)
#define PG8_LDB(dst, b, h) do { unsigned _bb = (unsigned)(boff + PG8_SB(b, h)); asm volatile("" : "+v"(_bb)); const LAS unsigned char* _pb = lds + _bb; _Pragma("unroll") for (int n = 0; n < 2; ++n) { \
        if constexpr (FP8) dst##8[n] = __builtin_shufflevector(*(const LAS v4i_*)(_pb + n * 2048), *(const LAS v4i_*)(_pb + n * 2048 + 1024), 0, 1, 2, 3, 4, 5, 6, 7); \
        else { _Pragma("unroll") for (int k = 0; k < 2; ++k) dst[n][k] = *(const LAS bf16x8*)(_pb + n * 2048 + k * 1024); } } } while (0)
#define PG8_MMA(ai, bj, At, Bt) do { __builtin_amdgcn_s_setprio(1); _Pragma("unroll") for (int m = 0; m < 4; ++m) _Pragma("unroll") for (int n = 0; n < 2; ++n) { \
        if constexpr (FP8) asm volatile("v_mfma_scale_f32_16x16x128_f8f6f4 %0, %1, %2, %0, %3, %3 op_sel_hi:[0,0,0]" : "+v"(acc[ai][bj][m][n]) : "v"(Bt##8[n]), "v"(At##8[m]), "v"(sc8_)); \
        else { _Pragma("unroll") for (int k = 0; k < 2; ++k) acc[ai][bj][m][n] = __builtin_amdgcn_mfma_f32_16x16x32_bf16(Bt[n][k], At[m][k], acc[ai][bj][m][n], 0, 0, 0); } } \
        __builtin_amdgcn_s_setprio(0); } while (0)
#define PG8_MMA0(ai, bj, At, Bt) do { __builtin_amdgcn_s_setprio(1); _Pragma("unroll") for (int m = 0; m < 4; ++m) _Pragma("unroll") for (int n = 0; n < 2; ++n) { \
        if constexpr (FP8) asm volatile("v_mfma_scale_f32_16x16x128_f8f6f4 %0, %1, %2, 0, %3, %3 op_sel_hi:[0,0,0]" : "=&v"(acc[ai][bj][m][n]) : "v"(Bt##8[n]), "v"(At##8[m]), "v"(sc8_)); \
        else { acc[ai][bj][m][n] = (f32x4){0.f, 0.f, 0.f, 0.f}; _Pragma("unroll") for (int k = 0; k < 2; ++k) acc[ai][bj][m][n] = __builtin_amdgcn_mfma_f32_16x16x32_bf16(Bt[n][k], At[m][k], acc[ai][bj][m][n], 0, 0, 0); } } \
        __builtin_amdgcn_s_setprio(0); } while (0)
#define PG8_WAIT_V(n) asm volatile("s_waitcnt vmcnt(" #n ")" ::: "memory")
#define PG8_WAIT_L(n) asm volatile("s_waitcnt lgkmcnt(" #n ")" ::: "memory")
#define PG8_BAR __builtin_amdgcn_s_barrier()
#define PG8_SCHED __builtin_amdgcn_sched_barrier(0)
    Unit cur, nxt; int ui = 0;
    if (!S.next(0, cur)) return;
    if constexpr (epi_has_hooks<Epi>::value) E.begin(cur, tid);
    if constexpr (STAG > 0) {
        const unsigned long long t0 = __builtin_amdgcn_s_memrealtime(); const unsigned long long dt = (unsigned long long)(((blockIdx.x >> 3) & 7) * STAG);
        while (__builtin_amdgcn_s_memrealtime() - t0 < dt) __builtin_amdgcn_s_sleep(8);
    }
    f32x4 acc[2][2][4][2];
    typedef int v8i_ __attribute__((ext_vector_type(8))); typedef int v4i_ __attribute__((ext_vector_type(4)));
    const int sc8_ = W8_E8M0;
    bf16x8 At[4][2], B0[2][2], B1[2][2]; v8i_ At8[4], B08[2], B18[2];
    PG8_SETA(vc, cur.tab);
    gcp cA = Ap + (GATHER ? (size_t)0 : (size_t)cur.orow * KB) + (SPLITK ? (size_t)cur.tab * (K * ES) : (size_t)0); gcp cB = Btp + (size_t)cur.brow * KB + (SPLITK ? (size_t)cur.tab * (K * ES) : (size_t)0);
    PG8_STAGE(PG8_SB(0, 0), cB, voffB); PG8_STAGE(PG8_SB(0, 1), cB + hstep, voffB); PG8_STAGE(PG8_SA(0, 0), cA, vc[0]); PG8_STAGE(PG8_SA(0, 1), cA + hA, vc[1]);
    if (wr == 1) PG8_BAR;
    PG8_WAIT_V(2); PG8_BAR;
    PG8_STAGE(PG8_SB(1, 0), cB + kstep, voffB); PG8_STAGE(PG8_SA(1, 0), cA + kstep, vc[0]); PG8_STAGE(PG8_SB(1, 1), cB + hstep + kstep, voffB);
    PG8_WAIT_V(6); PG8_BAR;
    for (;;) {
        const bool has_next = S.next(ui + 1, nxt);
        gcp nA = has_next ? Ap + (GATHER ? (size_t)0 : (size_t)nxt.orow * KB) + (SPLITK ? (size_t)nxt.tab * (K * ES) : (size_t)0) : cA; gcp nB = has_next ? Btp + (size_t)nxt.brow * KB + (SPLITK ? (size_t)nxt.tab * (K * ES) : (size_t)0) : cB;
#define PG8_ITER(MM, t) do { \
            const bool last = ((t) == nt - 2); \
            gcp a1 = cA + (size_t)((t) + 1) * kstep; \
            gcp a2 = last ? nA : cA + (size_t)((t) + 2) * kstep; gcp b2 = last ? nB : cB + (size_t)((t) + 2) * kstep; \
            gcp a3 = a2 + kstep; gcp b3 = b2 + kstep; \
              \
            PG8_LDB(B0, 0, 0); PG8_LDB(B1, 0, 1); PG8_SCHED; PG8_LDA(At, 0, 0); PG8_STAGE(PG8_SA(1, 1), a1 + hA, vc[1]); \
            if (GATHER && last && has_next) PG8_SETA(vc, nxt.tab);            \
            PG8_WAIT_V(8); PG8_WAIT_L(0); PG8_BAR; MM(0, 0, At, B0); MM(0, 1, At, B1); PG8_BAR; PG8_SCHED; \
              \
            PG8_LDA(At, 0, 1); PG8_STAGE(PG8_SB(0, 0), b2, voffB); PG8_STAGE(PG8_SB(0, 1), b2 + hstep, voffB); PG8_STAGE(PG8_SA(0, 0), a2, vc[0]); \
            PG8_WAIT_V(8); PG8_WAIT_L(0); PG8_BAR; MM(1, 0, At, B0); MM(1, 1, At, B1); PG8_BAR; PG8_SCHED; \
              \
            PG8_LDB(B0, 1, 0); PG8_LDB(B1, 1, 1); PG8_SCHED; PG8_LDA(At, 1, 0); PG8_STAGE(PG8_SA(0, 1), a2 + hA, vc[1]); \
            PG8_WAIT_V(8); PG8_WAIT_L(0); PG8_BAR; PG8_MMA(0, 0, At, B0); PG8_MMA(0, 1, At, B1); PG8_BAR; PG8_SCHED; \
              \
            PG8_LDA(At, 1, 1); PG8_STAGE(PG8_SB(1, 0), b3, voffB); PG8_STAGE(PG8_SB(1, 1), b3 + hstep, voffB); PG8_STAGE(PG8_SA(1, 0), a3, vc[0]); \
            PG8_WAIT_V(8); PG8_WAIT_L(0); PG8_BAR; PG8_MMA(1, 0, At, B0); PG8_MMA(1, 1, At, B1); PG8_BAR; PG8_SCHED; } while (0)
        PG8_ITER(PG8_MMA0, 0);
#pragma nounroll
        for (int t = 2; t < nt; t += 2) PG8_ITER(PG8_MMA, t);
        if (!(VAR & 2)) { if (wr == 0) PG8_BAR; }
        if (!(VAR & 1)) { const int t2 = opaque_tid(wv), l2 = t2 & 63;
            E(acc, cur, wr, wc, l2 & 15, l2 >> 4);
            if constexpr (epi_has_hooks<Epi>::value) { if (has_next) E.post(nxt, t2); } }
        if (!has_next) break;
        cur = nxt; cA = nA; cB = nB; ++ui;
        if (!(VAR & 2)) { if (wr == 1) PG8_BAR; }
    }
    PG8_WAIT_V(0);
    if (VAR & 2) { if (wr == 0) PG8_BAR; }
    PG8_BAR;
#undef PG8_SA
#undef PG8_SB
#undef PG8_STAGE
#undef PG8_SETA
#undef PG8_LDA
#undef PG8_LDB
#undef PG8_MMA
#undef PG8_MMA0
#undef PG8_ITER
#undef PG8_WAIT_V
#undef PG8_WAIT_L
#undef PG8_BAR
#undef PG8_SCHED
}
}
constexpr int NWAVES = 8, NTHR = 512;
constexpr int RING_OFF = 0, RING_BYTES = 131072;
constexpr int TAB_OFF = RING_BYTES, TAB_BYTES = 24576;
constexpr int MISC_OFF = TAB_OFF + TAB_BYTES;
constexpr int ULIST_OFF = MISC_OFF + 128, ULIST_CAP = 64;
constexpr int LDS_BYTES = 160 * 1024;
static_assert(ULIST_OFF + ULIST_CAP * 16 <= LDS_BYTES, "LDS map");
constexpr int CW_BAR = 1024;

#define XB_TMO      128
#define XB_XCNT(j)  (256  + 64 * (j))
#define XB_XSUB(j)  (1280 + 64 * (j))
#define XB_XGEN(j)  (2304 + 64 * (j))
#define XB_TOP      3328
#define XB_TOPGEN   3392
#define XCD_BAR_WORDS 3456
#define XB_SPIN_CAP (1u << 22)
static_assert((CW_BAR + XCD_BAR_WORDS) * 4 <= (int)CTL_ZERO_BYTES, "barrier words inside the memset region");

__device__ __forceinline__ unsigned xb_ld(unsigned* p)              { return __hip_atomic_load(p, __ATOMIC_RELAXED, __HIP_MEMORY_SCOPE_AGENT); }
__device__ __forceinline__ unsigned xb_add(unsigned* p, unsigned v) { return __hip_atomic_fetch_add(p, v, __ATOMIC_RELAXED, __HIP_MEMORY_SCOPE_AGENT); }
__device__ __forceinline__ unsigned xb_xcc_id() { return (unsigned)__builtin_amdgcn_s_getreg((3 << 11) | 20) & 0xFu; }
#define XB_SPIN(cond, bar) do { unsigned _sp = 0; while (cond) { __builtin_amdgcn_s_sleep(1); \
    if ((++_sp & 255u) == 0u) { if (xb_ld(&(bar)[XB_TMO])) break; if (_sp > XB_SPIN_CAP) { atomicAdd(&(bar)[XB_TMO], 1u); break; } } } } while (0)

struct XcdBarrier { unsigned* bar; unsigned x; volatile LAS unsigned* st; int w0; };
__device__ __forceinline__ XcdBarrier xcd_barrier_post(unsigned* bar, volatile LAS unsigned* st) {
    XcdBarrier b; b.bar = bar; b.x = xb_xcc_id(); b.st = st; b.w0 = (__builtin_amdgcn_readfirstlane(threadIdx.x >> 6) == 0) ? 1 : 0;
    if (threadIdx.x == 0) (void)xb_add(&bar[XB_XCNT(b.x)], 1u);
    return b;
}
__device__ __forceinline__ void xcd_barrier_complete(unsigned* bar, unsigned x, unsigned& nloc, unsigned& nx) {
    const unsigned G = gridDim.x * gridDim.y * gridDim.z;
    unsigned sum, cnt, mine, sp = 0u;
    for (;;) {
        sum = 0u; cnt = 0u; mine = 0u;
#pragma unroll
        for (unsigned j = 0; j < 16; ++j) { const unsigned c = xb_ld(&bar[XB_XCNT(j)]); sum += c; cnt += (c > 0u) ? 1u : 0u; mine = (j == x) ? c : mine; }
        if (sum == G) break;
        __builtin_amdgcn_s_sleep(1);
        if ((++sp & 255u) == 0u) { if (xb_ld(&bar[XB_TMO])) break; if (sp > XB_SPIN_CAP) { atomicAdd(&bar[XB_TMO], 1u); break; } }
    }
    nloc = mine > 0u ? mine : 1u; nx = cnt > 0u ? cnt : 1u;
}
__device__ __forceinline__ void xcd_barrier(const XcdBarrier& b) {
    asm volatile("s_waitcnt vmcnt(0)" ::: "memory");
    __syncthreads();
    if (b.w0 && lane_id() == 0) {
        unsigned* bar = b.bar;
        __builtin_amdgcn_s_waitcnt(0);
        unsigned nloc = b.st[0], nx = b.st[1];
        if (nloc == 0u) { xcd_barrier_complete(bar, b.x, nloc, nx); b.st[0] = nloc; b.st[1] = nx; }
        const unsigned old = xb_add(&bar[XB_XSUB(b.x)], 1u);
        const unsigned gen = old / nloc;
        if (old + 1u == (gen + 1u) * nloc) {
            __builtin_amdgcn_fence(__ATOMIC_RELEASE, "agent");
            asm volatile("s_waitcnt vmcnt(0)" ::: "memory");
            const unsigned og = xb_add(&bar[XB_TOP], 1u);
            const unsigned tg = og / nx;
            if (og + 1u == (tg + 1u) * nx) xb_add(&bar[XB_TOPGEN], 1u);
            else XB_SPIN(xb_ld(&bar[XB_TOPGEN]) == tg, bar);
            __builtin_amdgcn_fence(__ATOMIC_ACQUIRE, "agent");
            xb_add(&bar[XB_XGEN(b.x)], 1u);
            asm volatile("s_waitcnt vmcnt(0)" ::: "memory");
        } else {
            XB_SPIN(xb_ld(&bar[XB_XGEN(b.x)]) == gen, bar);
            __builtin_amdgcn_fence(__ATOMIC_ACQUIRE, "agent");
            asm volatile("s_waitcnt vmcnt(0)" ::: "memory");
        }
    }
    __syncthreads();
}

struct TItem { const float* W; unsigned char* WT; int K, N, k0, n0, drow, f8; };
__device__ __forceinline__ void ti_load(const TItem& t, float4 (&v)[8], int lane) {
#pragma unroll
    for (int i = 0; i < 8; ++i) v[i] = *(const float4*)(t.W + (size_t)(t.k0 + 8 * i + (lane >> 3)) * t.N + t.n0 + (lane & 7) * 4);
}
__device__ __forceinline__ void ti_store(const TItem& t, const float4 (&v)[8], LAS float* scr, int lane) {
#pragma unroll
    for (int i = 0; i < 8; ++i) { LAS float* p = scr + (8 * i + (lane >> 3)) * 33 + (lane & 7) * 4; p[0] = v[i].x; p[1] = v[i].y; p[2] = v[i].z; p[3] = v[i].w; }
    asm volatile("s_waitcnt lgkmcnt(0)" ::: "memory");
    const int c = lane & 7;
#pragma unroll
    for (int j = 0; j < 4; ++j) { const int n = (lane >> 3) + 8 * j; const LAS float* s = scr + (8 * c) * 33 + n;
        if (t.f8) { u32x2 o; o.x = cvt4_fp8(s[0 * 33] * W8_SCALE, s[1 * 33] * W8_SCALE, s[2 * 33] * W8_SCALE, s[3 * 33] * W8_SCALE); o.y = cvt4_fp8(s[4 * 33] * W8_SCALE, s[5 * 33] * W8_SCALE, s[6 * 33] * W8_SCALE, s[7 * 33] * W8_SCALE);
            *(u32x2*)(t.WT + (size_t)(t.drow + n) * t.K + t.k0 + 8 * c) = o; }
        else { u32x4 o; o.x = pk2(s[0 * 33], s[1 * 33]); o.y = pk2(s[2 * 33], s[3 * 33]); o.z = pk2(s[4 * 33], s[5 * 33]); o.w = pk2(s[6 * 33], s[7 * 33]);
            *(u32x4*)(t.WT + ((size_t)(t.drow + n) * t.K + t.k0 + 8 * c) * 2) = o; } }
    asm volatile("s_waitcnt lgkmcnt(0)" ::: "memory");
}
struct WPtrs { const float *w_in, *w_out, *gate, *plew, *ew1, *ew3, *ew2, *sw1, *sw3, *sw2, *rw, *lwa, *lwx; bf16_t* lru_wg; };
template <bool F8, bool F8DN>
__device__ __forceinline__ void convert_weights(unsigned char* ldsb, const WPtrs& P, unsigned char* wsw, int gw, int NGW, int wave, int lane) {
    LAS float* scr0 = (LAS float*)((LAS unsigned char*)ldsb + wave * 16896); LAS float* scr1 = scr0 + 2112;
    unsigned char* WIN = wsw + WO_WIN; unsigned char* WOUT = wsw + WO_WOUT; unsigned char* GATE = wsw + WO_GATE; unsigned char* PLEW = wsw + WO_PLEW;
    unsigned char* W2 = wsw + WO_W2; unsigned char* W13 = wsw + WO_W13; bf16_t* ROUT = (bf16_t*)(wsw + WO_ROUT);
    constexpr int I_IN = (D / 64) * (IN_COLS / 32), I_OUT = (D / 64) * (D / 32), I_GATE = I_OUT, I_PLE = (PLE / 64) * (D / 32), I_W2 = (EF / 64) * (D / 32), I_W13 = (D / 64) * (EF / 32), I_R = (D / 64) * (NE / 32);
    constexpr int NITEMS = I_R + I_IN + I_OUT + I_GATE + I_PLE + 65 * I_W2 + 65 * 2 * I_W13;
    auto decode = [&](int it) -> TItem { TItem t; int r = it; t.f8 = 0;
        if (r < I_R) { const int nb = NE / 32; t.W = P.rw; t.WT = (unsigned char*)ROUT; t.K = D; t.N = NE; t.k0 = 64 * (r / nb); t.n0 = 32 * (r % nb); t.drow = t.n0; return t; } r -= I_R;
        if (r < I_IN) { const int nb = IN_COLS / 32; t.W = P.w_in; t.WT = WIN; t.K = D; t.N = IN_COLS; t.k0 = 64 * (r / nb); t.n0 = 32 * (r % nb); t.drow = t.n0; return t; } r -= I_IN;
        if (r < I_OUT) { const int nb = D / 32; t.W = P.w_out; t.WT = WOUT; t.K = D; t.N = D; t.k0 = 64 * (r / nb); t.n0 = 32 * (r % nb); t.drow = t.n0; return t; } r -= I_OUT;
        if (r < I_GATE) { const int nb = D / 32; t.W = P.gate; t.WT = GATE; t.K = D; t.N = D; t.k0 = 64 * (r / nb); t.n0 = 32 * (r % nb); t.drow = t.n0; t.f8 = F8 ? 1 : 0; return t; } r -= I_GATE;
        if (r < I_PLE) { const int nb = D / 32; t.W = P.plew; t.WT = PLEW; t.K = PLE; t.N = D; t.k0 = 64 * (r / nb); t.n0 = 32 * (r % nb); t.drow = t.n0; return t; } r -= I_PLE;
        if (r < 65 * I_W2) { const int e = r / I_W2, q = r % I_W2, nb = D / 32; t.W = (e < 64) ? P.ew2 + (size_t)e * EF * D : P.sw2; t.f8 = F8DN ? 1 : 0;
            t.WT = W2 + (size_t)e * D * EF * (F8DN ? 1 : 2); t.K = EF; t.N = D; t.k0 = 64 * (q / nb); t.n0 = 32 * (q % nb); t.drow = t.n0; return t; } r -= 65 * I_W2;
        { const int e = r / (2 * I_W13), q2 = r % (2 * I_W13), mth = q2 / I_W13, q = q2 % I_W13, nb = EF / 32; const int n0 = 32 * (q % nb);
          t.W = (e < 64) ? (mth ? P.ew3 : P.ew1) + (size_t)e * D * EF : (mth ? P.sw3 : P.sw1); t.f8 = F8 ? 1 : 0;
          t.WT = W13 + (size_t)e * 1024 * D * (F8 ? 1 : 2); t.K = D; t.N = EF; t.k0 = 64 * (q / nb); t.n0 = n0; t.drow = 256 * (n0 >> 7) + 128 * mth + (n0 & 127); return t; } };
    {
        int it = gw; bool ha = it < NITEMS, hb = it + NGW < NITEMS;
        float4 v0[8], v1[8]; TItem ta = decode(ha ? it : 0), tb = decode(hb ? it + NGW : 0);
        if (ha) ti_load(ta, v0, lane);
        if (hb) ti_load(tb, v1, lane);
        while (ha) {
            ti_store(ta, v0, scr0, lane); it += 2 * NGW; ha = it < NITEMS;
            if (ha) { ta = decode(it); ti_load(ta, v0, lane); }
            if (hb) { ti_store(tb, v1, scr1, lane); hb = it + NGW < NITEMS; if (hb) { tb = decode(it + NGW); ti_load(tb, v1, lane); } }
        }
    }
    for (int i = gw * 64 + lane; i < 8 * 128 * 64; i += NGW * 64) { const int hh = i >> 13, jj = (i >> 6) & 127, ii = i & 63;
        P.lru_wg[i] = f2bf((jj < 64) ? P.lwa[(hh * 64 + ii) * 64 + jj] : P.lwx[(hh * 64 + ii) * 64 + jj - 64]); }
    for (int i = gw * 64 + lane; i < (256 - NE) * D * 2 / 16; i += NGW * 64) ((u32x4*)(ROUT + (size_t)NE * D))[i] = (u32x4){0u, 0u, 0u, 0u};
}
__device__ __forceinline__ void convert_rows(const float* src, bf16_t* dst, size_t n, size_t gtid, size_t nthr) {
    for (size_t i = gtid * 8; i < n; i += nthr * 32) {
        float4 a[4], b[4];
#pragma unroll
        for (int r = 0; r < 4; ++r) { a[r] = *(const float4*)(src + i + r * nthr * 8); b[r] = *(const float4*)(src + i + r * nthr * 8 + 4); }
#pragma unroll
        for (int r = 0; r < 4; ++r) { u32x4 o; o.x = cvt_pk_bf16(a[r].x, a[r].y); o.y = cvt_pk_bf16(a[r].z, a[r].w); o.z = cvt_pk_bf16(b[r].x, b[r].y); o.w = cvt_pk_bf16(b[r].z, b[r].w); *(u32x4*)(dst + i + r * nthr * 8) = o; }
    }
}

__device__ __forceinline__ void acc8(float (&v)[8], const u32x4 a) { v[0] += bflo(a.x); v[1] += bfhi(a.x); v[2] += bflo(a.y); v[3] += bfhi(a.y); v[4] += bflo(a.z); v[5] += bfhi(a.z); v[6] += bflo(a.w); v[7] += bfhi(a.w); }
__device__ __forceinline__ void ln_finish(float (&v)[4][8], const float* gain, const float* bias, float* outf, bf16_t* xb, int lane, unsigned char* x8 = nullptr) {
    float s = 0.f;
#pragma unroll
    for (int j = 0; j < 4; ++j)
#pragma unroll
        for (int e = 0; e < 8; ++e) s += v[j][e];
    const float mean = wave_sum(s) * (1.f / D); float q = 0.f;
#pragma unroll
    for (int j = 0; j < 4; ++j)
#pragma unroll
        for (int e = 0; e < 8; ++e) { v[j][e] -= mean; q += v[j][e] * v[j][e]; }
    const float rstd = rsqf_(wave_sum(q) * (1.f / D) + 1e-5f);
#pragma unroll
    for (int j = 0; j < 4; ++j) { const int c0 = 8 * (lane + 64 * j); const float4 g0 = *(const float4*)(gain + c0), g1 = *(const float4*)(gain + c0 + 4), b0 = *(const float4*)(bias + c0), b1 = *(const float4*)(bias + c0 + 4);
        float4 o0, o1; o0.x = v[j][0] * rstd * g0.x + b0.x; o0.y = v[j][1] * rstd * g0.y + b0.y; o0.z = v[j][2] * rstd * g0.z + b0.z; o0.w = v[j][3] * rstd * g0.w + b0.w;
        o1.x = v[j][4] * rstd * g1.x + b1.x; o1.y = v[j][5] * rstd * g1.y + b1.y; o1.z = v[j][6] * rstd * g1.z + b1.z; o1.w = v[j][7] * rstd * g1.w + b1.w;
        if (outf) { *(float4*)(outf + c0) = o0; *(float4*)(outf + c0 + 4) = o1; }
        if (xb) { u32x4 w; w.x = cvt_pk_bf16(o0.x, o0.y); w.y = cvt_pk_bf16(o0.z, o0.w); w.z = cvt_pk_bf16(o1.x, o1.y); w.w = cvt_pk_bf16(o1.z, o1.w); *(u32x4*)(xb + c0) = w; }
        if (x8) { u32x2 w; w.x = cvt4_fp8(o0.x, o0.y, o0.z, o0.w); w.y = cvt4_fp8(o1.x, o1.y, o1.z, o1.w); *(u32x2*)(x8 + c0) = w; } }
}
__device__ __forceinline__ void ln1_rows2(const bf16_t* z0, const bf16_t* z1, const float* gain, const float* bias, bf16_t* xb0, bf16_t* xb1, int lane, unsigned char* x80 = nullptr, unsigned char* x81 = nullptr) {
    u32x4 a[2][4], x[2][4];
#pragma unroll
    for (int j = 0; j < 4; ++j) { a[0][j] = *(const u32x4*)(z0 + 8 * (lane + 64 * j)); a[1][j] = *(const u32x4*)(z1 + 8 * (lane + 64 * j)); x[0][j] = *(const u32x4*)(xb0 + 8 * (lane + 64 * j)); x[1][j] = *(const u32x4*)(xb1 + 8 * (lane + 64 * j)); }
#pragma unroll
    for (int r = 0; r < 2; ++r) { float v[4][8];
#pragma unroll
        for (int j = 0; j < 4; ++j) {
#pragma unroll
            for (int e = 0; e < 8; ++e) v[j][e] = 0.f;
            acc8(v[j], x[r][j]);
#pragma unroll
            for (int e = 0; e < 8; ++e) v[j][e] *= ALPHA;
            acc8(v[j], a[r][j]); }
        ln_finish(v, gain, bias, nullptr, r ? xb1 : xb0, lane, r ? x81 : x80); }
}
__device__ __forceinline__ void ln2_row(const bf16_t* x1, const float* gain, const float* bias, float* outf, bf16_t* xb, const bf16_t* yrows, const bf16_t* yp, const bf16_t* ysh, int lane) {
    u32x4 a[3][4], y[8][4];
#pragma unroll
    for (int j = 0; j < 4; ++j) { const int c0 = 8 * (lane + 64 * j); a[0][j] = *(const u32x4*)(x1 + c0); a[1][j] = *(const u32x4*)(yp + c0); a[2][j] = *(const u32x4*)(ysh + c0); }
#pragma unroll
    for (int k = 0; k < TOPK; ++k)
#pragma unroll
        for (int j = 0; j < 4; ++j) y[k][j] = *(const u32x4*)(yrows + (size_t)k * D + 8 * (lane + 64 * j));
    float v[4][8];
#pragma unroll
    for (int j = 0; j < 4; ++j) {
#pragma unroll
        for (int e = 0; e < 8; ++e) v[j][e] = 0.f;
        acc8(v[j], a[0][j]);
#pragma unroll
        for (int e = 0; e < 8; ++e) v[j][e] *= ALPHA;
        acc8(v[j], a[1][j]); acc8(v[j], a[2][j]);
#pragma unroll
        for (int k = 0; k < TOPK; ++k) acc8(v[j], y[k][j]); }
    ln_finish(v, gain, bias, outf, xb, lane);
}
__device__ __forceinline__ void acc16_fp8(float (&v)[16], const u32x4 a) {
    const unsigned w[4] = {a.x, a.y, a.z, a.w};
#pragma unroll
    for (int i = 0; i < 4; ++i) { typedef float f2_ __attribute__((ext_vector_type(2))); const f2_ lo = __builtin_amdgcn_cvt_pk_f32_fp8((int)w[i], false), hi = __builtin_amdgcn_cvt_pk_f32_fp8((int)w[i], true);
        v[4 * i] += lo[0]; v[4 * i + 1] += lo[1]; v[4 * i + 2] += hi[0]; v[4 * i + 3] += hi[1]; }
}
__device__ __forceinline__ void ln2_row8(const bf16_t* x1, const float* gain, const float* bias, float* outf, bf16_t* xb, const unsigned char* yrows, const unsigned char* yp, const unsigned char* ysh, int lane_) {
    unsigned lane = (unsigned)lane_; asm volatile("" : "+v"(lane));
    float v[2][16]; float s = 0.f;
#pragma unroll
    for (int j = 0; j < 2; ++j) {
        const unsigned c0 = 16u * (lane + 64u * j);
        u32x4 y[10], xa[2];
        y[0] = *(const u32x4*)(ysh + c0); y[9] = *(const u32x4*)(yp + c0);
#pragma unroll
        for (int k = 0; k < TOPK; ++k) y[1 + k] = *(const u32x4*)(yrows + (size_t)k * D + c0);
        xa[0] = *(const u32x4*)(x1 + c0); xa[1] = *(const u32x4*)(x1 + c0 + 8);
        float e[16];
#pragma unroll
        for (int i = 0; i < 16; ++i) e[i] = 0.f;
#pragma unroll
        for (int k = 0; k < 10; ++k) acc16_fp8(e, y[k]);
#pragma unroll
        for (int hh = 0; hh < 2; ++hh) { float x8[8];
#pragma unroll
            for (int i = 0; i < 8; ++i) x8[i] = 0.f;
            acc8(x8, xa[hh]);
#pragma unroll
            for (int i = 0; i < 8; ++i) { v[j][8 * hh + i] = ALPHA * x8[i] + e[8 * hh + i] * (1.0f / Y8_SCALE); s += v[j][8 * hh + i]; } }
        if (j == 0) asm volatile("" ::: "memory");
    }
    const float mean = wave_sum(s) * (1.f / D); float q = 0.f;
#pragma unroll
    for (int j = 0; j < 2; ++j)
#pragma unroll
        for (int i = 0; i < 16; ++i) { v[j][i] -= mean; q += v[j][i] * v[j][i]; }
    const float rstd = rsqf_(wave_sum(q) * (1.f / D) + 1e-5f);
#pragma unroll
    for (int j = 0; j < 2; ++j) { const unsigned c0 = 16u * (lane + 64u * j); float o[16];
#pragma unroll
        for (int i4 = 0; i4 < 4; ++i4) { const float4 g = *(const float4*)(gain + c0 + 4 * i4), b = *(const float4*)(bias + c0 + 4 * i4);
            o[4 * i4] = v[j][4 * i4] * rstd * g.x + b.x; o[4 * i4 + 1] = v[j][4 * i4 + 1] * rstd * g.y + b.y; o[4 * i4 + 2] = v[j][4 * i4 + 2] * rstd * g.z + b.z; o[4 * i4 + 3] = v[j][4 * i4 + 3] * rstd * g.w + b.w;
            if (outf) *(float4*)(outf + c0 + 4 * i4) = make_float4(o[4 * i4], o[4 * i4 + 1], o[4 * i4 + 2], o[4 * i4 + 3]); }
        if (xb) { u32x4 w0, w1; w0.x = cvt_pk_bf16(o[0], o[1]); w0.y = cvt_pk_bf16(o[2], o[3]); w0.z = cvt_pk_bf16(o[4], o[5]); w0.w = cvt_pk_bf16(o[6], o[7]);
            w1.x = cvt_pk_bf16(o[8], o[9]); w1.y = cvt_pk_bf16(o[10], o[11]); w1.z = cvt_pk_bf16(o[12], o[13]); w1.w = cvt_pk_bf16(o[14], o[15]); *(u32x4*)(xb + c0) = w0; *(u32x4*)(xb + c0 + 8) = w1; } }
}
constexpr int AT_KS = 72, AT_VS = 264, AT_PS = 168;
constexpr int AT_LDS_K = 0, AT_LDS_V = 256 * AT_KS * 2, AT_LDS_P = AT_LDS_V + (64 * AT_VS + 64) * 2, AT_LDS_SS = AT_LDS_P + 8 * 16 * AT_PS * 2, AT_LDS_CS = AT_LDS_SS + 8 * 128 * 4, AT_LDS_BYTES = AT_LDS_CS + 128 * 16 * 4;
static_assert(AT_LDS_BYTES <= RING_BYTES, "attention LDS");
struct RotTab { double invf[8]; };
__device__ __forceinline__ void attn_unit(const int wv, unsigned char* lds, int u, const bf16_t* HIN, const int* positions, const float* sinks, bf16_t* MIX, float* SSQ, const RotTab& rt) {
    bf16_t* Ks = (bf16_t*)(lds + AT_LDS_K); bf16_t* Vt = (bf16_t*)(lds + AT_LDS_V); bf16_t* Ps = (bf16_t*)(lds + AT_LDS_P); float* SS = (float*)(lds + AT_LDS_SS); float* CS = (float*)(lds + AT_LDS_CS);
    const int g = u & 1, n = (u >> 1) & 31, b = u >> 6;
    const int tid = opaque_tid(wv), lane = tid & 63, w = tid >> 6;
    __syncthreads();
    {
        const int j = tid >> 1, half = tid & 1; const int kp = 128 * (n - 1) + j;
        u32x4 kv[4], vv[4];
        if (kp >= 0) {
            const bf16_t* kr = HIN + (size_t)(b * SEQ + kp) * IN_COLS + C_AK + g * 64 + half * 32;
            const bf16_t* vr = HIN + (size_t)(b * SEQ + kp) * IN_COLS + C_AV + g * 64 + half * 32;
#pragma unroll
            for (int i = 0; i < 4; ++i) { kv[i] = *(const u32x4*)(kr + 8 * i); vv[i] = *(const u32x4*)(vr + 8 * i); }
            if (half == 0) {
                const float pos = (float)positions[b * SEQ + kp];
                float t1[8], t2[8];
                t1[0] = bflo(kv[0].x); t1[1] = bfhi(kv[0].x); t1[2] = bflo(kv[0].y); t1[3] = bfhi(kv[0].y); t1[4] = bflo(kv[0].z); t1[5] = bfhi(kv[0].z); t1[6] = bflo(kv[0].w); t1[7] = bfhi(kv[0].w);
                t2[0] = bflo(kv[1].x); t2[1] = bfhi(kv[1].x); t2[2] = bflo(kv[1].y); t2[3] = bfhi(kv[1].y); t2[4] = bflo(kv[1].z); t2[5] = bfhi(kv[1].z); t2[6] = bflo(kv[1].w); t2[7] = bfhi(kv[1].w);
#pragma unroll
                for (int i = 0; i < 8; ++i) { float sn, cs; sincos_pos(pos, rt.invf[i], sn, cs); const float a = t1[i] * cs - t2[i] * sn, bb = t2[i] * cs + t1[i] * sn; t1[i] = a; t2[i] = bb;
                    if (j >= 128) { CS[(j - 128) * 16 + i] = cs; CS[(j - 128) * 16 + 8 + i] = sn; } }
                kv[0].x = cvt_pk_bf16(t1[0], t1[1]); kv[0].y = cvt_pk_bf16(t1[2], t1[3]); kv[0].z = cvt_pk_bf16(t1[4], t1[5]); kv[0].w = cvt_pk_bf16(t1[6], t1[7]);
                kv[1].x = cvt_pk_bf16(t2[0], t2[1]); kv[1].y = cvt_pk_bf16(t2[2], t2[3]); kv[1].z = cvt_pk_bf16(t2[4], t2[5]); kv[1].w = cvt_pk_bf16(t2[6], t2[7]);
            }
        } else {
#pragma unroll
            for (int i = 0; i < 4; ++i) { kv[i] = (u32x4){0u, 0u, 0u, 0u}; vv[i] = (u32x4){0u, 0u, 0u, 0u}; }
        }
#pragma unroll
        for (int i = 0; i < 4; ++i) *(u32x4*)(Ks + j * AT_KS + half * 32 + 8 * i) = kv[i];
#pragma unroll
        for (int i = 0; i < 4; ++i) { const int d = half * 32 + 8 * i;
            Vt[(d + 0) * AT_VS + j] = (bf16_t)(vv[i].x & 0xffff); Vt[(d + 1) * AT_VS + j] = (bf16_t)(vv[i].x >> 16); Vt[(d + 2) * AT_VS + j] = (bf16_t)(vv[i].y & 0xffff); Vt[(d + 3) * AT_VS + j] = (bf16_t)(vv[i].y >> 16);
            Vt[(d + 4) * AT_VS + j] = (bf16_t)(vv[i].z & 0xffff); Vt[(d + 5) * AT_VS + j] = (bf16_t)(vv[i].z >> 16); Vt[(d + 6) * AT_VS + j] = (bf16_t)(vv[i].w & 0xffff); Vt[(d + 7) * AT_VS + j] = (bf16_t)(vv[i].w >> 16); }
        if (tid < 64) {
#pragma unroll
            for (int i = 0; i < 8; ++i) Vt[tid * AT_VS + 256 + i] = 0;
            Vt[64 * AT_VS + tid] = 0;
        }
        for (int i = tid; i < 8 * 16 * 24; i += NTHR) { const int r = i / 24, c = 144 + i % 24; Ps[r * AT_PS + c] = 0; }
    }
    __syncthreads();
    const int hq = g * 8 + w;
    constexpr float LOG2E = 1.4426950408889634f, C2 = 0.125f * LOG2E;
    const float sink2 = sinks[hq] * LOG2E;
    const int lr = lane & 15, lg = lane >> 4;
    bf16_t* Pw = Ps + w * 16 * AT_PS;
    const bf16_t* qbase = HIN + (size_t)(b * SEQ + n * 128 + lr) * IN_COLS + C_AQ + hq * 64 + lg * 8;
    u32x4 nq0 = *(const u32x4*)qbase, nq1 = *(const u32x4*)(qbase + 32);
    for (int qi = 0; qi < 8; ++qi) {
        const int tq = b * SEQ + n * 128 + qi * 16 + lr;
        u32x4 q0 = nq0; const u32x4 q1 = nq1;
        if (qi < 7) { const bf16_t* qn = qbase + (size_t)(qi + 1) * 16 * IN_COLS; nq0 = *(const u32x4*)qn; nq1 = *(const u32x4*)(qn + 32); }
        {
            u32x4 other; other.x = __shfl_xor(q0.x, 16); other.y = __shfl_xor(q0.y, 16); other.z = __shfl_xor(q0.z, 16); other.w = __shfl_xor(q0.w, 16);
            if (lg < 2) {
                const float4 c0 = *(const float4*)(CS + (qi * 16 + lr) * 16), c1 = *(const float4*)(CS + (qi * 16 + lr) * 16 + 4), s0 = *(const float4*)(CS + (qi * 16 + lr) * 16 + 8), s1 = *(const float4*)(CS + (qi * 16 + lr) * 16 + 12);
                const float cs[8] = {c0.x, c0.y, c0.z, c0.w, c1.x, c1.y, c1.z, c1.w}; const float sn[8] = {s0.x, s0.y, s0.z, s0.w, s1.x, s1.y, s1.z, s1.w};
                float mv[8], ov[8];
                mv[0] = bflo(q0.x); mv[1] = bfhi(q0.x); mv[2] = bflo(q0.y); mv[3] = bfhi(q0.y); mv[4] = bflo(q0.z); mv[5] = bfhi(q0.z); mv[6] = bflo(q0.w); mv[7] = bfhi(q0.w);
                ov[0] = bflo(other.x); ov[1] = bfhi(other.x); ov[2] = bflo(other.y); ov[3] = bfhi(other.y); ov[4] = bflo(other.z); ov[5] = bfhi(other.z); ov[6] = bflo(other.w); ov[7] = bfhi(other.w);
                const float sg = (lg == 0) ? -1.f : 1.f;
#pragma unroll
                for (int i = 0; i < 8; ++i) mv[i] = mv[i] * cs[i] + sg * ov[i] * sn[i];
                q0.x = cvt_pk_bf16(mv[0], mv[1]); q0.y = cvt_pk_bf16(mv[2], mv[3]); q0.z = cvt_pk_bf16(mv[4], mv[5]); q0.w = cvt_pk_bf16(mv[6], mv[7]);
            }
        }
        const bf16x8 qa0 = __builtin_bit_cast(bf16x8, q0), qa1 = __builtin_bit_cast(bf16x8, q1);
        f32x4 s[9];
#pragma unroll
        for (int jt = 0; jt < 9; ++jt) {
            const int jr = (qi + jt) * 16 + lr;
            const bf16x8 kb0 = *(const bf16x8*)(Ks + jr * AT_KS + lg * 8), kb1 = *(const bf16x8*)(Ks + jr * AT_KS + 32 + lg * 8);
            f32x4 a = (f32x4){0.f, 0.f, 0.f, 0.f};
            a = __builtin_amdgcn_mfma_f32_16x16x32_bf16(kb0, qa0, a, 0, 0, 0);
            a = __builtin_amdgcn_mfma_f32_16x16x32_bf16(kb1, qa1, a, 0, 0, 0);
            s[jt] = a;
        }
#pragma unroll
        for (int r = 0; r < 4; ++r) { if (!(4 * lg + r > lr)) s[0][r] = -3.0e38f; if (!(4 * lg + r <= lr)) s[8][r] = -3.0e38f; }
        if (n == 0) {
#pragma unroll
            for (int jt = 0; jt < 8; ++jt) if (qi + jt < 8) s[jt] = (f32x4){-3.0e38f, -3.0e38f, -3.0e38f, -3.0e38f};
        }
        float m = -3.0e38f;
#pragma unroll
        for (int jt = 0; jt < 9; ++jt) m = fmaxf(fmaxf(m, fmaxf(s[jt][0], s[jt][1])), fmaxf(s[jt][2], s[jt][3]));
        m = fmaxf(m, __shfl_xor(m, 16)); m = fmaxf(m, __shfl_xor(m, 32));
        const float m2 = fmaxf(m * C2, sink2);
        float sum = 0.f;
#pragma unroll
        for (int jt = 0; jt < 9; ++jt) {
            f32x4 p;
#pragma unroll
            for (int r = 0; r < 4; ++r) { p[r] = __builtin_amdgcn_exp2f(fmaf(s[jt][r], C2, -m2)); sum += p[r]; }
            u32x2 pk; pk.x = cvt_pk_bf16(p[0], p[1]); pk.y = cvt_pk_bf16(p[2], p[3]);
            *(u32x2*)(Pw + lr * AT_PS + jt * 16 + 4 * lg) = pk;
        }
        sum += __shfl_xor(sum, 16); sum += __shfl_xor(sum, 32);
        const float inv = rcpf_(sum + __builtin_amdgcn_exp2f(sink2 - m2));
        asm volatile("s_waitcnt lgkmcnt(0)" ::: "memory");
        f32x4 o[4];
#pragma unroll
        for (int dt = 0; dt < 4; ++dt) o[dt] = (f32x4){0.f, 0.f, 0.f, 0.f};
#pragma unroll
        for (int ks = 0; ks < 5; ++ks) {
            const bf16x8 pa = *(const bf16x8*)(Pw + lr * AT_PS + ks * 32 + lg * 8);
#pragma unroll
            for (int dt = 0; dt < 4; ++dt) { const bf16x8 vb = *(const bf16x8*)(Vt + (dt * 16 + lr) * AT_VS + qi * 16 + ks * 32 + lg * 8); o[dt] = __builtin_amdgcn_mfma_f32_16x16x32_bf16(vb, pa, o[dt], 0, 0, 0); }
        }
        float q = 0.f;
        bf16_t* orow = MIX + (size_t)tq * D + hq * 64 + 4 * lg;
#pragma unroll
        for (int dt = 0; dt < 4; ++dt) { const f32x4 v = o[dt] * inv; q += (v[0] * v[0] + v[1] * v[1]) + (v[2] * v[2] + v[3] * v[3]);
            u32x2 pk; pk.x = cvt_pk_bf16(v[0], v[1]); pk.y = cvt_pk_bf16(v[2], v[3]); *(u32x2*)(orow + dt * 16) = pk; }
        q += __shfl_xor(q, 16); q += __shfl_xor(q, 32);
        if (lg == 0) SS[w * 128 + qi * 16 + lr] = q;
    }
    __syncthreads();
    if (tid < 128) { float q = 0.f;
#pragma unroll
        for (int ww = 0; ww < 8; ++ww) q += SS[ww * 128 + tid];
        SSQ[(size_t)(b * SEQ + n * 128 + tid) * 2 + g] = q; }
}
__device__ __forceinline__ void attn_fin_rows4(bf16_t* MIX, const float* SSQ, const float* gain, int t, int lane) {
    u32x4 v[4][2]; float sc[4];
#pragma unroll
    for (int r = 0; r < 4; ++r) { const u32x4* p = (const u32x4*)(MIX + (size_t)(t + r) * D) + lane * 2; v[r][0] = p[0]; v[r][1] = p[1]; sc[r] = rsqf_((SSQ[(size_t)(t + r) * 2] + SSQ[(size_t)(t + r) * 2 + 1]) * (1.0f / 1024.f) + 1e-6f); }
    const int c = lane * 16; const float4 g0 = *(const float4*)(gain + c), g1 = *(const float4*)(gain + c + 4), g2 = *(const float4*)(gain + c + 8), g3 = *(const float4*)(gain + c + 12);
#pragma unroll
    for (int r = 0; r < 4; ++r) { u32x4 a = v[r][0], b = v[r][1]; const float s = sc[r];
        a.x = cvt_pk_bf16(bflo(a.x) * s * g0.x, bfhi(a.x) * s * g0.y); a.y = cvt_pk_bf16(bflo(a.y) * s * g0.z, bfhi(a.y) * s * g0.w); a.z = cvt_pk_bf16(bflo(a.z) * s * g1.x, bfhi(a.z) * s * g1.y); a.w = cvt_pk_bf16(bflo(a.w) * s * g1.z, bfhi(a.w) * s * g1.w);
        b.x = cvt_pk_bf16(bflo(b.x) * s * g2.x, bfhi(b.x) * s * g2.y); b.y = cvt_pk_bf16(bflo(b.y) * s * g2.z, bfhi(b.y) * s * g2.w); b.z = cvt_pk_bf16(bflo(b.z) * s * g3.x, bfhi(b.z) * s * g3.y); b.w = cvt_pk_bf16(bflo(b.w) * s * g3.z, bfhi(b.w) * s * g3.w);
        u32x4* p = (u32x4*)(MIX + (size_t)(t + r) * D) + lane * 2; p[0] = a; p[1] = b; }
}

constexpr int HG_S72 = 72, HG_S136 = 136;
__device__ __forceinline__ float hg_lb(const float* lbl, int layer, int col) { if (layer == 0) return 0.f; return sigmoidf_(lbl[512 + col] - lbl[col]); }
constexpr int H1_LDS_KT = 0, H1_LDS_VT = 128 * HG_S72 * 2, H1_LDS_TOT = 2 * 128 * HG_S72 * 2, H1_LDS_BYTES = H1_LDS_TOT + 4 * 128 * 4;
__device__ __forceinline__ void hg1_unit(const int wv, unsigned char* lds, int u, const bf16_t* HIN, const float* lbl, int layer, bf16_t* SST, float* DV, int unext) {
    bf16_t* KT = (bf16_t*)(lds + H1_LDS_KT); bf16_t* VT = (bf16_t*)(lds + H1_LDS_VT); float* TOT = (float*)(lds + H1_LDS_TOT);
    const int c = u & 63, h = (u >> 6) & 3, b = u >> 8;
    const int tid = opaque_tid(wv), lane = tid & 63, w = tid >> 6, k = tid & 127, tq = tid >> 7;
    const size_t t0 = (size_t)b * SEQ + c * 64;
    const float lb = hg_lb(lbl, layer, h * 128 + k);
    __syncthreads();
    float bl[16], kf[16]; float cum = 0.f;
#pragma unroll
    for (int i = 0; i < 16; ++i) { const size_t row = (t0 + 16 * tq + i) * IN_COLS; const float fp = bf2f(HIN[row + C_HF + h * 128 + k]);
        const float sg = sigmoidf_(fp); const float f = lb + (1.f - lb) * sg; cum += __logf(fmaxf(f, 1e-30f)); bl[i] = cum; kf[i] = (1.f - lb) * (1.f - sg);
        VT[k * HG_S72 + 16 * tq + i] = HIN[row + C_HI + h * 128 + k]; }
    TOT[tq * 128 + k] = cum;
    unsigned pf = 0u;
    if (unext >= 0 && tid < 256) { const int cn = unext & 63, hn = (unext >> 6) & 3, bn = unext >> 8, part = tid & 3;
        pf = *(const volatile unsigned*)(HIN + ((size_t)bn * SEQ + cn * 64 + (tid >> 2)) * IN_COLS + ((part < 2) ? C_HF : C_HI) + hn * 128 + (part & 1) * 64); }
    __syncthreads();
    float pre = 0.f, total = 0.f;
#pragma unroll
    for (int j = 0; j < 4; ++j) { const float tj = TOT[j * 128 + k]; if (j < tq) pre += tj; total += tj; }
#pragma unroll
    for (int i = 0; i < 16; ++i) KT[k * HG_S72 + 16 * tq + i] = f2bf_hw(kf[i] * __expf(total - (pre + bl[i])));
    if (tq == 0) DV[(size_t)u * 128 + k] = __expf(total);
    __syncthreads();
    const int lr = lane & 15, lg = lane >> 4;
    bf16x8 a[2];
#pragma unroll
    for (int ks = 0; ks < 2; ++ks) a[ks] = *(const bf16x8*)(VT + (w * 16 + lr) * HG_S72 + ks * 32 + lg * 8);
    bf16_t* out = SST + (size_t)u * 16384;
#pragma unroll
    for (int kt = 0; kt < 8; ++kt) {
        f32x4 acc = (f32x4){0.f, 0.f, 0.f, 0.f};
#pragma unroll
        for (int ks = 0; ks < 2; ++ks) { const bf16x8 bb = *(const bf16x8*)(KT + (kt * 16 + lr) * HG_S72 + ks * 32 + lg * 8); acc = __builtin_amdgcn_mfma_f32_16x16x32_bf16(bb, a[ks], acc, 0, 0, 0); }
        { u32x2 pk; pk.x = pk2(acc[0], acc[1]); pk.y = pk2(acc[2], acc[3]); *(u32x2*)(out + (w * 16 + lr) * 128 + kt * 16 + 4 * lg) = pk; }
    }
    asm volatile("" :: "v"(pf));
}
__device__ __forceinline__ void hg2_unit(const int wv, int u, const bf16_t* SST, const float* DV, bf16_t* SPREV) {
    const int bh = u >> 3, part = u & 7, e4 = part * 512 + opaque_tid(wv);
    const int k4 = (e4 & 31) * 4;
    float4 S = make_float4(0.f, 0.f, 0.f, 0.f);
    for (int c0 = 0; c0 < 64; c0 += 4) {
        u32x2 ds[4]; float4 dv[4];
#pragma unroll
        for (int i = 0; i < 4; ++i) { const size_t uu = (size_t)bh * 64 + c0 + i; ds[i] = *((const u32x2*)(SST + uu * 16384) + e4); dv[i] = *(const float4*)(DV + uu * 128 + k4); }
#pragma unroll
        for (int i = 0; i < 4; ++i) { const size_t uu = (size_t)bh * 64 + c0 + i; u32x2 o; o.x = cvt_pk_bf16(S.x, S.y); o.y = cvt_pk_bf16(S.z, S.w); *((u32x2*)(SPREV + uu * 16384) + e4) = o;
            S.x = dv[i].x * S.x + bflo(ds[i].x); S.y = dv[i].y * S.y + bfhi(ds[i].x); S.z = dv[i].z * S.z + bflo(ds[i].y); S.w = dv[i].w * S.w + bfhi(ds[i].y); }
    }
}
constexpr int H3_QI = 0, H3_QE = H3_QI + 64 * HG_S136 * 2, H3_KI = H3_QE + 64 * HG_S136 * 2, H3_VT = H3_KI + 160 * HG_S136 * 2, H3_SB = H3_VT + 128 * HG_S72 * 2,
              H3_SC = H3_SB + 128 * HG_S136 * 2, H3_TOT = H3_SC + 64 * HG_S72 * 2, H3_LDS_BYTES = H3_TOT + 4 * 128 * 4;
constexpr int H3_OB = H3_KI, HG_OS = 132;
static_assert(H3_LDS_BYTES <= MISC_OFF, "HGRN2 LDS");
__device__ __forceinline__ void hg3_unit(const int wv, unsigned char* lds, int u, const bf16_t* HIN, const float* lbl, int layer, const bf16_t* SST, const float* gain, bf16_t* MIX, int unext) {
    bf16_t* QI = (bf16_t*)(lds + H3_QI); bf16_t* QE = (bf16_t*)(lds + H3_QE); bf16_t* KI = (bf16_t*)(lds + H3_KI); bf16_t* VT = (bf16_t*)(lds + H3_VT);
    bf16_t* SB = (bf16_t*)(lds + H3_SB); bf16_t* SC = (bf16_t*)(lds + H3_SC); float* TOT = (float*)(lds + H3_TOT); float* OB = (float*)(lds + H3_OB);
    const int c = u & 63, h = (u >> 6) & 3, b = u >> 8;
    const int tid = opaque_tid(wv), lane = tid & 63, w = tid >> 6, k = tid & 127, tq = tid >> 7;
    const size_t t0 = (size_t)b * SEQ + c * 64;
    const float lb = hg_lb(lbl, layer, h * 128 + k);
    const u32x4 g0 = *(const u32x4*)(HIN + (t0 + (tid >> 3)) * IN_COLS + C_HG + h * 128 + (tid & 7) * 16), g1 = *(const u32x4*)(HIN + (t0 + (tid >> 3)) * IN_COLS + C_HG + h * 128 + (tid & 7) * 16 + 8);
    __syncthreads();
    float bl[16], kf[16], qf[16]; float cum = 0.f;
#pragma unroll
    for (int i = 0; i < 16; ++i) { const size_t row = (t0 + 16 * tq + i) * IN_COLS; const float fp = bf2f(HIN[row + C_HF + h * 128 + k]);
        const float sg = sigmoidf_(fp); const float f = lb + (1.f - lb) * sg; cum += __logf(fmaxf(f, 1e-30f)); bl[i] = cum; kf[i] = (1.f - lb) * (1.f - sg);
        qf[i] = siluf_(bf2f(HIN[row + C_HQ + h * 128 + k]));
        VT[k * HG_S72 + 16 * tq + i] = HIN[row + C_HI + h * 128 + k]; }
    TOT[tq * 128 + k] = cum;
    { const u32x4* sp = (const u32x4*)(SST + (size_t)u * 16384);
#pragma unroll
      for (int i = 0; i < 4; ++i) { const int e8 = tid + 512 * i; const u32x4 s8 = sp[e8]; const int v = e8 >> 4, k8 = (e8 & 15) * 8; *(u32x4*)(SB + v * HG_S136 + k8) = s8; } }
    for (int i = tid; i < 64 * HG_S72 / 2; i += NTHR) ((unsigned*)SC)[i] = 0u;
    unsigned pf = 0u, pf2 = 0u;
    if (unext >= 0) { const int cn = unext & 63, hn = (unext >> 6) & 3, bn = unext >> 8, part = tid & 7; const int col = (part < 2) ? C_HF : (part < 4) ? C_HQ : (part < 6) ? C_HI : C_HG;
        pf = *(const volatile unsigned*)(HIN + ((size_t)bn * SEQ + cn * 64 + (tid >> 3)) * IN_COLS + col + hn * 128 + (part & 1) * 64);
        if (tid < 256) pf2 = *(const volatile unsigned*)(SST + (size_t)unext * 16384 + tid * 64); }
    __syncthreads();
    float rs[4]; { float acc = 0.f;
#pragma unroll
        for (int j = 0; j < 4; ++j) { rs[j] = acc; acc += TOT[j * 128 + k]; } }
    float pre = 0.f;
#pragma unroll
    for (int j = 0; j < 4; ++j) pre = (j == tq) ? rs[j] : pre;
    const float epre = __expf(pre);
    float fk[4];
#pragma unroll
    for (int ii = 0; ii < 4; ++ii) fk[ii] = __expf(fminf(rs[ii] - pre, 0.f));
#pragma unroll
    for (int i = 0; i < 16; ++i) {
        const int s = 16 * tq + i; const float e1 = fmaxf(__expf(bl[i]), 1e-30f), inv = rcpf_(e1);
        const float qi = qf[i] * e1, ki = kf[i] * inv;
        QI[s * HG_S136 + k] = f2bf_hw(qi);
        QE[s * HG_S136 + k] = f2bf_hw(qi * epre);
#pragma unroll
        for (int ii = 0; ii < 4; ++ii) if (ii >= tq) KI[((ii == 0 ? 0 : ii == 1 ? 16 : ii == 2 ? 48 : 96) + s) * HG_S136 + k] = f2bf_hw(ki * fk[ii]);
    }
    __syncthreads();
    const int lr = lane & 15, lg = lane >> 4;
    for (int tix = w; tix < 10; tix += 8) {
        int i, j; if (tix == 0) { i = 0; j = 0; } else if (tix < 3) { i = 1; j = tix - 1; } else if (tix < 6) { i = 2; j = tix - 3; } else { i = 3; j = tix - 6; }
        const int kb = (i == 0 ? 0 : i == 1 ? 16 : i == 2 ? 48 : 96);
        f32x4 acc = (f32x4){0.f, 0.f, 0.f, 0.f};
#pragma unroll
        for (int ks = 0; ks < 4; ++ks) { const bf16x8 a = *(const bf16x8*)(QI + (16 * i + lr) * HG_S136 + ks * 32 + lg * 8); const bf16x8 bb = *(const bf16x8*)(KI + (kb + 16 * j + lr) * HG_S136 + ks * 32 + lg * 8);
            acc = __builtin_amdgcn_mfma_f32_16x16x32_bf16(a, bb, acc, 0, 0, 0); }
#pragma unroll
        for (int r = 0; r < 4; ++r) { const int tr = 4 * lg + r; const float v = (i == j && lr > tr) ? 0.f : acc[r]; SC[(16 * i + tr) * HG_S72 + 16 * j + lr] = f2bf_hw(v); }
    }
    __syncthreads();
    f32x4 o[4];
#pragma unroll
    for (int tt = 0; tt < 4; ++tt) o[tt] = (f32x4){0.f, 0.f, 0.f, 0.f};
#pragma unroll
    for (int ks = 0; ks < 2; ++ks) { const bf16x8 vb = *(const bf16x8*)(VT + (w * 16 + lr) * HG_S72 + ks * 32 + lg * 8);
#pragma unroll
        for (int tt = 0; tt < 4; ++tt) { const bf16x8 a = *(const bf16x8*)(SC + (16 * tt + lr) * HG_S72 + ks * 32 + lg * 8); o[tt] = __builtin_amdgcn_mfma_f32_16x16x32_bf16(a, vb, o[tt], 0, 0, 0); } }
#pragma unroll
    for (int ks = 0; ks < 4; ++ks) { const bf16x8 sb = *(const bf16x8*)(SB + (w * 16 + lr) * HG_S136 + ks * 32 + lg * 8);
#pragma unroll
        for (int tt = 0; tt < 4; ++tt) { const bf16x8 a = *(const bf16x8*)(QE + (16 * tt + lr) * HG_S136 + ks * 32 + lg * 8); o[tt] = __builtin_amdgcn_mfma_f32_16x16x32_bf16(a, sb, o[tt], 0, 0, 0); } }
#pragma unroll
    for (int tt = 0; tt < 4; ++tt)
#pragma unroll
        for (int r = 0; r < 4; ++r) OB[(16 * tt + 4 * lg + r) * HG_OS + w * 16 + lr] = o[tt][r];
    __syncthreads();
    { const int t = tid >> 3, vg = tid & 7; float ov[16]; float q = 0.f;
#pragma unroll
      for (int i = 0; i < 4; ++i) { const float4 x = *(const float4*)(OB + t * HG_OS + vg * 16 + 4 * i); ov[4 * i] = x.x; ov[4 * i + 1] = x.y; ov[4 * i + 2] = x.z; ov[4 * i + 3] = x.w; q += (x.x * x.x + x.y * x.y) + (x.z * x.z + x.w * x.w); }
      q += __shfl_xor(q, 1); q += __shfl_xor(q, 2); q += __shfl_xor(q, 4);
      const float rinv = rsqf_(q * (1.0f / 128.f) + 1e-6f);
      const size_t row = t0 + t; const float* gn = gain + h * 128 + vg * 16;
      u32x4 o0, o1;
      o0.x = pk2(ov[0] * rinv * gn[0] * siluf_(bflo(g0.x)), ov[1] * rinv * gn[1] * siluf_(bfhi(g0.x))); o0.y = pk2(ov[2] * rinv * gn[2] * siluf_(bflo(g0.y)), ov[3] * rinv * gn[3] * siluf_(bfhi(g0.y)));
      o0.z = pk2(ov[4] * rinv * gn[4] * siluf_(bflo(g0.z)), ov[5] * rinv * gn[5] * siluf_(bfhi(g0.z))); o0.w = pk2(ov[6] * rinv * gn[6] * siluf_(bflo(g0.w)), ov[7] * rinv * gn[7] * siluf_(bfhi(g0.w)));
      o1.x = pk2(ov[8] * rinv * gn[8] * siluf_(bflo(g1.x)), ov[9] * rinv * gn[9] * siluf_(bfhi(g1.x))); o1.y = pk2(ov[10] * rinv * gn[10] * siluf_(bflo(g1.y)), ov[11] * rinv * gn[11] * siluf_(bfhi(g1.y)));
      o1.z = pk2(ov[12] * rinv * gn[12] * siluf_(bflo(g1.z)), ov[13] * rinv * gn[13] * siluf_(bfhi(g1.z))); o1.w = pk2(ov[14] * rinv * gn[14] * siluf_(bflo(g1.w)), ov[15] * rinv * gn[15] * siluf_(bfhi(g1.w)));
      bf16_t* op = MIX + row * D + 1024 + h * 128 + vg * 16; *(u32x4*)op = o0; *(u32x4*)(op + 8) = o1; }
    asm volatile("" :: "v"(pf), "v"(pf2));
}

constexpr int LRU_LDS_X = 0, LRU_LDS_MS = LCH * 516 * 4, LRU_LDS_BYTES = LRU_LDS_MS + LCH * 4;
static_assert(LRU_LDS_BYTES <= RING_BYTES, "LRU LDS");
struct LruW { const float *conv_w, *conv_b, *wa, *ba, *wx, *bx, *lam, *gain; };
constexpr int LRU_XS = 520;
__device__ __forceinline__ void lru1_unit(const int wv, unsigned char* lds, int u, const bf16_t* HIN, const LruW& W, const bf16_t* WG16, float* AGA, float* AGH, bf16_t* HL, bf16_t* PL) {
    bf16_t* XB16 = (bf16_t*)lds;
    const int ch = u % NLCH, b = u / NLCH;
    const int c = opaque_tid(wv);
    const size_t t0 = (size_t)b * SEQ + ch * LCH;
    {
        const int cg8 = (c & 63) * 8, tg = c >> 6;
        u32x4 xr[7];
#pragma unroll
        for (int i = 0; i < 7; ++i) { const int tt = ch * LCH + 4 * tg - 3 + i;
            xr[i] = (tt >= 0) ? *(const u32x4*)(HIN + ((size_t)b * SEQ + tt) * IN_COLS + C_LX + cg8) : (u32x4){0u, 0u, 0u, 0u}; }
        float4 wq[4][2], bq[2];
#pragma unroll
        for (int j = 0; j < 4; ++j) { wq[j][0] = *(const float4*)(W.conv_w + j * 512 + cg8); wq[j][1] = *(const float4*)(W.conv_w + j * 512 + cg8 + 4); }
        bq[0] = *(const float4*)(W.conv_b + cg8); bq[1] = *(const float4*)(W.conv_b + cg8 + 4);
        __syncthreads();
#pragma unroll
        for (int i = 0; i < 4; ++i) { float o[8];
#pragma unroll
            for (int e = 0; e < 8; ++e) o[e] = (e < 4) ? ((const float*)&bq[0])[e] : ((const float*)&bq[1])[e - 4];
#pragma unroll
            for (int j = 0; j < 4; ++j) { const u32x4 x = xr[i + j]; const float xv[8] = {bflo(x.x), bfhi(x.x), bflo(x.y), bfhi(x.y), bflo(x.z), bfhi(x.z), bflo(x.w), bfhi(x.w)};
#pragma unroll
                for (int e = 0; e < 8; ++e) o[e] += xv[e] * ((e < 4) ? ((const float*)&wq[j][0])[e] : ((const float*)&wq[j][1])[e - 4]); }
            u32x4 pk; pk.x = cvt_pk_bf16(o[0], o[1]); pk.y = cvt_pk_bf16(o[2], o[3]); pk.z = cvt_pk_bf16(o[4], o[5]); pk.w = cvt_pk_bf16(o[6], o[7]);
            *(u32x4*)(XB16 + (4 * tg + i) * LRU_XS + cg8) = pk; }
    }
    __syncthreads();
    const int lane = c & 63, h = wv, lr = lane & 15, lg = lane >> 4;
    f32x4 acc[2][8];
#pragma unroll
    for (int mt = 0; mt < 2; ++mt)
#pragma unroll
        for (int nt = 0; nt < 8; ++nt) acc[mt][nt] = (f32x4){0.f, 0.f, 0.f, 0.f};
#pragma unroll
    for (int ks = 0; ks < 2; ++ks) {
        bf16x8 a[2];
#pragma unroll
        for (int mt = 0; mt < 2; ++mt) a[mt] = *(const bf16x8*)(XB16 + (mt * 16 + lr) * LRU_XS + h * 64 + ks * 32 + lg * 8);
#pragma unroll
        for (int nt = 0; nt < 8; ++nt) { const bf16x8 bw = *(const bf16x8*)(WG16 + ((size_t)(h * 128 + nt * 16 + lr) * 64 + ks * 32 + lg * 8));
#pragma unroll
            for (int mt = 0; mt < 2; ++mt) acc[mt][nt] = __builtin_amdgcn_mfma_f32_16x16x32_bf16(a[mt], bw, acc[mt][nt], 0, 0, 0); }
    }
#pragma unroll
    for (int jt = 0; jt < 4; ++jt) {
        const int cc = h * 64 + jt * 16 + lr;
        const float bav = W.ba[cc], bxv = W.bx[cc]; const float lm = W.lam[cc]; const float sp = (lm > 15.f) ? __expf(-lm) : __logf(1.0f + __expf(-lm));
        float Pin = 1.f, Hin = 0.f;
#pragma unroll
        for (int mt = 0; mt < 2; ++mt) {
            float a[4], uu[4];
#pragma unroll
            for (int r = 0; r < 4; ++r) { const float rg = sigmoidf_(acc[mt][jt][r] + bav), ig = sigmoidf_(acc[mt][4 + jt][r] + bxv); const float la = -8.0f * rg * sp; a[r] = __expf(la);
                const float xcv = bf2f(XB16[(mt * 16 + 4 * lg + r) * LRU_XS + cc]); uu[r] = __builtin_amdgcn_sqrtf(fmaxf(1.0f - a[r] * a[r], 0.f)) * (ig * xcv); }
            float A = a[0], H = uu[0];
#pragma unroll
            for (int r = 1; r < 4; ++r) { H = a[r] * H + uu[r]; A *= a[r]; }
            float Ai = A, Hi = H;
            { const float Ap = __shfl_up(Ai, 16), Hp = __shfl_up(Hi, 16); if (lg >= 1) { Hi = Ai * Hp + Hi; Ai = Ai * Ap; } }
            { const float Ap = __shfl_up(Ai, 32), Hp = __shfl_up(Hi, 32); if (lg >= 2) { Hi = Ai * Hp + Hi; Ai = Ai * Ap; } }
            float Ae = __shfl_up(Ai, 16), He = __shfl_up(Hi, 16); if (lg == 0) { Ae = 1.f; He = 0.f; }
            float hs = Ae * Hin + He, ps = Ae * Pin;
            float h4[4], p4[4];
#pragma unroll
            for (int r = 0; r < 4; ++r) { hs = a[r] * hs + uu[r]; ps *= a[r]; h4[r] = hs; p4[r] = ps; }
            { const size_t o = (((size_t)b * NLCH + ch) * 512 + cc) * LCH + mt * 16 + 4 * lg;
              u32x2 hw, pw; hw.x = cvt_pk_bf16(h4[0], h4[1]); hw.y = cvt_pk_bf16(h4[2], h4[3]); pw.x = cvt_pk_bf16(p4[0], p4[1]); pw.y = cvt_pk_bf16(p4[2], p4[3]);
              *(u32x2*)(HL + o) = hw; *(u32x2*)(PL + o) = pw; }
            const float At = __shfl(Ai, 48 + lr), Ht = __shfl(Hi, 48 + lr);
            Hin = At * Hin + Ht; Pin = At * Pin;
        }
        if (lg == 0) { AGA[((size_t)b * NLCH + ch) * 512 + cc] = Pin; AGH[((size_t)b * NLCH + ch) * 512 + cc] = Hin; }
    }
}
__device__ __forceinline__ void lru_carry_unit(const int wv, int b, const float* AGA, float* AGH) {
    const int c = opaque_tid(wv); float carry = 0.f;
    for (int c0 = 0; c0 < NLCH; c0 += 16) {
        float a[16], hh[16];
#pragma unroll
        for (int i = 0; i < 16; ++i) { const size_t o = ((size_t)b * NLCH + c0 + i) * 512 + c; a[i] = AGA[o]; hh[i] = AGH[o]; }
#pragma unroll
        for (int i = 0; i < 16; ++i) { const size_t o = ((size_t)b * NLCH + c0 + i) * 512 + c; AGH[o] = carry; carry = a[i] * carry + hh[i]; }
    }
}
__device__ __forceinline__ void lru2_unit(const int wv, unsigned char* lds, int u, const bf16_t* HIN, const float* gain, const float* CAR, const bf16_t* HL, const bf16_t* PL, bf16_t* MIX) {
    float* XS = (float*)(lds + LRU_LDS_X);
    constexpr int XP = 516;
    const int ch = u % NLCH, b = u / NLCH;
    const int c = opaque_tid(wv);
    const size_t t0 = (size_t)b * SEQ + ch * LCH;
    const float carry = CAR[((size_t)b * NLCH + ch) * 512 + c];
    u32x4 hq[LCH / 8], pq[LCH / 8];
    { const u32x4* hp = (const u32x4*)(HL + (((size_t)b * NLCH + ch) * 512 + c) * LCH); const u32x4* pp = (const u32x4*)(PL + (((size_t)b * NLCH + ch) * 512 + c) * LCH);
#pragma unroll
      for (int q = 0; q < LCH / 8; ++q) { hq[q] = hp[q]; pq[q] = pp[q]; } }
    const int tb = c >> 4, cg = (c & 15) * 32;
    u32x4 gq[4]; float4 gn[8];
    { const u32x4* gp = (const u32x4*)(HIN + (t0 + tb) * IN_COLS + C_LG + cg);
#pragma unroll
      for (int q = 0; q < 4; ++q) gq[q] = gp[q];
#pragma unroll
      for (int q = 0; q < 8; ++q) gn[q] = *(const float4*)(gain + cg + 4 * q); }
    __syncthreads();
#pragma unroll
    for (int q = 0; q < LCH / 8; ++q) { const u32x4 h = hq[q], p = pq[q];
        XS[(8 * q + 0) * XP + c] = bflo(h.x) + bflo(p.x) * carry; XS[(8 * q + 1) * XP + c] = bfhi(h.x) + bfhi(p.x) * carry; XS[(8 * q + 2) * XP + c] = bflo(h.y) + bflo(p.y) * carry; XS[(8 * q + 3) * XP + c] = bfhi(h.y) + bfhi(p.y) * carry;
        XS[(8 * q + 4) * XP + c] = bflo(h.z) + bflo(p.z) * carry; XS[(8 * q + 5) * XP + c] = bfhi(h.z) + bfhi(p.z) * carry; XS[(8 * q + 6) * XP + c] = bflo(h.w) + bflo(p.w) * carry; XS[(8 * q + 7) * XP + c] = bfhi(h.w) + bfhi(p.w) * carry; }
    __syncthreads();
    float hv[32]; float q2 = 0.f;
#pragma unroll
    for (int q = 0; q < 8; ++q) { const float4 x = *(const float4*)(XS + tb * XP + cg + 4 * q); hv[4 * q] = x.x; hv[4 * q + 1] = x.y; hv[4 * q + 2] = x.z; hv[4 * q + 3] = x.w; q2 += (x.x * x.x + x.y * x.y) + (x.z * x.z + x.w * x.w); }
    q2 += __shfl_xor(q2, 1); q2 += __shfl_xor(q2, 2); q2 += __shfl_xor(q2, 4); q2 += __shfl_xor(q2, 8);
    const float rinv = rsqf_(q2 * (1.0f / 512.f) + 1e-6f);
    bf16_t* op = MIX + (t0 + tb) * D + 1536 + cg;
#pragma unroll
    for (int q = 0; q < 4; ++q) { const u32x4 g = gq[q]; const float4 n0 = gn[2 * q], n1 = gn[2 * q + 1]; u32x4 o;
        o.x = cvt_pk_bf16(hv[8 * q + 0] * rinv * n0.x * gelu_tanh(bflo(g.x)), hv[8 * q + 1] * rinv * n0.y * gelu_tanh(bfhi(g.x)));
        o.y = cvt_pk_bf16(hv[8 * q + 2] * rinv * n0.z * gelu_tanh(bflo(g.y)), hv[8 * q + 3] * rinv * n0.w * gelu_tanh(bfhi(g.y)));
        o.z = cvt_pk_bf16(hv[8 * q + 4] * rinv * n1.x * gelu_tanh(bflo(g.z)), hv[8 * q + 5] * rinv * n1.y * gelu_tanh(bfhi(g.z)));
        o.w = cvt_pk_bf16(hv[8 * q + 6] * rinv * n1.z * gelu_tanh(bflo(g.w)), hv[8 * q + 7] * rinv * n1.w * gelu_tanh(bfhi(g.w)));
        *(u32x4*)(op + 8 * q) = o; }
}

__device__ __forceinline__ void router_unit(const int wv, unsigned char* lds, int u, const float* X, const float* W, float* LOG) {
    float* xs = (float*)lds; float* ws = xs + 32 * 68;
    const int tid = opaque_tid(wv), tt = tid >> 4, eg = tid & 15; const size_t t0 = (size_t)u * 32;
    float a0 = 0.f, a1 = 0.f, a2 = 0.f, a3 = 0.f;
    for (int k0 = 0; k0 < D; k0 += 64) {
        const float4 xv = *(const float4*)(X + (t0 + (tid >> 4)) * D + k0 + (tid & 15) * 4);
        const float4 wv0 = *(const float4*)(W + (size_t)(k0 + (tid >> 4)) * 64 + (tid & 15) * 4), wv1 = *(const float4*)(W + (size_t)(k0 + 32 + (tid >> 4)) * 64 + (tid & 15) * 4);
        __syncthreads();
        *(float4*)(xs + (tid >> 4) * 68 + (tid & 15) * 4) = xv; *(float4*)(ws + (tid >> 4) * 64 + (tid & 15) * 4) = wv0; *(float4*)(ws + (32 + (tid >> 4)) * 64 + (tid & 15) * 4) = wv1;
        __syncthreads();
#pragma unroll 16
        for (int kk = 0; kk < 64; ++kk) { const float x = xs[tt * 68 + kk]; const float4 wv = *(const float4*)(ws + kk * 64 + eg * 4); a0 += x * wv.x; a1 += x * wv.y; a2 += x * wv.z; a3 += x * wv.w; }
    }
    *(float4*)(LOG + (t0 + tt) * 64 + eg * 4) = make_float4(a0, a1, a2, a3);
}
__device__ __forceinline__ void route_unit(const int wv, unsigned char* lds, int u, const float* LOG, const float* rbias, int* TKIDX, float* TKGATE, int* CNT) {
    int* hist = (int*)lds;
    const int tid = opaque_tid(wv);
    __syncthreads();
    if (tid < 64) hist[tid] = 0;
    __syncthreads();
    if (tid < RCHUNK) {
        const size_t t = (size_t)u * RCHUNK + tid;
        float sc[64], sel[64];
#pragma unroll
        for (int i = 0; i < 16; ++i) { const float4 va = *(const float4*)(LOG + t * 64 + 4 * i), vb = *(const float4*)(LOG + ((size_t)T + t) * 64 + 4 * i); const float4 v = make_float4(va.x + vb.x, va.y + vb.y, va.z + vb.z, va.w + vb.w);     sc[4 * i] = sigmoidf_(v.x); sc[4 * i + 1] = sigmoidf_(v.y); sc[4 * i + 2] = sigmoidf_(v.z); sc[4 * i + 3] = sigmoidf_(v.w); }
#pragma unroll
        for (int e = 0; e < 64; ++e) sel[e] = sc[e] + rbias[e];
        float gs[8];
#pragma unroll
        for (int g = 0; g < 8; ++g) { float m1 = -3.0e38f, m2 = -3.0e38f;
#pragma unroll
            for (int j = 0; j < 8; ++j) { const float v = sel[8 * g + j]; const float lo = fminf(m1, v); m1 = fmaxf(m1, v); m2 = fmaxf(m2, lo); }
            gs[g] = m1 + m2; }
#pragma unroll
        for (int g = 0; g < 8; ++g) { int rank = 0;
#pragma unroll
            for (int g2 = 0; g2 < 8; ++g2) rank += (gs[g2] > gs[g] || (gs[g2] == gs[g] && g2 < g)) ? 1 : 0;
            if (rank >= 4) {
#pragma unroll
                for (int j = 0; j < 8; ++j) sel[8 * g + j] = -1e30f; } }
        int idx[TOPK]; float wsel[TOPK]; float wsum = 0.f;
#pragma unroll
        for (int k = 0; k < TOPK; ++k) { float best = sel[0]; int bi = 0; float bs = sc[0];
#pragma unroll
            for (int e = 1; e < 64; ++e) { const bool gt = sel[e] > best; best = gt ? sel[e] : best; bi = gt ? e : bi; bs = gt ? sc[e] : bs; }
#pragma unroll
            for (int e = 0; e < 64; ++e) sel[e] = (e == bi) ? -3.0e38f : sel[e];
            idx[k] = bi; wsel[k] = bs; wsum += bs; }
        const float inv = 2.5f / wsum;
        int4 i0 = make_int4(idx[0], idx[1], idx[2], idx[3]), i1 = make_int4(idx[4], idx[5], idx[6], idx[7]);
        *(int4*)(TKIDX + t * TOPK) = i0; *(int4*)(TKIDX + t * TOPK + 4) = i1;
        *(float4*)(TKGATE + t * TOPK) = make_float4(wsel[0] * inv, wsel[1] * inv, wsel[2] * inv, wsel[3] * inv); *(float4*)(TKGATE + t * TOPK + 4) = make_float4(wsel[4] * inv, wsel[5] * inv, wsel[6] * inv, wsel[7] * inv);
#pragma unroll
        for (int k = 0; k < TOPK; ++k) atomicAdd(&hist[idx[k]], 1);
    }
    __syncthreads();
    if (tid < 64) CNT[u * 64 + tid] = hist[tid];
}
__device__ __forceinline__ void assign_unit(const int wv, unsigned char* lds, int chunk, const int* CNT, const int* TKIDX, const float* TKGATE, int* ROWTOK, int* ROWDST, float* ROWGATE, int* TILEE) {
    int* total = (int*)lds; int* mybase = total + 64; int* off = mybase + 64; unsigned* mask = (unsigned*)(off + 80); int* part = (int*)(mask + 256);
    const int tid = opaque_tid(wv);
    __syncthreads();
    if (tid < 256) mask[tid] = 0u;
    { const int e = tid & 63, pt = tid >> 6; int tot = 0, base = 0;
#pragma unroll 8
      for (int cc = pt * (NRCHUNK / 8); cc < (pt + 1) * (NRCHUNK / 8); ++cc) { const int v = CNT[cc * 64 + e]; tot += v; if (cc < chunk) base += v; }
      part[pt * 64 + e] = tot; part[512 + pt * 64 + e] = base; }
    __syncthreads();
    if (tid < 64) { int tot = 0, base = 0;
#pragma unroll
        for (int pt = 0; pt < 8; ++pt) { tot += part[pt * 64 + tid]; base += part[512 + pt * 64 + tid]; } total[tid] = tot; mybase[tid] = base; }
    __syncthreads();
    if (tid == 0) { int o = 0; for (int e = 0; e < 64; ++e) { off[e] = o; o += ((total[e] + 255) / 256) * 256; } off[64] = o; }
    __syncthreads();
    int e_[2]; int tt_[2], k_[2];
#pragma unroll
    for (int r = 0; r < 2; ++r) { const int p = tid + 512 * r; tt_[r] = p >> 3; k_[r] = p & 7; e_[r] = TKIDX[((size_t)chunk * RCHUNK + tt_[r]) * TOPK + k_[r]]; atomicOr(&mask[e_[r] * 4 + (tt_[r] >> 5)], 1u << (tt_[r] & 31)); }
    __syncthreads();
#pragma unroll
    for (int r = 0; r < 2; ++r) { const int e = e_[r], tt = tt_[r]; int rank = 0;
        for (int wd = 0; wd < (tt >> 5); ++wd) rank += __builtin_popcount(mask[e * 4 + wd]);
        rank += __builtin_popcount(mask[e * 4 + (tt >> 5)] & ((1u << (tt & 31)) - 1u));
        const int slot = off[e] + mybase[e] + rank; const int t = chunk * RCHUNK + tt;
        ROWTOK[slot] = t; ROWDST[slot] = t * TOPK + k_[r]; ROWGATE[slot] = TKGATE[(size_t)t * TOPK + k_[r]]; }
    if (chunk < 64) { const int e = chunk; const int lo = off[e] + total[e], hi = off[e + 1]; for (int s = lo + tid; s < hi; s += NTHR) { ROWTOK[s] = -1; ROWDST[s] = -1; ROWGATE[s] = 0.f; } }
    for (int t = chunk * RCHUNK + tid; t < (chunk + 1) * RCHUNK; t += NTHR) { ROWDST[A_PAD + t] = T * TOPK + t; ROWGATE[A_PAD + t] = 1.0f; }
    if (chunk == 0) { const int e = tid >> 3; for (int i = off[e] / 256 + (tid & 7); i < off[e + 1] / 256; i += 8) TILEE[i] = e; if (tid == 0) TILEE[MAXTILES] = off[64] / 256; }
}
#ifndef Y8_FIRST_LAYER
#define Y8_FIRST_LAYER 0
#endif
#ifndef DOWN_STAG
#define DOWN_STAG 0
#endif
#ifndef F8DN_FIRST_LAYER
#define F8DN_FIRST_LAYER 0
#endif
#ifndef F8_FIRST_LAYER
#define F8_FIRST_LAYER 0
#endif
constexpr int PH_PER_LAYER = 14, NPHASE = DEPTH * PH_PER_LAYER;
struct Args { const void* in[32]; float* out; unsigned char* ws; RotTab rt; int ph_lo, ph_hi, sub, pad; };
static_assert(sizeof(Args) == 32 * 8 + 8 + 8 + 64 + 16, "Args has no padding");

template <int l, int SUB>
__device__ __forceinline__ void layer_program(const int wv, const Args& args, unsigned char* lds, unsigned char* ws, float* out, const XcdBarrier& bar, const int lo, const int hi) {
    constexpr int pb = l * PH_PER_LAYER;
    constexpr bool Y8 = (l >= Y8_FIRST_LAYER);
    constexpr bool F8DN = (l >= F8DN_FIRST_LAYER);
    constexpr bool F8 = (l >= F8_FIRST_LAYER);
    if (hi <= pb || lo >= pb + PH_PER_LAYER) return;
    LAS unsigned char* ldsL = (LAS unsigned char*)lds;
    const int G = gridDim.x, bid = blockIdx.x;
    const int NGW = G * NWAVES;
    LAS int* ulist = (LAS int*)(ldsL + ULIST_OFF);
#ifndef PHMASK
#define PHMASK 0x3fff
#endif
#define IN(k) (lo <= (k) && (k) < hi && ((PHMASK >> ((k) % PH_PER_LAYER)) & 1))
#define SEAM(k) do { if (!MK_PER_PHASE && IN(k) && IN((k) + 1)) xcd_barrier(bar); } while (0)
#define TIDS() const int tid = opaque_tid(wv), lane = tid & 63, wave = wv, gw = bid * NWAVES + wave; (void)lane; (void)gw
        if (IN(pb + 0)) {
            TIDS();
            WPtrs P; P.w_in = (const float*)args.in[3] + (size_t)l * D * IN_COLS; P.w_out = (const float*)args.in[4] + (size_t)l * D * D; P.gate = (const float*)args.in[28] + (size_t)l * D * D;
            P.plew = (const float*)args.in[27] + (size_t)l * PLE * D; P.ew1 = (const float*)args.in[21] + (size_t)l * NE * D * EF; P.ew3 = (const float*)args.in[22] + (size_t)l * NE * D * EF;
            P.ew2 = (const float*)args.in[23] + (size_t)l * NE * EF * D; P.sw1 = (const float*)args.in[24] + (size_t)l * D * EF; P.sw3 = (const float*)args.in[25] + (size_t)l * D * EF; P.sw2 = (const float*)args.in[26] + (size_t)l * EF * D; P.rw = (const float*)args.in[19] + (size_t)l * D * NE; P.lwa = (const float*)args.in[11] + (size_t)l * 32768; P.lwx = (const float*)args.in[13] + (size_t)l * 32768; P.lru_wg = (bf16_t*)(ws + WS_LRUW);
            convert_weights<F8, F8DN>(lds, P, ws + WS_W, gw, NGW, wave, lane);
            convert_rows((const float*)args.in[1] + (size_t)l * T * PLE, (bf16_t*)(ws + WS_PB), (size_t)T * PLE, (size_t)bid * NTHR + tid, (size_t)G * NTHR);
            if (l == 0) convert_rows((const float*)args.in[0], (bf16_t*)(ws + WS_XB), (size_t)T * D, (size_t)bid * NTHR + tid, (size_t)G * NTHR);
        }
        SEAM(pb + 0);
        if (IN(pb + 1)) {
            pg8::DenseOrder S; S.init(T, IN_COLS, G, bid, 0);
            const pg8::ListOrder L = pg8::build_list(wv, ulist, ULIST_CAP, S);
            pg8::EpiStoreBf16L E{(bf16_t*)(ws + WS_HIN), ldsL + ((wv >> 2) ? TAB_OFF : 3 * pg8::HTB), IN_COLS};
            pg8::gemm_phase<D, pg8::EpiStoreBf16L, pg8::ListOrder, false>(wv, ldsL, (const bf16_t*)(ws + WS_XB), (const bf16_t*)(ws + WS_W + WO_WIN), L, E, nullptr);
        }
        SEAM(pb + 1);
        if (IN(pb + 2)) {
            const bf16_t* HIN = (const bf16_t*)(ws + WS_HIN); bf16_t* MIX = (bf16_t*)(ws + WS_MIX);
            if (!(SUB & 1)) for (int u = bid; u < 512; u += G) attn_unit(wv, lds, u, HIN, (const int*)args.in[2], (const float*)args.in[5] + l * 16, MIX, (float*)(ws + WS_SSQ), args.rt);
            LruW W; W.conv_w = (const float*)args.in[9] + l * 2048; W.conv_b = (const float*)args.in[10] + l * 512; W.wa = (const float*)args.in[11] + (size_t)l * 32768; W.ba = (const float*)args.in[12] + l * 512;
            W.wx = (const float*)args.in[13] + (size_t)l * 32768; W.bx = (const float*)args.in[14] + l * 512; W.lam = (const float*)args.in[15] + l * 512; W.gain = (const float*)args.in[16] + l * 512;
            if (!(SUB & 2)) for (int u = bid; u < BATCH * NLCH; u += G) lru1_unit(wv, lds, u, HIN, W, (const bf16_t*)(ws + WS_LRUW), (float*)(ws + WS_LRUA), (float*)(ws + WS_LRUH), (bf16_t*)(ws + WS_LRUHL), (bf16_t*)(ws + WS_LRUPL));
            if (!(SUB & 4)) for (int u = bid; u < 2048; u += G) hg1_unit(wv, lds, u, HIN, (const float*)args.in[7], l, (bf16_t*)(ws + WS_SST), (float*)(ws + WS_DV), (u + G < 2048) ? u + G : -1);
        }
        SEAM(pb + 2);
        if (IN(pb + 3)) {
            TIDS();
            const bf16_t* HIN = (const bf16_t*)(ws + WS_HIN); bf16_t* MIX = (bf16_t*)(ws + WS_MIX);
            if (!(SUB & 1)) for (int t = 4 * gw; t < T; t += 4 * NGW) attn_fin_rows4(MIX, (const float*)(ws + WS_SSQ), (const float*)args.in[6] + l * 1024, t, lane);
            if (!(SUB & 2)) for (int u = bid; u < 256; u += G) hg2_unit(wv, u, (const bf16_t*)(ws + WS_SST), (const float*)(ws + WS_DV), (bf16_t*)(ws + WS_SPREV));
            if (!(SUB & 4)) for (int u = bid; u < BATCH; u += G) lru_carry_unit(wv, u, (const float*)(ws + WS_LRUA), (float*)(ws + WS_LRUH));
        }
        SEAM(pb + 3);
        if (IN(pb + 4)) {
            if (!(SUB & 1)) for (int u = bid; u < BATCH * NLCH; u += G) lru2_unit(wv, lds, u, (const bf16_t*)(ws + WS_HIN), (const float*)args.in[16] + l * 512, (const float*)(ws + WS_LRUH), (const bf16_t*)(ws + WS_LRUHL), (const bf16_t*)(ws + WS_LRUPL), (bf16_t*)(ws + WS_MIX));
            if (!(SUB & 2))
            for (int u = bid; u < 2048; u += G) hg3_unit(wv, lds, u, (const bf16_t*)(ws + WS_HIN), (const float*)args.in[7], l, (const bf16_t*)(ws + WS_SPREV), (const float*)args.in[8] + l * 512, (bf16_t*)(ws + WS_MIX), (u + G < 2048) ? u + G : -1);
        }
        SEAM(pb + 4);
        if (IN(pb + 5)) {
            pg8::DenseOrder S; S.init(T, D, G, bid, 0);
            const pg8::ListOrder L = pg8::build_list(wv, ulist, ULIST_CAP, S);
            pg8::EpiStoreBf16L E{(bf16_t*)(ws + WS_HIN), ldsL + ((wv >> 2) ? TAB_OFF : 3 * pg8::HTB), D};
            pg8::gemm_phase<D, pg8::EpiStoreBf16L, pg8::ListOrder, false>(wv, ldsL, (const bf16_t*)(ws + WS_MIX), (const bf16_t*)(ws + WS_W + WO_WOUT), L, E, nullptr);
        }
        SEAM(pb + 5);
        if (IN(pb + 6)) {
            TIDS();
            const float* g1 = (const float*)args.in[17] + l * D; const float* b1 = (const float*)args.in[18] + l * D; bf16_t* XB = (bf16_t*)(ws + WS_XB); const bf16_t* ZB = (const bf16_t*)(ws + WS_HIN);
            unsigned char* X8 = (unsigned char*)(ws + WS_MIX);
            for (int t = 2 * gw; t < T; t += 2 * NGW) ln1_rows2(ZB + (size_t)t * D, ZB + (size_t)(t + 1) * D, g1, b1, XB + (size_t)t * D, XB + (size_t)(t + 1) * D, lane, F8 ? X8 + (size_t)t * D : nullptr, F8 ? X8 + (size_t)(t + 1) * D : nullptr);
        }
        SEAM(pb + 6);
        if (IN(pb + 7)) {
            if (!(SUB & 1)) { pg8::DenseOrder S; S.init(T, D, G, bid, 0);
              const pg8::ListOrder L = pg8::build_list(wv, ulist, ULIST_CAP, S);
              if constexpr (Y8) { pg8::EpiStore8L E{(unsigned char*)(ws + WS_U), ldsL + ((wv >> 2) ? TAB_OFF : 3 * pg8::HTB), D};
                pg8::gemm_phase<PLE, pg8::EpiStore8L, pg8::ListOrder, false>(wv, ldsL, (const bf16_t*)(ws + WS_PB), (const bf16_t*)(ws + WS_W + WO_PLEW), L, E, nullptr); }
              else { pg8::EpiStoreBf16 E{(bf16_t*)(ws + WS_U), D, 0};
                pg8::gemm_phase<PLE, pg8::EpiStoreBf16, pg8::ListOrder, false>(wv, ldsL, (const bf16_t*)(ws + WS_PB), (const bf16_t*)(ws + WS_W + WO_PLEW), L, E, nullptr); } }
            if (!(SUB & 2)) { pg8::RouterSplitOrder S; S.init(G, bid);
              const pg8::ListOrder L = pg8::build_list(wv, ulist, ULIST_CAP, S);
              pg8::EpiRouter E{(float*)(ws + WS_LOGITS)};
              pg8::gemm_phase<D / 2, pg8::EpiRouter, pg8::ListOrder, false, 0, false, 0, D>(wv, ldsL, (const bf16_t*)(ws + WS_XB), (const bf16_t*)(ws + WS_W + WO_ROUT), L, E, nullptr); }
        }
        SEAM(pb + 7);
        if (IN(pb + 8)) {
            for (int u = bid; u < NRCHUNK; u += G) route_unit(wv, lds, u, (const float*)(ws + WS_LOGITS), (const float*)args.in[20] + l * 64, (int*)(ws + WS_TKIDX), (float*)(ws + WS_TKGATE), (int*)(ws + WS_CNT));
        }
        SEAM(pb + 8);
        if (IN(pb + 9)) {
            for (int u = bid; u < NRCHUNK; u += G) assign_unit(wv, lds, u, (const int*)(ws + WS_CNT), (const int*)(ws + WS_TKIDX), (const float*)(ws + WS_TKGATE), (int*)(ws + WS_ROWTOK), (int*)(ws + WS_ROWDST), (float*)(ws + WS_ROWGATE), (int*)(ws + WS_TILEE));
        }
        SEAM(pb + 9);
        if (IN(pb + 10)) {
            TIDS();
            const int* TILEE = (const int*)(ws + WS_TILEE); const int* ROWTOK = (const int*)(ws + WS_ROWTOK);
            const int ntiles = TILEE[MAXTILES];
            pg8::UpOrder S2; S2.init(TILEE, ntiles, G, bid, 0);
            const pg8::ListOrder L2 = pg8::build_list(wv, ulist, TAB_BYTES / 1024, S2);
            LAS int* gtab = (LAS int*)(ldsL + TAB_OFF);
            for (int e0 = tid; e0 < L2.n * 256; e0 += 4 * NTHR) { int rr[4];
#pragma unroll
                for (int q = 0; q < 4; ++q) { const int e = e0 + q * NTHR; rr[q] = 0;
                    if (e < L2.n * 256) { const int orow = ulist[(e >> 8) * 4 + 2], tr = e & 255; if (orow < A_PAD) { const int r = ROWTOK[orow + tr]; rr[q] = r < 0 ? 0 : r; } else rr[q] = orow - A_PAD + tr; } }
#pragma unroll
                for (int q = 0; q < 4; ++q) { const int e = e0 + q * NTHR; if (e < L2.n * 256) gtab[e] = rr[q]; } }
            __syncthreads();
            if constexpr (F8 && F8DN) { pg8::EpiSwiglu8 E2{(unsigned char*)(ws + WS_HM)};
                pg8::gemm_phase<D, pg8::EpiSwiglu8, pg8::ListOrder, true, (SUB >> 3) & 3, true>(wv, ldsL, (const bf16_t*)(ws + WS_MIX), (const bf16_t*)(ws + WS_W + WO_W13), L2, E2, gtab); }
            else if constexpr (F8) { pg8::EpiSwiglu E2{(bf16_t*)(ws + WS_HM)};
                pg8::gemm_phase<D, pg8::EpiSwiglu, pg8::ListOrder, true, 0, true>(wv, ldsL, (const bf16_t*)(ws + WS_MIX), (const bf16_t*)(ws + WS_W + WO_W13), L2, E2, gtab); }
            else { pg8::EpiSwiglu E2{(bf16_t*)(ws + WS_HM)};
                pg8::gemm_phase<D, pg8::EpiSwiglu, pg8::ListOrder, true>(wv, ldsL, (const bf16_t*)(ws + WS_XB), (const bf16_t*)(ws + WS_W + WO_W13), L2, E2, gtab); }
            if (!(SUB & 4)) { pg8::DenseOrder S; S.init(T, D, G, bid, 0);
              const pg8::ListOrder L = pg8::build_list(wv, ulist, ULIST_CAP, S);
              if constexpr (F8 && Y8) { pg8::EpiGate8 E{(unsigned char*)(ws + WS_U), (const float*)args.in[29] + l * D};
                pg8::gemm_phase<D, pg8::EpiGate8, pg8::ListOrder, false, 0, true>(wv, ldsL, (const bf16_t*)(ws + WS_MIX), (const bf16_t*)(ws + WS_W + WO_GATE), L, E, nullptr); }
              else { pg8::EpiGate E{(bf16_t*)(ws + WS_U), (const float*)args.in[29] + l * D};
                if constexpr (F8) pg8::gemm_phase<D, pg8::EpiGate, pg8::ListOrder, false, 0, true>(wv, ldsL, (const bf16_t*)(ws + WS_MIX), (const bf16_t*)(ws + WS_W + WO_GATE), L, E, nullptr);
                else pg8::gemm_phase<D, pg8::EpiGate, pg8::ListOrder, false>(wv, ldsL, (const bf16_t*)(ws + WS_XB), (const bf16_t*)(ws + WS_W + WO_GATE), L, E, nullptr); } }
        }
        SEAM(pb + 10);
        if (IN(pb + 11)) {
            if (SUB & 2) return;
            const int* TILEE = (const int*)(ws + WS_TILEE);
            const int ntiles = TILEE[MAXTILES];
            pg8::DownOrder2 S3; S3.init(TILEE, ntiles, G, bid);
            const pg8::ListOrder L3 = pg8::build_list(wv, ulist, ULIST_CAP, S3);
            if constexpr (Y8 && F8DN) { pg8::EpiScatter8L E3{(unsigned char*)(ws + WS_Y), (const int*)(ws + WS_ROWDST), (const float*)(ws + WS_ROWGATE), ldsL + ((wv >> 2) ? TAB_OFF : 3 * pg8::HTB)};
                pg8::gemm_phase<EF, pg8::EpiScatter8L, pg8::ListOrder, false, (SUB >> 3) & 3, true, DOWN_STAG>(wv, ldsL, (const bf16_t*)(ws + WS_HM), (const bf16_t*)(ws + WS_W + WO_W2), L3, E3, nullptr); }
            else if constexpr (Y8) { pg8::EpiScatter8 E3{(unsigned char*)(ws + WS_Y), (const int*)(ws + WS_ROWDST), (const float*)(ws + WS_ROWGATE)};
                pg8::gemm_phase<EF, pg8::EpiScatter8, pg8::ListOrder, false, (SUB >> 3) & 3, F8DN, DOWN_STAG>(wv, ldsL, (const bf16_t*)(ws + WS_HM), (const bf16_t*)(ws + WS_W + WO_W2), L3, E3, nullptr); }
            else { pg8::EpiScatter2 E3{(bf16_t*)(ws + WS_Y), (bf16_t*)(ws + WS_W + WO_W13), (const int*)(ws + WS_ROWDST), (const float*)(ws + WS_ROWGATE)};
                pg8::gemm_phase<EF, pg8::EpiScatter2, pg8::ListOrder, false, (SUB >> 3) & 3, F8DN, DOWN_STAG>(wv, ldsL, (const bf16_t*)(ws + WS_HM), (const bf16_t*)(ws + WS_W + WO_W2), L3, E3, nullptr); }
        }
        SEAM(pb + 11);
        if (IN(pb + 13)) {
            TIDS();
            const float* g2 = (const float*)args.in[30] + l * D; const float* b2 = (const float*)args.in[31] + l * D; bf16_t* XB = (bf16_t*)(ws + WS_XB); const bf16_t* Y = (const bf16_t*)(ws + WS_Y);
            if constexpr (Y8) { for (int t = gw; t < T; t += NGW) ln2_row8(XB + (size_t)t * D, g2, b2, (l == DEPTH - 1) ? out + (size_t)t * D : nullptr, (l == DEPTH - 1) ? nullptr : XB + (size_t)t * D, (const unsigned char*)(ws + WS_Y) + (size_t)t * TOPK * D, (const unsigned char*)(ws + WS_U) + (size_t)t * D, (const unsigned char*)(ws + WS_Y) + ((size_t)T * TOPK + t) * D, lane); }
            else { for (int t = gw; t < T; t += NGW) ln2_row(XB + (size_t)t * D, g2, b2, (l == DEPTH - 1) ? out + (size_t)t * D : nullptr, (l == DEPTH - 1) ? nullptr : XB + (size_t)t * D, Y + (size_t)t * TOPK * D, (const bf16_t*)(ws + WS_U) + (size_t)t * D, (const bf16_t*)(ws + WS_W + WO_W13) + (size_t)t * D, lane); }
        }

#undef TIDS
#undef IN
#undef SEAM
}

template <int SUB>
__global__ void __launch_bounds__(NTHR, 2) mega_fwd(Args args) {
    extern __shared__ __attribute__((aligned(16))) unsigned char lds[];
    LAS unsigned char* ldsL = (LAS unsigned char*)lds;
    volatile LAS unsigned* MISC = (volatile LAS unsigned*)(ldsL + MISC_OFF);
    unsigned char* ws = args.ws; float* out = args.out;
    if (threadIdx.x < 32) MISC[threadIdx.x] = 0u;
    __syncthreads();
    XcdBarrier bar; bar.bar = (unsigned*)(ws + WS_CTL) + CW_BAR; bar.x = 0; bar.st = nullptr; bar.w0 = 0;
    if (!MK_PER_PHASE) bar = xcd_barrier_post((unsigned*)(ws + WS_CTL) + CW_BAR, MISC + 8);
    const int lo = args.ph_lo, hi = args.ph_hi;
    const int wv = __builtin_amdgcn_readfirstlane(threadIdx.x >> 6);
    layer_program<0, SUB>(wv, args, lds, ws, out, bar, lo, hi);
    if (!MK_PER_PHASE && lo <= PH_PER_LAYER - 1 && hi > PH_PER_LAYER) xcd_barrier(bar);
    layer_program<1, SUB>(wv, args, lds, ws, out, bar, lo, hi);
}

extern "C" void kernel_launch(void* const* d_in, const int* in_sizes, int n_in, void* d_out, int out_size, void* d_ws, size_t ws_size, hipStream_t stream) {
    static int grid = 0;
    if (grid == 0) {
        if (n_in != 32 || out_size != T * D || ws_size < WS_END) { fprintf(stderr, "kernel_launch: unexpected sizes n_in %d out %d ws %zu (need %zu); nothing launched\n", n_in, out_size, ws_size, (size_t)WS_END); grid = -1; return; }
        int dev = 0, cus = 0, per_cu = 0;
        if (hipGetDevice(&dev) != hipSuccess || hipDeviceGetAttribute(&cus, hipDeviceAttributeMultiprocessorCount, dev) != hipSuccess) { grid = -1; return; }
        if (hipFuncSetAttribute((const void*)mega_fwd<0>, hipFuncAttributeMaxDynamicSharedMemorySize, LDS_BYTES) != hipSuccess) { fprintf(stderr, "kernel_launch: hipFuncSetAttribute failed\n"); grid = -1; return; }
        if (hipOccupancyMaxActiveBlocksPerMultiprocessor(&per_cu, (const void*)mega_fwd<0>, NTHR, LDS_BYTES) != hipSuccess || per_cu < 1) { fprintf(stderr, "kernel_launch: occupancy query reports %d blocks per CU\n", per_cu); }
        (void)hipGetLastError();
        grid = cus;
    }
    if (grid < 0) return;
    if (hipMemsetAsync((char*)d_ws + WS_CTL, 0, CTL_ZERO_BYTES, stream) != hipSuccess) { fprintf(stderr, "kernel_launch: memset failed\n"); return; }
    Args a{};
    for (int i = 0; i < 32; ++i) a.in[i] = d_in[i];
    a.out = (float*)d_out; a.ws = (unsigned char*)d_ws;
    for (int i = 0; i < 8; ++i) a.rt.invf[i] = std::pow(500000.0, -(double)i / 8.0);
#if MK_PER_PHASE
    for (int ph = 0; ph < NPHASE; ++ph) { a.ph_lo = ph; a.ph_hi = ph + 1; hipLaunchKernelGGL(mega_fwd<0>, dim3(grid), dim3(NTHR), LDS_BYTES, stream, a); }
#else
    a.ph_lo = 0; a.ph_hi = NPHASE;
    hipLaunchKernelGGL(mega_fwd<0>, dim3(grid), dim3(NTHR), LDS_BYTES, stream, a);
#endif
#ifdef PROBE_PH
    { static bool once = false; if (!once) { (void)hipFuncSetAttribute((const void*)mega_fwd<PROBE_SUB>, hipFuncAttributeMaxDynamicSharedMemorySize, LDS_BYTES); once = true; }
      const int pl[] = {PROBE_PH}; for (unsigned i = 0; i < sizeof(pl) / sizeof(int); ++i) { a.ph_lo = pl[i]; a.ph_hi = pl[i] + 1; hipLaunchKernelGGL(mega_fwd<PROBE_SUB>, dim3(grid), dim3(NTHR), LDS_BYTES, stream, a); } }
#endif
    const hipError_t le = hipPeekAtLastError();
    if (le != hipSuccess) fprintf(stderr, "kernel_launch: launch failed: %s\n", hipGetErrorName(le));
}
```
